# Optimizing an MI355X kernel written in HIP

```python
import jax, jax.numpy as jnp
from jax import lax
import numpy as np

D_MODEL = 1024
BATCH = 8
SEQ = 2048
DEPTH = 1

HEAD_DIM = 64
DSA_HEADS = 8
DSA_LATENT = 128
IDX_HEADS = 8
IDX_DIM = 32
DSA_TOPK_MAX = 256
NSA_HEADS = 8
NSA_KV_HEADS = 2
NSA_GROUP = NSA_HEADS // NSA_KV_HEADS
CMP_LEN = 32
CMP_STRIDE = 16
CMP_HIDDEN = 128
SLC_LEN = 64
SLC_TOPN = 16
WINDOW = 512
FORCE_BONUS = 1e6
Q_BLOCK = 128
D_FF = 4 * D_MODEL
RMS_EPS = 1e-6
NEG_INF = -1e30

WIDTH_A = DSA_HEADS * HEAD_DIM
WIDTH_B = NSA_HEADS * HEAD_DIM
NSA_KV_W = NSA_KV_HEADS * HEAD_DIM
COL_SIZES = (WIDTH_A, DSA_LATENT, IDX_HEADS * IDX_DIM, IDX_DIM, IDX_HEADS,
             WIDTH_B, 6 * NSA_KV_W, 3 * NSA_HEADS, 2 * D_MODEL)
D_IN = WIDTH_A + DSA_LATENT + IDX_HEADS * IDX_DIM + IDX_DIM + IDX_HEADS + WIDTH_B + 6 * NSA_KV_W + 3 * NSA_HEADS + 2 * D_MODEL

kernel_name = "hybrid_dsa_nsa_gated_block"


def rms_norm(x, g):
    xf = x.astype(jnp.float32)
    y = xf * lax.rsqrt(jnp.mean(xf * xf, axis=-1, keepdims=True) + RMS_EPS)
    return (y * g.astype(jnp.float32)).astype(x.dtype)


def alibi_slopes(n_heads):
    return jnp.asarray(2.0 ** (-8.0 * np.arange(1, n_heads + 1) / n_heads), dtype=jnp.float32)


def masked_softmax(s, valid):
    p = jax.nn.softmax(jnp.where(valid, s, NEG_INF), axis=-1)
    return jnp.where(valid, p, 0.0)


def split_cols(a, sizes):
    out, start = [], 0
    for n in sizes:
        out.append(a[..., start:start + n])
        start += n
    return out


def to_blocks(a, nb):
    return a.reshape((a.shape[0], nb, Q_BLOCK) + a.shape[2:]).swapaxes(0, 1)


def from_blocks(a):
    a = a.swapaxes(0, 1)
    return a.reshape((a.shape[0], a.shape[1] * a.shape[2]) + a.shape[3:])


def dsa_mixer(q, c_kv, q_idx, k_idx, w_idx, g_q, g_k, g_lat, w_uk, w_uv):
    B, S = q.shape[0], q.shape[1]
    nb = S // Q_BLOCK
    topk = min(DSA_TOPK_MAX, S // 4)
    c = rms_norm(c_kv, g_lat)
    k = rms_norm(c @ w_uk, g_k)
    v = c @ w_uv
    q = rms_norm(q, g_q)
    w_idx = w_idx * (IDX_HEADS ** -0.5 * IDX_DIM ** -0.5)
    slopes = alibi_slopes(DSA_HEADS)
    bi = jnp.arange(B)[:, None, None]
    s_pos = jnp.arange(S)

    def block(args):
        qb, qib, wb, start = args
        t = start + jnp.arange(Q_BLOCK)
        logits = jnp.einsum('bthd,bsd->bths', qib, k_idx).astype(jnp.float32)
        score = jnp.einsum('bths,bth->bts', jax.nn.relu(logits), wb.astype(jnp.float32))
        score = jnp.where((s_pos[None, :] <= t[:, None])[None], score, -jnp.inf)
        _, idx = lax.top_k(score, topk)
        ks = k[bi, idx]
        vs = v[bi, idx]
        dist = (t[None, :, None] - idx).astype(jnp.float32)
        s = jnp.einsum('bthd,btkd->bthk', qb, ks).astype(jnp.float32) * (HEAD_DIM ** -0.5)
        s = s - slopes[None, None, :, None] * dist[:, :, None, :]
        p = masked_softmax(s, (dist >= 0)[:, :, None, :])
        return jnp.einsum('bthk,btkd->bthd', p.astype(vs.dtype), vs)

    starts = jnp.arange(nb, dtype=jnp.int32) * Q_BLOCK
    out = lax.map(block, (to_blocks(q, nb), to_blocks(q_idx, nb), to_blocks(w_idx, nb), starts))
    return from_blocks(out).reshape(B, S, WIDTH_A)


def nsa_mixer(q, kv, gates, g_q, g_kc, g_ks, g_kw, pe_cmp, phi_k1, phi_k2, phi_v1, phi_v2):
    B, S = q.shape[0], q.shape[1]
    KH, G, dh = NSA_KV_HEADS, NSA_GROUP, HEAD_DIM
    nb = S // Q_BLOCK
    scale = dh ** -0.5
    q = rms_norm(q.reshape(B, S, KH, G, dh), g_q)
    k_c, v_c, k_s, v_s, k_w, v_w = [a.reshape(B, S, KH, dh) for a in split_cols(kv, (NSA_KV_W,) * 6)]
    k_s = rms_norm(k_s, g_ks)
    k_w = rms_norm(k_w, g_kw)
    slopes = alibi_slopes(NSA_HEADS).reshape(KH, G)
    pos = jnp.arange(S)

    n_cmp = (S - CMP_LEN) // CMP_STRIDE + 1
    cmp_start = jnp.arange(n_cmp) * CMP_STRIDE
    blk_pos = cmp_start[:, None] + jnp.arange(CMP_LEN)[None, :]

    def compress(a, w1, w2):
        blocks = a[:, blk_pos] + pe_cmp[None, None, :, None, :]
        blocks = blocks.transpose(0, 1, 3, 2, 4).reshape(B, n_cmp, KH, CMP_LEN * dh)
        return jax.nn.gelu(blocks @ w1) @ w2

    kc = rms_norm(compress(k_c, phi_k1, phi_k2), g_kc)
    vc = compress(v_c, phi_v1, phi_v2)
    valid_c = (cmp_start + CMP_LEN - 1)[None, :] <= pos[:, None]
    s_c = jnp.einsum('bsgqd,bcgd->bsgqc', q, kc).astype(jnp.float32) * scale
    p_c = masked_softmax(s_c, valid_c[None, :, None, None, :])
    o_cmp = jnp.einsum('bsgqc,bcgd->bsgqd', p_c.astype(vc.dtype), vc)

    n_slc = S // SLC_LEN
    slc_start = jnp.arange(n_slc) * SLC_LEN
    overlap = ((cmp_start[:, None] < slc_start[None, :] + SLC_LEN)
               & (cmp_start[:, None] + CMP_LEN > slc_start[None, :])).astype(jnp.float32)
    imp = jnp.einsum('bsgqc,cj->bsgj', p_c, overlap)
    cur = pos // SLC_LEN
    blk = jnp.arange(n_slc)
    future = blk[None, :] > cur[:, None]
    forced = (blk[None, :] == 0) | (blk[None, :] == cur[:, None]) | (blk[None, :] == cur[:, None] - 1)
    imp = jnp.where(future[None, :, None, :], -jnp.inf,
                    imp + jnp.where(forced, FORCE_BONUS, 0.0)[None, :, None, :])
    n_top = min(SLC_TOPN, n_slc)
    _, sel = lax.top_k(imp, n_top)

    kb = k_s.reshape(B, n_slc, SLC_LEN, KH, dh).transpose(0, 3, 1, 2, 4)
    vb = v_s.reshape(B, n_slc, SLC_LEN, KH, dh).transpose(0, 3, 1, 2, 4)
    kw_pad = jnp.pad(k_w, ((0, 0), (WINDOW, 0), (0, 0), (0, 0)))
    vw_pad = jnp.pad(v_w, ((0, 0), (WINDOW, 0), (0, 0), (0, 0)))
    bi = jnp.arange(B)[:, None, None, None]
    gi = jnp.arange(KH)[None, None, :, None]
    win_len = WINDOW + Q_BLOCK

    def block(args):
        qb, selb, start = args
        t = start + jnp.arange(Q_BLOCK)
        ks = kb[bi, gi, selb]
        vs = vb[bi, gi, selb]
        kpos = selb[..., None] * SLC_LEN + jnp.arange(SLC_LEN)
        dist = (t[None, :, None, None, None] - kpos).astype(jnp.float32)
        s = jnp.einsum('btgqd,btgnld->btgqnl', qb, ks).astype(jnp.float32) * scale
        s = s - slopes[None, None, :, :, None, None] * dist[:, :, :, None]
        s = s.reshape(B, Q_BLOCK, KH, G, n_top * SLC_LEN)
        valid = (dist >= 0).reshape(B, Q_BLOCK, KH, 1, n_top * SLC_LEN)
        p = masked_softmax(s, valid).reshape(B, Q_BLOCK, KH, G, n_top, SLC_LEN)
        o_slc = jnp.einsum('btgqnl,btgnld->btgqd', p.astype(vs.dtype), vs)
        kw = lax.dynamic_slice_in_dim(kw_pad, start, win_len, axis=1)
        vw = lax.dynamic_slice_in_dim(vw_pad, start, win_len, axis=1)
        wpos = start - WINDOW + jnp.arange(win_len)
        wd = t[:, None] - wpos[None, :]
        wvalid = (wd >= 0) & (wd < WINDOW) & (wpos[None, :] >= 0)
        s_w = jnp.einsum('btgqd,bsgd->btgqs', qb, kw).astype(jnp.float32) * scale
        s_w = s_w - slopes[None, None, :, :, None] * wd.astype(jnp.float32)[None, :, None, None, :]
        p_w = masked_softmax(s_w, wvalid[None, :, None, None, :])
        o_win = jnp.einsum('btgqs,bsgd->btgqd', p_w.astype(vw.dtype), vw)
        return o_slc, o_win

    starts = jnp.arange(nb, dtype=jnp.int32) * Q_BLOCK
    o_slc, o_win = lax.map(block, (to_blocks(q, nb), to_blocks(sel, nb), starts))
    o_slc = from_blocks(o_slc)
    o_win = from_blocks(o_win)
    g = jax.nn.sigmoid(gates.reshape(B, S, KH, G, 3))
    o = g[..., 0:1] * o_cmp + g[..., 1:2] * o_slc + g[..., 2:3] * o_win
    return o.reshape(B, S, WIDTH_B)


def setup_inputs(seed: int = 0) -> dict:
    key = jax.random.key(seed)
    ks = jax.random.split(key, 24)
    f32 = jnp.float32
    L, dh = DEPTH, HEAD_DIM

    def nrm(k, shape, scale):
        return jax.random.normal(k, shape, f32) * scale

    def gain(k, n):
        return 1.0 + 0.05 * jax.random.normal(k, (DEPTH, n), f32)

    return {
        "x": nrm(ks[0], (BATCH, SEQ, D_MODEL), 1.0),
        "g_mix": gain(ks[1], D_MODEL),
        "w_in": nrm(ks[2], (L, D_MODEL, D_IN), D_MODEL ** -0.5),
        "g_q_a": gain(ks[3], dh),
        "g_k_a": gain(ks[4], dh),
        "g_lat_a": gain(ks[5], DSA_LATENT),
        "w_uk_a": nrm(ks[6], (L, DSA_LATENT, dh), DSA_LATENT ** -0.5),
        "w_uv_a": nrm(ks[7], (L, DSA_LATENT, dh), DSA_LATENT ** -0.5),
        "g_q_b": gain(ks[8], dh),
        "g_kc_b": gain(ks[9], dh),
        "g_ks_b": gain(ks[10], dh),
        "g_kw_b": gain(ks[11], dh),
        "pe_cmp_b": nrm(ks[12], (L, CMP_LEN, dh), 0.1),
        "phi_k1_b": nrm(ks[13], (L, CMP_LEN * dh, CMP_HIDDEN), (CMP_LEN * dh) ** -0.5),
        "phi_k2_b": nrm(ks[14], (L, CMP_HIDDEN, dh), CMP_HIDDEN ** -0.5),
        "phi_v1_b": nrm(ks[15], (L, CMP_LEN * dh, CMP_HIDDEN), (CMP_LEN * dh) ** -0.5),
        "phi_v2_b": nrm(ks[16], (L, CMP_HIDDEN, dh), CMP_HIDDEN ** -0.5),
        "w_up_a": nrm(ks[17], (L, WIDTH_A, D_MODEL), WIDTH_A ** -0.5),
        "w_up_b": nrm(ks[18], (L, WIDTH_B, D_MODEL), WIDTH_B ** -0.5),
        "w_out": nrm(ks[19], (L, D_MODEL, D_MODEL), D_MODEL ** -0.5),
        "g_mlp": gain(ks[20], D_MODEL),
        "w_ff1": nrm(ks[21], (L, D_MODEL, D_FF), D_MODEL ** -0.5),
        "w_ff2": nrm(ks[22], (L, D_FF, D_MODEL), D_FF ** -0.5),
    }


def reference(x, g_mix, w_in, g_q_a, g_k_a, g_lat_a, w_uk_a, w_uv_a, g_q_b, g_kc_b, g_ks_b, g_kw_b,
              pe_cmp_b, phi_k1_b, phi_k2_b, phi_v1_b, phi_v2_b, w_up_a, w_up_b, w_out, g_mlp, w_ff1, w_ff2):
    B, S = x.shape[0], x.shape[1]
    for l in range(DEPTH):
        h = rms_norm(x, g_mix[l])
        proj = h @ w_in[l]
        q_a, c_a, qi_a, ki_a, wi_a, q_b, kv_b, gate_b, gate_m = split_cols(proj, COL_SIZES)
        o_a = dsa_mixer(q_a.reshape(B, S, DSA_HEADS, HEAD_DIM), c_a,
                        qi_a.reshape(B, S, IDX_HEADS, IDX_DIM), ki_a, wi_a,
                        g_q_a[l], g_k_a[l], g_lat_a[l], w_uk_a[l], w_uv_a[l])
        o_b = nsa_mixer(q_b, kv_b, gate_b, g_q_b[l], g_kc_b[l], g_ks_b[l], g_kw_b[l],
                        pe_cmp_b[l], phi_k1_b[l], phi_k2_b[l], phi_v1_b[l], phi_v2_b[l])
        gate_a_m, gate_b_m = split_cols(gate_m, (D_MODEL, D_MODEL))
        merged = jax.nn.sigmoid(gate_a_m) * (o_a @ w_up_a[l]) + jax.nn.sigmoid(gate_b_m) * (o_b @ w_up_b[l])
        x = x + merged @ w_out[l]
        h2 = rms_norm(x, g_mlp[l])
        x = x + jnp.square(jax.nn.relu(h2 @ w_ff1[l])) @ w_ff2[l]
    return x
```

```cpp
#include <hip/hip_runtime.h>
#include <cstdio>
#include <cstdint>

namespace pg8 {
#define PG8_LAS __attribute__((address_space(3)))
typedef unsigned short bf16_t;
typedef short bf16x8 __attribute__((ext_vector_type(8)));
typedef float f32x4 __attribute__((ext_vector_type(4)));
typedef unsigned u32x4 __attribute__((ext_vector_type(4)));
typedef unsigned u32x2 __attribute__((ext_vector_type(2)));
constexpr int BM = 256, BK = 64, HALF = 128, HTB = HALF * BK * 2  , STAGE_BYTES = 8 * HTB, NXCD = 8, WGM = 8;

__host__ __device__ __forceinline__ int lds_byte(int r, int c) { const int st = (r >> 4) * 2 + (c >> 5), rr = r & 15, cc = c & 31, ob = rr * 64 + cc * 2; return st * 1024 + (ob ^ (((ob >> 9) & 1) << 5)); }
__host__ __device__ __forceinline__ void stage_rc(int b, int& R, int& C) { const int st = b / 1024, sb = b % 1024, swz = sb ^ (((sb >> 9) & 1) << 5); R = (st >> 1) * 16 + swz / 64; C = (st & 1) * 32 + (swz % 64) / 2; }
__host__ __device__ __forceinline__ int perm32(int rho) { const int n = rho >> 4, i = rho & 15; return 8 * (i >> 2) + 4 * n + (i & 3); }

struct Unit { int pm, pn; };
struct Gemm { const bf16_t* A; const bf16_t* Bt; int M, N, K, lda; };

struct StaticOrder {
    int nM, nN, nwg, G, c;
    __host__ __device__ void init(int M, int N, int G_, int c_) { nM = M / BM; nN = N / BM; nwg = nM * nN; G = G_; c = c_; }
    __host__ __device__ bool next(int i, Unit& u) const {
        const long L = (long)i * G + c; if (L >= nwg) return false;
        int wgid = (int)L; { const int q = nwg / NXCD, r = nwg % NXCD, xcd = wgid % NXCD, off = wgid / NXCD; wgid = (xcd < r ? xcd * (q + 1) : r * (q + 1) + (xcd - r) * q) + off; }
        const int nig = WGM * nN, gid = wgid / nig, fm = gid * WGM, gsz = (nM - fm) < WGM ? (nM - fm) : WGM;
        u.pm = fm + ((wgid % nig) % gsz); u.pn = (wgid % nig) / gsz; return true;
    }
};

__device__ __forceinline__ unsigned cvt_pk_bf16(float lo, float hi) { unsigned r; asm volatile("v_cvt_pk_bf16_f32 %0, %1, %2" : "=v"(r) : "v"(lo), "v"(hi)); return r; }
__device__ __forceinline__ float bflo(unsigned w) { return __uint_as_float(w << 16); }
__device__ __forceinline__ float bfhi(unsigned w) { return __uint_as_float(w & 0xffff0000u); }
__device__ __forceinline__ float sigm(float x) { return 1.0f / (1.0f + __expf(-x)); }

struct EpiStoreBf16 {
    static constexpr bool PERM = true; static constexpr int MIDK = 0;
    bf16_t* O; int ldc;
    __device__ __forceinline__ void operator()(const f32x4 (&acc)[2][2][4][2], const Unit& u, int wr, int wc, int fr, int fq) const {
        const int row0 = u.pm * BM + wr * 64 + fr, col0 = u.pn * BM + wc * 32 + 8 * fq;
#pragma unroll
        for (int ai = 0; ai < 2; ++ai)
#pragma unroll
            for (int m = 0; m < 4; ++m) { bf16_t* rowp = O + (size_t)(row0 + ai * HALF + m * 16) * ldc + col0;
#pragma unroll
                for (int bj = 0; bj < 2; ++bj) { const f32x4 v0 = acc[ai][bj][m][0], v1 = acc[ai][bj][m][1];
                    u32x4 w; w.x = cvt_pk_bf16(v0[0], v0[1]); w.y = cvt_pk_bf16(v0[2], v0[3]); w.z = cvt_pk_bf16(v1[0], v1[1]); w.w = cvt_pk_bf16(v1[2], v1[3]);
                    *(u32x4*)(rowp + bj * HALF) = w; } }
    }
};

struct EpiProj {
    static constexpr bool PERM = true; static constexpr int MIDK = 0;
    bf16_t* O; int ldc; const float *gqa, *gqb, *gks, *gkw; bf16_t* VST; bf16_t* VWT; float qscale, eps; int seq;
    __device__ __forceinline__ void operator()(const f32x4 (&acc)[2][2][4][2], const Unit& u, int wr, int wc, int fr, int fq) const {
        const int f0 = u.pn * BM + wc * 64;
        const float* g = nullptr; float sc = 1.f;
        if (f0 < 512) { g = gqa; sc = qscale; } else if (f0 >= 960 && f0 < 1472) { g = gqb; sc = qscale; } else if (f0 == 1728 || f0 == 1792) { g = gks; } else if (f0 == 1984 || f0 == 2048) { g = gkw; }
        bf16_t* VT = nullptr; int kh = 0;
        if (f0 == 1856 || f0 == 1920) { VT = VST; kh = (f0 - 1856) >> 6; } else if (f0 == 2112 || f0 == 2176) { VT = VWT; kh = (f0 - 2112) >> 6; }
        float gv[2][8];
#pragma unroll
        for (int bj = 0; bj < 2; ++bj)
#pragma unroll
            for (int k = 0; k < 8; ++k) gv[bj][k] = g ? g[32 * bj + 8 * fq + k] * sc : 1.f;
        const int row0 = u.pm * BM + wr * 64 + fr;
#pragma unroll
        for (int ai = 0; ai < 2; ++ai)
#pragma unroll
            for (int m = 0; m < 4; ++m) { const int row = row0 + ai * HALF + m * 16; bf16_t* rowp = O + (size_t)row * ldc + f0 + 8 * fq;
                float v[2][8];
#pragma unroll
                for (int bj = 0; bj < 2; ++bj) { const f32x4 v0 = acc[ai][bj][m][0], v1 = acc[ai][bj][m][1]; v[bj][0] = v0[0]; v[bj][1] = v0[1]; v[bj][2] = v0[2]; v[bj][3] = v0[3]; v[bj][4] = v1[0]; v[bj][5] = v1[1]; v[bj][6] = v1[2]; v[bj][7] = v1[3]; }
                if (g) { float ss = 0.f;
#pragma unroll
                    for (int bj = 0; bj < 2; ++bj)
#pragma unroll
                        for (int k = 0; k < 8; ++k) ss += v[bj][k] * v[bj][k];
                    ss += __shfl_xor(ss, 16); ss += __shfl_xor(ss, 32);
                    const float r = rsqrtf(ss * (1.f / 64.f) + eps);
#pragma unroll
                    for (int bj = 0; bj < 2; ++bj)
#pragma unroll
                        for (int k = 0; k < 8; ++k) v[bj][k] *= r * gv[bj][k]; }
#pragma unroll
                for (int bj = 0; bj < 2; ++bj) { u32x4 w; w.x = cvt_pk_bf16(v[bj][0], v[bj][1]); w.y = cvt_pk_bf16(v[bj][2], v[bj][3]); w.z = cvt_pk_bf16(v[bj][4], v[bj][5]); w.w = cvt_pk_bf16(v[bj][6], v[bj][7]);
                    *(u32x4*)(rowp + 32 * bj) = w;
                    if (VT) { const int b = row / seq, s = row % seq; bf16_t* tp = VT + ((size_t)(b * 2 + kh) * 64 + 32 * bj + 8 * fq) * seq + s;
                        tp[0] = (bf16_t)(w.x & 0xffffu); tp[seq] = (bf16_t)(w.x >> 16); tp[2 * seq] = (bf16_t)(w.y & 0xffffu); tp[3 * seq] = (bf16_t)(w.y >> 16);
                        tp[4 * seq] = (bf16_t)(w.z & 0xffffu); tp[5 * seq] = (bf16_t)(w.z >> 16); tp[6 * seq] = (bf16_t)(w.w & 0xffffu); tp[7 * seq] = (bf16_t)(w.w >> 16); } } }
    }
};
template <bool ADD> struct EpiGate {
    static constexpr bool PERM = true; static constexpr int MIDK = 0;
    bf16_t* O; int ldc; const bf16_t* Gt; int ldg; int gcol0;
    __device__ __forceinline__ void operator()(const f32x4 (&acc)[2][2][4][2], const Unit& u, int wr, int wc, int fr, int fq) const {
        const int row0 = u.pm * BM + wr * 64 + fr, col0 = u.pn * BM + wc * 32 + 8 * fq;
#pragma unroll
        for (int ai = 0; ai < 2; ++ai)
#pragma unroll
            for (int m = 0; m < 4; ++m) { const size_t row = (size_t)(row0 + ai * HALF + m * 16); bf16_t* rowp = O + row * ldc + col0; const bf16_t* gp = Gt + row * ldg + gcol0 + col0;
#pragma unroll
                for (int bj = 0; bj < 2; ++bj) { const f32x4 v0 = acc[ai][bj][m][0], v1 = acc[ai][bj][m][1];
                    const u32x4 g = *(const u32x4*)(gp + bj * HALF);
                    float o[8];
                    o[0] = v0[0] * sigm(bflo(g.x)); o[1] = v0[1] * sigm(bfhi(g.x)); o[2] = v0[2] * sigm(bflo(g.y)); o[3] = v0[3] * sigm(bfhi(g.y));
                    o[4] = v1[0] * sigm(bflo(g.z)); o[5] = v1[1] * sigm(bfhi(g.z)); o[6] = v1[2] * sigm(bflo(g.w)); o[7] = v1[3] * sigm(bfhi(g.w));
                    if (ADD) { const u32x4 p = *(const u32x4*)(rowp + bj * HALF);
                        o[0] += bflo(p.x); o[1] += bfhi(p.x); o[2] += bflo(p.y); o[3] += bfhi(p.y); o[4] += bflo(p.z); o[5] += bfhi(p.z); o[6] += bflo(p.w); o[7] += bfhi(p.w); }
                    u32x4 w; w.x = cvt_pk_bf16(o[0], o[1]); w.y = cvt_pk_bf16(o[2], o[3]); w.z = cvt_pk_bf16(o[4], o[5]); w.w = cvt_pk_bf16(o[6], o[7]);
                    *(u32x4*)(rowp + bj * HALF) = w; } }
    }
};

struct EpiGate2 {
    static constexpr bool PERM = true; static constexpr int MIDK = 8;
    bf16_t* O; int ldc; const bf16_t* Gt; int ldg; int gcol_a, gcol_b;
    __device__ __forceinline__ void mid(f32x4 (&acc)[2][2][4][2], const Unit& u, int wr, int wc, int fr, int fq) const {
        asm volatile("" : "+v"(fr), "+v"(fq));
        const int row0 = u.pm * BM + wr * 64 + fr, col0 = u.pn * BM + wc * 32 + 8 * fq;
#pragma unroll
        for (int ai = 0; ai < 2; ++ai)
#pragma unroll
            for (int m = 0; m < 4; ++m) { const size_t row = (size_t)(row0 + ai * HALF + m * 16); const bf16_t* gp = Gt + row * ldg + col0;
#pragma unroll
                for (int bj = 0; bj < 2; ++bj) { const u32x4 ga = *(const u32x4*)(gp + gcol_a + bj * HALF), gb = *(const u32x4*)(gp + gcol_b + bj * HALF);
                    float r[8];
                    r[0] = sigm(bflo(ga.x)) / fmaxf(sigm(bflo(gb.x)), 1e-30f); r[1] = sigm(bfhi(ga.x)) / fmaxf(sigm(bfhi(gb.x)), 1e-30f); r[2] = sigm(bflo(ga.y)) / fmaxf(sigm(bflo(gb.y)), 1e-30f); r[3] = sigm(bfhi(ga.y)) / fmaxf(sigm(bfhi(gb.y)), 1e-30f);
                    r[4] = sigm(bflo(ga.z)) / fmaxf(sigm(bflo(gb.z)), 1e-30f); r[5] = sigm(bfhi(ga.z)) / fmaxf(sigm(bfhi(gb.z)), 1e-30f); r[6] = sigm(bflo(ga.w)) / fmaxf(sigm(bflo(gb.w)), 1e-30f); r[7] = sigm(bfhi(ga.w)) / fmaxf(sigm(bfhi(gb.w)), 1e-30f);
#pragma unroll
                    for (int e = 0; e < 4; ++e) { acc[ai][bj][m][0][e] *= r[e]; acc[ai][bj][m][1][e] *= r[4 + e]; } }
                asm volatile("" ::: "memory"); }
    }
    __device__ __forceinline__ void operator()(const f32x4 (&acc)[2][2][4][2], const Unit& u, int wr, int wc, int fr, int fq) const {
        const int row0 = u.pm * BM + wr * 64 + fr, col0 = u.pn * BM + wc * 32 + 8 * fq;
#pragma unroll
        for (int ai = 0; ai < 2; ++ai)
#pragma unroll
            for (int m = 0; m < 4; ++m) { const size_t row = (size_t)(row0 + ai * HALF + m * 16); bf16_t* rowp = O + row * ldc + col0; const bf16_t* gp = Gt + row * ldg + gcol_b + col0;
#pragma unroll
                for (int bj = 0; bj < 2; ++bj) { const f32x4 v0 = acc[ai][bj][m][0], v1 = acc[ai][bj][m][1];
                    const u32x4 g = *(const u32x4*)(gp + bj * HALF);
                    u32x4 w; w.x = cvt_pk_bf16(v0[0] * sigm(bflo(g.x)), v0[1] * sigm(bfhi(g.x))); w.y = cvt_pk_bf16(v0[2] * sigm(bflo(g.y)), v0[3] * sigm(bfhi(g.y)));
                    w.z = cvt_pk_bf16(v1[0] * sigm(bflo(g.z)), v1[1] * sigm(bfhi(g.z))); w.w = cvt_pk_bf16(v1[2] * sigm(bflo(g.w)), v1[3] * sigm(bfhi(g.w)));
                    *(u32x4*)(rowp + bj * HALF) = w; } }
    }
};
struct EpiRelu2 {
    static constexpr bool PERM = true; static constexpr int MIDK = 0;
    bf16_t* O; int ldc; const float* parts; float eps; float inv_n;
    __device__ __forceinline__ void operator()(const f32x4 (&acc)[2][2][4][2], const Unit& u, int wr, int wc, int fr, int fq) const {
        const int row0 = u.pm * BM + wr * 64 + fr, col0 = u.pn * BM + wc * 32 + 8 * fq;
#pragma unroll
        for (int ai = 0; ai < 2; ++ai)
#pragma unroll
            for (int m = 0; m < 4; ++m) { const size_t row = (size_t)(row0 + ai * HALF + m * 16); bf16_t* rowp = O + row * ldc + col0;
                const f32x4* pp = (const f32x4*)(parts + row * 16); const f32x4 p0 = pp[0], p1 = pp[1], p2 = pp[2], p3 = pp[3];
                const float ss = ((p0[0] + p0[1]) + (p0[2] + p0[3])) + ((p1[0] + p1[1]) + (p1[2] + p1[3])) + ((p2[0] + p2[1]) + (p2[2] + p2[3])) + ((p3[0] + p3[1]) + (p3[2] + p3[3]));
                const float rs = rsqrtf(ss * inv_n + eps);
#pragma unroll
                for (int bj = 0; bj < 2; ++bj) { const f32x4 v0 = acc[ai][bj][m][0], v1 = acc[ai][bj][m][1];
                    float o[8] = {v0[0], v0[1], v0[2], v0[3], v1[0], v1[1], v1[2], v1[3]};
#pragma unroll
                    for (int e = 0; e < 8; ++e) { const float t = fmaxf(o[e], 0.f) * rs; o[e] = t * t; }
                    u32x4 w; w.x = cvt_pk_bf16(o[0], o[1]); w.y = cvt_pk_bf16(o[2], o[3]); w.z = cvt_pk_bf16(o[4], o[5]); w.w = cvt_pk_bf16(o[6], o[7]);
                    *(u32x4*)(rowp + bj * HALF) = w; } }
    }
};
struct EpiOutRes {
    static constexpr bool PERM = false; static constexpr int MIDK = 0;
    const float* base; float* out; bf16_t* xb; int ldc; float* parts;
    __device__ __forceinline__ void operator()(const f32x4 (&acc)[2][2][4][2], const Unit& u, int wr, int wc, int fr, int fq) const {
        const int col0 = u.pn * BM + wc * 32 + 4 * fq;
#pragma unroll
        for (int ai = 0; ai < 2; ++ai)
#pragma unroll
            for (int m = 0; m < 4; ++m) { const int r = u.pm * BM + ai * HALF + wr * 64 + m * 16 + fr; const size_t off = (size_t)r * ldc + col0; float ss = 0.f;
#pragma unroll
                for (int bj = 0; bj < 2; ++bj)
#pragma unroll
                    for (int n = 0; n < 2; ++n) { const f32x4 bs = *(const f32x4*)(base + off + bj * HALF + n * 16); const f32x4 o = bs + acc[ai][bj][m][n];
                        *(f32x4*)(out + off + bj * HALF + n * 16) = o; ss += (o[0] * o[0] + o[1] * o[1]) + (o[2] * o[2] + o[3] * o[3]);
                        u32x2 w; w.x = cvt_pk_bf16(o[0], o[1]); w.y = cvt_pk_bf16(o[2], o[3]); *(u32x2*)(xb + off + bj * HALF + n * 16) = w; }
                ss += __shfl_xor(ss, 16); ss += __shfl_xor(ss, 32);
                if (fq == 0) parts[(size_t)r * 16 + u.pn * 4 + wc] = ss; }
    }
};
struct EpiFinal {
    static constexpr bool PERM = false; static constexpr int MIDK = 0;
    float* out; int ldc;
    __device__ __forceinline__ void operator()(const f32x4 (&acc)[2][2][4][2], const Unit& u, int wr, int wc, int fr, int fq) const {
        const int col0 = u.pn * BM + wc * 32 + 4 * fq;
#pragma unroll
        for (int ai = 0; ai < 2; ++ai)
#pragma unroll
            for (int m = 0; m < 4; ++m) { const int r = u.pm * BM + ai * HALF + wr * 64 + m * 16 + fr; const size_t off = (size_t)r * ldc + col0;
#pragma unroll
                for (int bj = 0; bj < 2; ++bj)
#pragma unroll
                    for (int n = 0; n < 2; ++n) { float* p = out + off + bj * HALF + n * 16; const f32x4 bs = *(const f32x4*)p; *(f32x4*)p = bs + acc[ai][bj][m][n]; } }
    }
};

template <class Epi, class Sched, bool ALIGN_EPI = false>
__device__ __forceinline__ void gemm_phase(PG8_LAS unsigned char* lds, const Gemm g, const Sched& S, const Epi& E) {
    int tid_ = threadIdx.x; asm volatile("" : "+v"(tid_));
    const int tid = tid_, wid = __builtin_amdgcn_readfirstlane(tid >> 6), lane = tid & 63, wr = wid >> 2, wc = wid & 3, fr = lane & 15, fq = lane >> 4;
    const int K = g.K, nt = K / BK;
    unsigned voffA[2], voffB[2];
#pragma unroll
    for (int i = 0; i < 2; ++i) { int R, C; stage_rc(tid * 16 + i * 8192, R, C); const int Rb = Epi::PERM ? ((R & ~31) + perm32(R & 31)) : R;
        voffA[i] = (unsigned)(R * g.lda + C) * 2u; voffB[i] = (unsigned)(Rb * K + C) * 2u; }
    const size_t kstep = (size_t)(BK * 2);
    const size_t hstepA = (size_t)HALF * g.lda * 2, hstepB = (size_t)HALF * K * 2;
    const size_t tstepA = 2 * hstepA, tstepB = 2 * hstepB;
    const unsigned ldsw = (unsigned)wid * 1024u;
    const int aoff = lds_byte(wr * 64 + fr, fq * 8), boff = lds_byte(wc * 32 + fr, fq * 8);
#define PG8_SA(b, h) (((b) * 2 + (h)) * HTB)
#define PG8_SB(b, h) ((4 + (b) * 2 + (h)) * HTB)
#define PG8_STAGE(bufoff, gbase, voff) do { _Pragma("unroll") for (int _i = 0; _i < 2; ++_i) \
        __builtin_amdgcn_global_load_lds((const unsigned*)((const char*)(gbase) + (voff)[_i]), (PG8_LAS unsigned*)(lds + (bufoff) + ldsw + _i * 8192), 16, 0, 0); } while (0)
#define PG8_LDA(dst, b, h) do { _Pragma("unroll") for (int m = 0; m < 4; ++m) _Pragma("unroll") for (int k = 0; k < 2; ++k) dst[m][k] = *(const PG8_LAS bf16x8*)(lds + PG8_SA(b, h) + aoff + m * 2048 + k * 1024); } while (0)
#define PG8_LDB(dst, b, h) do { _Pragma("unroll") for (int n = 0; n < 2; ++n) _Pragma("unroll") for (int k = 0; k < 2; ++k) dst[n][k] = *(const PG8_LAS bf16x8*)(lds + PG8_SB(b, h) + boff + n * 2048 + k * 1024); } while (0)
#define PG8_MMA(ai, bj, At, Bt) do { __builtin_amdgcn_s_setprio(1); _Pragma("unroll") for (int m = 0; m < 4; ++m) _Pragma("unroll") for (int n = 0; n < 2; ++n) _Pragma("unroll") for (int k = 0; k < 2; ++k) \
        acc[ai][bj][m][n] = __builtin_amdgcn_mfma_f32_16x16x32_bf16(Bt[n][k], At[m][k], acc[ai][bj][m][n], 0, 0, 0); __builtin_amdgcn_s_setprio(0); } while (0)
#define PG8_WAIT_V(n) asm volatile("s_waitcnt vmcnt(" #n ")" ::: "memory")
#define PG8_WAIT_L(n) asm volatile("s_waitcnt lgkmcnt(" #n ")" ::: "memory")
#define PG8_BAR __builtin_amdgcn_s_barrier()
#define PG8_SCHED __builtin_amdgcn_sched_barrier(0)
    Unit cur, nxt; int ui = 0;
    if (!S.next(0, cur)) return;
    f32x4 acc[2][2][4][2];
#pragma unroll
    for (int a = 0; a < 2; ++a)
#pragma unroll
        for (int b = 0; b < 2; ++b)
#pragma unroll
            for (int m = 0; m < 4; ++m)
#pragma unroll
                for (int n = 0; n < 2; ++n) acc[a][b][m][n] = (f32x4){0.f, 0.f, 0.f, 0.f};
    bf16x8 At[4][2], B0[2][2], B1[2][2];
    const char* cA = (const char*)g.A + (size_t)cur.pm * tstepA; const char* cB = (const char*)g.Bt + (size_t)cur.pn * tstepB;
    PG8_STAGE(PG8_SB(0, 0), cB, voffB); PG8_STAGE(PG8_SB(0, 1), cB + hstepB, voffB); PG8_STAGE(PG8_SA(0, 0), cA, voffA); PG8_STAGE(PG8_SA(0, 1), cA + hstepA, voffA);
    if (wr == 1) PG8_BAR;
    PG8_WAIT_V(2); PG8_BAR;
    PG8_STAGE(PG8_SB(1, 0), cB + kstep, voffB); PG8_STAGE(PG8_SA(1, 0), cA + kstep, voffA); PG8_STAGE(PG8_SB(1, 1), cB + hstepB + kstep, voffB);
    PG8_WAIT_V(6); PG8_BAR;
    for (;;) {
        const bool has_next = S.next(ui + 1, nxt);
        const char* nA = has_next ? (const char*)g.A + (size_t)nxt.pm * tstepA : cA; const char* nB = has_next ? (const char*)g.Bt + (size_t)nxt.pn * tstepB : cB;
        for (int t = 0; t < nt; t += 2) {
            const bool last = (t == nt - 2);
            const char* a1 = cA + (size_t)(t + 1) * kstep;
            const char* a2 = last ? nA : cA + (size_t)(t + 2) * kstep; const char* b2 = last ? nB : cB + (size_t)(t + 2) * kstep;
            const char* a3 = a2 + kstep; const char* b3 = b2 + kstep;
            PG8_LDB(B0, 0, 0); PG8_LDB(B1, 0, 1); PG8_SCHED; PG8_LDA(At, 0, 0); PG8_STAGE(PG8_SA(1, 1), a1 + hstepA, voffA);
            PG8_WAIT_V(8); PG8_WAIT_L(0); PG8_BAR; PG8_MMA(0, 0, At, B0); PG8_MMA(0, 1, At, B1); PG8_BAR; PG8_SCHED;
            PG8_LDA(At, 0, 1); PG8_STAGE(PG8_SB(0, 0), b2, voffB); PG8_STAGE(PG8_SB(0, 1), b2 + hstepB, voffB); PG8_STAGE(PG8_SA(0, 0), a2, voffA);
            PG8_WAIT_V(8); PG8_WAIT_L(0); PG8_BAR; PG8_MMA(1, 0, At, B0); PG8_MMA(1, 1, At, B1); PG8_BAR; PG8_SCHED;
            PG8_LDB(B0, 1, 0); PG8_LDB(B1, 1, 1); PG8_SCHED; PG8_LDA(At, 1, 0); PG8_STAGE(PG8_SA(0, 1), a2 + hstepA, voffA);
            PG8_WAIT_V(8); PG8_WAIT_L(0); PG8_BAR; PG8_MMA(0, 0, At, B0); PG8_MMA(0, 1, At, B1); PG8_BAR; PG8_SCHED;
            PG8_LDA(At, 1, 1); PG8_STAGE(PG8_SB(1, 0), b3, voffB); PG8_STAGE(PG8_SB(1, 1), b3 + hstepB, voffB); PG8_STAGE(PG8_SA(1, 0), a3, voffA);
            PG8_WAIT_V(8); PG8_WAIT_L(0); PG8_BAR; PG8_MMA(1, 0, At, B0); PG8_MMA(1, 1, At, B1); PG8_BAR; PG8_SCHED;
            if constexpr (Epi::MIDK != 0) { if (t + 2 == Epi::MIDK) E.mid(acc, cur, wr, wc, fr, fq); }
        }
        if constexpr (ALIGN_EPI) { if (wr == 0) PG8_BAR; }
        E(acc, cur, wr, wc, fr, fq);
        if (!has_next) break;
#pragma unroll
        for (int a = 0; a < 2; ++a)
#pragma unroll
            for (int b = 0; b < 2; ++b)
#pragma unroll
                for (int m = 0; m < 4; ++m)
#pragma unroll
                    for (int n = 0; n < 2; ++n) acc[a][b][m][n] = (f32x4){0.f, 0.f, 0.f, 0.f};
        cur = nxt; cA = nA; cB = nB; ++ui;
        if constexpr (ALIGN_EPI) { if (wr == 1) PG8_BAR; }
    }
    PG8_WAIT_V(0);
    if constexpr (!ALIGN_EPI) { if (wr == 0) PG8_BAR; }
    PG8_BAR;
#undef PG8_SA
#undef PG8_SB
#undef PG8_STAGE
#undef PG8_LDA
#undef PG8_LDB
#undef PG8_MMA
#undef PG8_WAIT_V
#undef PG8_WAIT_L
#undef PG8_BAR
#undef PG8_SCHED
}
}

#ifndef PROBE_P3
#define PROBE_P3 1
#endif
#define PROBE_P0 1
#define PROBE_DPRE 1
#define PROBE_DIDX 1
#define PROBE_DTHR 1
#define PROBE_DATT 1
#define PROBE_NSA 1
#define PROBE_P1 1
#define PROBE_P2 1
#define PROBE_P4 1
#define PROBE_P5 1
#define PROBE_P6 1
constexpr int NWAVES = 8;
constexpr int BATCH = 8, SEQ = 2048, DM = 1024, M = BATCH * SEQ, FF = 4096;
constexpr int PITCH = 4352;
constexpr int C_QA = 0, C_CA = 512, C_QI = 640, C_KI = 896, C_WI = 928, C_GB = 936, C_QB = 960, C_KC = 1472, C_VC = 1600, C_KS = 1728, C_VS = 1856, C_KW = 1984, C_VW = 2112, C_GM = 2304;
constexpr int NCMP = 127, TOPK = 256;
constexpr float RMS_EPS = 1e-6f;
constexpr float LOG2E = 1.4426950408889634f;
constexpr float QSCALE = 0.125f * LOG2E;

constexpr size_t MiB = 1u << 20;
constexpr size_t WS_CTL = 0, CTL_ZERO_BYTES = 64 * 1024;
constexpr size_t WS_WIN = 1 * MiB;
constexpr size_t WS_WLT = 9 * MiB + 512 * 1024;
constexpr size_t WS_W2T = WS_WLT + 64 * 1024;
constexpr size_t WS_W1T = 31 * MiB;
constexpr size_t WS_WUPA = 10 * MiB, WS_WUPB = 11 * MiB;
constexpr size_t WS_WOUT = 12 * MiB;
constexpr size_t WS_WFF1 = 14 * MiB;
constexpr size_t WS_WFF2 = 22 * MiB;
constexpr size_t WS_PARTS = 30 * MiB;
constexpr size_t WS_PROJ = 32 * MiB;
constexpr size_t WS_MERGED = 168 * MiB;
constexpr size_t WS_X1B = 200 * MiB;
constexpr size_t WS_END = 232 * MiB;
constexpr size_t DO_H = 0;
constexpr size_t DO_O = 0;
constexpr size_t DO_KA = 32 * MiB;
constexpr size_t DO_VA = 34 * MiB;
constexpr size_t DO_VAT = 36 * MiB;
constexpr size_t DO_VST = 38 * MiB;
constexpr size_t DO_VWT = 42 * MiB;
constexpr size_t DO_KC = 46 * MiB;
constexpr size_t DO_VC = 47 * MiB;
constexpr size_t DO_VCT = 48 * MiB;

constexpr int CW_BAR = 4096;
constexpr int RING_BYTES = 131072;
constexpr int MISC_OFF = 141312 + 64;
constexpr int LDS_BYTES = 147456;

#define GAS __attribute__((address_space(1)))
#define LAS __attribute__((address_space(3)))
typedef unsigned short bf16;
typedef unsigned v4u __attribute__((ext_vector_type(4)));
typedef float f32x4 __attribute__((ext_vector_type(4)));
#define LDS_WAIT() asm volatile("s_waitcnt lgkmcnt(0)" ::: "memory")
typedef short bf16x8 __attribute__((ext_vector_type(8)));
typedef float f32x16 __attribute__((ext_vector_type(16)));
typedef unsigned long long u64;
typedef u64 u64x2 __attribute__((ext_vector_type(2)));

__device__ __forceinline__ unsigned f2bf(float f) { unsigned u = __builtin_bit_cast(unsigned, f); return (u + 0x7fffu + ((u >> 16) & 1u)) >> 16; }
__device__ __forceinline__ unsigned pk2(float lo, float hi) { return f2bf(lo) | (f2bf(hi) << 16); }
__device__ __forceinline__ float bf2f(bf16 b) { return __uint_as_float((unsigned)b << 16); }
__device__ __forceinline__ void unpack8(const v4u w, float* o) {
    o[0] = __uint_as_float(w.x << 16); o[1] = __uint_as_float(w.x & 0xffff0000u); o[2] = __uint_as_float(w.y << 16); o[3] = __uint_as_float(w.y & 0xffff0000u);
    o[4] = __uint_as_float(w.z << 16); o[5] = __uint_as_float(w.z & 0xffff0000u); o[6] = __uint_as_float(w.w << 16); o[7] = __uint_as_float(w.w & 0xffff0000u);
}
__device__ __forceinline__ float xhalf_max(float v) { auto rr = __builtin_amdgcn_permlane32_swap(__float_as_uint(v), __float_as_uint(v), false, false); return fmaxf(__uint_as_float(rr[0]), __uint_as_float(rr[1])); }
__device__ __forceinline__ float xhalf_sum(float v) { auto rr = __builtin_amdgcn_permlane32_swap(__float_as_uint(v), __float_as_uint(v), false, false); return __uint_as_float(rr[0]) + __uint_as_float(rr[1]); }
__device__ __forceinline__ float wave_sum(float v) {
#pragma unroll
    for (int o = 1; o < 64; o <<= 1) v += __shfl_xor(v, o);
    return v;
}
__device__ __forceinline__ float wave_max(float v) {
#pragma unroll
    for (int o = 1; o < 64; o <<= 1) v = fmaxf(v, __shfl_xor(v, o));
    return v;
}
__device__ __forceinline__ int wave_sum_i(int v) {
#pragma unroll
    for (int o = 1; o < 64; o <<= 1) v += __shfl_xor(v, o);
    return v;
}

#define XB_TMO      128
#define XB_XCNT(j)  (256  + 64 * (j))
#define XB_XSUB(j)  (1280 + 64 * (j))
#define XB_XGEN(j)  (2304 + 64 * (j))
#define XB_TOP      3328
#define XB_TOPGEN   3392
#define XCD_BAR_WORDS 3456
#define XB_SPIN_CAP (1u << 23)

__device__ __forceinline__ unsigned xb_ld(unsigned* p)              { return __hip_atomic_load(p, __ATOMIC_RELAXED, __HIP_MEMORY_SCOPE_AGENT); }
__device__ __forceinline__ unsigned xb_add(unsigned* p, unsigned v) { return __hip_atomic_fetch_add(p, v, __ATOMIC_RELAXED, __HIP_MEMORY_SCOPE_AGENT); }
__device__ __forceinline__ unsigned xb_xcc_id() { return (unsigned)__builtin_amdgcn_s_getreg((3 << 11) | 20) & 0xFu; }
#define XB_SPIN(cond, bar) do { unsigned _sp = 0; while (cond) { __builtin_amdgcn_s_sleep(1); \
    if ((++_sp & 255u) == 0u) { if (xb_ld(&(bar)[XB_TMO])) break; if (_sp > XB_SPIN_CAP) { atomicAdd(&(bar)[XB_TMO], 1u); break; } } } } while (0)

struct XcdBarrier { unsigned* bar; unsigned x; volatile LAS unsigned* st; };

__device__ __forceinline__ XcdBarrier xcd_barrier_post(unsigned* bar, volatile LAS unsigned* st) {
    XcdBarrier b; b.bar = bar; b.x = xb_xcc_id(); b.st = st;
    if (threadIdx.x == 0) (void)xb_add(&bar[XB_XCNT(b.x)], 1u);
    return b;
}
__device__ __forceinline__ void xcd_barrier_complete(unsigned* bar, unsigned x, unsigned& nloc, unsigned& nx) {
    const unsigned G = gridDim.x * gridDim.y * gridDim.z;
    unsigned sum, cnt, mine, sp = 0u;
    for (;;) {
        sum = 0u; cnt = 0u; mine = 0u;
#pragma unroll
        for (unsigned j = 0; j < 16; ++j) { const unsigned c = xb_ld(&bar[XB_XCNT(j)]); sum += c; cnt += (c > 0u) ? 1u : 0u; mine = (j == x) ? c : mine; }
        if (sum == G) break;
        __builtin_amdgcn_s_sleep(1);
        if ((++sp & 255u) == 0u) { if (xb_ld(&bar[XB_TMO])) break; if (sp > XB_SPIN_CAP) { atomicAdd(&bar[XB_TMO], 1u); break; } }
    }
    nloc = mine > 0u ? mine : 1u; nx = cnt > 0u ? cnt : 1u;
}
__device__ __forceinline__ void xcd_barrier(const XcdBarrier& b) {
    asm volatile("s_waitcnt vmcnt(0)" ::: "memory");
    __syncthreads();
    if (threadIdx.x == 0) {
        unsigned* bar = b.bar;
        __builtin_amdgcn_s_waitcnt(0);
        unsigned nloc = b.st[0], nx = b.st[1];
        if (nloc == 0u) { xcd_barrier_complete(bar, b.x, nloc, nx); b.st[0] = nloc; b.st[1] = nx; }
        const unsigned old = xb_add(&bar[XB_XSUB(b.x)], 1u);
        const unsigned gen = old / nloc;
        if (old + 1u == (gen + 1u) * nloc) {
            __builtin_amdgcn_fence(__ATOMIC_RELEASE, "agent");
            asm volatile("s_waitcnt vmcnt(0)" ::: "memory");
            const unsigned og = xb_add(&bar[XB_TOP], 1u);
            const unsigned tg = og / nx;
            if (og + 1u == (tg + 1u) * nx) xb_add(&bar[XB_TOPGEN], 1u);
            else XB_SPIN(xb_ld(&bar[XB_TOPGEN]) == tg, bar);
            __builtin_amdgcn_fence(__ATOMIC_ACQUIRE, "agent");
            xb_add(&bar[XB_XGEN(b.x)], 1u);
            asm volatile("s_waitcnt vmcnt(0)" ::: "memory");
        } else {
            XB_SPIN(xb_ld(&bar[XB_XGEN(b.x)]) == gen, bar);
            __builtin_amdgcn_fence(__ATOMIC_ACQUIRE, "agent");
            asm volatile("s_waitcnt vmcnt(0)" ::: "memory");
        }
    }
    __syncthreads();
}

__device__ __forceinline__ int proj_src_col(int d) {
    if (d < 936) return d;
    if (d < 960) return 2216 + (d - 936);
    if (d < 2240) return 936 + (d - 960);
    if (d < 2304) return -1;
    return 2240 + (d - 2304);
}
template <bool PROJMAP>
__device__ __forceinline__ void p0_transpose_item(const float* W, int K, int N, int Ndest, bf16* WT, const float* gk, LAS float* scr, int item, int lane, int dpitch = 0, int koff = 0) {
    if (dpitch == 0) dpitch = K;
    const int nblk = Ndest / 32, kb = item / nblk, nb = item % nblk, k0 = 64 * kb, n0 = 32 * nb;
    const int dn = n0 + (lane & 31); const int cl = dn & 255; const int sc = PROJMAP ? proj_src_col((dn & ~255) + ((cl >> 5) & 3) * 64 + (cl >> 7) * 32 + (cl & 31)) : dn;
    float tv[32];
#pragma unroll
    for (int i = 0; i < 32; ++i) { const int kk = 2 * i + (lane >> 5); tv[i] = (sc >= 0) ? W[(size_t)(k0 + kk) * N + sc] : 0.f; }
#pragma unroll
    for (int i = 0; i < 32; ++i) { const int kk = 2 * i + (lane >> 5); float v = tv[i]; if (gk) v *= gk[k0 + kk]; scr[kk * 33 + (lane & 31)] = v; }
    LDS_WAIT();
    const int c = lane & 7;
#pragma unroll
    for (int j = 0; j < 4; ++j) { const int n = (lane >> 3) + 8 * j; const LAS float* s = scr + (8 * c) * 33 + n;
        v4u o; o.x = pk2(s[0 * 33], s[1 * 33]); o.y = pk2(s[2 * 33], s[3 * 33]); o.z = pk2(s[4 * 33], s[5 * 33]); o.w = pk2(s[6 * 33], s[7 * 33]);
        *(GAS v4u*)(WT + (size_t)(n0 + n) * dpitch + koff + k0 + 8 * c) = o; }
    LDS_WAIT();
}
__device__ __forceinline__ void rms_row_to_bf16(const float* xrow, const float* g, bf16* orow, int lane) {
    const GAS f32x4* xr = (const GAS f32x4*)xrow + lane; const GAS f32x4* gr = (const GAS f32x4*)g + lane;
    f32x4 v[4]; float s = 0.f;
#pragma unroll
    for (int j = 0; j < 4; ++j) { v[j] = xr[64 * j]; s += (v[j].x * v[j].x + v[j].y * v[j].y) + (v[j].z * v[j].z + v[j].w * v[j].w); }
    const float rstd = rsqrtf(wave_sum(s) * (1.f / DM) + RMS_EPS);
    GAS unsigned long long* o8 = (GAS unsigned long long*)orow + lane;
#pragma unroll
    for (int j = 0; j < 4; ++j) { const f32x4 gg = gr[64 * j];
        o8[64 * j] = (unsigned long long)pk2(v[j].x * rstd * gg.x, v[j].y * rstd * gg.y) | ((unsigned long long)pk2(v[j].z * rstd * gg.z, v[j].w * rstd * gg.w) << 32); }
}

struct Ptrs {
    const float* in[23]; float* out; unsigned char* ws;
};

__device__ __forceinline__ void p0_prologue(const Ptrs& P, LAS unsigned char* lds, int gw, int NGW, int wave, int lane) {
    LAS float* scr = (LAS float*)(lds + wave * 16384);
    bf16* WIN = (bf16*)(P.ws + WS_WIN); bf16* WUPA = (bf16*)(P.ws + WS_WUPA); bf16* WUPB = (bf16*)(P.ws + WS_WUPB); bf16* WOUT = (bf16*)(P.ws + WS_WOUT);
    bf16* WFF1 = (bf16*)(P.ws + WS_WFF1); bf16* WFF2 = (bf16*)(P.ws + WS_WFF2);
    constexpr int I_IN = (DM / 64) * (PITCH / 32), I_UP = (512 / 64) * (DM / 32), I_OUT = (DM / 64) * (DM / 32), I_F1 = (DM / 64) * (FF / 32), I_F2 = (FF / 64) * (DM / 32);
    constexpr int I_LT = 4, I_P1 = (2048 / 64) * (128 / 32), I_P2 = 4;
    bf16* WLT = (bf16*)(P.ws + WS_WLT); bf16* W2T = (bf16*)(P.ws + WS_W2T); bf16* W1T = (bf16*)(P.ws + WS_W1T);
    constexpr int NITEMS = I_IN + 2 * I_UP + I_OUT + I_F1 + I_F2 + 2 * I_LT + 2 * I_P1 + 2 * I_P2;
    for (int it = gw; it < NITEMS; it += NGW) {
        int r = it;
        if (r < I_IN) { p0_transpose_item<true>(P.in[2], DM, 4288, PITCH, WIN, nullptr, scr, r, lane); continue; } r -= I_IN;
        if (r < I_UP) { p0_transpose_item<false>(P.in[17], 512, DM, DM, WUPA, nullptr, scr, r, lane, DM, 0); continue; } r -= I_UP;
        if (r < I_UP) { p0_transpose_item<false>(P.in[18], 512, DM, DM, WUPA, nullptr, scr, r, lane, DM, 512); continue; } r -= I_UP;
        if (r < I_OUT) { p0_transpose_item<false>(P.in[19], DM, DM, DM, WOUT, nullptr, scr, r, lane); continue; } r -= I_OUT;
        if (r < I_F1) { p0_transpose_item<false>(P.in[21], DM, FF, FF, WFF1, P.in[20], scr, r, lane); continue; } r -= I_F1;
        if (r < I_F2) { p0_transpose_item<false>(P.in[22], FF, DM, DM, WFF2, nullptr, scr, r, lane); continue; } r -= I_F2;
        if (r < I_LT) { p0_transpose_item<false>(P.in[6], 128, 64, 64, WLT, P.in[5], scr, r, lane); continue; } r -= I_LT;
        if (r < I_LT) { p0_transpose_item<false>(P.in[7], 128, 64, 64, WLT + 64 * 128, P.in[5], scr, r, lane); continue; } r -= I_LT;
        if (r < I_P1) { p0_transpose_item<false>(P.in[13], 2048, 128, 128, W1T, nullptr, scr, r, lane); continue; } r -= I_P1;
        if (r < I_P1) { p0_transpose_item<false>(P.in[15], 2048, 128, 128, W1T + 128 * 2048, nullptr, scr, r, lane); continue; } r -= I_P1;
        if (r < I_P2) { p0_transpose_item<false>(P.in[14], 128, 64, 64, W2T, nullptr, scr, r, lane); continue; } r -= I_P2;
        p0_transpose_item<false>(P.in[16], 128, 64, 64, W2T + 64 * 128, nullptr, scr, r, lane);
    }
    bf16* H = (bf16*)((unsigned char*)P.out + DO_H);
    for (int m = gw; m < M; m += 2 * NGW) {
        const int m2 = m + NGW < M ? m + NGW : m;
        const GAS f32x4* xa = (const GAS f32x4*)(P.in[0] + (size_t)m * DM) + lane; const GAS f32x4* xb = (const GAS f32x4*)(P.in[0] + (size_t)m2 * DM) + lane; const GAS f32x4* gr = (const GAS f32x4*)P.in[1] + lane;
        f32x4 va[4], vb[4]; float sa = 0.f, sb = 0.f;
#pragma unroll
        for (int j = 0; j < 4; ++j) { va[j] = xa[64 * j]; vb[j] = xb[64 * j]; }
#pragma unroll
        for (int j = 0; j < 4; ++j) { sa += (va[j].x * va[j].x + va[j].y * va[j].y) + (va[j].z * va[j].z + va[j].w * va[j].w); sb += (vb[j].x * vb[j].x + vb[j].y * vb[j].y) + (vb[j].z * vb[j].z + vb[j].w * vb[j].w); }
        const float ra = rsqrtf(wave_sum(sa) * (1.f / DM) + RMS_EPS), rb = rsqrtf(wave_sum(sb) * (1.f / DM) + RMS_EPS);
        GAS unsigned long long* oa = (GAS unsigned long long*)(H + (size_t)m * DM) + lane; GAS unsigned long long* ob = (GAS unsigned long long*)(H + (size_t)m2 * DM) + lane;
#pragma unroll
        for (int j = 0; j < 4; ++j) { const f32x4 gg = gr[64 * j];
            oa[64 * j] = (unsigned long long)pk2(va[j].x * ra * gg.x, va[j].y * ra * gg.y) | ((unsigned long long)pk2(va[j].z * ra * gg.z, va[j].w * ra * gg.w) << 32);
            if (m2 != m) ob[64 * j] = (unsigned long long)pk2(vb[j].x * rb * gg.x, vb[j].y * rb * gg.y) | ((unsigned long long)pk2(vb[j].z * rb * gg.z, vb[j].w * rb * gg.w) << 32); }
    }
}

__device__ __forceinline__ float gelu_tanh(float x) { const float u = 0.7978845608028654f * (x + 0.044715f * x * x * x); return 0.5f * x * (1.0f + tanhf(u)); }

__device__ __forceinline__ void p2_post(const Ptrs& P, LAS unsigned char* lds, int gw, int NGW, int wave, int lane) {
    bf16* PROJ = (bf16*)(P.ws + WS_PROJ);
    unsigned char* dob = (unsigned char*)P.out;
    bf16* KA = (bf16*)(dob + DO_KA); bf16* VA = (bf16*)(dob + DO_VA); bf16* VAT = (bf16*)(dob + DO_VAT); bf16* VST = (bf16*)(dob + DO_VST); bf16* VWT = (bf16*)(dob + DO_VWT);
    bf16* KC = (bf16*)(dob + DO_KC); bf16* VC = (bf16*)(dob + DO_VC); bf16* VCT = (bf16*)(dob + DO_VCT);
    const int gtid = gw * 64 + lane, NT = NGW * 64;
    for (int it = gtid; it < M * 20; it += NT) {
        const int tok = it / 20, wh = it % 20; int col; const float* g; float sc = 1.f;
        if (wh < 8) { col = C_QA + wh * 64; g = P.in[3]; sc = QSCALE; }
        else if (wh < 16) { col = C_QB + (wh - 8) * 64; g = P.in[8]; sc = QSCALE; }
        else if (wh < 18) { col = C_KS + (wh - 16) * 64; g = P.in[10]; }
        else { col = C_KW + (wh - 18) * 64; g = P.in[11]; }
        v4u* p = (v4u*)(PROJ + (size_t)tok * PITCH + col);
        float v[64]; float ss = 0.f;
#pragma unroll
        for (int j = 0; j < 8; ++j) { unpack8(p[j], v + 8 * j); }
#pragma unroll
        for (int j = 0; j < 64; ++j) ss += v[j] * v[j];
        const float r = rsqrtf(ss * (1.f / 64.f) + RMS_EPS) * sc;
#pragma unroll
        for (int j = 0; j < 8; ++j) { v4u o; o.x = pk2(v[8 * j] * r * g[8 * j], v[8 * j + 1] * r * g[8 * j + 1]); o.y = pk2(v[8 * j + 2] * r * g[8 * j + 2], v[8 * j + 3] * r * g[8 * j + 3]);
            o.z = pk2(v[8 * j + 4] * r * g[8 * j + 4], v[8 * j + 5] * r * g[8 * j + 5]); o.w = pk2(v[8 * j + 6] * r * g[8 * j + 6], v[8 * j + 7] * r * g[8 * j + 7]); p[j] = o; }
    }
    for (int it = gtid; it < 2 * BATCH * 2 * 64 * SEQ; it += NT) {
        const int s = it % SEQ; int r = it / SEQ; const int d = r % 64; r /= 64; const int kh = r % 2; r /= 2; const int b = r % BATCH; const int which = r / BATCH;
        const bf16 v = PROJ[(size_t)(b * SEQ + s) * PITCH + (which ? C_VW : C_VS) + kh * 64 + d];
        (which ? VWT : VST)[((size_t)(b * 2 + kh) * 64 + d) * SEQ + s] = v;
    }
    {
        LAS float* cn = (LAS float*)(lds + wave * 16384);
        const float* wuk = P.in[6]; const float* wuv = P.in[7];
        for (int tok = gw; tok < M; tok += NGW) {
            const bf16* pr = PROJ + (size_t)tok * PITCH + C_CA;
            const float c0 = bf2f(pr[lane]), c1 = bf2f(pr[lane + 64]);
            const float rstd = rsqrtf(wave_sum(c0 * c0 + c1 * c1) * (1.f / 128.f) + RMS_EPS);
            cn[lane] = c0 * rstd * P.in[5][lane]; cn[lane + 64] = c1 * rstd * P.in[5][lane + 64];
            LDS_WAIT();
            float ka = 0.f, va = 0.f;
#pragma unroll 8
            for (int k = 0; k < 128; ++k) { const float c = cn[k]; ka += c * wuk[k * 64 + lane]; va += c * wuv[k * 64 + lane]; }
            const float kr = rsqrtf(wave_sum(ka * ka) * (1.f / 64.f) + RMS_EPS);
            KA[(size_t)tok * 64 + lane] = (bf16)f2bf(ka * kr * P.in[4][lane]);
            VA[(size_t)tok * 64 + lane] = (bf16)f2bf(va);
            VAT[((size_t)(tok / SEQ) * 64 + lane) * SEQ + (tok % SEQ)] = (bf16)f2bf(va);
            LDS_WAIT();
        }
    }
    for (int it = gtid; it < BATCH * 2 * 64; it += NT) { const int d = it % 64, bk = it / 64; KC[((size_t)bk * 128 + 127) * 64 + d] = 0; VC[((size_t)bk * 128 + 127) * 64 + d] = 0; VCT[((size_t)bk * 64 + d) * 128 + 127] = 0; }
    {
        LAS float* hid = (LAS float*)(lds + wave * 16384);
        const float* pe = P.in[12];
        for (int it = gw; it < 2 * BATCH * NCMP * 2; it += NGW) {
            const int kh = it % 2; int r = it / 2; const int c = r % NCMP; r /= NCMP; const int b = r % BATCH; const int kv = r / BATCH;
            const float* w1 = kv ? P.in[15] : P.in[13]; const float* w2 = kv ? P.in[16] : P.in[14];
            const bf16* src = PROJ + (size_t)(b * SEQ + 16 * c) * PITCH + (kv ? C_VC : C_KC) + kh * 64;
            float h0 = 0.f, h1 = 0.f;
            for (int l = 0; l < 32; ++l) {
                const bf16* sr = src + (size_t)l * PITCH;
#pragma unroll 8
                for (int d = 0; d < 64; ++d) { const float a = bf2f(sr[d]) + pe[l * 64 + d]; const float* wr_ = w1 + (size_t)(l * 64 + d) * 128; h0 += a * wr_[lane]; h1 += a * wr_[lane + 64]; }
            }
            hid[lane] = gelu_tanh(h0); hid[lane + 64] = gelu_tanh(h1);
            LDS_WAIT();
            float o = 0.f;
#pragma unroll 8
            for (int n = 0; n < 128; ++n) o += hid[n] * w2[n * 64 + lane];
            if (kv == 0) { const float kr = rsqrtf(wave_sum(o * o) * (1.f / 64.f) + RMS_EPS); KC[((size_t)(b * 2 + kh) * 128 + c) * 64 + lane] = (bf16)f2bf(o * kr * P.in[9][lane]); }
            else { VC[((size_t)(b * 2 + kh) * 128 + c) * 64 + lane] = (bf16)f2bf(o); VCT[((size_t)(b * 2 + kh) * 64 + lane) * 128 + c] = (bf16)f2bf(o); }
            LDS_WAIT();
        }
    }
}


__device__ __forceinline__ void latent_group(const Ptrs& P, int grp, int lane) {
    const int r32 = lane & 31, hi = lane >> 5; const int tok = 32 * grp + r32;
    const bf16* PROJ = (const bf16*)(P.ws + WS_PROJ); const bf16* WLT = (const bf16*)(P.ws + WS_WLT);
    unsigned char* dob = (unsigned char*)P.out; bf16* KA = (bf16*)(dob + DO_KA); bf16* VAT = (bf16*)(dob + DO_VAT);
    bf16x8 cb[8]; float ss = 0.f;
    const bf16* cp = PROJ + (size_t)tok * PITCH + C_CA + hi * 8;
#pragma unroll
    for (int ks = 0; ks < 8; ++ks) { const v4u w = *(const GAS v4u*)(cp + ks * 16); cb[ks] = __builtin_bit_cast(bf16x8, w); float f[8]; unpack8(w, f);
#pragma unroll
        for (int j = 0; j < 8; ++j) ss += f[j] * f[j]; }
    ss = xhalf_sum(ss);
    const float rstd = rsqrtf(ss * (1.f / 128.f) + RMS_EPS);
    f32x16 acc[4];
#pragma unroll
    for (int nb = 0; nb < 4; ++nb) {
#pragma unroll
        for (int r = 0; r < 16; ++r) acc[nb][r] = 0.f;
#pragma unroll
        for (int ks = 0; ks < 8; ++ks) { const bf16x8 a = *(const GAS bf16x8*)(WLT + (size_t)(32 * nb + r32) * 128 + ks * 16 + hi * 8); acc[nb] = __builtin_amdgcn_mfma_f32_32x32x16_bf16(a, cb[ks], acc[nb], 0, 0, 0); } }
    float sk = 0.f;
#pragma unroll
    for (int nb = 0; nb < 2; ++nb)
#pragma unroll
        for (int r = 0; r < 16; ++r) { const float v = acc[nb][r] * rstd; sk += v * v; }
    sk = xhalf_sum(sk);
    const float kr = rsqrtf(sk * (1.f / 64.f) + RMS_EPS) * rstd;
    const float* gk = P.in[4];
#pragma unroll
    for (int nb = 0; nb < 2; ++nb)
#pragma unroll
        for (int a = 0; a < 4; ++a) { const int n0 = 32 * nb + 8 * a + 4 * hi; const f32x4 gg = *(const GAS f32x4*)(gk + n0);
            pg8::u32x2 w; w.x = pg8::cvt_pk_bf16(acc[nb][4 * a] * kr * gg[0], acc[nb][4 * a + 1] * kr * gg[1]); w.y = pg8::cvt_pk_bf16(acc[nb][4 * a + 2] * kr * gg[2], acc[nb][4 * a + 3] * kr * gg[3]);
            *(GAS pg8::u32x2*)(KA + (size_t)tok * 64 + n0) = w; }
    const int b = tok / SEQ, s = tok % SEQ;
#pragma unroll
    for (int nb = 2; nb < 4; ++nb)
#pragma unroll
        for (int r = 0; r < 16; ++r) { const int d = 32 * (nb - 2) + (r & 3) + 8 * (r >> 2) + 4 * hi; VAT[((size_t)b * 64 + d) * SEQ + s] = (bf16)f2bf(acc[nb][r] * rstd); }
}
__device__ __forceinline__ void compress_unit(const Ptrs& P, LAS unsigned char* lds, int unit, int tid, int wave, int lane) {
    const int cbk = unit & 3, kh = (unit >> 2) & 1, b = (unit >> 3) & 7, kv = unit >> 6;
    const int r32 = lane & 31, hi = lane >> 5, nb = wave & 3, kq = wave >> 2;
    const bf16* PROJ = (const bf16*)(P.ws + WS_PROJ);
    const bf16* W1T = (const bf16*)(P.ws + WS_W1T) + (size_t)kv * 128 * 2048; const bf16* W2T = (const bf16*)(P.ws + WS_W2T) + (size_t)kv * 64 * 128;
    unsigned char* dob = (unsigned char*)P.out; bf16* KC = (bf16*)(dob + DO_KC); bf16* VCT = (bf16*)(dob + DO_VCT);
    const bf16* src = PROJ + (size_t)(b * SEQ) * PITCH + (kv ? C_VC : C_KC) + kh * 64;
    const float* pe = P.in[12];
    const int c = 32 * cbk + r32;
    LAS float* red = (LAS float*)lds;
    LAS float* peL = (LAS float*)(lds + 32768);
    for (int i = tid; i < 2048; i += NWAVES * 64) peL[i] = pe[i];
    __syncthreads();
    LAS unsigned char* hidL = lds + 16384;
    f32x16 acc;
#pragma unroll
    for (int r = 0; r < 16; ++r) acc[r] = 0.f;
    const bf16* w1p = W1T + (size_t)(32 * nb + r32) * 2048 + hi * 8;
#pragma unroll 8
    for (int ks = 64 * kq; ks < 64 * kq + 64; ++ks) {
        const int l = ks >> 2, d = 16 * (ks & 3) + 8 * hi; int tokn = 16 * c + l; tokn = tokn > SEQ - 1 ? SEQ - 1 : tokn;
        const v4u raw = *(const GAS v4u*)(src + (size_t)tokn * PITCH + d); float a8[8]; unpack8(raw, a8);
        const f32x4 p0 = *(LAS const f32x4*)(peL + l * 64 + d), p1 = *(LAS const f32x4*)(peL + l * 64 + d + 4);
        pg8::u32x4 aw; aw.x = pg8::cvt_pk_bf16(a8[0] + p0[0], a8[1] + p0[1]); aw.y = pg8::cvt_pk_bf16(a8[2] + p0[2], a8[3] + p0[3]); aw.z = pg8::cvt_pk_bf16(a8[4] + p1[0], a8[5] + p1[1]); aw.w = pg8::cvt_pk_bf16(a8[6] + p1[2], a8[7] + p1[3]);
        const bf16x8 bw = *(const GAS bf16x8*)(w1p + ks * 16);
        acc = __builtin_amdgcn_mfma_f32_32x32x16_bf16(__builtin_bit_cast(bf16x8, aw), bw, acc, 0, 0, 0);
    }
    if (kq == 1) {
#pragma unroll
        for (int r = 0; r < 16; ++r) red[(nb * 16 + r) * 64 + lane] = acc[r]; }
    __syncthreads();
    if (kq == 0) {
#pragma unroll
        for (int r = 0; r < 16; ++r) { const float h = gelu_tanh(acc[r] + red[(nb * 16 + r) * 64 + lane]); const int cr = (r & 3) + 8 * (r >> 2) + 4 * hi;
            *(LAS bf16*)(hidL + cr * 272 + (32 * nb + r32) * 2) = (bf16)f2bf(h); } }
    __syncthreads();
    if (wave == 0) {
        f32x16 o2[2];
#pragma unroll
        for (int db = 0; db < 2; ++db) {
#pragma unroll
            for (int r = 0; r < 16; ++r) o2[db][r] = 0.f;
#pragma unroll
            for (int ks = 0; ks < 8; ++ks) { const bf16x8 a = *(const GAS bf16x8*)(W2T + (size_t)(32 * db + r32) * 128 + ks * 16 + hi * 8);
                const bf16x8 hb = *(LAS const bf16x8*)(hidL + r32 * 272 + (ks * 16 + hi * 8) * 2);
                o2[db] = __builtin_amdgcn_mfma_f32_32x32x16_bf16(a, hb, o2[db], 0, 0, 0); } }
        const size_t bk = (size_t)(b * 2 + kh);
        if (kv == 0) {
            float sk = 0.f;
#pragma unroll
            for (int db = 0; db < 2; ++db)
#pragma unroll
                for (int r = 0; r < 16; ++r) sk += o2[db][r] * o2[db][r];
            sk = xhalf_sum(sk);
            const float kr = (c < NCMP) ? rsqrtf(sk * (1.f / 64.f) + RMS_EPS) : 0.f;
            const float* gkc = P.in[9];
#pragma unroll
            for (int db = 0; db < 2; ++db)
#pragma unroll
                for (int a = 0; a < 4; ++a) { const int d0 = 32 * db + 8 * a + 4 * hi; const f32x4 gg = *(const GAS f32x4*)(gkc + d0);
                    pg8::u32x2 w; w.x = pg8::cvt_pk_bf16(o2[db][4 * a] * kr * gg[0], o2[db][4 * a + 1] * kr * gg[1]); w.y = pg8::cvt_pk_bf16(o2[db][4 * a + 2] * kr * gg[2], o2[db][4 * a + 3] * kr * gg[3]);
                    *(GAS pg8::u32x2*)(KC + (bk * 128 + c) * 64 + d0) = w; }
        } else {
            const float z = (c < NCMP) ? 1.f : 0.f;
#pragma unroll
            for (int db = 0; db < 2; ++db)
#pragma unroll
                for (int r = 0; r < 16; ++r) { const int d = 32 * db + (r & 3) + 8 * (r >> 2) + 4 * hi; VCT[(bk * 64 + d) * 128 + c] = (bf16)f2bf(o2[db][r] * z); }
        }
    }
    __syncthreads();
}
__device__ __forceinline__ void p2_fast(const Ptrs& P, LAS unsigned char* lds, int vcu, int G, int tid, int wave, int lane) {
    for (int u = vcu; u < 128; u += G) compress_unit(P, lds, u, tid, wave, lane);
    for (int grp = G * NWAVES - 1 - (vcu * NWAVES + wave); grp < M / 32; grp += G * NWAVES) latent_group(P, grp, lane);
}

__device__ __forceinline__ unsigned ord_u32(float f) { const unsigned u = __float_as_uint(f); return (u & 0x80000000u) ? ~u : (u | 0x80000000u); }

__device__ __forceinline__ float inv_ord_u32(unsigned u) { return __uint_as_float((u & 0x80000000u) ? (u ^ 0x80000000u) : ~u); }
template <int CTRL> __device__ __forceinline__ unsigned dpp_mov(unsigned x) { return (unsigned)__builtin_amdgcn_update_dpp(0, (int)x, CTRL, 0xf, 0xf, true); }
__device__ __forceinline__ unsigned wave_umax(unsigned x) {
    unsigned y = dpp_mov<0xB1>(x); x = x > y ? x : y; y = dpp_mov<0x4E>(x); x = x > y ? x : y; y = dpp_mov<0x141>(x); x = x > y ? x : y; y = dpp_mov<0x140>(x); x = x > y ? x : y;
    const unsigned a = __builtin_amdgcn_readlane(x, 0), b = __builtin_amdgcn_readlane(x, 16), c = __builtin_amdgcn_readlane(x, 32), d = __builtin_amdgcn_readlane(x, 48);
    const unsigned ab = a > b ? a : b, cd = c > d ? c : d; return ab > cd ? ab : cd;
}
__device__ __forceinline__ unsigned wave_umin(unsigned x) {
    unsigned y = dpp_mov<0xB1>(x); x = x < y ? x : y; y = dpp_mov<0x4E>(x); x = x < y ? x : y; y = dpp_mov<0x141>(x); x = x < y ? x : y; y = dpp_mov<0x140>(x); x = x < y ? x : y;
    const unsigned a = __builtin_amdgcn_readlane(x, 0), b = __builtin_amdgcn_readlane(x, 16), c = __builtin_amdgcn_readlane(x, 32), d = __builtin_amdgcn_readlane(x, 48);
    const unsigned ab = a < b ? a : b, cd = c < d ? c : d; return ab < cd ? ab : cd;
}
__device__ __forceinline__ unsigned long long lanemask_lt(int lane) { return (1ull << lane) - 1ull; }

__device__ __forceinline__ void dsa_token(const Ptrs& P, LAS unsigned char* wl, int b, int t, int lane) {
    bf16* PROJ = (bf16*)(P.ws + WS_PROJ);
    const bf16* KA = (const bf16*)((unsigned char*)P.out + DO_KA); const bf16* VA = (const bf16*)((unsigned char*)P.out + DO_VA);
    LAS float* sc = (LAS float*)wl; LAS float* aux = sc + 2048; LAS int* idx = (LAS int*)(aux + 512); LAS float* pl = (LAS float*)(idx + 256);
    bf16* prow = PROJ + (size_t)(b * SEQ + t) * PITCH;
#pragma unroll
    for (int i = 0; i < 4; ++i) aux[lane + 64 * i] = bf2f(prow[C_QI + lane + 64 * i]);
    if (lane < 8) aux[256 + lane] = bf2f(prow[C_WI + lane]);
    LDS_WAIT();
    for (int s = lane; s <= t; s += 64) {
        const v4u* kp = (const v4u*)(PROJ + (size_t)(b * SEQ + s) * PITCH + C_KI);
        float kf[32]; unpack8(kp[0], kf); unpack8(kp[1], kf + 8); unpack8(kp[2], kf + 16); unpack8(kp[3], kf + 24);
        float score = 0.f;
#pragma unroll
        for (int h = 0; h < 8; ++h) { float dot = 0.f;
#pragma unroll
            for (int d = 0; d < 32; ++d) dot += aux[h * 32 + d] * kf[d];
            score += fmaxf(dot, 0.f) * aux[256 + h]; }
        sc[s] = score + 0.0f;
    }
    LDS_WAIT();
    unsigned u[32];
#pragma unroll
    for (int i = 0; i < 32; ++i) { const int s = lane + 64 * i; u[i] = (s <= t) ? ord_u32(sc[s]) : 0u; }
    unsigned T = 1u; int need = 1 << 30;
    if (t + 1 > TOPK) {
        T = 0u;
        for (int bit = 31; bit >= 0; --bit) { const unsigned cand = T | (1u << bit); int cnt = 0;
#pragma unroll
            for (int i = 0; i < 32; ++i) cnt += (u[i] >= cand) ? 1 : 0;
            cnt = wave_sum_i(cnt); if (cnt >= TOPK) T = cand; }
        int cg = 0;
#pragma unroll
        for (int i = 0; i < 32; ++i) cg += (u[i] > T) ? 1 : 0;
        need = TOPK - wave_sum_i(cg);
    }
    int base = 0, ties = 0; const unsigned long long lt = lanemask_lt(lane);
#pragma unroll
    for (int i = 0; i < 32; ++i) {
        const bool valid = (lane + 64 * i) <= t; const bool gt = valid && (u[i] > T); const bool eq = valid && (u[i] == T) && (t + 1 > TOPK);
        const unsigned long long meq = __ballot(eq); const int myrank = ties + __popcll(meq & lt); const bool take = gt || (eq && myrank < need); ties += __popcll(meq);
        const unsigned long long mt = __ballot(take); const int pos = base + __popcll(mt & lt); if (take && pos < TOPK) idx[pos] = lane + 64 * i; base += __popcll(mt);
    }
    const int nsel = base < TOPK ? base : TOPK;
    LDS_WAIT();
    for (int h = 0; h < 8; ++h) {
        float qf[64];
        { const v4u* qp = (const v4u*)(prow + C_QA + h * 64);
#pragma unroll
          for (int j = 0; j < 8; ++j) unpack8(qp[j], qf + 8 * j); }
        const float slope2 = exp2f(-(float)(h + 1)) * LOG2E;
        float sv[4]; float mx = -INFINITY;
#pragma unroll
        for (int jj = 0; jj < 4; ++jj) { const int j = lane + 64 * jj; sv[jj] = -INFINITY;
            if (j < nsel) { const int ix = idx[j]; const v4u* kp = (const v4u*)(KA + (size_t)(b * SEQ + ix) * 64); float dot = 0.f;
#pragma unroll
                for (int c8 = 0; c8 < 8; ++c8) { float kf[8]; unpack8(kp[c8], kf);
#pragma unroll
                    for (int e = 0; e < 8; ++e) dot += qf[c8 * 8 + e] * kf[e]; }
                sv[jj] = dot - slope2 * (float)(t - ix); }
            mx = fmaxf(mx, sv[jj]); }
        mx = wave_max(mx);
        float ls = 0.f;
#pragma unroll
        for (int jj = 0; jj < 4; ++jj) { const float p = exp2f(sv[jj] - mx); pl[lane + 64 * jj] = p; ls += p; }
        ls = wave_sum(ls);
        LDS_WAIT();
        float acc = 0.f;
        for (int j = 0; j < nsel; ++j) acc += pl[j] * bf2f(VA[(size_t)(b * SEQ + idx[j]) * 64 + lane]);
        LDS_WAIT();
        prow[C_QA + h * 64 + lane] = (bf16)f2bf(acc / ls);
    }
}

struct NsaAcc { float m[4], l[4], a[4]; };
__device__ __forceinline__ void nsa_block(NsaAcc& S, LAS const float* ql, LAS float* pl, const bf16* Kb, const bf16* Vb, size_t pitch, int kpos0, int t, int wlim, const float* slope2, int lane) {
    const int kpos = kpos0 + lane; const int dist = t - kpos; const bool valid = (kpos >= 0) && (dist >= 0) && (dist < wlim);
    float s[4] = {-INFINITY, -INFINITY, -INFINITY, -INFINITY};
    if (valid) { const v4u* kp = (const v4u*)(Kb + (size_t)kpos * pitch); float d4[4] = {0.f, 0.f, 0.f, 0.f};
#pragma unroll
        for (int c8 = 0; c8 < 8; ++c8) { float kf[8]; unpack8(kp[c8], kf);
#pragma unroll
            for (int g = 0; g < 4; ++g)
#pragma unroll
                for (int e = 0; e < 8; ++e) d4[g] += ql[g * 64 + c8 * 8 + e] * kf[e]; }
#pragma unroll
        for (int g = 0; g < 4; ++g) s[g] = d4[g] - slope2[g] * (float)dist; }
    bool any = false;
#pragma unroll
    for (int g = 0; g < 4; ++g) { const float bm = wave_max(s[g]); const float mn = fmaxf(S.m[g], bm);
        if (mn > -INFINITY) { const float alpha = exp2f(S.m[g] - mn); const float p = exp2f(s[g] - mn); S.l[g] = S.l[g] * alpha + wave_sum(p); S.a[g] *= alpha; S.m[g] = mn; pl[g * 64 + lane] = p; any = true; }
        else pl[g * 64 + lane] = 0.f; }
    LDS_WAIT();
    if (any) {
        const int k_lo = kpos0 < 0 ? -kpos0 : 0;
        for (int k = k_lo; k < 64; ++k) { if (kpos0 + k > t) break; const float v = bf2f(Vb[(size_t)(kpos0 + k) * pitch + lane]);
#pragma unroll
            for (int g = 0; g < 4; ++g) S.a[g] += pl[g * 64 + k] * v; }
    }
    LDS_WAIT();
}
__device__ __forceinline__ void nsa_token(const Ptrs& P, LAS unsigned char* wl, int b, int t, int kh, int lane) {
    bf16* PROJ = (bf16*)(P.ws + WS_PROJ);
    const bf16* KC = (const bf16*)((unsigned char*)P.out + DO_KC) + (size_t)(b * 2 + kh) * 128 * 64; const bf16* VC = (const bf16*)((unsigned char*)P.out + DO_VC) + (size_t)(b * 2 + kh) * 128 * 64;
    LAS float* ql = (LAS float*)wl; LAS float* pc = ql + 256; LAS float* pl = pc + 512;
    bf16* prow = PROJ + (size_t)(b * SEQ + t) * PITCH;
#pragma unroll
    for (int i = 0; i < 4; ++i) ql[lane + 64 * i] = bf2f(prow[C_QB + kh * 256 + lane + 64 * i]);
    LDS_WAIT();
    float slope2[4];
#pragma unroll
    for (int g = 0; g < 4; ++g) slope2[g] = exp2f(-(float)(kh * 4 + g + 1)) * LOG2E;
    float outv[4];
    {
        float s[2][4];
#pragma unroll
        for (int hb = 0; hb < 2; ++hb) { const int c = lane + 64 * hb; const bool valid = (c < NCMP) && (16 * c + 31 <= t);
#pragma unroll
            for (int g = 0; g < 4; ++g) s[hb][g] = -INFINITY;
            if (valid) { const v4u* kp = (const v4u*)(KC + (size_t)c * 64); float d4[4] = {0.f, 0.f, 0.f, 0.f};
#pragma unroll
                for (int c8 = 0; c8 < 8; ++c8) { float kf[8]; unpack8(kp[c8], kf);
#pragma unroll
                    for (int g = 0; g < 4; ++g)
#pragma unroll
                        for (int e = 0; e < 8; ++e) d4[g] += ql[g * 64 + c8 * 8 + e] * kf[e]; }
#pragma unroll
                for (int g = 0; g < 4; ++g) s[hb][g] = d4[g]; } }
#pragma unroll
        for (int g = 0; g < 4; ++g) { const float mx = wave_max(fmaxf(s[0][g], s[1][g]));
            float p0 = 0.f, p1 = 0.f; if (mx > -INFINITY) { p0 = exp2f(s[0][g] - mx); p1 = exp2f(s[1][g] - mx); }
            const float l = wave_sum(p0 + p1); const float inv = l > 0.f ? 1.f / l : 0.f;
            pc[g * 128 + lane] = p0 * inv; pc[g * 128 + 64 + lane] = p1 * inv; }
        LDS_WAIT();
        float a[4] = {0.f, 0.f, 0.f, 0.f};
        for (int c = 0; c < NCMP; ++c) { if (16 * c + 31 > t) break; const float v = bf2f(VC[(size_t)c * 64 + lane]);
#pragma unroll
            for (int g = 0; g < 4; ++g) a[g] += pc[g * 128 + c] * v; }
#pragma unroll
        for (int g = 0; g < 4; ++g) outv[g] = a[g] / (1.0f + __expf(-bf2f(prow[C_GB + (kh * 4 + g) * 3 + 0])));
    }
    unsigned selmask;
    {
        const int j = lane & 31; const int cur = t >> 6; float imp = 0.f;
        for (int c = 4 * j - 1; c <= 4 * j + 3; ++c) if (c >= 0 && c < NCMP) imp += (pc[c] + pc[128 + c]) + (pc[256 + c] + pc[384 + c]);
        const bool forced = (j == 0) || (j == cur) || (j == cur - 1);
        const float eff = (j > cur) ? -INFINITY : (imp + (forced ? 1e6f : 0.f));
        int rank = 0;
        for (int jp = 0; jp < 32; ++jp) { const float e2 = __shfl(eff, jp); rank += (e2 > eff || (e2 == eff && jp < j)) ? 1 : 0; }
        selmask = (unsigned)__ballot((lane < 32) && (rank < 16) && (j <= cur));
    }
    LDS_WAIT();
    {
        NsaAcc S;
#pragma unroll
        for (int g = 0; g < 4; ++g) { S.m[g] = -INFINITY; S.l[g] = 0.f; S.a[g] = 0.f; }
        const bf16* Kb = PROJ + (size_t)b * SEQ * PITCH + C_KS + kh * 64; const bf16* Vb = PROJ + (size_t)b * SEQ * PITCH + C_VS + kh * 64;
        for (int j = 31; j >= 0; --j) if ((selmask >> j) & 1u) nsa_block(S, ql, pl, Kb, Vb, PITCH, 64 * j, t, 1 << 30, slope2, lane);
#pragma unroll
        for (int g = 0; g < 4; ++g) outv[g] += (S.a[g] / S.l[g]) / (1.0f + __expf(-bf2f(prow[C_GB + (kh * 4 + g) * 3 + 1])));
    }
    {
        NsaAcc S;
#pragma unroll
        for (int g = 0; g < 4; ++g) { S.m[g] = -INFINITY; S.l[g] = 0.f; S.a[g] = 0.f; }
        const bf16* Kb = PROJ + (size_t)b * SEQ * PITCH + C_KW + kh * 64; const bf16* Vb = PROJ + (size_t)b * SEQ * PITCH + C_VW + kh * 64;
        const int lo = t - 511 < 0 ? 0 : t - 511;
        for (int j = t >> 6; j >= (lo >> 6); --j) nsa_block(S, ql, pl, Kb, Vb, PITCH, 64 * j, t, 512, slope2, lane);
#pragma unroll
        for (int g = 0; g < 4; ++g) outv[g] += (S.a[g] / S.l[g]) / (1.0f + __expf(-bf2f(prow[C_GB + (kh * 4 + g) * 3 + 2])));
    }
#pragma unroll
    for (int g = 0; g < 4; ++g) prow[C_QB + (kh * 4 + g) * 64 + lane] = (bf16)f2bf(outv[g]);
}

__device__ __forceinline__ void p3_mixers(const Ptrs& P, LAS unsigned char* lds, int gw, int NGW, int wave, int lane) {
    LAS unsigned char* wl = lds + wave * 16384;
    for (int it = gw; it < 3 * M; it += NGW) {
        const int kind = it / M, r = it % M, b = r / SEQ, t = ((r % SEQ) + 293 * b + 1021 * kind) % SEQ;
        if (kind == 0) dsa_token(P, wl, b, t, lane);
        else nsa_token(P, wl, b, t, kind - 1, lane);
    }
}


constexpr int KT_STRIDE = 144, VT_STRIDE = 136;
constexpr int KT_BYTES = 64 * KT_STRIDE, VT_BYTES = 64 * VT_STRIDE, TILE_BYTES = KT_BYTES + VT_BYTES;
constexpr int A_TILE0 = 0, A_TILE1 = TILE_BYTES, A_STG = 36864, A_IMP = 69632, A_EFF = 102400, A_SEL = 110592;
constexpr int D_MASK = 131072, A_WSC = 139264;
constexpr int SROW = 2048;


struct TileRegs { v4u k, v; };
__device__ __forceinline__ TileRegs tile_fetch(const bf16* Kb, size_t kpitch, const bf16* Vb, size_t vpitch, int tid) {
    const int row = tid >> 3, ch = tid & 7; TileRegs r;
    r.k = *(const GAS v4u*)(Kb + (size_t)row * kpitch + ch * 8);
    r.v = *(const GAS v4u*)(Vb + (size_t)row * vpitch + ch * 8);
    return r;
}
__device__ __forceinline__ void tile_store(LAS unsigned char* buf, const TileRegs& r, int tid) {
    const int row = tid >> 3, ch = tid & 7;
    *(LAS v4u*)(buf + row * KT_STRIDE + ch * 16) = r.k;
    LAS u64* vp = (LAS u64*)(buf + KT_BYTES + row * VT_STRIDE + ch * 16);
    vp[0] = (u64)r.v.x | ((u64)r.v.y << 32); vp[1] = (u64)r.v.z | ((u64)r.v.w << 32);
}
struct AttnState { f32x16 o0, o1; pg8::u32x4 qx; float m, l; bool started; };
struct KxOps { pg8::u32x4 k0, k1; };
__device__ __forceinline__ KxOps kx_ops(int r32, int hi) {
    KxOps k; k.k0 = (pg8::u32x4){0u, 0u, 0u, 0u}; k.k1 = k.k0;
    if (hi == 0) { const unsigned v0 = f2bf((float)r32), v1 = f2bf((float)(r32 + 32)); k.k0.y = v0 * 0x10001u; k.k1.y = v1 * 0x10001u; k.k0.z = k.k0.w = k.k1.z = k.k1.w = 0x3F803F80u; }
    return k;
}
__device__ __forceinline__ void attn_init(AttnState& s, float slope2, int hi) {
#pragma unroll
    for (int r = 0; r < 16; ++r) { s.o0[r] = 0.f; s.o1[r] = 0.f; }
    s.qx = (pg8::u32x4){0u, 0u, 0u, 0u};
    if (hi == 0) { const unsigned sh = f2bf(slope2); const unsigned sl = f2bf(slope2 - __uint_as_float(sh << 16)); s.qx.x = sh | (sl << 16); s.qx.y = s.qx.x; }
    s.m = 0.f; s.l = 0.f; s.started = false;
}
__device__ __forceinline__ bf16x8 pack8(const f32x16& p, int b0) {
    pg8::u32x4 w; w.x = pg8::cvt_pk_bf16(p[b0], p[b0 + 1]); w.y = pg8::cvt_pk_bf16(p[b0 + 2], p[b0 + 3]); w.z = pg8::cvt_pk_bf16(p[b0 + 4], p[b0 + 5]); w.w = pg8::cvt_pk_bf16(p[b0 + 6], p[b0 + 7]);
    return __builtin_bit_cast(bf16x8, w);
}
constexpr float ATT_THR = 8.0f;
template <bool BITS, bool IMP, bool QLDS>
__device__ __forceinline__ void tile_compute(AttnState& st, const bf16x8 (&qf)[4], LAS const unsigned char* qlds, KxOps& KX, float koff, bool active, bool all_active, LAS const unsigned char* buf, LAS float* wsc,
                                             bool need_mask, int lo, int hi_, unsigned mw0, unsigned mw1, f32x16& oimp, int c0, int r32, int hi) {
    f32x16 p0, p1;
    { const unsigned kw = (hi == 0) ? f2bf(koff) * 0x10001u : 0u; KX.k0.x = kw; KX.k1.x = kw;
      pg8::u32x4 q = st.qx; if (!all_active) q.w = (q.w & 0xffffu) | ((active || hi != 0) ? 0u : 0xff800000u);
#pragma unroll
      for (int r = 0; r < 16; ++r) { p0[r] = 0.f; p1[r] = 0.f; }
      p0 = __builtin_amdgcn_mfma_f32_32x32x16_bf16(__builtin_bit_cast(bf16x8, KX.k0), __builtin_bit_cast(bf16x8, q), p0, 0, 0, 0);
      p1 = __builtin_amdgcn_mfma_f32_32x32x16_bf16(__builtin_bit_cast(bf16x8, KX.k1), __builtin_bit_cast(bf16x8, q), p1, 0, 0, 0); }
    { LAS const unsigned char* kp = buf + r32 * KT_STRIDE + hi * 16;
#pragma unroll
      for (int ds = 0; ds < 4; ++ds) {
          const bf16x8 k0 = *(LAS const bf16x8*)(kp + ds * 32);
          const bf16x8 k1 = *(LAS const bf16x8*)(kp + 32 * KT_STRIDE + ds * 32);
          const bf16x8 qv = QLDS ? *(LAS const bf16x8*)(qlds + (((2 * ds + hi) ^ (r32 & 7)) * 16)) : qf[ds];
          p0 = __builtin_amdgcn_mfma_f32_32x32x16_bf16(k0, qv, p0, 0, 0, 0);
          p1 = __builtin_amdgcn_mfma_f32_32x32x16_bf16(k1, qv, p1, 0, 0, 0); } }
    if (BITS) { const unsigned w0 = mw0 >> (4 * hi), w1 = mw1 >> (4 * hi);
#pragma unroll
        for (int r = 0; r < 16; ++r) { const int c = (r & 3) + 8 * (r >> 2); if (!((w0 >> c) & 1u)) p0[r] = -INFINITY; if (!((w1 >> c) & 1u)) p1[r] = -INFINITY; } }
    else if (need_mask) { const int lo2 = lo - 4 * hi, hi2 = hi_ - 4 * hi;
#pragma unroll
        for (int r = 0; r < 16; ++r) { const int c = (r & 3) + 8 * (r >> 2); if (c < lo2 || c > hi2) p0[r] = -INFINITY; if (c + 32 < lo2 || c + 32 > hi2) p1[r] = -INFINITY; } }
    float rm = fmaxf(p0[0], p1[0]);
#pragma unroll
    for (int r = 1; r < 16; ++r) rm = fmaxf(rm, fmaxf(p0[r], p1[r]));
    rm = xhalf_max(rm);
    const bool need = st.started ? (rm > ATT_THR) : (rm > -INFINITY);
    if (__any(need)) {
        const float dl = need ? rm : 0.f; const float f = st.started ? __builtin_amdgcn_exp2f(-dl) : 1.0f;
        st.m += dl; st.l *= f; st.started = st.started || need;
        { const float nm = -st.m; const unsigned m1 = f2bf(nm); const float r1 = nm - __uint_as_float(m1 << 16); const unsigned m2 = f2bf(r1); const float r2 = r1 - __uint_as_float(m2 << 16); const unsigned m3 = f2bf(r2);
          if (hi == 0) { st.qx.z = m1 | (m2 << 16); st.qx.w = m3; } }
#pragma unroll
        for (int r = 0; r < 16; ++r) { p0[r] -= dl; p1[r] -= dl; }
        if (hi == 0) wsc[r32] = f;
        LDS_WAIT();
#pragma unroll
        for (int a = 0; a < 4; ++a) { const f32x4 av = *(LAS const f32x4*)(wsc + 8 * a + 4 * hi);
#pragma unroll
            for (int i = 0; i < 4; ++i) { st.o0[4 * a + i] *= av[i]; st.o1[4 * a + i] *= av[i]; if (IMP) oimp[4 * a + i] *= av[i]; } }
        LDS_WAIT();
    }
    float ps = 0.f;
#pragma unroll
    for (int r = 0; r < 16; ++r) { p0[r] = __builtin_amdgcn_exp2f(p0[r]); p1[r] = __builtin_amdgcn_exp2f(p1[r]); ps += p0[r] + p1[r]; }
    st.l += ps;
    bf16x8 pa[4]; pa[0] = pack8(p0, 0); pa[1] = pack8(p0, 8); pa[2] = pack8(p1, 0); pa[3] = pack8(p1, 8);
    { LAS const unsigned char* vp = buf + KT_BYTES + r32 * VT_STRIDE + hi * 8;
#pragma unroll
      for (int s = 0; s < 4; ++s) {
          u64x2 x0, x1; x0[0] = *(LAS const u64*)(vp + s * 32); x0[1] = *(LAS const u64*)(vp + s * 32 + 16);
          x1[0] = *(LAS const u64*)(vp + 32 * VT_STRIDE + s * 32); x1[1] = *(LAS const u64*)(vp + 32 * VT_STRIDE + s * 32 + 16);
          st.o0 = __builtin_amdgcn_mfma_f32_32x32x16_bf16(pa[s], __builtin_bit_cast(bf16x8, x0), st.o0, 0, 0, 0);
          st.o1 = __builtin_amdgcn_mfma_f32_32x32x16_bf16(pa[s], __builtin_bit_cast(bf16x8, x1), st.o1, 0, 0, 0); } }
    if (IMP) {
#pragma unroll
        for (int s = 0; s < 4; ++s) { bf16x8 ov;
#pragma unroll
            for (int e = 0; e < 8; ++e) { const int c = c0 + 16 * s + 8 * (e >> 2) + 4 * hi + (e & 3); ov[e] = (c >= 4 * r32 - 1 && c <= 4 * r32 + 3) ? (short)0x3F80 : (short)0; }
            oimp = __builtin_amdgcn_mfma_f32_32x32x16_bf16(pa[s], ov, oimp, 0, 0, 0); } }
}
__device__ __forceinline__ void attn_accum(f32x16& out0, f32x16& out1, const AttnState& st, float fac, LAS float* wsc, int r32, int hi) {
    if (hi == 0) wsc[r32] = fac;
    LDS_WAIT();
#pragma unroll
    for (int a = 0; a < 4; ++a) { const f32x4 av = *(LAS const f32x4*)(wsc + 8 * a + 4 * hi);
#pragma unroll
        for (int i = 0; i < 4; ++i) { out0[4 * a + i] += st.o0[4 * a + i] * av[i]; out1[4 * a + i] += st.o1[4 * a + i] * av[i]; } }
    LDS_WAIT();
}
__device__ __forceinline__ void store_tile_bf16(const f32x16& out0, const f32x16& out1, LAS bf16* stg, bf16* dst, size_t pitch, int lane, int r32, int hi) {
#pragma unroll
    for (int r = 0; r < 16; ++r) { const int q = (r & 3) + 8 * (r >> 2) + 4 * hi; stg[q * 64 + r32] = (bf16)f2bf(out0[r]); stg[q * 64 + 32 + r32] = (bf16)f2bf(out1[r]); }
    LDS_WAIT();
#pragma unroll
    for (int i = 0; i < 4; ++i) { const int row = i * 8 + (lane >> 3), ch = lane & 7; const v4u v = *(LAS const v4u*)(stg + row * 64 + ch * 8); *(GAS v4u*)(dst + (size_t)row * pitch + ch * 8) = v; }
    LDS_WAIT();
}


#define TILE_PIPELINE(FIRST, AFTER, FETCH, COMPUTE) do { \
        int jc_ = (FIRST); int jn_ = AFTER(jc_); int jnn_; TileRegs rA_ = FETCH(jc_), rB_; \
        tile_store(buf0, rA_, tid); if (jn_ >= 0) rB_ = FETCH(jn_); \
        __syncthreads(); \
        for (;;) { \
            jnn_ = jn_ >= 0 ? AFTER(jn_) : -1; if (jnn_ >= 0) rA_ = FETCH(jnn_); \
            COMPUTE(jc_, buf0); \
            if (jn_ < 0) break; \
            tile_store(buf1, rB_, tid); __syncthreads(); jc_ = jn_; jn_ = jnn_; \
            jnn_ = jn_ >= 0 ? AFTER(jn_) : -1; if (jnn_ >= 0) rB_ = FETCH(jnn_); \
            COMPUTE(jc_, buf1); \
            if (jn_ < 0) break; \
            tile_store(buf0, rA_, tid); __syncthreads(); jc_ = jn_; jn_ = jnn_; \
        } } while (0)
__device__ __forceinline__ void nsa_unit(const Ptrs& P, LAS unsigned char* lds, int b, int kh, int qb, int tid, int wave, int lane) {
    asm volatile("" : "+v"(tid), "+v"(lane));
    const int r32 = lane & 31, hi = lane >> 5, g = wave & 3, th = wave >> 2;
    bf16* PROJ = (bf16*)(P.ws + WS_PROJ);
    unsigned char* dob = (unsigned char*)P.out;
    const bf16* KCb = (const bf16*)(dob + DO_KC) + (size_t)(b * 2 + kh) * 128 * 64; const bf16* VCTb = (const bf16*)(dob + DO_VCT) + (size_t)(b * 2 + kh) * 64 * 128;
    const bf16* VSTb = (const bf16*)(dob + DO_VST) + (size_t)(b * 2 + kh) * 64 * SEQ; const bf16* VWTb = (const bf16*)(dob + DO_VWT) + (size_t)(b * 2 + kh) * 64 * SEQ;
    LAS unsigned char* buf0 = lds + A_TILE0; LAS unsigned char* buf1 = lds + A_TILE1;
    LAS float* wsc = (LAS float*)(lds + A_WSC) + wave * 64;
    LAS float* impL = (LAS float*)(lds + A_IMP); LAS float* effL = (LAS float*)(lds + A_EFF); LAS unsigned* selL = (LAS unsigned*)(lds + A_SEL);
    const int tq = 64 * qb + 32 * th + r32;
    const bf16* prow = PROJ + (size_t)(b * SEQ + tq) * PITCH;
    const float slope2 = exp2f(-(float)(kh * 4 + g + 1)) * LOG2E;
    bf16x8 qf[4];
#pragma unroll
    for (int ds = 0; ds < 4; ++ds) qf[ds] = *(const GAS bf16x8*)(prow + C_QB + (kh * 4 + g) * 64 + ds * 16 + hi * 8);
    KxOps KX = kx_ops(r32, hi);
    LAS unsigned char* qlds = lds + A_STG + wave * 4096 + r32 * 128;
#pragma unroll
    for (int ds = 0; ds < 4; ++ds) *(LAS bf16x8*)(qlds + (((2 * ds + hi) ^ (r32 & 7)) * 16)) = qf[ds];
    const float g0 = pg8::sigm(bf2f(prow[C_GB + (kh * 4 + g) * 3 + 0])), g1 = pg8::sigm(bf2f(prow[C_GB + (kh * 4 + g) * 3 + 1])), g2 = pg8::sigm(bf2f(prow[C_GB + (kh * 4 + g) * 3 + 2]));
    f32x16 out0, out1, oimp;
#pragma unroll
    for (int r = 0; r < 16; ++r) { out0[r] = 0.f; out1[r] = 0.f; oimp[r] = 0.f; }
    AttnState st;
    {
        TileRegs tr = tile_fetch(KCb, 64, VCTb, 128, tid); tile_store(buf0, tr, tid);
        tr = tile_fetch(KCb + 64 * 64, 64, VCTb + 64, 128, tid); tile_store(buf1, tr, tid);
        if (tid < 64) selL[tid] = 0u;
        __syncthreads();
        attn_init(st, 0.f, hi);
        const int hc = (tq - 31) >> 4;
#pragma unroll 1
        for (int ct = 0; ct < 2; ++ct) { tile_compute<false, true, true>(st, qf, qlds, KX, 0.f, true, true, ct ? buf1 : buf0, wsc, true, -(1 << 20), hc - 64 * ct, 0u, 0u, oimp, 64 * ct, r32, hi); __builtin_amdgcn_sched_barrier(0); }
        const float lt = xhalf_sum(st.l); const float linv = lt > 0.f ? 1.0f / lt : 0.f;
        attn_accum(out0, out1, st, linv * g0, wsc, r32, hi);
        if (hi == 0) wsc[r32] = linv;
        LDS_WAIT();
#pragma unroll
        for (int a = 0; a < 4; ++a) { const f32x4 av = *(LAS const f32x4*)(wsc + 8 * a + 4 * hi);
#pragma unroll
            for (int i = 0; i < 4; ++i) { const int q = 8 * a + 4 * hi + i; impL[(wave * 32 + q) * 32 + r32] = oimp[4 * a + i] * av[i]; } }
        LDS_WAIT();
        __syncthreads();
        const int tk = tid >> 3, th2 = tk >> 5, q2 = tk & 31, sub = tid & 7;
        float e[4];
#pragma unroll
        for (int i = 0; i < 4; ++i) { const int j = sub * 4 + i; float imp = 0.f;
#pragma unroll
            for (int g2 = 0; g2 < 4; ++g2) imp += impL[((th2 * 4 + g2) * 32 + q2) * 32 + j];
            const bool forced = (j == 0) || (j == qb) || (j == qb - 1);
            e[i] = (j > qb) ? -INFINITY : (imp + (forced ? 1e6f : 0.f)); effL[tk * 32 + j] = e[i]; }
        __syncthreads();
        int rank[4] = {0, 0, 0, 0};
#pragma unroll 1
        for (int jp = 0; jp < 32; ++jp) { const float e2 = effL[tk * 32 + jp];
#pragma unroll
            for (int i = 0; i < 4; ++i) rank[i] += (e2 > e[i] || (e2 == e[i] && jp < sub * 4 + i)) ? 1 : 0; }
        unsigned bits = 0u;
#pragma unroll
        for (int i = 0; i < 4; ++i) if (rank[i] < 16 && sub * 4 + i <= qb) bits |= 1u << (sub * 4 + i);
        if (bits) __hip_atomic_fetch_or(selL + tk, bits, __ATOMIC_RELAXED, __HIP_MEMORY_SCOPE_WORKGROUP);
        __syncthreads();
    }
    unsigned U = 0u;
#pragma unroll
    for (int k = 0; k < 16; ++k) { const v4u w = *(LAS const v4u*)(selL + 4 * k); U |= (w.x | w.y) | (w.z | w.w); }
    U = __builtin_amdgcn_readfirstlane(U);
    const unsigned msk = selL[32 * th + r32];
    {
        const bf16* Kb = PROJ + (size_t)b * SEQ * PITCH + C_KS + kh * 64;
        attn_init(st, slope2, hi);
#define SEL_AFTER(j) ((U & ((1u << (j)) - 1u)) ? 31 - __builtin_clz(U & ((1u << (j)) - 1u)) : -1)
#define SEL_FETCH(j) tile_fetch(Kb + (size_t)(64 * (j)) * PITCH, PITCH, VSTb + 64 * (j), SEQ, tid)
#define SEL_COMPUTE(j, buf) { const bool rowsel = (msk >> (j)) & 1u; const int dq = tq - 64 * (j); \
            if (__any(rowsel)) tile_compute<false, false, true>(st, qf, qlds, KX, (float)(64 * (j)), rowsel, __all(rowsel) != 0, buf, wsc, (j) == qb, -(1 << 20), dq, 0u, 0u, oimp, 0, r32, hi); }
        TILE_PIPELINE(31 - __builtin_clz(U), SEL_AFTER, SEL_FETCH, SEL_COMPUTE);
#undef SEL_AFTER
#undef SEL_FETCH
#undef SEL_COMPUTE
        const float lt = xhalf_sum(st.l);
        attn_accum(out0, out1, st, g1 / lt, wsc, r32, hi);
        __syncthreads();
    }
    {
        const bf16* Kb = PROJ + (size_t)b * SEQ * PITCH + C_KW + kh * 64;
        attn_init(st, slope2, hi);
        const int jlo = qb - 8 < 0 ? 0 : qb - 8;
#define WIN_AFTER(j) ((j) > jlo ? (j) - 1 : -1)
#define WIN_FETCH(j) tile_fetch(Kb + (size_t)(64 * (j)) * PITCH, PITCH, VWTb + 64 * (j), SEQ, tid)
#define WIN_COMPUTE(j, buf) { const int dq = tq - 64 * (j); \
            tile_compute<false, false, true>(st, qf, qlds, KX, (float)(64 * (j)), true, true, buf, wsc, ((j) == qb) || ((j) == qb - 8), dq - 511, dq, 0u, 0u, oimp, 0, r32, hi); }
        TILE_PIPELINE(qb, WIN_AFTER, WIN_FETCH, WIN_COMPUTE);
#undef WIN_AFTER
#undef WIN_FETCH
#undef WIN_COMPUTE
        const float lt = xhalf_sum(st.l);
        attn_accum(out0, out1, st, g2 / lt, wsc, r32, hi);
    }
    store_tile_bf16(out0, out1, (LAS bf16*)(lds + A_STG) + wave * 2048, (bf16*)(dob + DO_O) + (size_t)(b * SEQ + 64 * qb + 32 * th) * DM + 512 + (kh * 4 + g) * 64, DM, lane, r32, hi);
    __syncthreads();
}


__device__ __forceinline__ void dsa_unit(const Ptrs& P, LAS unsigned char* lds, int b, int ti, int tid, int wave, int lane) {
    asm volatile("" : "+v"(tid), "+v"(lane));
    const int r32 = lane & 31, hi = lane >> 5, fr = lane & 15, fq = lane >> 4;
    bf16* PROJ = (bf16*)(P.ws + WS_PROJ);
    unsigned char* dob = (unsigned char*)P.out;
    const bf16* Kb = (const bf16*)(dob + DO_KA) + (size_t)b * SEQ * 64; const bf16* VTb = (const bf16*)(dob + DO_VAT) + (size_t)b * 64 * SEQ;
    const bf16* PB = PROJ + (size_t)b * SEQ * PITCH;
    LAS float* scL = (LAS float*)lds; LAS unsigned* maskL = (LAS unsigned*)(lds + D_MASK);
    LAS float* wsc = (LAS float*)(lds + A_WSC) + wave * 64;
    const int t0 = 32 * ti;
    const u64 ltm = (1ull << lane) - 1ull;
    for (int half_ = 0; half_ < 2 * PROBE_DPRE; ++half_) {
        const int half = half_ & 1;
        const int th0 = t0 + 16 * half; const int ntile = (th0 >> 4) + 1;
        {
            bf16x8 qa[8];
            const bf16* qrow = PB + (size_t)(th0 + fr) * PITCH + C_QI + fq * 8;
#pragma unroll
            for (int hh = 0; hh < 8; ++hh) qa[hh] = *(const GAS bf16x8*)(qrow + hh * 32);
            float wv[4][8];
#pragma unroll
            for (int i = 0; i < 4; ++i) { const v4u w = *(const GAS v4u*)(PB + (size_t)(th0 + 4 * fq + i) * PITCH + C_WI); unpack8(w, wv[i]); }
            const bf16* kbase = PB + (size_t)fr * PITCH + C_KI + fq * 8;
            bf16x8 kbn[4];
#pragma unroll
            for (int q4 = 0; q4 < 4; ++q4) { int kt = wave + 8 * q4; kt = kt < ntile ? kt : ntile - 1; kbn[q4] = *(const GAS bf16x8*)(kbase + (size_t)(16 * kt) * PITCH); }
            for (int rep_ = 0; rep_ < PROBE_DIDX; ++rep_)
            for (int kt0 = wave; kt0 < ntile; kt0 += 32) {
                bf16x8 kbc[4];
#pragma unroll
                for (int q4 = 0; q4 < 4; ++q4) kbc[q4] = kbn[q4];
                if (kt0 + 32 < ntile) {
#pragma unroll
                    for (int q4 = 0; q4 < 4; ++q4) { int kt = kt0 + 32 + 8 * q4; kt = kt < ntile ? kt : ntile - 1; kbn[q4] = *(const GAS bf16x8*)(kbase + (size_t)(16 * kt) * PITCH); } }
#pragma unroll
                for (int q4 = 0; q4 < 4; ++q4) { const int kt = kt0 + 8 * q4;
                    if (kt < ntile) {
                        float sc[4] = {0.f, 0.f, 0.f, 0.f};
#pragma unroll
                        for (int hh = 0; hh < 8; ++hh) { f32x4 acc = {0.f, 0.f, 0.f, 0.f}; acc = __builtin_amdgcn_mfma_f32_16x16x32_bf16(qa[hh], kbc[q4], acc, 0, 0, 0);
#pragma unroll
                            for (int i = 0; i < 4; ++i) sc[i] += fmaxf(acc[i], 0.f) * wv[i][hh]; }
#pragma unroll
                        for (int i = 0; i < 4; ++i) scL[(4 * fq + i) * SROW + 16 * kt + fr] = sc[i] + 0.0f;
                    } }
            }
        }
        __syncthreads();
        for (int rr_ = 0; rr_ < 2 * PROBE_DTHR; ++rr_) {
            const int rr = rr_ & 1;
            const int row = 2 * wave + rr; const int t = th0 + row; const int nch = (t >> 6) + 1;
            unsigned u[32];
#pragma unroll
            for (int i = 0; i < 32; ++i) { const int s = lane + 64 * i; u[i] = 0u; if (s <= t) u[i] = ord_u32(scL[row * SROW + s]); }
            LAS unsigned* mrow = maskL + (16 * half + row) * 64;
            const bool big = (t + 1 > TOPK);
            unsigned T = 1u; bool exact = true;
            if (big) {
                unsigned vmx = 0u, vmn = 0xffffffffu;
#pragma unroll
                for (int i = 0; i < 32; ++i) { vmx = vmx > u[i] ? vmx : u[i]; const unsigned w = u[i] ? u[i] : 0xffffffffu; vmn = vmn < w ? vmn : w; }
                unsigned lo = wave_umin(vmn), hi = wave_umax(vmx) + 1u; int clo = t + 1, chi = 0;
                exact = false;
#define DSA_CNT8(g) { u64 m0, m1, m2, m3, m4, m5, m6, m7; \
                    asm volatile("v_cmp_ge_u32_e64 %0, %1, %2" : "=s"(m0) : "v"(u[8 * (g) + 0]), "v"(c)); asm volatile("v_cmp_ge_u32_e64 %0, %1, %2" : "=s"(m1) : "v"(u[8 * (g) + 1]), "v"(c)); \
                    asm volatile("v_cmp_ge_u32_e64 %0, %1, %2" : "=s"(m2) : "v"(u[8 * (g) + 2]), "v"(c)); asm volatile("v_cmp_ge_u32_e64 %0, %1, %2" : "=s"(m3) : "v"(u[8 * (g) + 3]), "v"(c)); \
                    asm volatile("v_cmp_ge_u32_e64 %0, %1, %2" : "=s"(m4) : "v"(u[8 * (g) + 4]), "v"(c)); asm volatile("v_cmp_ge_u32_e64 %0, %1, %2" : "=s"(m5) : "v"(u[8 * (g) + 5]), "v"(c)); \
                    asm volatile("v_cmp_ge_u32_e64 %0, %1, %2" : "=s"(m6) : "v"(u[8 * (g) + 6]), "v"(c)); asm volatile("v_cmp_ge_u32_e64 %0, %1, %2" : "=s"(m7) : "v"(u[8 * (g) + 7]), "v"(c)); \
                    int c0, c1, c2, c3, c4, c5, c6, c7; \
                    asm volatile("s_bcnt1_i32_b64 %0, %1" : "=s"(c0) : "s"(m0) : "scc"); asm volatile("s_bcnt1_i32_b64 %0, %1" : "=s"(c1) : "s"(m1) : "scc"); asm volatile("s_bcnt1_i32_b64 %0, %1" : "=s"(c2) : "s"(m2) : "scc"); asm volatile("s_bcnt1_i32_b64 %0, %1" : "=s"(c3) : "s"(m3) : "scc"); \
                    asm volatile("s_bcnt1_i32_b64 %0, %1" : "=s"(c4) : "s"(m4) : "scc"); asm volatile("s_bcnt1_i32_b64 %0, %1" : "=s"(c5) : "s"(m5) : "scc"); asm volatile("s_bcnt1_i32_b64 %0, %1" : "=s"(c6) : "s"(m6) : "scc"); asm volatile("s_bcnt1_i32_b64 %0, %1" : "=s"(c7) : "s"(m7) : "scc"); \
                    cnt_ += ((c0 + c1) + (c2 + c3)) + ((c4 + c5) + (c6 + c7)); }
#define DSA_COUNT(res, cv) { const unsigned c = (cv); int cnt_ = 0; if (nch <= 16) { DSA_CNT8(0) DSA_CNT8(1) } else { DSA_CNT8(0) DSA_CNT8(1) DSA_CNT8(2) DSA_CNT8(3) } res = cnt_; }
                if (hi - lo > 64u) {
                    LAS unsigned* hist = (LAS unsigned*)wsc; const unsigned lo0 = lo, hi0 = hi;
                    const float fmin = inv_ord_u32(lo0), fmax = inv_ord_u32(hi0 - 1u); const float scale = 64.0f / fmaxf(fmax - fmin, 1e-30f);
                    hist[lane] = 0u;
                    LDS_WAIT();
#pragma unroll
                    for (int i = 0; i < 32; ++i) if (u[i]) { int bk = (int)((inv_ord_u32(u[i]) - fmin) * scale); bk = bk > 63 ? 63 : bk; __hip_atomic_fetch_add(hist + bk, 1u, __ATOMIC_RELAXED, __HIP_MEMORY_SCOPE_WORKGROUP); }
                    LDS_WAIT();
                    unsigned hv = hist[lane];
#pragma unroll
                    for (int o = 1; o < 64; o <<= 1) { const unsigned tt = (unsigned)__builtin_amdgcn_ds_bpermute(((lane + o) & 63) << 2, (int)hv); hv += (lane + o < 64) ? tt : 0u; }
                    const u64 bal = __ballot(hv >= (unsigned)TOPK);
                    const int bs = 63 - __builtin_clzll(bal | 1ull);
                    const float wdt = (fmax - fmin) * (1.0f / 64.0f);
                    unsigned l1 = ord_u32(fmin + (float)bs * wdt), h1 = ord_u32(fmin + (float)(bs + 1) * wdt);
                    l1 = l1 < lo0 ? lo0 : l1; h1 = h1 > hi0 ? hi0 : h1;
                    l1 = __builtin_amdgcn_readfirstlane(l1); h1 = __builtin_amdgcn_readfirstlane(h1);
                    if (l1 > lo0 && l1 < hi0) { int cl; DSA_COUNT(cl, l1) if (cl >= TOPK) { lo = l1; clo = cl; } else { hi = l1; chi = cl; } }
                    if (h1 > lo && h1 < hi) { int ch; DSA_COUNT(ch, h1) if (ch >= TOPK) { lo = h1; clo = ch; } else { hi = h1; chi = ch; } }
                    LDS_WAIT();
                }
                for (int it = 0; ; ++it) {
                    if (clo == TOPK) { exact = true; break; }
                    if (hi - lo <= 1u) break;
                    unsigned cq;
                    if (it % 3 == 2) cq = lo + ((hi - lo) >> 1);
                    else { const float flo = inv_ord_u32(lo), fhi = inv_ord_u32(hi); const float frac = ((float)(clo - TOPK) - 0.5f) / (float)(clo - chi); cq = ord_u32(flo + (fhi - flo) * frac); }
                    cq = cq <= lo ? lo + 1u : cq; cq = cq >= hi ? hi - 1u : cq;
                    cq = __builtin_amdgcn_readfirstlane(cq);
                    int cnt; DSA_COUNT(cnt, cq)
                    if (cnt >= TOPK) { lo = cq; clo = cnt; } else { hi = cq; chi = cnt; }
                }
#undef DSA_COUNT
#undef DSA_CNT8
                T = lo;
            }
            if (exact) {
                unsigned wlo = 0u, whi = 0u;
#pragma unroll
                for (int i = 0; i < 32; ++i) { const u64 mt = __ballot(u[i] >= T); wlo = (lane == i) ? (unsigned)mt : wlo; whi = (lane == i) ? (unsigned)(mt >> 32) : whi; }
                if (lane < 32) { mrow[2 * lane] = wlo; mrow[2 * lane + 1] = whi; }
            } else {
                int cg = 0;
#pragma unroll
                for (int i = 0; i < 32; ++i) cg += __popcll(__ballot(u[i] > T));
                const int need = TOPK - cg; int ties = 0;
#pragma unroll
                for (int i = 0; i < 32; ++i) {
                    const bool gt = u[i] > T; const bool eq = u[i] == T;
                    const u64 meq = __ballot(eq); const int myrank = ties + __popcll(meq & ltm); const bool take = gt || (eq && myrank < need); ties += __popcll(meq);
                    const u64 mt = __ballot(take);
                    if (lane == 0) { mrow[2 * i] = (unsigned)mt; mrow[2 * i + 1] = (unsigned)(mt >> 32); }
                }
            }
        }
        __syncthreads();
    }
    const int tq = t0 + r32; const int h = wave;
    const bf16* prow = PB + (size_t)tq * PITCH;
    bf16x8 qf[4];
#pragma unroll
    for (int ds = 0; ds < 4; ++ds) qf[ds] = *(const GAS bf16x8*)(prow + C_QA + h * 64 + ds * 16 + hi * 8);
    const float slope2 = exp2f(-(float)(h + 1)) * LOG2E;
    KxOps KX = kx_ops(r32, hi);
    LAS unsigned char* buf0 = lds + A_TILE0; LAS unsigned char* buf1 = lds + A_TILE1;
    AttnState st;
    f32x16 dummy;
#pragma unroll
    for (int r = 0; r < 16; ++r) dummy[r] = 0.f;
    for (int rep = 0; rep < PROBE_DATT; ++rep) {
    attn_init(st, slope2, hi);
#define DSA_AFTER(j) ((j) - 1)
#define DSA_FETCH(j) tile_fetch(Kb + (size_t)(64 * (j)) * 64, 64, VTb + 64 * (j), SEQ, tid)
#define DSA_COMPUTE(j, buf) { const unsigned mw0 = maskL[r32 * 64 + 2 * (j)], mw1 = maskL[r32 * 64 + 2 * (j) + 1]; \
        tile_compute<true, false, false>(st, qf, nullptr, KX, (float)(64 * (j)), true, true, buf, wsc, false, 0, 0, mw0, mw1, dummy, 0, r32, hi); }
    TILE_PIPELINE((t0 + 31) >> 6, DSA_AFTER, DSA_FETCH, DSA_COMPUTE);
#undef DSA_AFTER
#undef DSA_FETCH
#undef DSA_COMPUTE
    __syncthreads();
    }
    const float lt = xhalf_sum(st.l);
    f32x16 out0, out1;
#pragma unroll
    for (int r = 0; r < 16; ++r) { out0[r] = 0.f; out1[r] = 0.f; }
    attn_accum(out0, out1, st, 1.0f / lt, wsc, r32, hi);
    __syncthreads();
    store_tile_bf16(out0, out1, (LAS bf16*)(lds + A_STG) + wave * 2048, (bf16*)(dob + DO_O) + (size_t)(b * SEQ + t0) * DM + h * 64, DM, lane, r32, hi);
    __syncthreads();
}

__device__ __forceinline__ void p3_fast(const Ptrs& P, LAS unsigned char* lds, int vcu, int G, int tid, int wave, int lane) {
    for (int u = vcu; u < 256; u += G) {
        for (int k = 0; k < 2; ++k) { const int b = u >> 5, p = u & 31; dsa_unit(P, lds, b, k ? p : 63 - p, tid, wave, lane); }
        for (int k = 0; k < 2 * PROBE_NSA; ++k) { const int b = u >> 5, kh = (u >> 4) & 1, p = u & 15; nsa_unit(P, lds, b, kh, (k & 1) ? p : 31 - p, tid, wave, lane); }
    }
}

struct Args { Ptrs p; };
__global__ void __launch_bounds__(NWAVES * 64, 2) fwd_kernel(Args args) {
    extern __shared__ __attribute__((aligned(16))) unsigned char lds_raw[];
    LAS unsigned char* lds = (LAS unsigned char*)lds_raw;
    const Ptrs& P = args.p;
    const int tid = threadIdx.x, lane = tid & 63, wave = __builtin_amdgcn_readfirstlane(tid >> 6);
    const int G = gridDim.x; const int bx = blockIdx.x; const int vcu = (G % 8 == 0) ? (bx % 8) * (G / 8) + bx / 8 : bx;
    const int gw = vcu * NWAVES + wave, NGW = G * NWAVES;
    volatile LAS unsigned* MISC = (volatile LAS unsigned*)(lds + MISC_OFF);
    for (int u = tid; u < (LDS_BYTES - RING_BYTES) / 4; u += NWAVES * 64) ((LAS unsigned*)(lds + RING_BYTES))[u] = 0u;
    __syncthreads();
    unsigned* ctl = (unsigned*)(P.ws + WS_CTL);
    XcdBarrier bar = xcd_barrier_post(ctl + CW_BAR, MISC + 8);

    bf16* H = (bf16*)((unsigned char*)P.out + DO_H);
    bf16* PROJ = (bf16*)(P.ws + WS_PROJ); bf16* HID = (bf16*)(P.ws + WS_PROJ);
    bf16* MERGED = (bf16*)(P.ws + WS_MERGED); bf16* X1B = (bf16*)(P.ws + WS_X1B); float* PARTS = (float*)(P.ws + WS_PARTS);

    for (int rep = 0; rep < PROBE_P0; ++rep) p0_prologue(P, lds, gw, NGW, wave, lane);
    xcd_barrier(bar);
    for (int rep = 0; rep < PROBE_P1; ++rep) {
        pg8::Gemm g{H, (const bf16*)(P.ws + WS_WIN), M, PITCH, DM, DM}; pg8::StaticOrder S; S.init(M, PITCH, G, bx);
        pg8::EpiProj E{PROJ, PITCH, P.in[3], P.in[8], P.in[10], P.in[11], (bf16*)((unsigned char*)P.out + DO_VST), (bf16*)((unsigned char*)P.out + DO_VWT), QSCALE, RMS_EPS, SEQ};
        pg8::gemm_phase<pg8::EpiProj, pg8::StaticOrder, true>(lds, g, S, E);
    }
    xcd_barrier(bar);
    for (int rep = 0; rep < PROBE_P2; ++rep) p2_fast(P, lds, vcu, G, tid, wave, lane);
    xcd_barrier(bar);
    for (int rep = 0; rep < PROBE_P3; ++rep) p3_fast(P, lds, vcu, G, tid, wave, lane);
    xcd_barrier(bar);
    for (int rep = 0; rep < PROBE_P4; ++rep) {
        pg8::StaticOrder S; S.init(M, DM, G, bx);
        const bf16* OB = (const bf16*)((unsigned char*)P.out + DO_O);
        pg8::Gemm g{OB, (const bf16*)(P.ws + WS_WUPA), M, DM, DM, DM}; pg8::EpiGate2 E{MERGED, DM, PROJ, PITCH, C_GM, C_GM + DM};
        pg8::gemm_phase<pg8::EpiGate2, pg8::StaticOrder, false>(lds, g, S, E);
    }
    xcd_barrier(bar);
    for (int rep = 0; rep < PROBE_P5; ++rep) {
        pg8::Gemm g{MERGED, (const bf16*)(P.ws + WS_WOUT), M, DM, DM, DM}; pg8::StaticOrder S; S.init(M, DM, G, bx);
        pg8::EpiOutRes E{P.in[0], P.out, X1B, DM, PARTS};
        pg8::gemm_phase<pg8::EpiOutRes, pg8::StaticOrder, false>(lds, g, S, E);
    }
    xcd_barrier(bar);
    for (int rep = 0; rep < PROBE_P6; ++rep) {
        pg8::Gemm g{X1B, (const bf16*)(P.ws + WS_WFF1), M, FF, DM, DM}; pg8::StaticOrder S; S.init(M, FF, G, bx);
        pg8::EpiRelu2 E{HID, FF, PARTS, RMS_EPS, 1.0f / DM};
        pg8::gemm_phase<pg8::EpiRelu2, pg8::StaticOrder, true>(lds, g, S, E);
    }
    xcd_barrier(bar);
    {
        pg8::Gemm g{HID, (const bf16*)(P.ws + WS_WFF2), M, DM, FF, FF}; pg8::StaticOrder S; S.init(M, DM, G, bx);
        pg8::EpiFinal E{P.out, DM};
        pg8::gemm_phase<pg8::EpiFinal, pg8::StaticOrder, false>(lds, g, S, E);
    }
}

extern "C" void kernel_launch(void* const* d_in, const int* in_sizes, int n_in, void* d_out, int out_size, void* d_ws, size_t ws_size, hipStream_t stream) {
    static int grid = 0;
    if (grid == 0) {
        if (n_in != 23 || in_sizes[0] != M * DM || out_size != M * DM || ws_size < WS_END) { fprintf(stderr, "kernel_launch: unexpected shapes (n_in %d, in0 %d, out %d, ws %zu)\n", n_in, n_in > 0 ? in_sizes[0] : -1, out_size, ws_size); grid = -1; return; }
        int dev = 0, cus = 0, per_cu = 0;
        if (hipGetDevice(&dev) != hipSuccess || hipDeviceGetAttribute(&cus, hipDeviceAttributeMultiprocessorCount, dev) != hipSuccess) { grid = -1; return; }
        if (hipFuncSetAttribute((const void*)fwd_kernel, hipFuncAttributeMaxDynamicSharedMemorySize, LDS_BYTES) != hipSuccess) { fprintf(stderr, "kernel_launch: hipFuncSetAttribute failed\n"); grid = -1; return; }
        if (hipOccupancyMaxActiveBlocksPerMultiprocessor(&per_cu, (const void*)fwd_kernel, NWAVES * 64, LDS_BYTES) != hipSuccess || per_cu < 1) { fprintf(stderr, "kernel_launch: occupancy query reports %d blocks per CU\n", per_cu); }
        (void)hipGetLastError();
        grid = cus;
    }
    if (grid < 0) return;
    if (hipMemsetAsync((char*)d_ws + WS_CTL, 0, CTL_ZERO_BYTES, stream) != hipSuccess) { fprintf(stderr, "kernel_launch: memset failed\n"); return; }
    Args a{};
    for (int i = 0; i < 23; ++i) a.p.in[i] = (const float*)d_in[i];
    a.p.out = (float*)d_out; a.p.ws = (unsigned char*)d_ws;
    void* kargs[] = {&a};
    hipError_t e = hipLaunchCooperativeKernel((const void*)fwd_kernel, dim3(grid), dim3(NWAVES * 64), kargs, LDS_BYTES, stream);
    if (e != hipSuccess) fprintf(stderr, "kernel_launch: cooperative launch failed: %s (grid %d)\n", hipGetErrorString(e), grid);
}
```

```cpp
#include <hip/hip_runtime.h>
#include <cstdio>
#include <cstdint>

namespace pg8 {
#define PG8_LAS __attribute__((address_space(3)))
typedef unsigned short bf16_t;
typedef short bf16x8 __attribute__((ext_vector_type(8)));
typedef float f32x4 __attribute__((ext_vector_type(4)));
typedef unsigned u32x4 __attribute__((ext_vector_type(4)));
typedef unsigned u32x2 __attribute__((ext_vector_type(2)));
constexpr int BM = 256, BK = 64, HALF = 128, HTB = HALF * BK * 2  , STAGE_BYTES = 8 * HTB, NXCD = 8, WGM = 8;

__host__ __device__ __forceinline__ int lds_byte(int r, int c) { const int st = (r >> 4) * 2 + (c >> 5), rr = r & 15, cc = c & 31, ob = rr * 64 + cc * 2; return st * 1024 + (ob ^ (((ob >> 9) & 1) << 5)); }
__host__ __device__ __forceinline__ void stage_rc(int b, int& R, int& C) { const int st = b / 1024, sb = b % 1024, swz = sb ^ (((sb >> 9) & 1) << 5); R = (st >> 1) * 16 + swz / 64; C = (st & 1) * 32 + (swz % 64) / 2; }
__host__ __device__ __forceinline__ int perm32(int rho) { const int n = rho >> 4, i = rho & 15; return 8 * (i >> 2) + 4 * n + (i & 3); }

struct Unit { int pm, pn; };
struct Gemm { const bf16_t* A; const bf16_t* Bt; int M, N, K, lda; };

struct StaticOrder {
    int nM, nN, nwg, G, c;
    __host__ __device__ void init(int M, int N, int G_, int c_) { nM = M / BM; nN = N / BM; nwg = nM * nN; G = G_; c = c_; }
    __host__ __device__ bool next(int i, Unit& u) const {
        const long L = (long)i * G + c; if (L >= nwg) return false;
        int wgid = (int)L; { const int q = nwg / NXCD, r = nwg % NXCD, xcd = wgid % NXCD, off = wgid / NXCD; wgid = (xcd < r ? xcd * (q + 1) : r * (q + 1) + (xcd - r) * q) + off; }
        const int nig = WGM * nN, gid = wgid / nig, fm = gid * WGM, gsz = (nM - fm) < WGM ? (nM - fm) : WGM;
        u.pm = fm + ((wgid % nig) % gsz); u.pn = (wgid % nig) / gsz; return true;
    }
};

__device__ __forceinline__ unsigned cvt_pk_bf16(float lo, float hi) { unsigned r; asm volatile("v_cvt_pk_bf16_f32 %0, %1, %2" : "=v"(r) : "v"(lo), "v"(hi)); return r; }
__device__ __forceinline__ float bflo(unsigned w) { return __uint_as_float(w << 16); }
__device__ __forceinline__ float bfhi(unsigned w) { return __uint_as_float(w & 0xffff0000u); }
__device__ __forceinline__ float sigm(float x) { return 1.0f / (1.0f + __expf(-x)); }


__device__ __forceinline__ void st16_wt(void* p, u32x4 v) { asm volatile("global_store_dwordx4 %0, %1, off sc1\n\ts_nop 1" :: "v"(p), "v"(v) : "memory"); }
__device__ __forceinline__ void st16f_wt(void* p, f32x4 v) { asm volatile("global_store_dwordx4 %0, %1, off sc1\n\ts_nop 1" :: "v"(p), "v"(v) : "memory"); }
__device__ __forceinline__ void st8_wt(void* p, u32x2 v) { asm volatile("global_store_dwordx2 %0, %1, off sc1\n\ts_nop 1" :: "v"(p), "v"(v) : "memory"); }
struct EpiStoreBf16 {
    static constexpr bool PERM = true; static constexpr int MIDK = 0;
    bf16_t* O; int ldc;
    __device__ __forceinline__ void operator()(const f32x4 (&acc)[2][2][4][2], const Unit& u, int wr, int wc, int fr, int fq) const {
        const int row0 = u.pm * BM + wr * 64 + fr, col0 = u.pn * BM + wc * 32 + 8 * fq;
#pragma unroll
        for (int ai = 0; ai < 2; ++ai)
#pragma unroll
            for (int m = 0; m < 4; ++m) { bf16_t* rowp = O + (size_t)(row0 + ai * HALF + m * 16) * ldc + col0;
#pragma unroll
                for (int bj = 0; bj < 2; ++bj) { const f32x4 v0 = acc[ai][bj][m][0], v1 = acc[ai][bj][m][1];
                    u32x4 w; w.x = cvt_pk_bf16(v0[0], v0[1]); w.y = cvt_pk_bf16(v0[2], v0[3]); w.z = cvt_pk_bf16(v1[0], v1[1]); w.w = cvt_pk_bf16(v1[2], v1[3]);
                    *(u32x4*)(rowp + bj * HALF) = w; } }
    }
};

struct EpiProj {
    static constexpr bool PERM = true; static constexpr int MIDK = 0;
    bf16_t* O; int ldc; const float *gqa, *gqb, *gks, *gkw; bf16_t* VST; bf16_t* VWT; float qscale, eps; int seq;
    __device__ __forceinline__ void operator()(const f32x4 (&acc)[2][2][4][2], const Unit& u, int wr, int wc, int fr, int fq) const {
        const int f0 = u.pn * BM + wc * 64;
        const float* g = nullptr; float sc = 1.f;
        if (f0 < 512) { g = gqa; sc = qscale; } else if (f0 >= 960 && f0 < 1472) { g = gqb; sc = qscale; } else if (f0 == 1728 || f0 == 1792) { g = gks; } else if (f0 == 1984 || f0 == 2048) { g = gkw; }
        bf16_t* VT = nullptr; int kh = 0;
        if (f0 == 1856 || f0 == 1920) { VT = VST; kh = (f0 - 1856) >> 6; } else if (f0 == 2112 || f0 == 2176) { VT = VWT; kh = (f0 - 2112) >> 6; }
        float gv[2][8];
#pragma unroll
        for (int bj = 0; bj < 2; ++bj)
#pragma unroll
            for (int k = 0; k < 8; ++k) gv[bj][k] = g ? g[32 * bj + 8 * fq + k] * sc : 1.f;
        const int row0 = u.pm * BM + wr * 64 + fr;
#pragma unroll
        for (int ai = 0; ai < 2; ++ai)
#pragma unroll
            for (int m = 0; m < 4; ++m) { const int row = row0 + ai * HALF + m * 16; bf16_t* rowp = O + (size_t)row * ldc + f0 + 8 * fq;
                float v[2][8];
#pragma unroll
                for (int bj = 0; bj < 2; ++bj) { const f32x4 v0 = acc[ai][bj][m][0], v1 = acc[ai][bj][m][1]; v[bj][0] = v0[0]; v[bj][1] = v0[1]; v[bj][2] = v0[2]; v[bj][3] = v0[3]; v[bj][4] = v1[0]; v[bj][5] = v1[1]; v[bj][6] = v1[2]; v[bj][7] = v1[3]; }
                if (g) { float ss = 0.f;
#pragma unroll
                    for (int bj = 0; bj < 2; ++bj)
#pragma unroll
                        for (int k = 0; k < 8; ++k) ss += v[bj][k] * v[bj][k];
                    ss += __shfl_xor(ss, 16); ss += __shfl_xor(ss, 32);
                    const float r = rsqrtf(ss * (1.f / 64.f) + eps);
#pragma unroll
                    for (int bj = 0; bj < 2; ++bj)
#pragma unroll
                        for (int k = 0; k < 8; ++k) v[bj][k] *= r * gv[bj][k]; }
#pragma unroll
                for (int bj = 0; bj < 2; ++bj) { u32x4 w; w.x = cvt_pk_bf16(v[bj][0], v[bj][1]); w.y = cvt_pk_bf16(v[bj][2], v[bj][3]); w.z = cvt_pk_bf16(v[bj][4], v[bj][5]); w.w = cvt_pk_bf16(v[bj][6], v[bj][7]);
                    st16_wt(rowp + 32 * bj, w);
                    if (VT) { const int b = row / seq, s = row % seq; bf16_t* tp = VT + ((size_t)(b * 2 + kh) * 64 + 32 * bj + 8 * fq) * seq + s;
                        tp[0] = (bf16_t)(w.x & 0xffffu); tp[seq] = (bf16_t)(w.x >> 16); tp[2 * seq] = (bf16_t)(w.y & 0xffffu); tp[3 * seq] = (bf16_t)(w.y >> 16);
                        tp[4 * seq] = (bf16_t)(w.z & 0xffffu); tp[5 * seq] = (bf16_t)(w.z >> 16); tp[6 * seq] = (bf16_t)(w.w & 0xffffu); tp[7 * seq] = (bf16_t)(w.w >> 16); } } }
    }
};
template <bool ADD> struct EpiGate {
    static constexpr bool PERM = true; static constexpr int MIDK = 0;
    bf16_t* O; int ldc; const bf16_t* Gt; int ldg; int gcol0;
    __device__ __forceinline__ void operator()(const f32x4 (&acc)[2][2][4][2], const Unit& u, int wr, int wc, int fr, int fq) const {
        const int row0 = u.pm * BM + wr * 64 + fr, col0 = u.pn * BM + wc * 32 + 8 * fq;
#pragma unroll
        for (int ai = 0; ai < 2; ++ai)
#pragma unroll
            for (int m = 0; m < 4; ++m) { const size_t row = (size_t)(row0 + ai * HALF + m * 16); bf16_t* rowp = O + row * ldc + col0; const bf16_t* gp = Gt + row * ldg + gcol0 + col0;
#pragma unroll
                for (int bj = 0; bj < 2; ++bj) { const f32x4 v0 = acc[ai][bj][m][0], v1 = acc[ai][bj][m][1];
                    const u32x4 g = *(const u32x4*)(gp + bj * HALF);
                    float o[8];
                    o[0] = v0[0] * sigm(bflo(g.x)); o[1] = v0[1] * sigm(bfhi(g.x)); o[2] = v0[2] * sigm(bflo(g.y)); o[3] = v0[3] * sigm(bfhi(g.y));
                    o[4] = v1[0] * sigm(bflo(g.z)); o[5] = v1[1] * sigm(bfhi(g.z)); o[6] = v1[2] * sigm(bflo(g.w)); o[7] = v1[3] * sigm(bfhi(g.w));
                    if (ADD) { const u32x4 p = *(const u32x4*)(rowp + bj * HALF);
                        o[0] += bflo(p.x); o[1] += bfhi(p.x); o[2] += bflo(p.y); o[3] += bfhi(p.y); o[4] += bflo(p.z); o[5] += bfhi(p.z); o[6] += bflo(p.w); o[7] += bfhi(p.w); }
                    u32x4 w; w.x = cvt_pk_bf16(o[0], o[1]); w.y = cvt_pk_bf16(o[2], o[3]); w.z = cvt_pk_bf16(o[4], o[5]); w.w = cvt_pk_bf16(o[6], o[7]);
                    *(u32x4*)(rowp + bj * HALF) = w; } }
    }
};

struct EpiGate2 {
    static constexpr bool PERM = true; static constexpr int MIDK = 8;
    bf16_t* O; int ldc; const bf16_t* Gt; int ldg; int gcol_a, gcol_b;
    __device__ __forceinline__ void mid(f32x4 (&acc)[2][2][4][2], const Unit& u, int wr, int wc, int fr, int fq) const {
        asm volatile("" : "+v"(fr), "+v"(fq));
        const int row0 = u.pm * BM + wr * 64 + fr, col0 = u.pn * BM + wc * 32 + 8 * fq;
#pragma unroll
        for (int ai = 0; ai < 2; ++ai)
#pragma unroll
            for (int m = 0; m < 4; ++m) { const size_t row = (size_t)(row0 + ai * HALF + m * 16); const bf16_t* gp = Gt + row * ldg + col0;
#pragma unroll
                for (int bj = 0; bj < 2; ++bj) { const u32x4 ga = *(const u32x4*)(gp + gcol_a + bj * HALF), gb = *(const u32x4*)(gp + gcol_b + bj * HALF);
                    float r[8];
                    r[0] = sigm(bflo(ga.x)) / fmaxf(sigm(bflo(gb.x)), 1e-30f); r[1] = sigm(bfhi(ga.x)) / fmaxf(sigm(bfhi(gb.x)), 1e-30f); r[2] = sigm(bflo(ga.y)) / fmaxf(sigm(bflo(gb.y)), 1e-30f); r[3] = sigm(bfhi(ga.y)) / fmaxf(sigm(bfhi(gb.y)), 1e-30f);
                    r[4] = sigm(bflo(ga.z)) / fmaxf(sigm(bflo(gb.z)), 1e-30f); r[5] = sigm(bfhi(ga.z)) / fmaxf(sigm(bfhi(gb.z)), 1e-30f); r[6] = sigm(bflo(ga.w)) / fmaxf(sigm(bflo(gb.w)), 1e-30f); r[7] = sigm(bfhi(ga.w)) / fmaxf(sigm(bfhi(gb.w)), 1e-30f);
#pragma unroll
                    for (int e = 0; e < 4; ++e) { acc[ai][bj][m][0][e] *= r[e]; acc[ai][bj][m][1][e] *= r[4 + e]; } }
                asm volatile("" ::: "memory"); }
    }
    __device__ __forceinline__ void operator()(const f32x4 (&acc)[2][2][4][2], const Unit& u, int wr, int wc, int fr, int fq) const {
        const int row0 = u.pm * BM + wr * 64 + fr, col0 = u.pn * BM + wc * 32 + 8 * fq;
#pragma unroll
        for (int ai = 0; ai < 2; ++ai)
#pragma unroll
            for (int m = 0; m < 4; ++m) { const size_t row = (size_t)(row0 + ai * HALF + m * 16); bf16_t* rowp = O + row * ldc + col0; const bf16_t* gp = Gt + row * ldg + gcol_b + col0;
#pragma unroll
                for (int bj = 0; bj < 2; ++bj) { const f32x4 v0 = acc[ai][bj][m][0], v1 = acc[ai][bj][m][1];
                    const u32x4 g = *(const u32x4*)(gp + bj * HALF);
                    u32x4 w; w.x = cvt_pk_bf16(v0[0] * sigm(bflo(g.x)), v0[1] * sigm(bfhi(g.x))); w.y = cvt_pk_bf16(v0[2] * sigm(bflo(g.y)), v0[3] * sigm(bfhi(g.y)));
                    w.z = cvt_pk_bf16(v1[0] * sigm(bflo(g.z)), v1[1] * sigm(bfhi(g.z))); w.w = cvt_pk_bf16(v1[2] * sigm(bflo(g.w)), v1[3] * sigm(bfhi(g.w)));
                    *(u32x4*)(rowp + bj * HALF) = w; } }
    }
};
struct EpiRelu2 {
    static constexpr bool PERM = true; static constexpr int MIDK = 0;
    bf16_t* O; int ldc; const float* parts; float eps; float inv_n;
    __device__ __forceinline__ void operator()(const f32x4 (&acc)[2][2][4][2], const Unit& u, int wr, int wc, int fr, int fq) const {
        const int row0 = u.pm * BM + wr * 64 + fr, col0 = u.pn * BM + wc * 32 + 8 * fq;
#pragma unroll
        for (int ai = 0; ai < 2; ++ai)
#pragma unroll
            for (int m = 0; m < 4; ++m) { const size_t row = (size_t)(row0 + ai * HALF + m * 16); bf16_t* rowp = O + row * ldc + col0;
                const f32x4* pp = (const f32x4*)(parts + row * 16); const f32x4 p0 = pp[0], p1 = pp[1], p2 = pp[2], p3 = pp[3];
                const float ss = ((p0[0] + p0[1]) + (p0[2] + p0[3])) + ((p1[0] + p1[1]) + (p1[2] + p1[3])) + ((p2[0] + p2[1]) + (p2[2] + p2[3])) + ((p3[0] + p3[1]) + (p3[2] + p3[3]));
                const float rs = rsqrtf(ss * inv_n + eps);
#pragma unroll
                for (int bj = 0; bj < 2; ++bj) { const f32x4 v0 = acc[ai][bj][m][0], v1 = acc[ai][bj][m][1];
                    float o[8] = {v0[0], v0[1], v0[2], v0[3], v1[0], v1[1], v1[2], v1[3]};
#pragma unroll
                    for (int e = 0; e < 8; ++e) { const float t = fmaxf(o[e], 0.f) * rs; o[e] = t * t; }
                    u32x4 w; w.x = cvt_pk_bf16(o[0], o[1]); w.y = cvt_pk_bf16(o[2], o[3]); w.z = cvt_pk_bf16(o[4], o[5]); w.w = cvt_pk_bf16(o[6], o[7]);
                    st16_wt(rowp + bj * HALF, w); } }
    }
};
struct EpiOutRes {
    static constexpr bool PERM = false; static constexpr int MIDK = 0;
    const float* base; float* out; bf16_t* xb; int ldc; float* parts;
    __device__ __forceinline__ void operator()(const f32x4 (&acc)[2][2][4][2], const Unit& u, int wr, int wc, int fr, int fq) const {
        const int col0 = u.pn * BM + wc * 32 + 4 * fq;
#pragma unroll
        for (int ai = 0; ai < 2; ++ai)
#pragma unroll
            for (int m = 0; m < 4; ++m) { const int r = u.pm * BM + ai * HALF + wr * 64 + m * 16 + fr; const size_t off = (size_t)r * ldc + col0; float ss = 0.f;
#pragma unroll
                for (int bj = 0; bj < 2; ++bj)
#pragma unroll
                    for (int n = 0; n < 2; ++n) { const f32x4 bs = *(const f32x4*)(base + off + bj * HALF + n * 16); const f32x4 o = bs + acc[ai][bj][m][n];
                        st16f_wt(out + off + bj * HALF + n * 16, o); ss += (o[0] * o[0] + o[1] * o[1]) + (o[2] * o[2] + o[3] * o[3]);
                        u32x2 w; w.x = cvt_pk_bf16(o[0], o[1]); w.y = cvt_pk_bf16(o[2], o[3]); st8_wt(xb + off + bj * HALF + n * 16, w); }
                ss += __shfl_xor(ss, 16); ss += __shfl_xor(ss, 32);
                if (fq == 0) parts[(size_t)r * 16 + u.pn * 4 + wc] = ss; }
    }
};
struct EpiFinal {
    static constexpr bool PERM = false; static constexpr int MIDK = 0;
    float* out; int ldc;
    __device__ __forceinline__ void operator()(const f32x4 (&acc)[2][2][4][2], const Unit& u, int wr, int wc, int fr, int fq) const {
        const int col0 = u.pn * BM + wc * 32 + 4 * fq;
#pragma unroll
        for (int ai = 0; ai < 2; ++ai)
#pragma unroll
            for (int m = 0; m < 4; ++m) { const int r = u.pm * BM + ai * HALF + wr * 64 + m * 16 + fr; const size_t off = (size_t)r * ldc + col0;
#pragma unroll
                for (int bj = 0; bj < 2; ++bj)
#pragma unroll
                    for (int n = 0; n < 2; ++n) { float* p = out + off + bj * HALF + n * 16; const f32x4 bs = *(const f32x4*)p; *(f32x4*)p = bs + acc[ai][bj][m][n]; } }
    }
};

template <class Epi, class Sched, bool ALIGN_EPI = false>
__device__ __forceinline__ void gemm_phase(PG8_LAS unsigned char* lds, const Gemm g, const Sched& S, const Epi& E) {
    int tid_ = threadIdx.x; asm volatile("" : "+v"(tid_));
    const int tid = tid_, wid = __builtin_amdgcn_readfirstlane(tid >> 6), lane = tid & 63, wr = wid >> 2, wc = wid & 3, fr = lane & 15, fq = lane >> 4;
    const int K = g.K, nt = K / BK;
    unsigned voffA[2], voffB[2];
#pragma unroll
    for (int i = 0; i < 2; ++i) { int R, C; stage_rc(tid * 16 + i * 8192, R, C); const int Rb = Epi::PERM ? ((R & ~31) + perm32(R & 31)) : R;
        voffA[i] = (unsigned)(R * g.lda + C) * 2u; voffB[i] = (unsigned)(Rb * K + C) * 2u; }
    const size_t kstep = (size_t)(BK * 2);
    const size_t hstepA = (size_t)HALF * g.lda * 2, hstepB = (size_t)HALF * K * 2;
    const size_t tstepA = 2 * hstepA, tstepB = 2 * hstepB;
    const unsigned ldsw = (unsigned)wid * 1024u;
    const int aoff = lds_byte(wr * 64 + fr, fq * 8), boff = lds_byte(wc * 32 + fr, fq * 8);
#define PG8_SA(b, h) (((b) * 2 + (h)) * HTB)
#define PG8_SB(b, h) ((4 + (b) * 2 + (h)) * HTB)
#define PG8_STAGE(bufoff, gbase, voff) do { _Pragma("unroll") for (int _i = 0; _i < 2; ++_i) \
        __builtin_amdgcn_global_load_lds((const unsigned*)((const char*)(gbase) + (voff)[_i]), (PG8_LAS unsigned*)(lds + (bufoff) + ldsw + _i * 8192), 16, 0, 0); } while (0)
#define PG8_LDA(dst, b, h) do { _Pragma("unroll") for (int m = 0; m < 4; ++m) _Pragma("unroll") for (int k = 0; k < 2; ++k) dst[m][k] = *(const PG8_LAS bf16x8*)(lds + PG8_SA(b, h) + aoff + m * 2048 + k * 1024); } while (0)
#define PG8_LDB(dst, b, h) do { _Pragma("unroll") for (int n = 0; n < 2; ++n) _Pragma("unroll") for (int k = 0; k < 2; ++k) dst[n][k] = *(const PG8_LAS bf16x8*)(lds + PG8_SB(b, h) + boff + n * 2048 + k * 1024); } while (0)
#define PG8_MMA(ai, bj, At, Bt) do { __builtin_amdgcn_s_setprio(1); _Pragma("unroll") for (int m = 0; m < 4; ++m) _Pragma("unroll") for (int n = 0; n < 2; ++n) _Pragma("unroll") for (int k = 0; k < 2; ++k) \
        acc[ai][bj][m][n] = __builtin_amdgcn_mfma_f32_16x16x32_bf16(Bt[n][k], At[m][k], acc[ai][bj][m][n], 0, 0, 0); __builtin_amdgcn_s_setprio(0); } while (0)
#define PG8_WAIT_V(n) asm volatile("s_waitcnt vmcnt(" #n ")" ::: "memory")
#define PG8_WAIT_L(n) asm volatile("s_waitcnt lgkmcnt(" #n ")" ::: "memory")
#define PG8_BAR __builtin_amdgcn_s_barrier()
#define PG8_SCHED __builtin_amdgcn_sched_barrier(0)
    Unit cur, nxt; int ui = 0;
    if (!S.next(0, cur)) return;
    f32x4 acc[2][2][4][2];
#pragma unroll
    for (int a = 0; a < 2; ++a)
#pragma unroll
        for (int b = 0; b < 2; ++b)
#pragma unroll
            for (int m = 0; m < 4; ++m)
#pragma unroll
                for (int n = 0; n < 2; ++n) acc[a][b][m][n] = (f32x4){0.f, 0.f, 0.f, 0.f};
    bf16x8 At[4][2], B0[2][2], B1[2][2];
    const char* cA = (const char*)g.A + (size_t)cur.pm * tstepA; const char* cB = (const char*)g.Bt + (size_t)cur.pn * tstepB;
    PG8_STAGE(PG8_SB(0, 0), cB, voffB); PG8_STAGE(PG8_SB(0, 1), cB + hstepB, voffB); PG8_STAGE(PG8_SA(0, 0), cA, voffA); PG8_STAGE(PG8_SA(0, 1), cA + hstepA, voffA);
    if (wr == 1) PG8_BAR;
    PG8_WAIT_V(2); PG8_BAR;
    PG8_STAGE(PG8_SB(1, 0), cB + kstep, voffB); PG8_STAGE(PG8_SA(1, 0), cA + kstep, voffA); PG8_STAGE(PG8_SB(1, 1), cB + hstepB + kstep, voffB);
    PG8_WAIT_V(6); PG8_BAR;
    for (;;) {
        const bool has_next = S.next(ui + 1, nxt);
        const char* nA = has_next ? (const char*)g.A + (size_t)nxt.pm * tstepA : cA; const char* nB = has_next ? (const char*)g.Bt + (size_t)nxt.pn * tstepB : cB;
        for (int t = 0; t < nt; t += 2) {
            const bool last = (t == nt - 2);
            const char* a1 = cA + (size_t)(t + 1) * kstep;
            const char* a2 = last ? nA : cA + (size_t)(t + 2) * kstep; const char* b2 = last ? nB : cB + (size_t)(t + 2) * kstep;
            const char* a3 = a2 + kstep; const char* b3 = b2 + kstep;
            PG8_LDB(B0, 0, 0); PG8_LDB(B1, 0, 1); PG8_SCHED; PG8_LDA(At, 0, 0); PG8_STAGE(PG8_SA(1, 1), a1 + hstepA, voffA);
            PG8_WAIT_V(8); PG8_WAIT_L(0); PG8_BAR; PG8_MMA(0, 0, At, B0); PG8_MMA(0, 1, At, B1); PG8_BAR; PG8_SCHED;
            PG8_LDA(At, 0, 1); PG8_STAGE(PG8_SB(0, 0), b2, voffB); PG8_STAGE(PG8_SB(0, 1), b2 + hstepB, voffB); PG8_STAGE(PG8_SA(0, 0), a2, voffA);
            PG8_WAIT_V(8); PG8_WAIT_L(0); PG8_BAR; PG8_MMA(1, 0, At, B0); PG8_MMA(1, 1, At, B1); PG8_BAR; PG8_SCHED;
            PG8_LDB(B0, 1, 0); PG8_LDB(B1, 1, 1); PG8_SCHED; PG8_LDA(At, 1, 0); PG8_STAGE(PG8_SA(0, 1), a2 + hstepA, voffA);
            PG8_WAIT_V(8); PG8_WAIT_L(0); PG8_BAR; PG8_MMA(0, 0, At, B0); PG8_MMA(0, 1, At, B1); PG8_BAR; PG8_SCHED;
            PG8_LDA(At, 1, 1); PG8_STAGE(PG8_SB(1, 0), b3, voffB); PG8_STAGE(PG8_SB(1, 1), b3 + hstepB, voffB); PG8_STAGE(PG8_SA(1, 0), a3, voffA);
            PG8_WAIT_V(8); PG8_WAIT_L(0); PG8_BAR; PG8_MMA(1, 0, At, B0); PG8_MMA(1, 1, At, B1); PG8_BAR; PG8_SCHED;
            if constexpr (Epi::MIDK != 0) { if (t + 2 == Epi::MIDK) E.mid(acc, cur, wr, wc, fr, fq); }
        }
        if constexpr (ALIGN_EPI) { if (wr == 0) PG8_BAR; }
        E(acc, cur, wr, wc, fr, fq);
        if (!has_next) break;
#pragma unroll
        for (int a = 0; a < 2; ++a)
#pragma unroll
            for (int b = 0; b < 2; ++b)
#pragma unroll
                for (int m = 0; m < 4; ++m)
#pragma unroll
                    for (int n = 0; n < 2; ++n) acc[a][b][m][n] = (f32x4){0.f, 0.f, 0.f, 0.f};
        cur = nxt; cA = nA; cB = nB; ++ui;
        if constexpr (ALIGN_EPI) { if (wr == 1) PG8_BAR; }
    }
    PG8_WAIT_V(0);
    if constexpr (!ALIGN_EPI) { if (wr == 0) PG8_BAR; }
    PG8_BAR;
#undef PG8_SA
#undef PG8_SB
#undef PG8_STAGE
#undef PG8_LDA
#undef PG8_LDB
#undef PG8_MMA
#undef PG8_WAIT_V
#undef PG8_WAIT_L
#undef PG8_BAR
#undef PG8_SCHED
}
}

#ifndef PROBE_P3
#define PROBE_P3 1
#endif
#define PROBE_P0 1
#define PROBE_DPRE 1
#define PROBE_DIDX 1
#define PROBE_DTHR 1
#define PROBE_DATT 1
#define PROBE_NSA 1
#define PROBE_P1 1
#define PROBE_P2 1
#define PROBE_P4 1
#define PROBE_P5 1
#define PROBE_P6 1
constexpr int NWAVES = 8;
constexpr int BATCH = 8, SEQ = 2048, DM = 1024, M = BATCH * SEQ, FF = 4096;
constexpr int PITCH = 4352;
constexpr int C_QA = 0, C_CA = 512, C_QI = 640, C_KI = 896, C_WI = 928, C_GB = 936, C_QB = 960, C_KC = 1472, C_VC = 1600, C_KS = 1728, C_VS = 1856, C_KW = 1984, C_VW = 2112, C_GM = 2304;
constexpr int NCMP = 127, TOPK = 256;
constexpr float RMS_EPS = 1e-6f;
constexpr float LOG2E = 1.4426950408889634f;
constexpr float QSCALE = 0.125f * LOG2E;

constexpr size_t MiB = 1u << 20;
constexpr size_t WS_CTL = 0, CTL_ZERO_BYTES = 64 * 1024;
constexpr size_t WS_WIN = 1 * MiB;
constexpr size_t WS_WLT = 9 * MiB + 512 * 1024;
constexpr size_t WS_W2T = WS_WLT + 64 * 1024;
constexpr size_t WS_W1T = 31 * MiB;
constexpr size_t WS_WUPA = 10 * MiB, WS_WUPB = 11 * MiB;
constexpr size_t WS_WOUT = 12 * MiB;
constexpr size_t WS_WFF1 = 14 * MiB;
constexpr size_t WS_WFF2 = 22 * MiB;
constexpr size_t WS_PARTS = 30 * MiB;
constexpr size_t WS_PROJ = 32 * MiB;
constexpr size_t WS_MERGED = 168 * MiB;
constexpr size_t WS_X1B = 200 * MiB;
constexpr size_t WS_END = 232 * MiB;
constexpr size_t DO_H = 0;
constexpr size_t DO_O = 0;
constexpr size_t DO_KA = 32 * MiB;
constexpr size_t DO_VA = 34 * MiB;
constexpr size_t DO_VAT = 36 * MiB;
constexpr size_t DO_VST = 38 * MiB;
constexpr size_t DO_VWT = 42 * MiB;
constexpr size_t DO_KC = 46 * MiB;
constexpr size_t DO_VC = 47 * MiB;
constexpr size_t DO_VCT = 48 * MiB;

constexpr int CW_BAR = 4096;
constexpr int RING_BYTES = 131072;
constexpr int MISC_OFF = 141312 + 64;
constexpr int LDS_BYTES = 147456;

#define GAS __attribute__((address_space(1)))
#define LAS __attribute__((address_space(3)))
typedef unsigned short bf16;
typedef unsigned v4u __attribute__((ext_vector_type(4)));
typedef float f32x4 __attribute__((ext_vector_type(4)));
#define LDS_WAIT() asm volatile("s_waitcnt lgkmcnt(0)" ::: "memory")
typedef short bf16x8 __attribute__((ext_vector_type(8)));
typedef float f32x16 __attribute__((ext_vector_type(16)));
typedef unsigned long long u64;
typedef u64 u64x2 __attribute__((ext_vector_type(2)));

__device__ __forceinline__ unsigned f2bf(float f) { unsigned u = __builtin_bit_cast(unsigned, f); return (u + 0x7fffu + ((u >> 16) & 1u)) >> 16; }
__device__ __forceinline__ unsigned pk2(float lo, float hi) { return f2bf(lo) | (f2bf(hi) << 16); }
__device__ __forceinline__ float bf2f(bf16 b) { return __uint_as_float((unsigned)b << 16); }
__device__ __forceinline__ void unpack8(const v4u w, float* o) {
    o[0] = __uint_as_float(w.x << 16); o[1] = __uint_as_float(w.x & 0xffff0000u); o[2] = __uint_as_float(w.y << 16); o[3] = __uint_as_float(w.y & 0xffff0000u);
    o[4] = __uint_as_float(w.z << 16); o[5] = __uint_as_float(w.z & 0xffff0000u); o[6] = __uint_as_float(w.w << 16); o[7] = __uint_as_float(w.w & 0xffff0000u);
}
__device__ __forceinline__ float xhalf_max(float v) { auto rr = __builtin_amdgcn_permlane32_swap(__float_as_uint(v), __float_as_uint(v), false, false); return fmaxf(__uint_as_float(rr[0]), __uint_as_float(rr[1])); }
__device__ __forceinline__ float xhalf_sum(float v) { auto rr = __builtin_amdgcn_permlane32_swap(__float_as_uint(v), __float_as_uint(v), false, false); return __uint_as_float(rr[0]) + __uint_as_float(rr[1]); }
__device__ __forceinline__ float wave_sum(float v) {
#pragma unroll
    for (int o = 1; o < 64; o <<= 1) v += __shfl_xor(v, o);
    return v;
}
__device__ __forceinline__ float wave_max(float v) {
#pragma unroll
    for (int o = 1; o < 64; o <<= 1) v = fmaxf(v, __shfl_xor(v, o));
    return v;
}
__device__ __forceinline__ int wave_sum_i(int v) {
#pragma unroll
    for (int o = 1; o < 64; o <<= 1) v += __shfl_xor(v, o);
    return v;
}

#define XB_TMO      128
#define XB_XCNT(j)  (256  + 64 * (j))
#define XB_XSUB(j)  (1280 + 64 * (j))
#define XB_XGEN(j)  (2304 + 64 * (j))
#define XB_TOP      3328
#define XB_TOPGEN   3392
#define XCD_BAR_WORDS 3456
#define XB_SPIN_CAP (1u << 23)

__device__ __forceinline__ unsigned xb_ld(unsigned* p)              { return __hip_atomic_load(p, __ATOMIC_RELAXED, __HIP_MEMORY_SCOPE_AGENT); }
__device__ __forceinline__ unsigned xb_add(unsigned* p, unsigned v) { return __hip_atomic_fetch_add(p, v, __ATOMIC_RELAXED, __HIP_MEMORY_SCOPE_AGENT); }
__device__ __forceinline__ unsigned xb_xcc_id() { return (unsigned)__builtin_amdgcn_s_getreg((3 << 11) | 20) & 0xFu; }
#define XB_SPIN(cond, bar) do { unsigned _sp = 0; while (cond) { __builtin_amdgcn_s_sleep(1); \
    if ((++_sp & 255u) == 0u) { if (xb_ld(&(bar)[XB_TMO])) break; if (_sp > XB_SPIN_CAP) { atomicAdd(&(bar)[XB_TMO], 1u); break; } } } } while (0)

struct XcdBarrier { unsigned* bar; unsigned x; volatile LAS unsigned* st; };

__device__ __forceinline__ XcdBarrier xcd_barrier_post(unsigned* bar, volatile LAS unsigned* st) {
    XcdBarrier b; b.bar = bar; b.x = xb_xcc_id(); b.st = st;
    if (threadIdx.x == 0) (void)xb_add(&bar[XB_XCNT(b.x)], 1u);
    return b;
}
__device__ __forceinline__ void xcd_barrier_complete(unsigned* bar, unsigned x, unsigned& nloc, unsigned& nx) {
    const unsigned G = gridDim.x * gridDim.y * gridDim.z;
    unsigned sum, cnt, mine, sp = 0u;
    for (;;) {
        sum = 0u; cnt = 0u; mine = 0u;
#pragma unroll
        for (unsigned j = 0; j < 16; ++j) { const unsigned c = xb_ld(&bar[XB_XCNT(j)]); sum += c; cnt += (c > 0u) ? 1u : 0u; mine = (j == x) ? c : mine; }
        if (sum == G) break;
        __builtin_amdgcn_s_sleep(1);
        if ((++sp & 255u) == 0u) { if (xb_ld(&bar[XB_TMO])) break; if (sp > XB_SPIN_CAP) { atomicAdd(&bar[XB_TMO], 1u); break; } }
    }
    nloc = mine > 0u ? mine : 1u; nx = cnt > 0u ? cnt : 1u;
}
__device__ __forceinline__ void xcd_barrier(const XcdBarrier& b) {
    asm volatile("s_waitcnt vmcnt(0)" ::: "memory");
    __syncthreads();
    if (threadIdx.x == 0) {
        unsigned* bar = b.bar;
        __builtin_amdgcn_s_waitcnt(0);
        unsigned nloc = b.st[0], nx = b.st[1];
        if (nloc == 0u) { xcd_barrier_complete(bar, b.x, nloc, nx); b.st[0] = nloc; b.st[1] = nx; }
        const unsigned old = xb_add(&bar[XB_XSUB(b.x)], 1u);
        const unsigned gen = old / nloc;
        if (old + 1u == (gen + 1u) * nloc) {
            __builtin_amdgcn_fence(__ATOMIC_RELEASE, "agent");
            asm volatile("s_waitcnt vmcnt(0)" ::: "memory");
            const unsigned og = xb_add(&bar[XB_TOP], 1u);
            const unsigned tg = og / nx;
            if (og + 1u == (tg + 1u) * nx) xb_add(&bar[XB_TOPGEN], 1u);
            else XB_SPIN(xb_ld(&bar[XB_TOPGEN]) == tg, bar);
            __builtin_amdgcn_fence(__ATOMIC_ACQUIRE, "agent");
            xb_add(&bar[XB_XGEN(b.x)], 1u);
            asm volatile("s_waitcnt vmcnt(0)" ::: "memory");
        } else {
            XB_SPIN(xb_ld(&bar[XB_XGEN(b.x)]) == gen, bar);
            __builtin_amdgcn_fence(__ATOMIC_ACQUIRE, "agent");
            asm volatile("s_waitcnt vmcnt(0)" ::: "memory");
        }
    }
    __syncthreads();
}

__device__ __forceinline__ int proj_src_col(int d) {
    if (d < 936) return d;
    if (d < 960) return 2216 + (d - 936);
    if (d < 2240) return 936 + (d - 960);
    if (d < 2304) return -1;
    return 2240 + (d - 2304);
}
template <bool PROJMAP>
__device__ __forceinline__ void p0_transpose_item(const float* W, int K, int N, int Ndest, bf16* WT, const float* gk, LAS float* scr, int item, int lane, int dpitch = 0, int koff = 0) {
    if (dpitch == 0) dpitch = K;
    const int nblk = Ndest / 32, kb = item / nblk, nb = item % nblk, k0 = 64 * kb, n0 = 32 * nb;
    const int dn = n0 + (lane & 31); const int cl = dn & 255; const int sc = PROJMAP ? proj_src_col((dn & ~255) + ((cl >> 5) & 3) * 64 + (cl >> 7) * 32 + (cl & 31)) : dn;
    float tv[32];
#pragma unroll
    for (int i = 0; i < 32; ++i) { const int kk = 2 * i + (lane >> 5); tv[i] = (sc >= 0) ? W[(size_t)(k0 + kk) * N + sc] : 0.f; }
#pragma unroll
    for (int i = 0; i < 32; ++i) { const int kk = 2 * i + (lane >> 5); float v = tv[i]; if (gk) v *= gk[k0 + kk]; scr[kk * 33 + (lane & 31)] = v; }
    LDS_WAIT();
    const int c = lane & 7;
#pragma unroll
    for (int j = 0; j < 4; ++j) { const int n = (lane >> 3) + 8 * j; const LAS float* s = scr + (8 * c) * 33 + n;
        v4u o; o.x = pk2(s[0 * 33], s[1 * 33]); o.y = pk2(s[2 * 33], s[3 * 33]); o.z = pk2(s[4 * 33], s[5 * 33]); o.w = pk2(s[6 * 33], s[7 * 33]);
        *(GAS v4u*)(WT + (size_t)(n0 + n) * dpitch + koff + k0 + 8 * c) = o; }
    LDS_WAIT();
}
__device__ __forceinline__ void rms_row_to_bf16(const float* xrow, const float* g, bf16* orow, int lane) {
    const GAS f32x4* xr = (const GAS f32x4*)xrow + lane; const GAS f32x4* gr = (const GAS f32x4*)g + lane;
    f32x4 v[4]; float s = 0.f;
#pragma unroll
    for (int j = 0; j < 4; ++j) { v[j] = xr[64 * j]; s += (v[j].x * v[j].x + v[j].y * v[j].y) + (v[j].z * v[j].z + v[j].w * v[j].w); }
    const float rstd = rsqrtf(wave_sum(s) * (1.f / DM) + RMS_EPS);
    GAS unsigned long long* o8 = (GAS unsigned long long*)orow + lane;
#pragma unroll
    for (int j = 0; j < 4; ++j) { const f32x4 gg = gr[64 * j];
        o8[64 * j] = (unsigned long long)pk2(v[j].x * rstd * gg.x, v[j].y * rstd * gg.y) | ((unsigned long long)pk2(v[j].z * rstd * gg.z, v[j].w * rstd * gg.w) << 32); }
}

struct Ptrs {
    const float* in[23]; float* out; unsigned char* ws;
};

__device__ __forceinline__ void p0_prologue(const Ptrs& P, LAS unsigned char* lds, int gw, int NGW, int wave, int lane) {
    LAS float* scr = (LAS float*)(lds + wave * 16384);
    bf16* WIN = (bf16*)(P.ws + WS_WIN); bf16* WUPA = (bf16*)(P.ws + WS_WUPA); bf16* WUPB = (bf16*)(P.ws + WS_WUPB); bf16* WOUT = (bf16*)(P.ws + WS_WOUT);
    bf16* WFF1 = (bf16*)(P.ws + WS_WFF1); bf16* WFF2 = (bf16*)(P.ws + WS_WFF2);
    constexpr int I_IN = (DM / 64) * (PITCH / 32), I_UP = (512 / 64) * (DM / 32), I_OUT = (DM / 64) * (DM / 32), I_F1 = (DM / 64) * (FF / 32), I_F2 = (FF / 64) * (DM / 32);
    constexpr int I_LT = 4, I_P1 = (2048 / 64) * (128 / 32), I_P2 = 4;
    bf16* WLT = (bf16*)(P.ws + WS_WLT); bf16* W2T = (bf16*)(P.ws + WS_W2T); bf16* W1T = (bf16*)(P.ws + WS_W1T);
    constexpr int NITEMS = I_IN + 2 * I_UP + I_OUT + I_F1 + I_F2 + 2 * I_LT + 2 * I_P1 + 2 * I_P2;
    for (int it = gw; it < NITEMS; it += NGW) {
        int r = it;
        if (r < I_IN) { p0_transpose_item<true>(P.in[2], DM, 4288, PITCH, WIN, nullptr, scr, r, lane); continue; } r -= I_IN;
        if (r < I_UP) { p0_transpose_item<false>(P.in[17], 512, DM, DM, WUPA, nullptr, scr, r, lane, DM, 0); continue; } r -= I_UP;
        if (r < I_UP) { p0_transpose_item<false>(P.in[18], 512, DM, DM, WUPA, nullptr, scr, r, lane, DM, 512); continue; } r -= I_UP;
        if (r < I_OUT) { p0_transpose_item<false>(P.in[19], DM, DM, DM, WOUT, nullptr, scr, r, lane); continue; } r -= I_OUT;
        if (r < I_F1) { p0_transpose_item<false>(P.in[21], DM, FF, FF, WFF1, P.in[20], scr, r, lane); continue; } r -= I_F1;
        if (r < I_F2) { p0_transpose_item<false>(P.in[22], FF, DM, DM, WFF2, nullptr, scr, r, lane); continue; } r -= I_F2;
        if (r < I_LT) { p0_transpose_item<false>(P.in[6], 128, 64, 64, WLT, P.in[5], scr, r, lane); continue; } r -= I_LT;
        if (r < I_LT) { p0_transpose_item<false>(P.in[7], 128, 64, 64, WLT + 64 * 128, P.in[5], scr, r, lane); continue; } r -= I_LT;
        if (r < I_P1) { p0_transpose_item<false>(P.in[13], 2048, 128, 128, W1T, nullptr, scr, r, lane); continue; } r -= I_P1;
        if (r < I_P1) { p0_transpose_item<false>(P.in[15], 2048, 128, 128, W1T + 128 * 2048, nullptr, scr, r, lane); continue; } r -= I_P1;
        if (r < I_P2) { p0_transpose_item<false>(P.in[14], 128, 64, 64, W2T, nullptr, scr, r, lane); continue; } r -= I_P2;
        p0_transpose_item<false>(P.in[16], 128, 64, 64, W2T + 64 * 128, nullptr, scr, r, lane);
    }
    bf16* H = (bf16*)((unsigned char*)P.out + DO_H);
    for (int m = gw; m < M; m += 2 * NGW) {
        const int m2 = m + NGW < M ? m + NGW : m;
        const GAS f32x4* xa = (const GAS f32x4*)(P.in[0] + (size_t)m * DM) + lane; const GAS f32x4* xb = (const GAS f32x4*)(P.in[0] + (size_t)m2 * DM) + lane; const GAS f32x4* gr = (const GAS f32x4*)P.in[1] + lane;
        f32x4 va[4], vb[4]; float sa = 0.f, sb = 0.f;
#pragma unroll
        for (int j = 0; j < 4; ++j) { va[j] = xa[64 * j]; vb[j] = xb[64 * j]; }
#pragma unroll
        for (int j = 0; j < 4; ++j) { sa += (va[j].x * va[j].x + va[j].y * va[j].y) + (va[j].z * va[j].z + va[j].w * va[j].w); sb += (vb[j].x * vb[j].x + vb[j].y * vb[j].y) + (vb[j].z * vb[j].z + vb[j].w * vb[j].w); }
        const float ra = rsqrtf(wave_sum(sa) * (1.f / DM) + RMS_EPS), rb = rsqrtf(wave_sum(sb) * (1.f / DM) + RMS_EPS);
        GAS unsigned long long* oa = (GAS unsigned long long*)(H + (size_t)m * DM) + lane; GAS unsigned long long* ob = (GAS unsigned long long*)(H + (size_t)m2 * DM) + lane;
#pragma unroll
        for (int j = 0; j < 4; ++j) { const f32x4 gg = gr[64 * j];
            oa[64 * j] = (unsigned long long)pk2(va[j].x * ra * gg.x, va[j].y * ra * gg.y) | ((unsigned long long)pk2(va[j].z * ra * gg.z, va[j].w * ra * gg.w) << 32);
            if (m2 != m) ob[64 * j] = (unsigned long long)pk2(vb[j].x * rb * gg.x, vb[j].y * rb * gg.y) | ((unsigned long long)pk2(vb[j].z * rb * gg.z, vb[j].w * rb * gg.w) << 32); }
    }
}

__device__ __forceinline__ float gelu_tanh(float x) { const float u = 0.7978845608028654f * (x + 0.044715f * x * x * x); return 0.5f * x * (1.0f + tanhf(u)); }

__device__ __forceinline__ void p2_post(const Ptrs& P, LAS unsigned char* lds, int gw, int NGW, int wave, int lane) {
    bf16* PROJ = (bf16*)(P.ws + WS_PROJ);
    unsigned char* dob = (unsigned char*)P.out;
    bf16* KA = (bf16*)(dob + DO_KA); bf16* VA = (bf16*)(dob + DO_VA); bf16* VAT = (bf16*)(dob + DO_VAT); bf16* VST = (bf16*)(dob + DO_VST); bf16* VWT = (bf16*)(dob + DO_VWT);
    bf16* KC = (bf16*)(dob + DO_KC); bf16* VC = (bf16*)(dob + DO_VC); bf16* VCT = (bf16*)(dob + DO_VCT);
    const int gtid = gw * 64 + lane, NT = NGW * 64;
    for (int it = gtid; it < M * 20; it += NT) {
        const int tok = it / 20, wh = it % 20; int col; const float* g; float sc = 1.f;
        if (wh < 8) { col = C_QA + wh * 64; g = P.in[3]; sc = QSCALE; }
        else if (wh < 16) { col = C_QB + (wh - 8) * 64; g = P.in[8]; sc = QSCALE; }
        else if (wh < 18) { col = C_KS + (wh - 16) * 64; g = P.in[10]; }
        else { col = C_KW + (wh - 18) * 64; g = P.in[11]; }
        v4u* p = (v4u*)(PROJ + (size_t)tok * PITCH + col);
        float v[64]; float ss = 0.f;
#pragma unroll
        for (int j = 0; j < 8; ++j) { unpack8(p[j], v + 8 * j); }
#pragma unroll
        for (int j = 0; j < 64; ++j) ss += v[j] * v[j];
        const float r = rsqrtf(ss * (1.f / 64.f) + RMS_EPS) * sc;
#pragma unroll
        for (int j = 0; j < 8; ++j) { v4u o; o.x = pk2(v[8 * j] * r * g[8 * j], v[8 * j + 1] * r * g[8 * j + 1]); o.y = pk2(v[8 * j + 2] * r * g[8 * j + 2], v[8 * j + 3] * r * g[8 * j + 3]);
            o.z = pk2(v[8 * j + 4] * r * g[8 * j + 4], v[8 * j + 5] * r * g[8 * j + 5]); o.w = pk2(v[8 * j + 6] * r * g[8 * j + 6], v[8 * j + 7] * r * g[8 * j + 7]); p[j] = o; }
    }
    for (int it = gtid; it < 2 * BATCH * 2 * 64 * SEQ; it += NT) {
        const int s = it % SEQ; int r = it / SEQ; const int d = r % 64; r /= 64; const int kh = r % 2; r /= 2; const int b = r % BATCH; const int which = r / BATCH;
        const bf16 v = PROJ[(size_t)(b * SEQ + s) * PITCH + (which ? C_VW : C_VS) + kh * 64 + d];
        (which ? VWT : VST)[((size_t)(b * 2 + kh) * 64 + d) * SEQ + s] = v;
    }
    {
        LAS float* cn = (LAS float*)(lds + wave * 16384);
        const float* wuk = P.in[6]; const float* wuv = P.in[7];
        for (int tok = gw; tok < M; tok += NGW) {
            const bf16* pr = PROJ + (size_t)tok * PITCH + C_CA;
            const float c0 = bf2f(pr[lane]), c1 = bf2f(pr[lane + 64]);
            const float rstd = rsqrtf(wave_sum(c0 * c0 + c1 * c1) * (1.f / 128.f) + RMS_EPS);
            cn[lane] = c0 * rstd * P.in[5][lane]; cn[lane + 64] = c1 * rstd * P.in[5][lane + 64];
            LDS_WAIT();
            float ka = 0.f, va = 0.f;
#pragma unroll 8
            for (int k = 0; k < 128; ++k) { const float c = cn[k]; ka += c * wuk[k * 64 + lane]; va += c * wuv[k * 64 + lane]; }
            const float kr = rsqrtf(wave_sum(ka * ka) * (1.f / 64.f) + RMS_EPS);
            KA[(size_t)tok * 64 + lane] = (bf16)f2bf(ka * kr * P.in[4][lane]);
            VA[(size_t)tok * 64 + lane] = (bf16)f2bf(va);
            VAT[((size_t)(tok / SEQ) * 64 + lane) * SEQ + (tok % SEQ)] = (bf16)f2bf(va);
            LDS_WAIT();
        }
    }
    for (int it = gtid; it < BATCH * 2 * 64; it += NT) { const int d = it % 64, bk = it / 64; KC[((size_t)bk * 128 + 127) * 64 + d] = 0; VC[((size_t)bk * 128 + 127) * 64 + d] = 0; VCT[((size_t)bk * 64 + d) * 128 + 127] = 0; }
    {
        LAS float* hid = (LAS float*)(lds + wave * 16384);
        const float* pe = P.in[12];
        for (int it = gw; it < 2 * BATCH * NCMP * 2; it += NGW) {
            const int kh = it % 2; int r = it / 2; const int c = r % NCMP; r /= NCMP; const int b = r % BATCH; const int kv = r / BATCH;
            const float* w1 = kv ? P.in[15] : P.in[13]; const float* w2 = kv ? P.in[16] : P.in[14];
            const bf16* src = PROJ + (size_t)(b * SEQ + 16 * c) * PITCH + (kv ? C_VC : C_KC) + kh * 64;
            float h0 = 0.f, h1 = 0.f;
            for (int l = 0; l < 32; ++l) {
                const bf16* sr = src + (size_t)l * PITCH;
#pragma unroll 8
                for (int d = 0; d < 64; ++d) { const float a = bf2f(sr[d]) + pe[l * 64 + d]; const float* wr_ = w1 + (size_t)(l * 64 + d) * 128; h0 += a * wr_[lane]; h1 += a * wr_[lane + 64]; }
            }
            hid[lane] = gelu_tanh(h0); hid[lane + 64] = gelu_tanh(h1);
            LDS_WAIT();
            float o = 0.f;
#pragma unroll 8
            for (int n = 0; n < 128; ++n) o += hid[n] * w2[n * 64 + lane];
            if (kv == 0) { const float kr = rsqrtf(wave_sum(o * o) * (1.f / 64.f) + RMS_EPS); KC[((size_t)(b * 2 + kh) * 128 + c) * 64 + lane] = (bf16)f2bf(o * kr * P.in[9][lane]); }
            else { VC[((size_t)(b * 2 + kh) * 128 + c) * 64 + lane] = (bf16)f2bf(o); VCT[((size_t)(b * 2 + kh) * 64 + lane) * 128 + c] = (bf16)f2bf(o); }
            LDS_WAIT();
        }
    }
}


__device__ __forceinline__ void latent_group(const Ptrs& P, int grp, int lane) {
    const int r32 = lane & 31, hi = lane >> 5; const int tok = 32 * grp + r32;
    const bf16* PROJ = (const bf16*)(P.ws + WS_PROJ); const bf16* WLT = (const bf16*)(P.ws + WS_WLT);
    unsigned char* dob = (unsigned char*)P.out; bf16* KA = (bf16*)(dob + DO_KA); bf16* VAT = (bf16*)(dob + DO_VAT);
    bf16x8 cb[8]; float ss = 0.f;
    const bf16* cp = PROJ + (size_t)tok * PITCH + C_CA + hi * 8;
#pragma unroll
    for (int ks = 0; ks < 8; ++ks) { const v4u w = *(const GAS v4u*)(cp + ks * 16); cb[ks] = __builtin_bit_cast(bf16x8, w); float f[8]; unpack8(w, f);
#pragma unroll
        for (int j = 0; j < 8; ++j) ss += f[j] * f[j]; }
    ss = xhalf_sum(ss);
    const float rstd = rsqrtf(ss * (1.f / 128.f) + RMS_EPS);
    f32x16 acc[4];
#pragma unroll
    for (int nb = 0; nb < 4; ++nb) {
#pragma unroll
        for (int r = 0; r < 16; ++r) acc[nb][r] = 0.f;
#pragma unroll
        for (int ks = 0; ks < 8; ++ks) { const bf16x8 a = *(const GAS bf16x8*)(WLT + (size_t)(32 * nb + r32) * 128 + ks * 16 + hi * 8); acc[nb] = __builtin_amdgcn_mfma_f32_32x32x16_bf16(a, cb[ks], acc[nb], 0, 0, 0); } }
    float sk = 0.f;
#pragma unroll
    for (int nb = 0; nb < 2; ++nb)
#pragma unroll
        for (int r = 0; r < 16; ++r) { const float v = acc[nb][r] * rstd; sk += v * v; }
    sk = xhalf_sum(sk);
    const float kr = rsqrtf(sk * (1.f / 64.f) + RMS_EPS) * rstd;
    const float* gk = P.in[4];
#pragma unroll
    for (int nb = 0; nb < 2; ++nb)
#pragma unroll
        for (int a = 0; a < 4; ++a) { const int n0 = 32 * nb + 8 * a + 4 * hi; const f32x4 gg = *(const GAS f32x4*)(gk + n0);
            pg8::u32x2 w; w.x = pg8::cvt_pk_bf16(acc[nb][4 * a] * kr * gg[0], acc[nb][4 * a + 1] * kr * gg[1]); w.y = pg8::cvt_pk_bf16(acc[nb][4 * a + 2] * kr * gg[2], acc[nb][4 * a + 3] * kr * gg[3]);
            *(GAS pg8::u32x2*)(KA + (size_t)tok * 64 + n0) = w; }
    const int b = tok / SEQ, s = tok % SEQ;
#pragma unroll
    for (int nb = 2; nb < 4; ++nb)
#pragma unroll
        for (int r = 0; r < 16; ++r) { const int d = 32 * (nb - 2) + (r & 3) + 8 * (r >> 2) + 4 * hi; VAT[((size_t)b * 64 + d) * SEQ + s] = (bf16)f2bf(acc[nb][r] * rstd); }
}
__device__ __forceinline__ void compress_unit(const Ptrs& P, LAS unsigned char* lds, int unit, int tid, int wave, int lane) {
    const int cbk = unit & 3, kh = (unit >> 2) & 1, b = (unit >> 3) & 7, kv = unit >> 6;
    const int r32 = lane & 31, hi = lane >> 5, nb = wave & 3, kq = wave >> 2;
    const bf16* PROJ = (const bf16*)(P.ws + WS_PROJ);
    const bf16* W1T = (const bf16*)(P.ws + WS_W1T) + (size_t)kv * 128 * 2048; const bf16* W2T = (const bf16*)(P.ws + WS_W2T) + (size_t)kv * 64 * 128;
    unsigned char* dob = (unsigned char*)P.out; bf16* KC = (bf16*)(dob + DO_KC); bf16* VCT = (bf16*)(dob + DO_VCT);
    const bf16* src = PROJ + (size_t)(b * SEQ) * PITCH + (kv ? C_VC : C_KC) + kh * 64;
    const float* pe = P.in[12];
    const int c = 32 * cbk + r32;
    LAS float* red = (LAS float*)lds;
    LAS float* peL = (LAS float*)(lds + 32768);
    for (int i = tid; i < 2048; i += NWAVES * 64) peL[i] = pe[i];
    __syncthreads();
    LAS unsigned char* hidL = lds + 16384;
    f32x16 acc;
#pragma unroll
    for (int r = 0; r < 16; ++r) acc[r] = 0.f;
    const bf16* w1p = W1T + (size_t)(32 * nb + r32) * 2048 + hi * 8;
#pragma unroll 8
    for (int ks = 64 * kq; ks < 64 * kq + 64; ++ks) {
        const int l = ks >> 2, d = 16 * (ks & 3) + 8 * hi; int tokn = 16 * c + l; tokn = tokn > SEQ - 1 ? SEQ - 1 : tokn;
        const v4u raw = *(const GAS v4u*)(src + (size_t)tokn * PITCH + d); float a8[8]; unpack8(raw, a8);
        const f32x4 p0 = *(LAS const f32x4*)(peL + l * 64 + d), p1 = *(LAS const f32x4*)(peL + l * 64 + d + 4);
        pg8::u32x4 aw; aw.x = pg8::cvt_pk_bf16(a8[0] + p0[0], a8[1] + p0[1]); aw.y = pg8::cvt_pk_bf16(a8[2] + p0[2], a8[3] + p0[3]); aw.z = pg8::cvt_pk_bf16(a8[4] + p1[0], a8[5] + p1[1]); aw.w = pg8::cvt_pk_bf16(a8[6] + p1[2], a8[7] + p1[3]);
        const bf16x8 bw = *(const GAS bf16x8*)(w1p + ks * 16);
        acc = __builtin_amdgcn_mfma_f32_32x32x16_bf16(__builtin_bit_cast(bf16x8, aw), bw, acc, 0, 0, 0);
    }
    if (kq == 1) {
#pragma unroll
        for (int r = 0; r < 16; ++r) red[(nb * 16 + r) * 64 + lane] = acc[r]; }
    __syncthreads();
    if (kq == 0) {
#pragma unroll
        for (int r = 0; r < 16; ++r) { const float h = gelu_tanh(acc[r] + red[(nb * 16 + r) * 64 + lane]); const int cr = (r & 3) + 8 * (r >> 2) + 4 * hi;
            *(LAS bf16*)(hidL + cr * 272 + (32 * nb + r32) * 2) = (bf16)f2bf(h); } }
    __syncthreads();
    if (wave == 0) {
        f32x16 o2[2];
#pragma unroll
        for (int db = 0; db < 2; ++db) {
#pragma unroll
            for (int r = 0; r < 16; ++r) o2[db][r] = 0.f;
#pragma unroll
            for (int ks = 0; ks < 8; ++ks) { const bf16x8 a = *(const GAS bf16x8*)(W2T + (size_t)(32 * db + r32) * 128 + ks * 16 + hi * 8);
                const bf16x8 hb = *(LAS const bf16x8*)(hidL + r32 * 272 + (ks * 16 + hi * 8) * 2);
                o2[db] = __builtin_amdgcn_mfma_f32_32x32x16_bf16(a, hb, o2[db], 0, 0, 0); } }
        const size_t bk = (size_t)(b * 2 + kh);
        if (kv == 0) {
            float sk = 0.f;
#pragma unroll
            for (int db = 0; db < 2; ++db)
#pragma unroll
                for (int r = 0; r < 16; ++r) sk += o2[db][r] * o2[db][r];
            sk = xhalf_sum(sk);
            const float kr = (c < NCMP) ? rsqrtf(sk * (1.f / 64.f) + RMS_EPS) : 0.f;
            const float* gkc = P.in[9];
#pragma unroll
            for (int db = 0; db < 2; ++db)
#pragma unroll
                for (int a = 0; a < 4; ++a) { const int d0 = 32 * db + 8 * a + 4 * hi; const f32x4 gg = *(const GAS f32x4*)(gkc + d0);
                    pg8::u32x2 w; w.x = pg8::cvt_pk_bf16(o2[db][4 * a] * kr * gg[0], o2[db][4 * a + 1] * kr * gg[1]); w.y = pg8::cvt_pk_bf16(o2[db][4 * a + 2] * kr * gg[2], o2[db][4 * a + 3] * kr * gg[3]);
                    *(GAS pg8::u32x2*)(KC + (bk * 128 + c) * 64 + d0) = w; }
        } else {
            const float z = (c < NCMP) ? 1.f : 0.f;
#pragma unroll
            for (int db = 0; db < 2; ++db)
#pragma unroll
                for (int r = 0; r < 16; ++r) { const int d = 32 * db + (r & 3) + 8 * (r >> 2) + 4 * hi; VCT[(bk * 64 + d) * 128 + c] = (bf16)f2bf(o2[db][r] * z); }
        }
    }
    __syncthreads();
}
__device__ __forceinline__ void p2_fast(const Ptrs& P, LAS unsigned char* lds, int vcu, int G, int tid, int wave, int lane) {
    for (int u = vcu; u < 128; u += G) compress_unit(P, lds, u, tid, wave, lane);
    for (int grp = G * NWAVES - 1 - (vcu * NWAVES + wave); grp < M / 32; grp += G * NWAVES) latent_group(P, grp, lane);
}

__device__ __forceinline__ unsigned ord_u32(float f) { const unsigned u = __float_as_uint(f); return (u & 0x80000000u) ? ~u : (u | 0x80000000u); }

__device__ __forceinline__ float inv_ord_u32(unsigned u) { return __uint_as_float((u & 0x80000000u) ? (u ^ 0x80000000u) : ~u); }
template <int CTRL> __device__ __forceinline__ unsigned dpp_mov(unsigned x) { return (unsigned)__builtin_amdgcn_update_dpp(0, (int)x, CTRL, 0xf, 0xf, true); }
__device__ __forceinline__ unsigned wave_umax(unsigned x) {
    unsigned y = dpp_mov<0xB1>(x); x = x > y ? x : y; y = dpp_mov<0x4E>(x); x = x > y ? x : y; y = dpp_mov<0x141>(x); x = x > y ? x : y; y = dpp_mov<0x140>(x); x = x > y ? x : y;
    const unsigned a = __builtin_amdgcn_readlane(x, 0), b = __builtin_amdgcn_readlane(x, 16), c = __builtin_amdgcn_readlane(x, 32), d = __builtin_amdgcn_readlane(x, 48);
    const unsigned ab = a > b ? a : b, cd = c > d ? c : d; return ab > cd ? ab : cd;
}
__device__ __forceinline__ unsigned wave_umin(unsigned x) {
    unsigned y = dpp_mov<0xB1>(x); x = x < y ? x : y; y = dpp_mov<0x4E>(x); x = x < y ? x : y; y = dpp_mov<0x141>(x); x = x < y ? x : y; y = dpp_mov<0x140>(x); x = x < y ? x : y;
    const unsigned a = __builtin_amdgcn_readlane(x, 0), b = __builtin_amdgcn_readlane(x, 16), c = __builtin_amdgcn_readlane(x, 32), d = __builtin_amdgcn_readlane(x, 48);
    const unsigned ab = a < b ? a : b, cd = c < d ? c : d; return ab < cd ? ab : cd;
}
__device__ __forceinline__ unsigned long long lanemask_lt(int lane) { return (1ull << lane) - 1ull; }

__device__ __forceinline__ void dsa_token(const Ptrs& P, LAS unsigned char* wl, int b, int t, int lane) {
    bf16* PROJ = (bf16*)(P.ws + WS_PROJ);
    const bf16* KA = (const bf16*)((unsigned char*)P.out + DO_KA); const bf16* VA = (const bf16*)((unsigned char*)P.out + DO_VA);
    LAS float* sc = (LAS float*)wl; LAS float* aux = sc + 2048; LAS int* idx = (LAS int*)(aux + 512); LAS float* pl = (LAS float*)(idx + 256);
    bf16* prow = PROJ + (size_t)(b * SEQ + t) * PITCH;
#pragma unroll
    for (int i = 0; i < 4; ++i) aux[lane + 64 * i] = bf2f(prow[C_QI + lane + 64 * i]);
    if (lane < 8) aux[256 + lane] = bf2f(prow[C_WI + lane]);
    LDS_WAIT();
    for (int s = lane; s <= t; s += 64) {
        const v4u* kp = (const v4u*)(PROJ + (size_t)(b * SEQ + s) * PITCH + C_KI);
        float kf[32]; unpack8(kp[0], kf); unpack8(kp[1], kf + 8); unpack8(kp[2], kf + 16); unpack8(kp[3], kf + 24);
        float score = 0.f;
#pragma unroll
        for (int h = 0; h < 8; ++h) { float dot = 0.f;
#pragma unroll
            for (int d = 0; d < 32; ++d) dot += aux[h * 32 + d] * kf[d];
            score += fmaxf(dot, 0.f) * aux[256 + h]; }
        sc[s] = score + 0.0f;
    }
    LDS_WAIT();
    unsigned u[32];
#pragma unroll
    for (int i = 0; i < 32; ++i) { const int s = lane + 64 * i; u[i] = (s <= t) ? ord_u32(sc[s]) : 0u; }
    unsigned T = 1u; int need = 1 << 30;
    if (t + 1 > TOPK) {
        T = 0u;
        for (int bit = 31; bit >= 0; --bit) { const unsigned cand = T | (1u << bit); int cnt = 0;
#pragma unroll
            for (int i = 0; i < 32; ++i) cnt += (u[i] >= cand) ? 1 : 0;
            cnt = wave_sum_i(cnt); if (cnt >= TOPK) T = cand; }
        int cg = 0;
#pragma unroll
        for (int i = 0; i < 32; ++i) cg += (u[i] > T) ? 1 : 0;
        need = TOPK - wave_sum_i(cg);
    }
    int base = 0, ties = 0; const unsigned long long lt = lanemask_lt(lane);
#pragma unroll
    for (int i = 0; i < 32; ++i) {
        const bool valid = (lane + 64 * i) <= t; const bool gt = valid && (u[i] > T); const bool eq = valid && (u[i] == T) && (t + 1 > TOPK);
        const unsigned long long meq = __ballot(eq); const int myrank = ties + __popcll(meq & lt); const bool take = gt || (eq && myrank < need); ties += __popcll(meq);
        const unsigned long long mt = __ballot(take); const int pos = base + __popcll(mt & lt); if (take && pos < TOPK) idx[pos] = lane + 64 * i; base += __popcll(mt);
    }
    const int nsel = base < TOPK ? base : TOPK;
    LDS_WAIT();
    for (int h = 0; h < 8; ++h) {
        float qf[64];
        { const v4u* qp = (const v4u*)(prow + C_QA + h * 64);
#pragma unroll
          for (int j = 0; j < 8; ++j) unpack8(qp[j], qf + 8 * j); }
        const float slope2 = exp2f(-(float)(h + 1)) * LOG2E;
        float sv[4]; float mx = -INFINITY;
#pragma unroll
        for (int jj = 0; jj < 4; ++jj) { const int j = lane + 64 * jj; sv[jj] = -INFINITY;
            if (j < nsel) { const int ix = idx[j]; const v4u* kp = (const v4u*)(KA + (size_t)(b * SEQ + ix) * 64); float dot = 0.f;
#pragma unroll
                for (int c8 = 0; c8 < 8; ++c8) { float kf[8]; unpack8(kp[c8], kf);
#pragma unroll
                    for (int e = 0; e < 8; ++e) dot += qf[c8 * 8 + e] * kf[e]; }
                sv[jj] = dot - slope2 * (float)(t - ix); }
            mx = fmaxf(mx, sv[jj]); }
        mx = wave_max(mx);
        float ls = 0.f;
#pragma unroll
        for (int jj = 0; jj < 4; ++jj) { const float p = exp2f(sv[jj] - mx); pl[lane + 64 * jj] = p; ls += p; }
        ls = wave_sum(ls);
        LDS_WAIT();
        float acc = 0.f;
        for (int j = 0; j < nsel; ++j) acc += pl[j] * bf2f(VA[(size_t)(b * SEQ + idx[j]) * 64 + lane]);
        LDS_WAIT();
        prow[C_QA + h * 64 + lane] = (bf16)f2bf(acc / ls);
    }
}

struct NsaAcc { float m[4], l[4], a[4]; };
__device__ __forceinline__ void nsa_block(NsaAcc& S, LAS const float* ql, LAS float* pl, const bf16* Kb, const bf16* Vb, size_t pitch, int kpos0, int t, int wlim, const float* slope2, int lane) {
    const int kpos = kpos0 + lane; const int dist = t - kpos; const bool valid = (kpos >= 0) && (dist >= 0) && (dist < wlim);
    float s[4] = {-INFINITY, -INFINITY, -INFINITY, -INFINITY};
    if (valid) { const v4u* kp = (const v4u*)(Kb + (size_t)kpos * pitch); float d4[4] = {0.f, 0.f, 0.f, 0.f};
#pragma unroll
        for (int c8 = 0; c8 < 8; ++c8) { float kf[8]; unpack8(kp[c8], kf);
#pragma unroll
            for (int g = 0; g < 4; ++g)
#pragma unroll
                for (int e = 0; e < 8; ++e) d4[g] += ql[g * 64 + c8 * 8 + e] * kf[e]; }
#pragma unroll
        for (int g = 0; g < 4; ++g) s[g] = d4[g] - slope2[g] * (float)dist; }
    bool any = false;
#pragma unroll
    for (int g = 0; g < 4; ++g) { const float bm = wave_max(s[g]); const float mn = fmaxf(S.m[g], bm);
        if (mn > -INFINITY) { const float alpha = exp2f(S.m[g] - mn); const float p = exp2f(s[g] - mn); S.l[g] = S.l[g] * alpha + wave_sum(p); S.a[g] *= alpha; S.m[g] = mn; pl[g * 64 + lane] = p; any = true; }
        else pl[g * 64 + lane] = 0.f; }
    LDS_WAIT();
    if (any) {
        const int k_lo = kpos0 < 0 ? -kpos0 : 0;
        for (int k = k_lo; k < 64; ++k) { if (kpos0 + k > t) break; const float v = bf2f(Vb[(size_t)(kpos0 + k) * pitch + lane]);
#pragma unroll
            for (int g = 0; g < 4; ++g) S.a[g] += pl[g * 64 + k] * v; }
    }
    LDS_WAIT();
}
__device__ __forceinline__ void nsa_token(const Ptrs& P, LAS unsigned char* wl, int b, int t, int kh, int lane) {
    bf16* PROJ = (bf16*)(P.ws + WS_PROJ);
    const bf16* KC = (const bf16*)((unsigned char*)P.out + DO_KC) + (size_t)(b * 2 + kh) * 128 * 64; const bf16* VC = (const bf16*)((unsigned char*)P.out + DO_VC) + (size_t)(b * 2 + kh) * 128 * 64;
    LAS float* ql = (LAS float*)wl; LAS float* pc = ql + 256; LAS float* pl = pc + 512;
    bf16* prow = PROJ + (size_t)(b * SEQ + t) * PITCH;
#pragma unroll
    for (int i = 0; i < 4; ++i) ql[lane + 64 * i] = bf2f(prow[C_QB + kh * 256 + lane + 64 * i]);
    LDS_WAIT();
    float slope2[4];
#pragma unroll
    for (int g = 0; g < 4; ++g) slope2[g] = exp2f(-(float)(kh * 4 + g + 1)) * LOG2E;
    float outv[4];
    {
        float s[2][4];
#pragma unroll
        for (int hb = 0; hb < 2; ++hb) { const int c = lane + 64 * hb; const bool valid = (c < NCMP) && (16 * c + 31 <= t);
#pragma unroll
            for (int g = 0; g < 4; ++g) s[hb][g] = -INFINITY;
            if (valid) { const v4u* kp = (const v4u*)(KC + (size_t)c * 64); float d4[4] = {0.f, 0.f, 0.f, 0.f};
#pragma unroll
                for (int c8 = 0; c8 < 8; ++c8) { float kf[8]; unpack8(kp[c8], kf);
#pragma unroll
                    for (int g = 0; g < 4; ++g)
#pragma unroll
                        for (int e = 0; e < 8; ++e) d4[g] += ql[g * 64 + c8 * 8 + e] * kf[e]; }
#pragma unroll
                for (int g = 0; g < 4; ++g) s[hb][g] = d4[g]; } }
#pragma unroll
        for (int g = 0; g < 4; ++g) { const float mx = wave_max(fmaxf(s[0][g], s[1][g]));
            float p0 = 0.f, p1 = 0.f; if (mx > -INFINITY) { p0 = exp2f(s[0][g] - mx); p1 = exp2f(s[1][g] - mx); }
            const float l = wave_sum(p0 + p1); const float inv = l > 0.f ? 1.f / l : 0.f;
            pc[g * 128 + lane] = p0 * inv; pc[g * 128 + 64 + lane] = p1 * inv; }
        LDS_WAIT();
        float a[4] = {0.f, 0.f, 0.f, 0.f};
        for (int c = 0; c < NCMP; ++c) { if (16 * c + 31 > t) break; const float v = bf2f(VC[(size_t)c * 64 + lane]);
#pragma unroll
            for (int g = 0; g < 4; ++g) a[g] += pc[g * 128 + c] * v; }
#pragma unroll
        for (int g = 0; g < 4; ++g) outv[g] = a[g] / (1.0f + __expf(-bf2f(prow[C_GB + (kh * 4 + g) * 3 + 0])));
    }
    unsigned selmask;
    {
        const int j = lane & 31; const int cur = t >> 6; float imp = 0.f;
        for (int c = 4 * j - 1; c <= 4 * j + 3; ++c) if (c >= 0 && c < NCMP) imp += (pc[c] + pc[128 + c]) + (pc[256 + c] + pc[384 + c]);
        const bool forced = (j == 0) || (j == cur) || (j == cur - 1);
        const float eff = (j > cur) ? -INFINITY : (imp + (forced ? 1e6f : 0.f));
        int rank = 0;
        for (int jp = 0; jp < 32; ++jp) { const float e2 = __shfl(eff, jp); rank += (e2 > eff || (e2 == eff && jp < j)) ? 1 : 0; }
        selmask = (unsigned)__ballot((lane < 32) && (rank < 16) && (j <= cur));
    }
    LDS_WAIT();
    {
        NsaAcc S;
#pragma unroll
        for (int g = 0; g < 4; ++g) { S.m[g] = -INFINITY; S.l[g] = 0.f; S.a[g] = 0.f; }
        const bf16* Kb = PROJ + (size_t)b * SEQ * PITCH + C_KS + kh * 64; const bf16* Vb = PROJ + (size_t)b * SEQ * PITCH + C_VS + kh * 64;
        for (int j = 31; j >= 0; --j) if ((selmask >> j) & 1u) nsa_block(S, ql, pl, Kb, Vb, PITCH, 64 * j, t, 1 << 30, slope2, lane);
#pragma unroll
        for (int g = 0; g < 4; ++g) outv[g] += (S.a[g] / S.l[g]) / (1.0f + __expf(-bf2f(prow[C_GB + (kh * 4 + g) * 3 + 1])));
    }
    {
        NsaAcc S;
#pragma unroll
        for (int g = 0; g < 4; ++g) { S.m[g] = -INFINITY; S.l[g] = 0.f; S.a[g] = 0.f; }
        const bf16* Kb = PROJ + (size_t)b * SEQ * PITCH + C_KW + kh * 64; const bf16* Vb = PROJ + (size_t)b * SEQ * PITCH + C_VW + kh * 64;
        const int lo = t - 511 < 0 ? 0 : t - 511;
        for (int j = t >> 6; j >= (lo >> 6); --j) nsa_block(S, ql, pl, Kb, Vb, PITCH, 64 * j, t, 512, slope2, lane);
#pragma unroll
        for (int g = 0; g < 4; ++g) outv[g] += (S.a[g] / S.l[g]) / (1.0f + __expf(-bf2f(prow[C_GB + (kh * 4 + g) * 3 + 2])));
    }
#pragma unroll
    for (int g = 0; g < 4; ++g) prow[C_QB + (kh * 4 + g) * 64 + lane] = (bf16)f2bf(outv[g]);
}

__device__ __forceinline__ void p3_mixers(const Ptrs& P, LAS unsigned char* lds, int gw, int NGW, int wave, int lane) {
    LAS unsigned char* wl = lds + wave * 16384;
    for (int it = gw; it < 3 * M; it += NGW) {
        const int kind = it / M, r = it % M, b = r / SEQ, t = ((r % SEQ) + 293 * b + 1021 * kind) % SEQ;
        if (kind == 0) dsa_token(P, wl, b, t, lane);
        else nsa_token(P, wl, b, t, kind - 1, lane);
    }
}


constexpr int KT_STRIDE = 144, VT_STRIDE = 136;
constexpr int KT_BYTES = 64 * KT_STRIDE, VT_BYTES = 64 * VT_STRIDE, TILE_BYTES = KT_BYTES + VT_BYTES;
constexpr int A_TILE0 = 0, A_TILE1 = TILE_BYTES, A_STG = 36864, A_IMP = 69632, A_EFF = 102400, A_SEL = 110592;
constexpr int D_MASK = 131072, A_WSC = 139264;
constexpr int SROW = 2048;


struct TileRegs { v4u k, v; };
__device__ __forceinline__ TileRegs tile_fetch(const bf16* Kb, size_t kpitch, const bf16* Vb, size_t vpitch, int tid) {
    const int row = tid >> 3, ch = tid & 7; TileRegs r;
    r.k = *(const GAS v4u*)(Kb + (size_t)row * kpitch + ch * 8);
    r.v = *(const GAS v4u*)(Vb + (size_t)row * vpitch + ch * 8);
    return r;
}
__device__ __forceinline__ void tile_store(LAS unsigned char* buf, const TileRegs& r, int tid) {
    const int row = tid >> 3, ch = tid & 7;
    *(LAS v4u*)(buf + row * KT_STRIDE + ch * 16) = r.k;
    LAS u64* vp = (LAS u64*)(buf + KT_BYTES + row * VT_STRIDE + ch * 16);
    vp[0] = (u64)r.v.x | ((u64)r.v.y << 32); vp[1] = (u64)r.v.z | ((u64)r.v.w << 32);
}
struct AttnState { f32x16 o0, o1; pg8::u32x4 qx; float m, l; bool started; };
struct KxOps { pg8::u32x4 k0, k1; };
__device__ __forceinline__ KxOps kx_ops(int r32, int hi) {
    KxOps k; k.k0 = (pg8::u32x4){0u, 0u, 0u, 0u}; k.k1 = k.k0;
    if (hi == 0) { const unsigned v0 = f2bf((float)r32), v1 = f2bf((float)(r32 + 32)); k.k0.y = v0 * 0x10001u; k.k1.y = v1 * 0x10001u; k.k0.z = k.k0.w = k.k1.z = k.k1.w = 0x3F803F80u; }
    return k;
}
__device__ __forceinline__ void attn_init(AttnState& s, float slope2, int hi) {
#pragma unroll
    for (int r = 0; r < 16; ++r) { s.o0[r] = 0.f; s.o1[r] = 0.f; }
    s.qx = (pg8::u32x4){0u, 0u, 0u, 0u};
    if (hi == 0) { const unsigned sh = f2bf(slope2); const unsigned sl = f2bf(slope2 - __uint_as_float(sh << 16)); s.qx.x = sh | (sl << 16); s.qx.y = s.qx.x; }
    s.m = 0.f; s.l = 0.f; s.started = false;
}
__device__ __forceinline__ bf16x8 pack8(const f32x16& p, int b0) {
    pg8::u32x4 w; w.x = pg8::cvt_pk_bf16(p[b0], p[b0 + 1]); w.y = pg8::cvt_pk_bf16(p[b0 + 2], p[b0 + 3]); w.z = pg8::cvt_pk_bf16(p[b0 + 4], p[b0 + 5]); w.w = pg8::cvt_pk_bf16(p[b0 + 6], p[b0 + 7]);
    return __builtin_bit_cast(bf16x8, w);
}
constexpr float ATT_THR = 8.0f;
template <bool BITS, bool IMP, bool QLDS>
__device__ __forceinline__ void tile_compute(AttnState& st, const bf16x8 (&qf)[4], LAS const unsigned char* qlds, KxOps& KX, float koff, bool active, bool all_active, LAS const unsigned char* buf, LAS float* wsc,
                                             bool need_mask, int lo, int hi_, unsigned mw0, unsigned mw1, f32x16& oimp, int c0, int r32, int hi) {
    f32x16 p0, p1;
    { const unsigned kw = (hi == 0) ? f2bf(koff) * 0x10001u : 0u; KX.k0.x = kw; KX.k1.x = kw;
      pg8::u32x4 q = st.qx; if (!all_active) q.w = (q.w & 0xffffu) | ((active || hi != 0) ? 0u : 0xff800000u);
#pragma unroll
      for (int r = 0; r < 16; ++r) { p0[r] = 0.f; p1[r] = 0.f; }
      p0 = __builtin_amdgcn_mfma_f32_32x32x16_bf16(__builtin_bit_cast(bf16x8, KX.k0), __builtin_bit_cast(bf16x8, q), p0, 0, 0, 0);
      p1 = __builtin_amdgcn_mfma_f32_32x32x16_bf16(__builtin_bit_cast(bf16x8, KX.k1), __builtin_bit_cast(bf16x8, q), p1, 0, 0, 0); }
    { LAS const unsigned char* kp = buf + r32 * KT_STRIDE + hi * 16;
#pragma unroll
      for (int ds = 0; ds < 4; ++ds) {
          const bf16x8 k0 = *(LAS const bf16x8*)(kp + ds * 32);
          const bf16x8 k1 = *(LAS const bf16x8*)(kp + 32 * KT_STRIDE + ds * 32);
          const bf16x8 qv = QLDS ? *(LAS const bf16x8*)(qlds + (((2 * ds + hi) ^ (r32 & 7)) * 16)) : qf[ds];
          p0 = __builtin_amdgcn_mfma_f32_32x32x16_bf16(k0, qv, p0, 0, 0, 0);
          p1 = __builtin_amdgcn_mfma_f32_32x32x16_bf16(k1, qv, p1, 0, 0, 0); } }
    if (BITS) { const unsigned w0 = mw0 >> (4 * hi), w1 = mw1 >> (4 * hi);
#pragma unroll
        for (int r = 0; r < 16; ++r) { const int c = (r & 3) + 8 * (r >> 2); if (!((w0 >> c) & 1u)) p0[r] = -INFINITY; if (!((w1 >> c) & 1u)) p1[r] = -INFINITY; } }
    else if (need_mask) { const int lo2 = lo - 4 * hi, hi2 = hi_ - 4 * hi;
#pragma unroll
        for (int r = 0; r < 16; ++r) { const int c = (r & 3) + 8 * (r >> 2); if (c < lo2 || c > hi2) p0[r] = -INFINITY; if (c + 32 < lo2 || c + 32 > hi2) p1[r] = -INFINITY; } }
    float rm = fmaxf(p0[0], p1[0]);
#pragma unroll
    for (int r = 1; r < 16; ++r) rm = fmaxf(rm, fmaxf(p0[r], p1[r]));
    rm = xhalf_max(rm);
    const bool need = st.started ? (rm > ATT_THR) : (rm > -INFINITY);
    if (__any(need)) {
        const float dl = need ? rm : 0.f; const float f = st.started ? __builtin_amdgcn_exp2f(-dl) : 1.0f;
        st.m += dl; st.l *= f; st.started = st.started || need;
        { const float nm = -st.m; const unsigned m1 = f2bf(nm); const float r1 = nm - __uint_as_float(m1 << 16); const unsigned m2 = f2bf(r1); const float r2 = r1 - __uint_as_float(m2 << 16); const unsigned m3 = f2bf(r2);
          if (hi == 0) { st.qx.z = m1 | (m2 << 16); st.qx.w = m3; } }
#pragma unroll
        for (int r = 0; r < 16; ++r) { p0[r] -= dl; p1[r] -= dl; }
        if (hi == 0) wsc[r32] = f;
        LDS_WAIT();
#pragma unroll
        for (int a = 0; a < 4; ++a) { const f32x4 av = *(LAS const f32x4*)(wsc + 8 * a + 4 * hi);
#pragma unroll
            for (int i = 0; i < 4; ++i) { st.o0[4 * a + i] *= av[i]; st.o1[4 * a + i] *= av[i]; if (IMP) oimp[4 * a + i] *= av[i]; } }
        LDS_WAIT();
    }
    float ps = 0.f;
#pragma unroll
    for (int r = 0; r < 16; ++r) { p0[r] = __builtin_amdgcn_exp2f(p0[r]); p1[r] = __builtin_amdgcn_exp2f(p1[r]); ps += p0[r] + p1[r]; }
    st.l += ps;
    bf16x8 pa[4]; pa[0] = pack8(p0, 0); pa[1] = pack8(p0, 8); pa[2] = pack8(p1, 0); pa[3] = pack8(p1, 8);
    { LAS const unsigned char* vp = buf + KT_BYTES + r32 * VT_STRIDE + hi * 8;
#pragma unroll
      for (int s = 0; s < 4; ++s) {
          u64x2 x0, x1; x0[0] = *(LAS const u64*)(vp + s * 32); x0[1] = *(LAS const u64*)(vp + s * 32 + 16);
          x1[0] = *(LAS const u64*)(vp + 32 * VT_STRIDE + s * 32); x1[1] = *(LAS const u64*)(vp + 32 * VT_STRIDE + s * 32 + 16);
          st.o0 = __builtin_amdgcn_mfma_f32_32x32x16_bf16(pa[s], __builtin_bit_cast(bf16x8, x0), st.o0, 0, 0, 0);
          st.o1 = __builtin_amdgcn_mfma_f32_32x32x16_bf16(pa[s], __builtin_bit_cast(bf16x8, x1), st.o1, 0, 0, 0); } }
    if (IMP) {
#pragma unroll
        for (int s = 0; s < 4; ++s) { bf16x8 ov;
#pragma unroll
            for (int e = 0; e < 8; ++e) { const int c = c0 + 16 * s + 8 * (e >> 2) + 4 * hi + (e & 3); ov[e] = (c >= 4 * r32 - 1 && c <= 4 * r32 + 3) ? (short)0x3F80 : (short)0; }
            oimp = __builtin_amdgcn_mfma_f32_32x32x16_bf16(pa[s], ov, oimp, 0, 0, 0); } }
}
__device__ __forceinline__ void attn_accum(f32x16& out0, f32x16& out1, const AttnState& st, float fac, LAS float* wsc, int r32, int hi) {
    if (hi == 0) wsc[r32] = fac;
    LDS_WAIT();
#pragma unroll
    for (int a = 0; a < 4; ++a) { const f32x4 av = *(LAS const f32x4*)(wsc + 8 * a + 4 * hi);
#pragma unroll
        for (int i = 0; i < 4; ++i) { out0[4 * a + i] += st.o0[4 * a + i] * av[i]; out1[4 * a + i] += st.o1[4 * a + i] * av[i]; } }
    LDS_WAIT();
}
__device__ __forceinline__ void store_tile_bf16(const f32x16& out0, const f32x16& out1, LAS bf16* stg, bf16* dst, size_t pitch, int lane, int r32, int hi) {
#pragma unroll
    for (int r = 0; r < 16; ++r) { const int q = (r & 3) + 8 * (r >> 2) + 4 * hi; stg[q * 64 + r32] = (bf16)f2bf(out0[r]); stg[q * 64 + 32 + r32] = (bf16)f2bf(out1[r]); }
    LDS_WAIT();
#pragma unroll
    for (int i = 0; i < 4; ++i) { const int row = i * 8 + (lane >> 3), ch = lane & 7; const v4u v = *(LAS const v4u*)(stg + row * 64 + ch * 8); *(GAS v4u*)(dst + (size_t)row * pitch + ch * 8) = v; }
    LDS_WAIT();
}


#define TILE_PIPELINE(FIRST, AFTER, FETCH, COMPUTE) do { \
        int jc_ = (FIRST); int jn_ = AFTER(jc_); int jnn_; TileRegs rA_ = FETCH(jc_), rB_; \
        tile_store(buf0, rA_, tid); if (jn_ >= 0) rB_ = FETCH(jn_); \
        __syncthreads(); \
        for (;;) { \
            jnn_ = jn_ >= 0 ? AFTER(jn_) : -1; if (jnn_ >= 0) rA_ = FETCH(jnn_); \
            COMPUTE(jc_, buf0); \
            if (jn_ < 0) break; \
            tile_store(buf1, rB_, tid); __syncthreads(); jc_ = jn_; jn_ = jnn_; \
            jnn_ = jn_ >= 0 ? AFTER(jn_) : -1; if (jnn_ >= 0) rB_ = FETCH(jnn_); \
            COMPUTE(jc_, buf1); \
            if (jn_ < 0) break; \
            tile_store(buf0, rA_, tid); __syncthreads(); jc_ = jn_; jn_ = jnn_; \
        } } while (0)
__device__ __forceinline__ void nsa_unit(const Ptrs& P, LAS unsigned char* lds, int b, int kh, int qb, int tid, int wave, int lane) {
    asm volatile("" : "+v"(tid), "+v"(lane));
    const int r32 = lane & 31, hi = lane >> 5, g = wave & 3, th = wave >> 2;
    bf16* PROJ = (bf16*)(P.ws + WS_PROJ);
    unsigned char* dob = (unsigned char*)P.out;
    const bf16* KCb = (const bf16*)(dob + DO_KC) + (size_t)(b * 2 + kh) * 128 * 64; const bf16* VCTb = (const bf16*)(dob + DO_VCT) + (size_t)(b * 2 + kh) * 64 * 128;
    const bf16* VSTb = (const bf16*)(dob + DO_VST) + (size_t)(b * 2 + kh) * 64 * SEQ; const bf16* VWTb = (const bf16*)(dob + DO_VWT) + (size_t)(b * 2 + kh) * 64 * SEQ;
    LAS unsigned char* buf0 = lds + A_TILE0; LAS unsigned char* buf1 = lds + A_TILE1;
    LAS float* wsc = (LAS float*)(lds + A_WSC) + wave * 64;
    LAS float* impL = (LAS float*)(lds + A_IMP); LAS float* effL = (LAS float*)(lds + A_EFF); LAS unsigned* selL = (LAS unsigned*)(lds + A_SEL);
    const int tq = 64 * qb + 32 * th + r32;
    const bf16* prow = PROJ + (size_t)(b * SEQ + tq) * PITCH;
    const float slope2 = exp2f(-(float)(kh * 4 + g + 1)) * LOG2E;
    bf16x8 qf[4];
#pragma unroll
    for (int ds = 0; ds < 4; ++ds) qf[ds] = *(const GAS bf16x8*)(prow + C_QB + (kh * 4 + g) * 64 + ds * 16 + hi * 8);
    KxOps KX = kx_ops(r32, hi);
    LAS unsigned char* qlds = lds + A_STG + wave * 4096 + r32 * 128;
#pragma unroll
    for (int ds = 0; ds < 4; ++ds) *(LAS bf16x8*)(qlds + (((2 * ds + hi) ^ (r32 & 7)) * 16)) = qf[ds];
    const float g0 = pg8::sigm(bf2f(prow[C_GB + (kh * 4 + g) * 3 + 0])), g1 = pg8::sigm(bf2f(prow[C_GB + (kh * 4 + g) * 3 + 1])), g2 = pg8::sigm(bf2f(prow[C_GB + (kh * 4 + g) * 3 + 2]));
    f32x16 out0, out1, oimp;
#pragma unroll
    for (int r = 0; r < 16; ++r) { out0[r] = 0.f; out1[r] = 0.f; oimp[r] = 0.f; }
    AttnState st;
    {
        TileRegs tr = tile_fetch(KCb, 64, VCTb, 128, tid); tile_store(buf0, tr, tid);
        tr = tile_fetch(KCb + 64 * 64, 64, VCTb + 64, 128, tid); tile_store(buf1, tr, tid);
        if (tid < 64) selL[tid] = 0u;
        __syncthreads();
        attn_init(st, 0.f, hi);
        const int hc = (tq - 31) >> 4;
#pragma unroll 1
        for (int ct = 0; ct < 2; ++ct) { tile_compute<false, true, true>(st, qf, qlds, KX, 0.f, true, true, ct ? buf1 : buf0, wsc, true, -(1 << 20), hc - 64 * ct, 0u, 0u, oimp, 64 * ct, r32, hi); __builtin_amdgcn_sched_barrier(0); }
        const float lt = xhalf_sum(st.l); const float linv = lt > 0.f ? 1.0f / lt : 0.f;
        attn_accum(out0, out1, st, linv * g0, wsc, r32, hi);
        if (hi == 0) wsc[r32] = linv;
        LDS_WAIT();
#pragma unroll
        for (int a = 0; a < 4; ++a) { const f32x4 av = *(LAS const f32x4*)(wsc + 8 * a + 4 * hi);
#pragma unroll
            for (int i = 0; i < 4; ++i) { const int q = 8 * a + 4 * hi + i; impL[(wave * 32 + q) * 32 + r32] = oimp[4 * a + i] * av[i]; } }
        LDS_WAIT();
        __syncthreads();
        const int tk = tid >> 3, th2 = tk >> 5, q2 = tk & 31, sub = tid & 7;
        float e[4];
#pragma unroll
        for (int i = 0; i < 4; ++i) { const int j = sub * 4 + i; float imp = 0.f;
#pragma unroll
            for (int g2 = 0; g2 < 4; ++g2) imp += impL[((th2 * 4 + g2) * 32 + q2) * 32 + j];
            const bool forced = (j == 0) || (j == qb) || (j == qb - 1);
            e[i] = (j > qb) ? -INFINITY : (imp + (forced ? 1e6f : 0.f)); effL[tk * 32 + j] = e[i]; }
        __syncthreads();
        int rank[4] = {0, 0, 0, 0};
#pragma unroll 1
        for (int jp = 0; jp < 32; ++jp) { const float e2 = effL[tk * 32 + jp];
#pragma unroll
            for (int i = 0; i < 4; ++i) rank[i] += (e2 > e[i] || (e2 == e[i] && jp < sub * 4 + i)) ? 1 : 0; }
        unsigned bits = 0u;
#pragma unroll
        for (int i = 0; i < 4; ++i) if (rank[i] < 16 && sub * 4 + i <= qb) bits |= 1u << (sub * 4 + i);
        if (bits) __hip_atomic_fetch_or(selL + tk, bits, __ATOMIC_RELAXED, __HIP_MEMORY_SCOPE_WORKGROUP);
        __syncthreads();
    }
    unsigned U = 0u;
#pragma unroll
    for (int k = 0; k < 16; ++k) { const v4u w = *(LAS const v4u*)(selL + 4 * k); U |= (w.x | w.y) | (w.z | w.w); }
    U = __builtin_amdgcn_readfirstlane(U);
    const unsigned msk = selL[32 * th + r32];
    {
        const bf16* Kb = PROJ + (size_t)b * SEQ * PITCH + C_KS + kh * 64;
        attn_init(st, slope2, hi);
#define SEL_AFTER(j) ((U & ((1u << (j)) - 1u)) ? 31 - __builtin_clz(U & ((1u << (j)) - 1u)) : -1)
#define SEL_FETCH(j) tile_fetch(Kb + (size_t)(64 * (j)) * PITCH, PITCH, VSTb + 64 * (j), SEQ, tid)
#define SEL_COMPUTE(j, buf) { const bool rowsel = (msk >> (j)) & 1u; const int dq = tq - 64 * (j); \
            if (__any(rowsel)) tile_compute<false, false, true>(st, qf, qlds, KX, (float)(64 * (j)), rowsel, __all(rowsel) != 0, buf, wsc, (j) == qb, -(1 << 20), dq, 0u, 0u, oimp, 0, r32, hi); }
        TILE_PIPELINE(31 - __builtin_clz(U), SEL_AFTER, SEL_FETCH, SEL_COMPUTE);
#undef SEL_AFTER
#undef SEL_FETCH
#undef SEL_COMPUTE
        const float lt = xhalf_sum(st.l);
        attn_accum(out0, out1, st, g1 / lt, wsc, r32, hi);
        __syncthreads();
    }
    {
        const bf16* Kb = PROJ + (size_t)b * SEQ * PITCH + C_KW + kh * 64;
        attn_init(st, slope2, hi);
        const int jlo = qb - 8 < 0 ? 0 : qb - 8;
#define WIN_AFTER(j) ((j) > jlo ? (j) - 1 : -1)
#define WIN_FETCH(j) tile_fetch(Kb + (size_t)(64 * (j)) * PITCH, PITCH, VWTb + 64 * (j), SEQ, tid)
#define WIN_COMPUTE(j, buf) { const int dq = tq - 64 * (j); \
            tile_compute<false, false, true>(st, qf, qlds, KX, (float)(64 * (j)), true, true, buf, wsc, ((j) == qb) || ((j) == qb - 8), dq - 511, dq, 0u, 0u, oimp, 0, r32, hi); }
        TILE_PIPELINE(qb, WIN_AFTER, WIN_FETCH, WIN_COMPUTE);
#undef WIN_AFTER
#undef WIN_FETCH
#undef WIN_COMPUTE
        const float lt = xhalf_sum(st.l);
        attn_accum(out0, out1, st, g2 / lt, wsc, r32, hi);
    }
    store_tile_bf16(out0, out1, (LAS bf16*)(lds + A_STG) + wave * 2048, (bf16*)(dob + DO_O) + (size_t)(b * SEQ + 64 * qb + 32 * th) * DM + 512 + (kh * 4 + g) * 64, DM, lane, r32, hi);
    __syncthreads();
}


__device__ __forceinline__ void dsa_unit(const Ptrs& P, LAS unsigned char* lds, int b, int ti, int tid, int wave, int lane) {
    asm volatile("" : "+v"(tid), "+v"(lane));
    const int r32 = lane & 31, hi = lane >> 5, fr = lane & 15, fq = lane >> 4;
    bf16* PROJ = (bf16*)(P.ws + WS_PROJ);
    unsigned char* dob = (unsigned char*)P.out;
    const bf16* Kb = (const bf16*)(dob + DO_KA) + (size_t)b * SEQ * 64; const bf16* VTb = (const bf16*)(dob + DO_VAT) + (size_t)b * 64 * SEQ;
    const bf16* PB = PROJ + (size_t)b * SEQ * PITCH;
    LAS float* scL = (LAS float*)lds; LAS unsigned* maskL = (LAS unsigned*)(lds + D_MASK);
    LAS float* wsc = (LAS float*)(lds + A_WSC) + wave * 64;
    const int t0 = 32 * ti;
    const u64 ltm = (1ull << lane) - 1ull;
    for (int half_ = 0; half_ < 2 * PROBE_DPRE; ++half_) {
        const int half = half_ & 1;
        const int th0 = t0 + 16 * half; const int ntile = (th0 >> 4) + 1;
        {
            bf16x8 qa[8];
            const bf16* qrow = PB + (size_t)(th0 + fr) * PITCH + C_QI + fq * 8;
#pragma unroll
            for (int hh = 0; hh < 8; ++hh) qa[hh] = *(const GAS bf16x8*)(qrow + hh * 32);
            float wv[4][8];
#pragma unroll
            for (int i = 0; i < 4; ++i) { const v4u w = *(const GAS v4u*)(PB + (size_t)(th0 + 4 * fq + i) * PITCH + C_WI); unpack8(w, wv[i]); }
            const bf16* kbase = PB + (size_t)fr * PITCH + C_KI + fq * 8;
            bf16x8 kbn[4];
#pragma unroll
            for (int q4 = 0; q4 < 4; ++q4) { int kt = wave + 8 * q4; kt = kt < ntile ? kt : ntile - 1; kbn[q4] = *(const GAS bf16x8*)(kbase + (size_t)(16 * kt) * PITCH); }
            for (int rep_ = 0; rep_ < PROBE_DIDX; ++rep_)
            for (int kt0 = wave; kt0 < ntile; kt0 += 32) {
                bf16x8 kbc[4];
#pragma unroll
                for (int q4 = 0; q4 < 4; ++q4) kbc[q4] = kbn[q4];
                if (kt0 + 32 < ntile) {
#pragma unroll
                    for (int q4 = 0; q4 < 4; ++q4) { int kt = kt0 + 32 + 8 * q4; kt = kt < ntile ? kt : ntile - 1; kbn[q4] = *(const GAS bf16x8*)(kbase + (size_t)(16 * kt) * PITCH); } }
#pragma unroll
                for (int q4 = 0; q4 < 4; ++q4) { const int kt = kt0 + 8 * q4;
                    if (kt < ntile) {
                        float sc[4] = {0.f, 0.f, 0.f, 0.f};
#pragma unroll
                        for (int hh = 0; hh < 8; ++hh) { f32x4 acc = {0.f, 0.f, 0.f, 0.f}; acc = __builtin_amdgcn_mfma_f32_16x16x32_bf16(qa[hh], kbc[q4], acc, 0, 0, 0);
#pragma unroll
                            for (int i = 0; i < 4; ++i) sc[i] += fmaxf(acc[i], 0.f) * wv[i][hh]; }
#pragma unroll
                        for (int i = 0; i < 4; ++i) scL[(4 * fq + i) * SROW + 16 * kt + fr] = sc[i] + 0.0f;
                    } }
            }
        }
        __syncthreads();
        for (int rr_ = 0; rr_ < 2 * PROBE_DTHR; ++rr_) {
            const int rr = rr_ & 1;
            const int row = 2 * wave + rr; const int t = th0 + row; const int nch = (t >> 6) + 1;
            unsigned u[32];
#pragma unroll
            for (int i = 0; i < 32; ++i) { const int s = lane + 64 * i; u[i] = 0u; if (s <= t) u[i] = ord_u32(scL[row * SROW + s]); }
            LAS unsigned* mrow = maskL + (16 * half + row) * 64;
            const bool big = (t + 1 > TOPK);
            unsigned T = 1u; bool exact = true;
            if (big) {
                unsigned vmx = 0u, vmn = 0xffffffffu;
#pragma unroll
                for (int i = 0; i < 32; ++i) { vmx = vmx > u[i] ? vmx : u[i]; const unsigned w = u[i] ? u[i] : 0xffffffffu; vmn = vmn < w ? vmn : w; }
                unsigned lo = wave_umin(vmn), hi = wave_umax(vmx) + 1u; int clo = t + 1, chi = 0;
                exact = false;
#define DSA_CNT8(g) { u64 m0, m1, m2, m3, m4, m5, m6, m7; \
                    asm volatile("v_cmp_ge_u32_e64 %0, %1, %2" : "=s"(m0) : "v"(u[8 * (g) + 0]), "v"(c)); asm volatile("v_cmp_ge_u32_e64 %0, %1, %2" : "=s"(m1) : "v"(u[8 * (g) + 1]), "v"(c)); \
                    asm volatile("v_cmp_ge_u32_e64 %0, %1, %2" : "=s"(m2) : "v"(u[8 * (g) + 2]), "v"(c)); asm volatile("v_cmp_ge_u32_e64 %0, %1, %2" : "=s"(m3) : "v"(u[8 * (g) + 3]), "v"(c)); \
                    asm volatile("v_cmp_ge_u32_e64 %0, %1, %2" : "=s"(m4) : "v"(u[8 * (g) + 4]), "v"(c)); asm volatile("v_cmp_ge_u32_e64 %0, %1, %2" : "=s"(m5) : "v"(u[8 * (g) + 5]), "v"(c)); \
                    asm volatile("v_cmp_ge_u32_e64 %0, %1, %2" : "=s"(m6) : "v"(u[8 * (g) + 6]), "v"(c)); asm volatile("v_cmp_ge_u32_e64 %0, %1, %2" : "=s"(m7) : "v"(u[8 * (g) + 7]), "v"(c)); \
                    int c0, c1, c2, c3, c4, c5, c6, c7; \
                    asm volatile("s_bcnt1_i32_b64 %0, %1" : "=s"(c0) : "s"(m0) : "scc"); asm volatile("s_bcnt1_i32_b64 %0, %1" : "=s"(c1) : "s"(m1) : "scc"); asm volatile("s_bcnt1_i32_b64 %0, %1" : "=s"(c2) : "s"(m2) : "scc"); asm volatile("s_bcnt1_i32_b64 %0, %1" : "=s"(c3) : "s"(m3) : "scc"); \
                    asm volatile("s_bcnt1_i32_b64 %0, %1" : "=s"(c4) : "s"(m4) : "scc"); asm volatile("s_bcnt1_i32_b64 %0, %1" : "=s"(c5) : "s"(m5) : "scc"); asm volatile("s_bcnt1_i32_b64 %0, %1" : "=s"(c6) : "s"(m6) : "scc"); asm volatile("s_bcnt1_i32_b64 %0, %1" : "=s"(c7) : "s"(m7) : "scc"); \
                    cnt += ((c0 + c1) + (c2 + c3)) + ((c4 + c5) + (c6 + c7)); }
                for (int it = 0; ; ++it) {
                    if (clo == TOPK) { exact = true; break; }
                    if (hi - lo <= 1u) break;
                    unsigned c;
                    if (it % 3 == 2) c = lo + ((hi - lo) >> 1);
                    else { const float flo = inv_ord_u32(lo), fhi = inv_ord_u32(hi); const float frac = ((float)(clo - TOPK) - 0.5f) / (float)(clo - chi); c = ord_u32(flo + (fhi - flo) * frac); }
                    c = c <= lo ? lo + 1u : c; c = c >= hi ? hi - 1u : c;
                    c = __builtin_amdgcn_readfirstlane(c);
                    int cnt = 0;
                    if (nch <= 16) { DSA_CNT8(0) DSA_CNT8(1) } else { DSA_CNT8(0) DSA_CNT8(1) DSA_CNT8(2) DSA_CNT8(3) }
                    if (cnt >= TOPK) { lo = c; clo = cnt; } else { hi = c; chi = cnt; }
                }
#undef DSA_CNT8
                T = lo;
            }
            if (exact) {
                unsigned wlo = 0u, whi = 0u;
#pragma unroll
                for (int i = 0; i < 32; ++i) { const u64 mt = __ballot(u[i] >= T); wlo = (lane == i) ? (unsigned)mt : wlo; whi = (lane == i) ? (unsigned)(mt >> 32) : whi; }
                if (lane < 32) { mrow[2 * lane] = wlo; mrow[2 * lane + 1] = whi; }
            } else {
                int cg = 0;
#pragma unroll
                for (int i = 0; i < 32; ++i) cg += __popcll(__ballot(u[i] > T));
                const int need = TOPK - cg; int ties = 0;
#pragma unroll
                for (int i = 0; i < 32; ++i) {
                    const bool gt = u[i] > T; const bool eq = u[i] == T;
                    const u64 meq = __ballot(eq); const int myrank = ties + __popcll(meq & ltm); const bool take = gt || (eq && myrank < need); ties += __popcll(meq);
                    const u64 mt = __ballot(take);
                    if (lane == 0) { mrow[2 * i] = (unsigned)mt; mrow[2 * i + 1] = (unsigned)(mt >> 32); }
                }
            }
        }
        __syncthreads();
    }
    const int tq = t0 + r32; const int h = wave;
    const bf16* prow = PB + (size_t)tq * PITCH;
    bf16x8 qf[4];
#pragma unroll
    for (int ds = 0; ds < 4; ++ds) qf[ds] = *(const GAS bf16x8*)(prow + C_QA + h * 64 + ds * 16 + hi * 8);
    const float slope2 = exp2f(-(float)(h + 1)) * LOG2E;
    KxOps KX = kx_ops(r32, hi);
    LAS unsigned char* buf0 = lds + A_TILE0; LAS unsigned char* buf1 = lds + A_TILE1;
    AttnState st;
    f32x16 dummy;
#pragma unroll
    for (int r = 0; r < 16; ++r) dummy[r] = 0.f;
    for (int rep = 0; rep < PROBE_DATT; ++rep) {
    attn_init(st, slope2, hi);
#define DSA_AFTER(j) ((j) - 1)
#define DSA_FETCH(j) tile_fetch(Kb + (size_t)(64 * (j)) * 64, 64, VTb + 64 * (j), SEQ, tid)
#define DSA_COMPUTE(j, buf) { const unsigned mw0 = maskL[r32 * 64 + 2 * (j)], mw1 = maskL[r32 * 64 + 2 * (j) + 1]; \
        tile_compute<true, false, false>(st, qf, nullptr, KX, (float)(64 * (j)), true, true, buf, wsc, false, 0, 0, mw0, mw1, dummy, 0, r32, hi); }
    TILE_PIPELINE((t0 + 31) >> 6, DSA_AFTER, DSA_FETCH, DSA_COMPUTE);
#undef DSA_AFTER
#undef DSA_FETCH
#undef DSA_COMPUTE
    __syncthreads();
    }
    const float lt = xhalf_sum(st.l);
    f32x16 out0, out1;
#pragma unroll
    for (int r = 0; r < 16; ++r) { out0[r] = 0.f; out1[r] = 0.f; }
    attn_accum(out0, out1, st, 1.0f / lt, wsc, r32, hi);
    __syncthreads();
    store_tile_bf16(out0, out1, (LAS bf16*)(lds + A_STG) + wave * 2048, (bf16*)(dob + DO_O) + (size_t)(b * SEQ + t0) * DM + h * 64, DM, lane, r32, hi);
    __syncthreads();
}

__device__ __forceinline__ void p3_fast(const Ptrs& P, LAS unsigned char* lds, int vcu, int G, int tid, int wave, int lane) {
    for (int u = vcu; u < 256; u += G) {
        for (int k = 0; k < 2; ++k) { const int b = u >> 5, p = u & 31; dsa_unit(P, lds, b, k ? p : 63 - p, tid, wave, lane); }
        for (int k = 0; k < 2 * PROBE_NSA; ++k) { const int b = u >> 5, kh = (u >> 4) & 1, p = u & 15; nsa_unit(P, lds, b, kh, (k & 1) ? p : 31 - p, tid, wave, lane); }
    }
}

struct Args { Ptrs p; };
__global__ void __launch_bounds__(NWAVES * 64, 2) fwd_kernel(Args args) {
    extern __shared__ __attribute__((aligned(16))) unsigned char lds_raw[];
    LAS unsigned char* lds = (LAS unsigned char*)lds_raw;
    const Ptrs& P = args.p;
    const int tid = threadIdx.x, lane = tid & 63, wave = __builtin_amdgcn_readfirstlane(tid >> 6);
    const int G = gridDim.x; const int bx = blockIdx.x; const int vcu = (G % 8 == 0) ? (bx % 8) * (G / 8) + bx / 8 : bx;
    const int gw = vcu * NWAVES + wave, NGW = G * NWAVES;
    volatile LAS unsigned* MISC = (volatile LAS unsigned*)(lds + MISC_OFF);
    for (int u = tid; u < (LDS_BYTES - RING_BYTES) / 4; u += NWAVES * 64) ((LAS unsigned*)(lds + RING_BYTES))[u] = 0u;
    __syncthreads();
    unsigned* ctl = (unsigned*)(P.ws + WS_CTL);
    XcdBarrier bar = xcd_barrier_post(ctl + CW_BAR, MISC + 8);

    bf16* H = (bf16*)((unsigned char*)P.out + DO_H);
    bf16* PROJ = (bf16*)(P.ws + WS_PROJ); bf16* HID = (bf16*)(P.ws + WS_PROJ);
    bf16* MERGED = (bf16*)(P.ws + WS_MERGED); bf16* X1B = (bf16*)(P.ws + WS_X1B); float* PARTS = (float*)(P.ws + WS_PARTS);

    for (int rep = 0; rep < PROBE_P0; ++rep) p0_prologue(P, lds, gw, NGW, wave, lane);
    xcd_barrier(bar);
    for (int rep = 0; rep < PROBE_P1; ++rep) {
        pg8::Gemm g{H, (const bf16*)(P.ws + WS_WIN), M, PITCH, DM, DM}; pg8::StaticOrder S; S.init(M, PITCH, G, bx);
        pg8::EpiProj E{PROJ, PITCH, P.in[3], P.in[8], P.in[10], P.in[11], (bf16*)((unsigned char*)P.out + DO_VST), (bf16*)((unsigned char*)P.out + DO_VWT), QSCALE, RMS_EPS, SEQ};
        pg8::gemm_phase<pg8::EpiProj, pg8::StaticOrder, true>(lds, g, S, E);
    }
    xcd_barrier(bar);
    for (int rep = 0; rep < PROBE_P2; ++rep) p2_fast(P, lds, vcu, G, tid, wave, lane);
    xcd_barrier(bar);
    for (int rep = 0; rep < PROBE_P3; ++rep) p3_fast(P, lds, vcu, G, tid, wave, lane);
    xcd_barrier(bar);
    for (int rep = 0; rep < PROBE_P4; ++rep) {
        pg8::StaticOrder S; S.init(M, DM, G, bx);
        const bf16* OB = (const bf16*)((unsigned char*)P.out + DO_O);
        pg8::Gemm g{OB, (const bf16*)(P.ws + WS_WUPA), M, DM, DM, DM}; pg8::EpiGate2 E{MERGED, DM, PROJ, PITCH, C_GM, C_GM + DM};
        pg8::gemm_phase<pg8::EpiGate2, pg8::StaticOrder, false>(lds, g, S, E);
    }
    xcd_barrier(bar);
    for (int rep = 0; rep < PROBE_P5; ++rep) {
        pg8::Gemm g{MERGED, (const bf16*)(P.ws + WS_WOUT), M, DM, DM, DM}; pg8::StaticOrder S; S.init(M, DM, G, bx);
        pg8::EpiOutRes E{P.in[0], P.out, X1B, DM, PARTS};
        pg8::gemm_phase<pg8::EpiOutRes, pg8::StaticOrder, false>(lds, g, S, E);
    }
    xcd_barrier(bar);
    for (int rep = 0; rep < PROBE_P6; ++rep) {
        pg8::Gemm g{X1B, (const bf16*)(P.ws + WS_WFF1), M, FF, DM, DM}; pg8::StaticOrder S; S.init(M, FF, G, bx);
        pg8::EpiRelu2 E{HID, FF, PARTS, RMS_EPS, 1.0f / DM};
        pg8::gemm_phase<pg8::EpiRelu2, pg8::StaticOrder, true>(lds, g, S, E);
    }
    xcd_barrier(bar);
    {
        pg8::Gemm g{HID, (const bf16*)(P.ws + WS_WFF2), M, DM, FF, FF}; pg8::StaticOrder S; S.init(M, DM, G, bx);
        pg8::EpiFinal E{P.out, DM};
        pg8::gemm_phase<pg8::EpiFinal, pg8::StaticOrder, false>(lds, g, S, E);
    }
}

extern "C" void kernel_launch(void* const* d_in, const int* in_sizes, int n_in, void* d_out, int out_size, void* d_ws, size_t ws_size, hipStream_t stream) {
    static int grid = 0;
    if (grid == 0) {
        if (n_in != 23 || in_sizes[0] != M * DM || out_size != M * DM || ws_size < WS_END) { fprintf(stderr, "kernel_launch: unexpected shapes (n_in %d, in0 %d, out %d, ws %zu)\n", n_in, n_in > 0 ? in_sizes[0] : -1, out_size, ws_size); grid = -1; return; }
        int dev = 0, cus = 0, per_cu = 0;
        if (hipGetDevice(&dev) != hipSuccess || hipDeviceGetAttribute(&cus, hipDeviceAttributeMultiprocessorCount, dev) != hipSuccess) { grid = -1; return; }
        if (hipFuncSetAttribute((const void*)fwd_kernel, hipFuncAttributeMaxDynamicSharedMemorySize, LDS_BYTES) != hipSuccess) { fprintf(stderr, "kernel_launch: hipFuncSetAttribute failed\n"); grid = -1; return; }
        if (hipOccupancyMaxActiveBlocksPerMultiprocessor(&per_cu, (const void*)fwd_kernel, NWAVES * 64, LDS_BYTES) != hipSuccess || per_cu < 1) { fprintf(stderr, "kernel_launch: occupancy query reports %d blocks per CU\n", per_cu); }
        (void)hipGetLastError();
        grid = cus;
    }
    if (grid < 0) return;
    if (hipMemsetAsync((char*)d_ws + WS_CTL, 0, CTL_ZERO_BYTES, stream) != hipSuccess) { fprintf(stderr, "kernel_launch: memset failed\n"); return; }
    Args a{};
    for (int i = 0; i < 23; ++i) a.p.in[i] = (const float*)d_in[i];
    a.p.out = (float*)d_out; a.p.ws = (unsigned char*)d_ws;
    void* kargs[] = {&a};
    hipError_t e = hipLaunchCooperativeKernel((const void*)fwd_kernel, dim3(grid), dim3(NWAVES * 64), kargs, LDS_BYTES, stream);
    if (e != hipSuccess) fprintf(stderr, "kernel_launch: cooperative launch failed: %s (grid %d)\n", hipGetErrorString(e), grid);
}
```

```cpp
#include <hip/hip_runtime.h>
#include <cstdio>
#include <cstdint>

namespace pg8 {
#define PG8_LAS __attribute__((address_space(3)))
typedef unsigned short bf16_t;
typedef short bf16x8 __attribute__((ext_vector_type(8)));
typedef float f32x4 __attribute__((ext_vector_type(4)));
typedef unsigned u32x4 __attribute__((ext_vector_type(4)));
typedef unsigned u32x2 __attribute__((ext_vector_type(2)));
typedef int i32x8 __attribute__((ext_vector_type(8)));
constexpr int BM = 256, BK = 64, HALF = 128, HTB = HALF * BK * 2  , STAGE_BYTES = 8 * HTB, NXCD = 8, WGM = 8;

__host__ __device__ __forceinline__ int lds_byte(int r, int c) { const int st = (r >> 4) * 2 + (c >> 5), rr = r & 15, cc = c & 31, ob = rr * 64 + cc * 2; return st * 1024 + (ob ^ (((ob >> 9) & 1) << 5)); }
__host__ __device__ __forceinline__ void stage_rc(int b, int& R, int& C) { const int st = b / 1024, sb = b % 1024, swz = sb ^ (((sb >> 9) & 1) << 5); R = (st >> 1) * 16 + swz / 64; C = (st & 1) * 32 + (swz % 64) / 2; }
__host__ __device__ __forceinline__ int perm32(int rho) { const int n = rho >> 4, i = rho & 15; return 8 * (i >> 2) + 4 * n + (i & 3); }

struct Unit { int pm, pn; };
struct Gemm { const bf16_t* A; const bf16_t* Bt; int M, N, K, lda; };

struct StaticOrder {
    int nM, nN, nwg, G, c;
    __host__ __device__ void init(int M, int N, int G_, int c_) { nM = M / BM; nN = N / BM; nwg = nM * nN; G = G_; c = c_; }
    __host__ __device__ bool next(int i, Unit& u) const {
        const long L = (long)i * G + c; if (L >= nwg) return false;
        int wgid = (int)L; { const int q = nwg / NXCD, r = nwg % NXCD, xcd = wgid % NXCD, off = wgid / NXCD; wgid = (xcd < r ? xcd * (q + 1) : r * (q + 1) + (xcd - r) * q) + off; }
        const int nig = WGM * nN, gid = wgid / nig, fm = gid * WGM, gsz = (nM - fm) < WGM ? (nM - fm) : WGM;
        u.pm = fm + ((wgid % nig) % gsz); u.pn = (wgid % nig) / gsz; return true;
    }
};

struct ColTileOrder { int pn, first, stride, nM; __host__ __device__ bool next(int i, Unit& u) const { const int pm = first + i * stride; if (pm >= nM) return false; u.pm = pm; u.pn = pn; return true; } };

typedef float f32x2v __attribute__((ext_vector_type(2))); typedef __bf16 bf16x2v __attribute__((ext_vector_type(2)));
__device__ __forceinline__ unsigned cvt_pk_bf16(float lo, float hi) { const f32x2v v = {lo, hi}; const bf16x2v b = __builtin_convertvector(v, bf16x2v); return __builtin_bit_cast(unsigned, b); }
__device__ __forceinline__ unsigned cvt4_fp8(float a, float b, float c, float d) { int w = __builtin_amdgcn_cvt_pk_fp8_f32(a, b, 0, false); w = __builtin_amdgcn_cvt_pk_fp8_f32(c, d, w, true); return (unsigned)w; }
typedef float f32x2u __attribute__((ext_vector_type(2)));
__device__ __forceinline__ void unpack8_fp8(const u32x2 g, float (&o)[8]) { const f32x2u a = __builtin_amdgcn_cvt_pk_f32_fp8((int)g.x, false), b = __builtin_amdgcn_cvt_pk_f32_fp8((int)g.x, true), c = __builtin_amdgcn_cvt_pk_f32_fp8((int)g.y, false), d = __builtin_amdgcn_cvt_pk_f32_fp8((int)g.y, true);
    o[0] = a[0]; o[1] = a[1]; o[2] = b[0]; o[3] = b[1]; o[4] = c[0]; o[5] = c[1]; o[6] = d[0]; o[7] = d[1]; }
__device__ __forceinline__ float bflo(unsigned w) { return __uint_as_float(w << 16); }
__device__ __forceinline__ float bfhi(unsigned w) { return __uint_as_float(w & 0xffff0000u); }
__device__ __forceinline__ float sigm(float x) { return 1.0f / (1.0f + __expf(-x)); }
__device__ __forceinline__ float sigq(float x) { return fmaxf(sigm(x), 0.001953125f); }
__device__ __forceinline__ unsigned cvt4_fp8c(float a, float b, float c, float d) { return cvt4_fp8(__builtin_amdgcn_fmed3f(a, -448.f, 448.f), __builtin_amdgcn_fmed3f(b, -448.f, 448.f), __builtin_amdgcn_fmed3f(c, -448.f, 448.f), __builtin_amdgcn_fmed3f(d, -448.f, 448.f)); }

template <int F8_> struct EpiProjT {
    static constexpr bool PERM = true; static constexpr int F8 = F8_, F8W = 0x7A7A7A7A, F8A = 0x7F7F7F7F; static constexpr int MIDK = 0;
    bf16_t* O; int ldc; const float *gqa, *gqb, *gks, *gkw; bf16_t* VST; bf16_t* VWT; float qscale, eps; int seq; bf16_t* GT;
    __device__ __forceinline__ void operator()(const f32x4 (&acc)[2][2][4][2], const Unit& u, int wr, int wc, int fr, int fq) const {
        const int f0 = u.pn * BM + wc * 64;
        const float* g = nullptr; float sc = 1.f;
        if (f0 >= 1024 && f0 < 1536) { g = gqa; sc = qscale; } else if (f0 >= 320 && f0 < 832) { g = gqb; sc = qscale; } else if (f0 == 1792 || f0 == 1856) { g = gks; } else if (f0 == 2048 || f0 == 2112) { g = gkw; }
        bf16_t* VT = nullptr; int kh = 0;
        if (f0 == 1920 || f0 == 1984) { VT = VST; kh = (f0 - 1920) >> 6; } else if (f0 == 2176 || f0 == 2240) { VT = VWT; kh = (f0 - 2176) >> 6; }
        float gv[2][8];
#pragma unroll
        for (int bj = 0; bj < 2; ++bj)
#pragma unroll
            for (int k = 0; k < 8; ++k) gv[bj][k] = g ? g[32 * bj + 8 * fq + k] * sc : 1.f;
        const int row0 = u.pm * BM + wr * 64 + fr;
#pragma unroll
        for (int ai = 0; ai < 2; ++ai)
#pragma unroll
            for (int m = 0; m < 4; ++m) { const int row = row0 + ai * HALF + m * 16; bf16_t* rowp = O + (size_t)row * ldc + f0 + 8 * fq;
                float v[2][8];
#pragma unroll
                for (int bj = 0; bj < 2; ++bj) { const f32x4 v0 = acc[ai][bj][m][0], v1 = acc[ai][bj][m][1]; v[bj][0] = v0[0]; v[bj][1] = v0[1]; v[bj][2] = v0[2]; v[bj][3] = v0[3]; v[bj][4] = v1[0]; v[bj][5] = v1[1]; v[bj][6] = v1[2]; v[bj][7] = v1[3]; }
                if (g) { float ss = 0.f;
#pragma unroll
                    for (int bj = 0; bj < 2; ++bj)
#pragma unroll
                        for (int k = 0; k < 8; ++k) ss += v[bj][k] * v[bj][k];
                    ss += __shfl_xor(ss, 16); ss += __shfl_xor(ss, 32);
                    const float r = rsqrtf(ss * (1.f / 64.f) + eps);
#pragma unroll
                    for (int bj = 0; bj < 2; ++bj)
#pragma unroll
                        for (int k = 0; k < 8; ++k) v[bj][k] *= r * gv[bj][k]; }
#pragma unroll
                for (int bj = 0; bj < 2; ++bj) { u32x4 w; w.x = cvt_pk_bf16(v[bj][0], v[bj][1]); w.y = cvt_pk_bf16(v[bj][2], v[bj][3]); w.z = cvt_pk_bf16(v[bj][4], v[bj][5]); w.w = cvt_pk_bf16(v[bj][6], v[bj][7]);
                    *(u32x4*)(rowp + 32 * bj) = w;
                    if (VT) { const int b = row / seq, s = row % seq; bf16_t* tp = VT + ((size_t)(b * 2 + kh) * 64 + 32 * bj + 8 * fq) * seq + s;
                        tp[0] = (bf16_t)(w.x & 0xffffu); tp[seq] = (bf16_t)(w.x >> 16); tp[2 * seq] = (bf16_t)(w.y & 0xffffu); tp[3 * seq] = (bf16_t)(w.y >> 16);
                        tp[4 * seq] = (bf16_t)(w.z & 0xffffu); tp[5 * seq] = (bf16_t)(w.z >> 16); tp[6 * seq] = (bf16_t)(w.w & 0xffffu); tp[7 * seq] = (bf16_t)(w.w >> 16); } } }
    }
};
using EpiProj = EpiProjT<0>;

struct EpiGateSig {
    static constexpr bool PERM = true; static constexpr int F8 = 1, F8W = 0x7A7A7A7A, F8A = 0x7F7F7F7F; static constexpr int MIDK = 0;
    unsigned char* GT;
    __device__ __forceinline__ void operator()(const f32x4 (&acc)[2][2][4][2], const Unit& u, int wr, int wc, int fr, int fq) const {
        unsigned char* tp = GT + ((size_t)(u.pm * 8 + u.pn) * 65536) + ((size_t)(wr * 4 + wc) * 64 + fq * 16 + fr) * 8;
#pragma unroll
        for (int ai = 0; ai < 2; ++ai)
#pragma unroll
            for (int m = 0; m < 4; ++m)
#pragma unroll
                for (int bj = 0; bj < 2; ++bj) { const f32x4 v0 = acc[ai][bj][m][0], v1 = acc[ai][bj][m][1];
                    u32x2 w; w.x = cvt4_fp8(sigq(v0[0]), sigq(v0[1]), sigq(v0[2]), sigq(v0[3])); w.y = cvt4_fp8(sigq(v1[0]), sigq(v1[1]), sigq(v1[2]), sigq(v1[3]));
                    *(u32x2*)(tp + (size_t)(((ai * 4 + m) * 2 + bj) * 4096)) = w; }
    }
};

struct EpiProjGate8 {
    static constexpr bool PERM = true; static constexpr int F8 = 1, F8W = 0x7A7A7A7A, F8A = 0x7F7F7F7F; static constexpr int MIDK = 0;
    EpiProjT<1> ep; EpiGateSig eg;
    __device__ __forceinline__ void operator()(const f32x4 (&acc)[2][2][4][2], const Unit& u, int wr, int wc, int fr, int fq) const {
        Unit v = u;
        if (u.pn < 4) { v.pn = u.pn + 4; ep(acc, v, wr, wc, fr, fq); } else { v.pn = u.pn - 4; eg(acc, v, wr, wc, fr, fq); }
    }
};

struct EpiGate2 {
    static constexpr bool PERM = true; static constexpr int F8 = 1, F8W = 0x7A7A7A7A, F8A = 0x7B7B7B7B; static constexpr int MIDK = 4;
    unsigned char* O; int ldc; const unsigned char* GT;
    __device__ __forceinline__ void mid(f32x4 (&acc)[2][2][4][2], const Unit& u, int wr, int wc, int fr, int fq) const {
        asm volatile("" : "+v"(fr), "+v"(fq));
        const unsigned char* ta = GT + ((size_t)(u.pm * 8 + u.pn) * 65536) + ((size_t)(wr * 4 + wc) * 64 + fq * 16 + fr) * 8; const unsigned char* tb = ta + 4 * 65536;
        u32x2 ga[3][2], gb[3][2];
#define EG2_LOAD(slot, g) { _Pragma("unroll") for (int bj = 0; bj < 2; ++bj) { const int so = ((g) * 2 + bj) * 4096; ga[slot][bj] = *(const u32x2*)(ta + so); gb[slot][bj] = *(const u32x2*)(tb + so); } }
        EG2_LOAD(0, 0) EG2_LOAD(1, 1)
#pragma unroll
        for (int g = 0; g < 8; ++g) { const int ai = g >> 2, m = g & 3;
            if (g + 2 < 8) EG2_LOAD((g + 2) % 3, g + 2)
#pragma unroll
            for (int bj = 0; bj < 2; ++bj) { float fa[8], fb[8], r[8]; unpack8_fp8(ga[g % 3][bj], fa); unpack8_fp8(gb[g % 3][bj], fb);
#pragma unroll
                for (int e = 0; e < 8; ++e) r[e] = fa[e] / fmaxf(fb[e], 1e-30f);
#pragma unroll
                for (int e = 0; e < 4; ++e) { acc[ai][bj][m][0][e] *= r[e]; acc[ai][bj][m][1][e] *= r[4 + e]; } }
            asm volatile("" ::: "memory"); }
#undef EG2_LOAD
    }
    __device__ __forceinline__ void operator()(const f32x4 (&acc)[2][2][4][2], const Unit& u, int wr, int wc, int fr, int fq) const {
        const int row0 = u.pm * BM + wr * 64 + fr, col0 = u.pn * BM + wc * 32 + 8 * fq;
        const unsigned char* tb = GT + ((size_t)(u.pm * 8 + u.pn + 4) * 65536) + ((size_t)(wr * 4 + wc) * 64 + fq * 16 + fr) * 8;
#pragma unroll
        for (int ai = 0; ai < 2; ++ai)
#pragma unroll
            for (int m = 0; m < 4; ++m) { const size_t row = (size_t)(row0 + ai * HALF + m * 16); unsigned char* rowp = O + row * ldc + col0;
#pragma unroll
                for (int bj = 0; bj < 2; ++bj) { const f32x4 v0 = acc[ai][bj][m][0] * 16.f, v1 = acc[ai][bj][m][1] * 16.f;
                    float gg[8]; unpack8_fp8(*(const u32x2*)(tb + ((ai * 4 + m) * 2 + bj) * 4096), gg);
                    u32x2 w; w.x = cvt4_fp8c(v0[0] * gg[0], v0[1] * gg[1], v0[2] * gg[2], v0[3] * gg[3]);
                    w.y = cvt4_fp8c(v1[0] * gg[4], v1[1] * gg[5], v1[2] * gg[6], v1[3] * gg[7]);
                    *(u32x2*)(rowp + bj * HALF) = w; } }
    }
};
struct EpiRelu2 {
    static constexpr bool PERM = true; static constexpr int F8 = 1, F8W = 0x79797979, F8A = 0x7F7F7F7F; static constexpr int MIDK = 0;
    unsigned char* O; int ldc; const float* parts; float eps; float inv_n;
    __device__ __forceinline__ void operator()(const f32x4 (&acc)[2][2][4][2], const Unit& u, int wr, int wc, int fr, int fq) const {
        const int row0 = u.pm * BM + wr * 64 + fr, col0 = u.pn * BM + wc * 32 + 8 * fq;
#pragma unroll
        for (int ai = 0; ai < 2; ++ai)
#pragma unroll
            for (int m = 0; m < 4; ++m) { const size_t row = (size_t)(row0 + ai * HALF + m * 16); unsigned char* rowp = O + row * ldc + col0;
                const f32x4* pp = (const f32x4*)(parts + row * 16); const f32x4 p0 = pp[0], p1 = pp[1], p2 = pp[2], p3 = pp[3];
                const float ss = ((p0[0] + p0[1]) + (p0[2] + p0[3])) + ((p1[0] + p1[1]) + (p1[2] + p1[3])) + ((p2[0] + p2[1]) + (p2[2] + p2[3])) + ((p3[0] + p3[1]) + (p3[2] + p3[3]));
                const float rs = rsqrtf(ss * inv_n + eps) * 2.8284271247461903f;
#pragma unroll
                for (int bj = 0; bj < 2; ++bj) { const f32x4 v0 = acc[ai][bj][m][0], v1 = acc[ai][bj][m][1];
                    float o[8] = {v0[0], v0[1], v0[2], v0[3], v1[0], v1[1], v1[2], v1[3]};
#pragma unroll
                    for (int e = 0; e < 8; ++e) { const float t = fmaxf(o[e], 0.f) * rs; o[e] = fminf(t * t, 448.f); }
                    u32x2 w; w.x = cvt4_fp8(o[0], o[1], o[2], o[3]); w.y = cvt4_fp8(o[4], o[5], o[6], o[7]);
                    *(u32x2*)(rowp + bj * HALF) = w; } }
    }
};
struct EpiOutRes {
    static constexpr bool PERM = false; static constexpr int F8 = 1, F8W = 0x7A7A7A7A, F8A = 0x7B7B7B7B; static constexpr int MIDK = 0;
    const float* base; float* out; bf16_t* xb; int ldc; float* parts; unsigned char* x8;
    __device__ __forceinline__ void operator()(const f32x4 (&acc)[2][2][4][2], const Unit& u, int wr, int wc, int fr, int fq) const {
        const int col0 = u.pn * BM + wc * 32 + 4 * fq;
#pragma unroll
        for (int ai = 0; ai < 2; ++ai)
#pragma unroll
            for (int m = 0; m < 4; ++m) { const int r = u.pm * BM + ai * HALF + wr * 64 + m * 16 + fr; const size_t off = (size_t)r * ldc + col0; float ss = 0.f;
#pragma unroll
                for (int bj = 0; bj < 2; ++bj)
#pragma unroll
                    for (int n = 0; n < 2; ++n) { const f32x4 bs = *(const f32x4*)(base + off + bj * HALF + n * 16); const f32x4 o = bs + acc[ai][bj][m][n];
                        ss += (o[0] * o[0] + o[1] * o[1]) + (o[2] * o[2] + o[3] * o[3]);
                        u32x2 w; w.x = cvt_pk_bf16(o[0], o[1]); w.y = cvt_pk_bf16(o[2], o[3]); *(u32x2*)(xb + off + bj * HALF + n * 16) = w;
                        *(unsigned*)(x8 + off + bj * HALF + n * 16) = cvt4_fp8c(o[0], o[1], o[2], o[3]); }
                ss += __shfl_xor(ss, 16); ss += __shfl_xor(ss, 32);
                if (fq == 0) parts[(size_t)r * 16 + u.pn * 4 + wc] = ss; }
    }
};
struct EpiFinal {
    static constexpr bool PERM = false; static constexpr int F8 = 1, F8W = 0x78787878, F8A = 0x7C7C7C7C; static constexpr int MIDK = 0;
    float* out; const bf16_t* xb; int ldc;
    __device__ __forceinline__ void operator()(const f32x4 (&acc)[2][2][4][2], const Unit& u, int wr, int wc, int fr, int fq) const {
        const int col0 = u.pn * BM + wc * 32 + 4 * fq;
#pragma unroll
        for (int ai = 0; ai < 2; ++ai)
#pragma unroll
            for (int m = 0; m < 4; ++m) { const int r = u.pm * BM + ai * HALF + wr * 64 + m * 16 + fr; const size_t off = (size_t)r * ldc + col0;
#pragma unroll
                for (int bj = 0; bj < 2; ++bj)
#pragma unroll
                    for (int n = 0; n < 2; ++n) { const u32x2 w = *(const u32x2*)(xb + off + bj * HALF + n * 16); const f32x4 a = acc[ai][bj][m][n];
                        f32x4 o; o[0] = bflo(w.x) + a[0]; o[1] = bfhi(w.x) + a[1]; o[2] = bflo(w.y) + a[2]; o[3] = bfhi(w.y) + a[3];
                        *(f32x4*)(out + off + bj * HALF + n * 16) = o; } }
    }
};

template <class Epi, class Sched, bool ALIGN_EPI = false>
__device__ __forceinline__ void gemm_phase(PG8_LAS unsigned char* lds, const Gemm g, const Sched& S, const Epi& E) {
    int tid_ = threadIdx.x; asm volatile("" : "+v"(tid_));
    const int tid = tid_, wid = __builtin_amdgcn_readfirstlane(tid >> 6), lane = tid & 63, wr = wid >> 2, wc = wid & 3, fr = lane & 15, fq = lane >> 4;
    int K_ = g.K; asm volatile("" : "+s"(K_));
    const int K = K_, nt = K / BK;
    unsigned voffA[2], voffB[2];
#pragma unroll
    for (int i = 0; i < 2; ++i) { int R, C; stage_rc(tid * 16 + i * 8192, R, C); const int Rb = Epi::PERM ? ((R & ~31) + perm32(R & 31)) : R;
        voffA[i] = (unsigned)(R * g.lda + C) * 2u; voffB[i] = (unsigned)(Rb * K + C) * 2u; }
    const size_t kstep = (size_t)(BK * 2);
    const size_t hstepA = (size_t)HALF * g.lda * 2, hstepB = (size_t)HALF * K * 2;
    const size_t tstepA = 2 * hstepA, tstepB = 2 * hstepB;
    const unsigned ldsw = (unsigned)wid * 1024u;
    const int aoff = lds_byte(wr * 64 + fr, fq * 8), boff = lds_byte(wc * 32 + fr, fq * 8);
#define PG8_SA(b, h) (((b) * 2 + (h)) * HTB)
#define PG8_SB(b, h) ((4 + (b) * 2 + (h)) * HTB)
#define PG8_STAGE(bufoff, gbase, voff) do { _Pragma("unroll") for (int _i = 0; _i < 2; ++_i) \
        __builtin_amdgcn_global_load_lds((const unsigned*)((const char*)(gbase) + (voff)[_i]), (PG8_LAS unsigned*)(lds + (bufoff) + ldsw + _i * 8192), 16, 0, 0); } while (0)
#define PG8_LDA(dst, b, h) do { _Pragma("unroll") for (int m = 0; m < 4; ++m) _Pragma("unroll") for (int k = 0; k < 2; ++k) dst[m][k] = *(const PG8_LAS bf16x8*)(lds + PG8_SA(b, h) + aoff + m * 2048 + k * 1024); } while (0)
#define PG8_LDB(dst, b, h) do { _Pragma("unroll") for (int n = 0; n < 2; ++n) _Pragma("unroll") for (int k = 0; k < 2; ++k) dst[n][k] = *(const PG8_LAS bf16x8*)(lds + PG8_SB(b, h) + boff + n * 2048 + k * 1024); } while (0)
#define PG8_CAT(x) __builtin_bit_cast(i32x8, __builtin_shufflevector((x)[0], (x)[1], 0, 1, 2, 3, 4, 5, 6, 7, 8, 9, 10, 11, 12, 13, 14, 15))
#define PG8_MMA(ai, bj, At, Bt) do { __builtin_amdgcn_s_setprio(1); _Pragma("unroll") for (int m = 0; m < 4; ++m) _Pragma("unroll") for (int n = 0; n < 2; ++n) { \
        if constexpr (Epi::F8 != 0) asm volatile("v_mfma_scale_f32_16x16x128_f8f6f4 %0, %1, %2, %0, %3, %4 op_sel_hi:[0,0,0]" : "+v"(acc[ai][bj][m][n]) : "v"(PG8_CAT(Bt[n])), "v"(PG8_CAT(At[m])), "v"(f8w), "v"(f8a)); \
        else { _Pragma("unroll") for (int k = 0; k < 2; ++k) acc[ai][bj][m][n] = __builtin_amdgcn_mfma_f32_16x16x32_bf16(Bt[n][k], At[m][k], acc[ai][bj][m][n], 0, 0, 0); } } \
        __builtin_amdgcn_s_setprio(0); } while (0)
#define PG8_WAIT_V(n) asm volatile("s_waitcnt vmcnt(" #n ")" ::: "memory")
#define PG8_WAIT_L(n) asm volatile("s_waitcnt lgkmcnt(" #n ")" ::: "memory")
#define PG8_BAR __builtin_amdgcn_s_barrier()
#define PG8_SCHED __builtin_amdgcn_sched_barrier(0)
    Unit cur, nxt; int ui = 0;
    if (!S.next(0, cur)) return;
    int f8w = Epi::F8W, f8a = Epi::F8A; asm volatile("" : "+v"(f8w), "+v"(f8a));
    f32x4 acc[2][2][4][2];
#pragma unroll
    for (int a = 0; a < 2; ++a)
#pragma unroll
        for (int b = 0; b < 2; ++b)
#pragma unroll
            for (int m = 0; m < 4; ++m)
#pragma unroll
                for (int n = 0; n < 2; ++n) acc[a][b][m][n] = (f32x4){0.f, 0.f, 0.f, 0.f};
    bf16x8 At[4][2], B0[2][2], B1[2][2];
    const char* cA = (const char*)g.A + (size_t)cur.pm * tstepA; const char* cB = (const char*)g.Bt + (size_t)cur.pn * tstepB;
    PG8_STAGE(PG8_SB(0, 0), cB, voffB); PG8_STAGE(PG8_SB(0, 1), cB + hstepB, voffB); PG8_STAGE(PG8_SA(0, 0), cA, voffA); PG8_STAGE(PG8_SA(0, 1), cA + hstepA, voffA);
    if (wr == 1) PG8_BAR;
    PG8_WAIT_V(2); PG8_BAR;
    PG8_STAGE(PG8_SB(1, 0), cB + kstep, voffB); PG8_STAGE(PG8_SA(1, 0), cA + kstep, voffA); PG8_STAGE(PG8_SB(1, 1), cB + hstepB + kstep, voffB);
    PG8_WAIT_V(6); PG8_BAR;
    for (;;) {
        const bool has_next = S.next(ui + 1, nxt);
        const char* nA = has_next ? (const char*)g.A + (size_t)nxt.pm * tstepA : cA; const char* nB = has_next ? (const char*)g.Bt + (size_t)nxt.pn * tstepB : cB;
#pragma unroll 1
        for (int t = 0; t < nt; t += 2) {
            const bool last = (t == nt - 2);
            const char* a1 = cA + (size_t)(t + 1) * kstep;
            const char* a2 = last ? nA : cA + (size_t)(t + 2) * kstep; const char* b2 = last ? nB : cB + (size_t)(t + 2) * kstep;
            const char* a3 = a2 + kstep; const char* b3 = b2 + kstep;
            PG8_LDB(B0, 0, 0); PG8_LDB(B1, 0, 1); PG8_SCHED; PG8_LDA(At, 0, 0); PG8_STAGE(PG8_SA(1, 1), a1 + hstepA, voffA);
            PG8_WAIT_V(8); PG8_WAIT_L(0); PG8_BAR; PG8_MMA(0, 0, At, B0); PG8_MMA(0, 1, At, B1); PG8_BAR; PG8_SCHED;
            PG8_LDA(At, 0, 1); PG8_STAGE(PG8_SB(0, 0), b2, voffB); PG8_STAGE(PG8_SB(0, 1), b2 + hstepB, voffB); PG8_STAGE(PG8_SA(0, 0), a2, voffA);
            PG8_WAIT_V(8); PG8_WAIT_L(0); PG8_BAR; PG8_MMA(1, 0, At, B0); PG8_MMA(1, 1, At, B1); PG8_BAR; PG8_SCHED;
            PG8_LDB(B0, 1, 0); PG8_LDB(B1, 1, 1); PG8_SCHED; PG8_LDA(At, 1, 0); PG8_STAGE(PG8_SA(0, 1), a2 + hstepA, voffA);
            PG8_WAIT_V(8); PG8_WAIT_L(0); PG8_BAR; PG8_MMA(0, 0, At, B0); PG8_MMA(0, 1, At, B1); PG8_BAR; PG8_SCHED;
            PG8_LDA(At, 1, 1); PG8_STAGE(PG8_SB(1, 0), b3, voffB); PG8_STAGE(PG8_SB(1, 1), b3 + hstepB, voffB); PG8_STAGE(PG8_SA(1, 0), a3, voffA);
            PG8_WAIT_V(8); PG8_WAIT_L(0); PG8_BAR; PG8_MMA(1, 0, At, B0); PG8_MMA(1, 1, At, B1); PG8_BAR; PG8_SCHED;
            if constexpr (Epi::MIDK != 0) { if (t + 2 == Epi::MIDK) { if (wr == 0) PG8_BAR; if constexpr (Epi::F8 != 0) asm volatile("s_nop 15\n\ts_nop 7" ::: "memory"); E.mid(acc, cur, wr, wc, fr, fq); if constexpr (Epi::F8 != 0) asm volatile("s_nop 7" ::: "memory"); if (wr == 1) PG8_BAR; } }
        }
        if constexpr (ALIGN_EPI) { if (wr == 0) PG8_BAR; }
        if constexpr (Epi::F8 != 0) asm volatile("s_nop 15\n\ts_nop 7" ::: "memory");
        E(acc, cur, wr, wc, fr, fq);
        if (!has_next) break;
#pragma unroll
        for (int a = 0; a < 2; ++a)
#pragma unroll
            for (int b = 0; b < 2; ++b)
#pragma unroll
                for (int m = 0; m < 4; ++m)
#pragma unroll
                    for (int n = 0; n < 2; ++n) acc[a][b][m][n] = (f32x4){0.f, 0.f, 0.f, 0.f};
        cur = nxt; cA = nA; cB = nB; ++ui;
        if constexpr (ALIGN_EPI) { if (wr == 1) PG8_BAR; }
    }
    PG8_WAIT_V(0);
    if constexpr (!ALIGN_EPI) { if (wr == 0) PG8_BAR; }
    PG8_BAR;
#undef PG8_SA
#undef PG8_SB
#undef PG8_STAGE
#undef PG8_LDA
#undef PG8_LDB
#undef PG8_MMA
#undef PG8_CAT
#undef PG8_WAIT_V
#undef PG8_WAIT_L
#undef PG8_BAR
#undef PG8_SCHED
}
}

#ifndef PROBE_P3
#define PROBE_P3 1
#endif
#define PROBE_P0 1
#define PROBE_BAR 0
#ifndef PROBE_SPAN
#define PROBE_SPAN 0
#endif
#define PROBE_DPRE 1
#define PROBE_DIDX 1
#define PROBE_DTHR 1
#define PROBE_DATT 1
#define PROBE_NSA 1
#define PROBE_P1 1
#define PROBE_P2 1
#define PROBE_P4 1
#define PROBE_P5 1
#define PROBE_P6 1
constexpr int NWAVES = 8;
constexpr int BATCH = 8, SEQ = 2048, DM = 1024, M = BATCH * SEQ, FF = 4096;
constexpr int NPROJ = 4352;
constexpr int PITCH = 2304;
constexpr int C_QI = 0, C_KI = 256, C_WI = 288, C_GB = 296, C_QB = 320, C_KC = 832, C_QA = 1024, C_CA = 1536, C_VC = 1664, C_KS = 1792, C_VS = 1920, C_KW = 2048, C_VW = 2176, C_GM = 2304;
constexpr int NCMP = 127, TOPK = 256;
constexpr float RMS_EPS = 1e-6f;
constexpr float LOG2E = 1.4426950408889634f;
constexpr float QSCALE = 0.125f * LOG2E;

constexpr size_t MiB = 1u << 20;
constexpr size_t WS_CTL = 0, CTL_ZERO_BYTES = 64 * 1024;
constexpr size_t WS_WIN = 1 * MiB;
constexpr size_t WS_WIN8C = 3 * MiB;
constexpr size_t WS_WIN8T = 6 * MiB;
constexpr size_t WS_WLT = 9 * MiB + 512 * 1024;
constexpr size_t WS_W2T = WS_WLT + 64 * 1024;
constexpr size_t WS_W1T = 31 * MiB;
constexpr size_t WS_WUPA = 10 * MiB, WS_WUPB = 11 * MiB;
constexpr size_t WS_WOUT = 12 * MiB;
constexpr size_t WS_WFF1 = 14 * MiB;
constexpr size_t WS_WFF2 = 22 * MiB;
constexpr size_t WS_PARTS = 30 * MiB;
constexpr size_t WS_PROJ = 32 * MiB;
constexpr size_t WS_GT = 104 * MiB;
constexpr size_t WS_MERGED = 168 * MiB;
constexpr size_t WS_H8 = 184 * MiB;
constexpr size_t WS_X1B = 200 * MiB;
constexpr size_t WS_OUTSCR = 232 * MiB;
constexpr size_t WS_END = 248 * MiB;
constexpr size_t DO_H = 0;
constexpr size_t DO_O = 0;
constexpr size_t DO_KA = 32 * MiB;
constexpr size_t DO_VA = 34 * MiB;
constexpr size_t DO_VAT = 36 * MiB;
constexpr size_t DO_VST = 38 * MiB;
constexpr size_t DO_VWT = 42 * MiB;
constexpr size_t DO_KC = 46 * MiB;
constexpr size_t DO_VC = 47 * MiB;
constexpr size_t DO_VCT = 48 * MiB;

constexpr int CW_BAR = 4096;
constexpr int RING_BYTES = 131072;
constexpr int MISC_OFF = 141312 + 64;
constexpr int LDS_BYTES = 147456;

#define GAS __attribute__((address_space(1)))
#define LAS __attribute__((address_space(3)))
typedef unsigned short bf16;
typedef unsigned v4u __attribute__((ext_vector_type(4)));
typedef float f32x4 __attribute__((ext_vector_type(4)));
#define LDS_WAIT() asm volatile("s_waitcnt lgkmcnt(0)" ::: "memory")
typedef short bf16x8 __attribute__((ext_vector_type(8)));
typedef float f32x16 __attribute__((ext_vector_type(16)));
typedef unsigned long long u64;
typedef u64 u64x2 __attribute__((ext_vector_type(2)));

__device__ __forceinline__ unsigned f2bf(float f) { unsigned u = __builtin_bit_cast(unsigned, f); return (u + 0x7fffu + ((u >> 16) & 1u)) >> 16; }
__device__ __forceinline__ unsigned pk2(float lo, float hi) { return f2bf(lo) | (f2bf(hi) << 16); }
__device__ __forceinline__ float bf2f(bf16 b) { return __uint_as_float((unsigned)b << 16); }
__device__ __forceinline__ void unpack8(const v4u w, float* o) {
    o[0] = __uint_as_float(w.x << 16); o[1] = __uint_as_float(w.x & 0xffff0000u); o[2] = __uint_as_float(w.y << 16); o[3] = __uint_as_float(w.y & 0xffff0000u);
    o[4] = __uint_as_float(w.z << 16); o[5] = __uint_as_float(w.z & 0xffff0000u); o[6] = __uint_as_float(w.w << 16); o[7] = __uint_as_float(w.w & 0xffff0000u);
}
__device__ __forceinline__ float xhalf_max(float v) { auto rr = __builtin_amdgcn_permlane32_swap(__float_as_uint(v), __float_as_uint(v), false, false); return fmaxf(__uint_as_float(rr[0]), __uint_as_float(rr[1])); }
__device__ __forceinline__ float xhalf_sum(float v) { auto rr = __builtin_amdgcn_permlane32_swap(__float_as_uint(v), __float_as_uint(v), false, false); return __uint_as_float(rr[0]) + __uint_as_float(rr[1]); }
typedef float f32x2_t __attribute__((ext_vector_type(2))); typedef __bf16 bf16x2_t __attribute__((ext_vector_type(2)));
__device__ __forceinline__ unsigned cvt2(float lo, float hi) { const f32x2_t v = {lo, hi}; const bf16x2_t b = __builtin_convertvector(v, bf16x2_t); return __builtin_bit_cast(unsigned, b); }
__device__ __forceinline__ float wave_sum(float v) {
#pragma unroll
    for (int o = 1; o < 64; o <<= 1) v += __shfl_xor(v, o);
    return v;
}
__device__ __forceinline__ float wave_max(float v) {
#pragma unroll
    for (int o = 1; o < 64; o <<= 1) v = fmaxf(v, __shfl_xor(v, o));
    return v;
}
__device__ __forceinline__ int wave_sum_i(int v) {
#pragma unroll
    for (int o = 1; o < 64; o <<= 1) v += __shfl_xor(v, o);
    return v;
}

#define XB_TMO      128
#define XB_XCNT(j)  (256  + 64 * (j))
#define XB_XSUB(j)  (1280 + 64 * (j))
#define XB_XGEN(j)  (2304 + 64 * (j))
#define XB_TOP      3328
#define XB_TOPGEN   3392
#define XCD_BAR_WORDS 3456
#define XB_SPIN_CAP (1u << 23)

__device__ __forceinline__ unsigned xb_ld(unsigned* p)              { return __hip_atomic_load(p, __ATOMIC_RELAXED, __HIP_MEMORY_SCOPE_AGENT); }
__device__ __forceinline__ unsigned xb_add(unsigned* p, unsigned v) { return __hip_atomic_fetch_add(p, v, __ATOMIC_RELAXED, __HIP_MEMORY_SCOPE_AGENT); }
__device__ __forceinline__ unsigned xb_xcc_id() { return (unsigned)__builtin_amdgcn_s_getreg((3 << 11) | 20) & 0xFu; }
#define XB_SPIN(cond, bar) do { unsigned _sp = 0; while (cond) { __builtin_amdgcn_s_sleep(1); \
    if ((++_sp & 255u) == 0u) { if (xb_ld(&(bar)[XB_TMO])) break; if (_sp > XB_SPIN_CAP) { atomicAdd(&(bar)[XB_TMO], 1u); break; } } } } while (0)

struct XcdBarrier { unsigned* bar; unsigned x; volatile LAS unsigned* st; };

__device__ __forceinline__ XcdBarrier xcd_barrier_post(unsigned* bar, volatile LAS unsigned* st) {
    XcdBarrier b; b.bar = bar; b.x = xb_xcc_id(); b.st = st;
    if (threadIdx.x == 0) (void)xb_add(&bar[XB_XCNT(b.x)], 1u);
    return b;
}
__device__ __forceinline__ void xcd_barrier_complete(unsigned* bar, unsigned x, unsigned& nloc, unsigned& nx) {
    const unsigned G = gridDim.x * gridDim.y * gridDim.z;
    unsigned sum, cnt, mine, sp = 0u;
    for (;;) {
        sum = 0u; cnt = 0u; mine = 0u;
#pragma unroll
        for (unsigned j = 0; j < 16; ++j) { const unsigned c = xb_ld(&bar[XB_XCNT(j)]); sum += c; cnt += (c > 0u) ? 1u : 0u; mine = (j == x) ? c : mine; }
        if (sum == G) break;
        __builtin_amdgcn_s_sleep(1);
        if ((++sp & 255u) == 0u) { if (xb_ld(&bar[XB_TMO])) break; if (sp > XB_SPIN_CAP) { atomicAdd(&bar[XB_TMO], 1u); break; } }
    }
    nloc = mine > 0u ? mine : 1u; nx = cnt > 0u ? cnt : 1u;
}
__device__ __forceinline__ void xcd_barrier(const XcdBarrier& b) {
    asm volatile("s_waitcnt vmcnt(0)" ::: "memory");
    __syncthreads();
    if (threadIdx.x == 0) {
        unsigned* bar = b.bar;
        __builtin_amdgcn_s_waitcnt(0);
        unsigned nloc = b.st[0], nx = b.st[1];
        if (nloc == 0u) { xcd_barrier_complete(bar, b.x, nloc, nx); b.st[0] = nloc; b.st[1] = nx; }
        const unsigned old = xb_add(&bar[XB_XSUB(b.x)], 1u);
        const unsigned gen = old / nloc;
        if (old + 1u == (gen + 1u) * nloc) {
            __builtin_amdgcn_fence(__ATOMIC_RELEASE, "agent");
            asm volatile("s_waitcnt vmcnt(0)" ::: "memory");
            const unsigned og = xb_add(&bar[XB_TOP], 1u);
            const unsigned tg = og / nx;
            if (og + 1u == (tg + 1u) * nx) xb_add(&bar[XB_TOPGEN], 1u);
            else XB_SPIN(xb_ld(&bar[XB_TOPGEN]) == tg, bar);
            __builtin_amdgcn_fence(__ATOMIC_ACQUIRE, "agent");
            xb_add(&bar[XB_XGEN(b.x)], 1u);
            asm volatile("s_waitcnt vmcnt(0)" ::: "memory");
        } else {
            XB_SPIN(xb_ld(&bar[XB_XGEN(b.x)]) == gen, bar);
            __builtin_amdgcn_fence(__ATOMIC_ACQUIRE, "agent");
            asm volatile("s_waitcnt vmcnt(0)" ::: "memory");
        }
    }
    __syncthreads();
}

__device__ __forceinline__ int proj_src_col(int f) {
    if (f < 256) return 640 + f;
    if (f < 288) return 896 + (f - 256);
    if (f < 296) return 928 + (f - 288);
    if (f < 320) return 2216 + (f - 296);
    if (f < 832) return 936 + (f - 320);
    if (f < 960) return 1448 + (f - 832);
    if (f < 1024) return -1;
    if (f < 1536) return f - 1024;
    if (f < 1664) return 512 + (f - 1536);
    if (f < 1792) return 1576 + (f - 1664);
    if (f < 1920) return 1704 + (f - 1792);
    if (f < 2048) return 1832 + (f - 1920);
    if (f < 2176) return 1960 + (f - 2048);
    return 2088 + (f - 2176);
}
struct Ptrs {
    const float* in[23]; float* out; unsigned char* ws;
};

constexpr int I_IN = (DM / 64) * (1024 / 32), I_INB = (DM / 64) * (1024 / 32), I_IN8 = (DM / 64) * (256 / 32), I_ING = (DM / 64) * (2048 / 32), I_UP = (512 / 64) * (DM / 32), I_OUT = (DM / 64) * (DM / 32), I_F1 = (DM / 64) * (FF / 32), I_F2 = (FF / 64) * (DM / 32);
constexpr int I_LT = 4, I_P1 = (2048 / 64) * (128 / 32), I_P2 = 4;
constexpr int P0_EARLY = I_IN + I_INB + I_IN8 + I_ING + 2 * I_LT + 2 * I_P1 + 2 * I_P2, P0_ALL = P0_EARLY + 2 * I_UP + I_OUT + I_F1 + I_F2;
struct P0Item { const float* W; const float* gk; unsigned char* WT; int N, Ndest, dpitch, koff, r, dnoff; float f8s; bool projmap; };
__device__ __forceinline__ P0Item p0_decode(const Ptrs& P, int it) {
    P0Item d; d.gk = nullptr; d.koff = 0; d.f8s = 0.f; d.projmap = false; d.dnoff = 0; int r = it;
    do {
        if (r < I_IN) { d.W = P.in[2]; d.N = 4288; d.Ndest = 1024; d.WT = P.ws + WS_WIN; d.dpitch = DM; d.projmap = true; break; } r -= I_IN;
        if (r < I_INB) { d.W = P.in[2]; d.N = 4288; d.Ndest = 1024; d.WT = P.ws + WS_WIN8C; d.dpitch = DM; d.projmap = true; d.dnoff = 1024; d.f8s = 32.f; break; } r -= I_INB;
        if (r < I_IN8) { d.W = P.in[2]; d.N = 4288; d.Ndest = 256; d.WT = P.ws + WS_WIN8T; d.dpitch = DM; d.projmap = true; d.dnoff = 2048; d.f8s = 32.f; break; } r -= I_IN8;
        if (r < I_ING) { d.W = P.in[2] + 2240; d.N = 4288; d.Ndest = 2048; d.WT = P.ws + WS_WIN8C + (size_t)1024 * 1024; d.dpitch = DM; d.f8s = 32.f; break; } r -= I_ING;
        if (r < I_LT) { d.W = P.in[6]; d.N = 64; d.Ndest = 64; d.WT = P.ws + WS_WLT; d.dpitch = 128; d.gk = P.in[5]; break; } r -= I_LT;
        if (r < I_LT) { d.W = P.in[7]; d.N = 64; d.Ndest = 64; d.WT = P.ws + WS_WLT + 64 * 128 * 2; d.dpitch = 128; d.gk = P.in[5]; break; } r -= I_LT;
        if (r < I_P1) { d.W = P.in[13]; d.N = 128; d.Ndest = 128; d.WT = P.ws + WS_W1T; d.dpitch = 2048; break; } r -= I_P1;
        if (r < I_P1) { d.W = P.in[15]; d.N = 128; d.Ndest = 128; d.WT = P.ws + WS_W1T + 128 * 2048 * 2; d.dpitch = 2048; break; } r -= I_P1;
        if (r < I_P2) { d.W = P.in[14]; d.N = 64; d.Ndest = 64; d.WT = P.ws + WS_W2T; d.dpitch = 128; break; } r -= I_P2;
        if (r < I_P2) { d.W = P.in[16]; d.N = 64; d.Ndest = 64; d.WT = P.ws + WS_W2T + 64 * 128 * 2; d.dpitch = 128; break; } r -= I_P2;
        if (r < I_UP) { d.W = P.in[17]; d.N = DM; d.Ndest = DM; d.WT = P.ws + WS_WUPA; d.dpitch = DM; d.f8s = 32.f; break; } r -= I_UP;
        if (r < I_UP) { d.W = P.in[18]; d.N = DM; d.Ndest = DM; d.WT = P.ws + WS_WUPA; d.dpitch = DM; d.koff = 512; d.f8s = 32.f; break; } r -= I_UP;
        if (r < I_OUT) { d.W = P.in[19]; d.N = DM; d.Ndest = DM; d.WT = P.ws + WS_WOUT; d.dpitch = DM; d.f8s = 32.f; break; } r -= I_OUT;
        if (r < I_F1) { d.W = P.in[21]; d.N = FF; d.Ndest = FF; d.WT = P.ws + WS_WFF1; d.dpitch = DM; d.gk = P.in[20]; d.f8s = 64.f; break; } r -= I_F1;
        d.W = P.in[22]; d.N = DM; d.Ndest = DM; d.WT = P.ws + WS_WFF2; d.dpitch = FF; d.f8s = 128.f;
    } while (0);
    d.r = r; return d;
}
struct P0Regs { float tv[32]; f32x4 g0, g1; };
__device__ __forceinline__ void p0_load(const P0Item& d, int lane, P0Regs& R) {
    const int nblk = d.Ndest / 32, kb = d.r / nblk, nb = d.r % nblk, k0 = 64 * kb, n0 = 32 * nb;
    const int dn = n0 + (lane & 31); const int dg = dn + d.dnoff; const int cl = dg & 255; const int sc = d.projmap ? proj_src_col((dg & ~255) + ((cl >> 5) & 3) * 64 + (cl >> 7) * 32 + (cl & 31)) : dn;
    const float* wp = d.W + (size_t)(k0 + (lane >> 5)) * d.N + (sc >= 0 ? sc : 0);
#pragma unroll
    for (int i = 0; i < 32; ++i) R.tv[i] = wp[(size_t)(2 * i) * d.N];
    if (sc < 0) {
#pragma unroll
        for (int i = 0; i < 32; ++i) R.tv[i] = 0.f; }
    if (d.gk) { const GAS f32x4* gp = (const GAS f32x4*)(d.gk + k0 + 8 * (lane & 7)); R.g0 = gp[0]; R.g1 = gp[1]; } else { R.g0 = (f32x4){1.f, 1.f, 1.f, 1.f}; R.g1 = R.g0; }
}
__device__ __forceinline__ void p0_finish(const P0Item& d, const P0Regs& R, LAS float* scr, int lane) {
    const int nblk = d.Ndest / 32, kb = d.r / nblk, nb = d.r % nblk, k0 = 64 * kb, n0 = 32 * nb;
#pragma unroll
    for (int i = 0; i < 32; ++i) { const int kk = 2 * i + (lane >> 5); scr[kk * 33 + (lane & 31)] = R.tv[i]; }
    LDS_WAIT();
    const int c = lane & 7; const float f = d.f8s != 0.f ? d.f8s : 1.f;
    const float m0 = R.g0[0] * f, m1 = R.g0[1] * f, m2 = R.g0[2] * f, m3 = R.g0[3] * f, m4 = R.g1[0] * f, m5 = R.g1[1] * f, m6 = R.g1[2] * f, m7 = R.g1[3] * f;
#pragma unroll
    for (int j = 0; j < 4; ++j) { const int n = (lane >> 3) + 8 * j; const LAS float* s = scr + (8 * c) * 33 + n;
        const float v0 = s[0 * 33] * m0, v1 = s[1 * 33] * m1, v2 = s[2 * 33] * m2, v3 = s[3 * 33] * m3, v4 = s[4 * 33] * m4, v5 = s[5 * 33] * m5, v6 = s[6 * 33] * m6, v7 = s[7 * 33] * m7;
        const size_t eo = (size_t)(n0 + n) * d.dpitch + d.koff + k0 + 8 * c;
        if (d.f8s != 0.f) { pg8::u32x2 o; o.x = pg8::cvt4_fp8c(v0, v1, v2, v3); o.y = pg8::cvt4_fp8c(v4, v5, v6, v7); *(GAS pg8::u32x2*)(d.WT + eo) = o; }
        else { v4u o; o.x = pk2(v0, v1); o.y = pk2(v2, v3); o.z = pk2(v4, v5); o.w = pk2(v6, v7); *(GAS v4u*)(d.WT + 2 * eo) = o; } }
    LDS_WAIT();
}
__device__ __forceinline__ void p0_items(const Ptrs& P, LAS unsigned char* lds, int first, int last, int worker, int nworkers, int wave, int lane) {
    LAS float* scr = (LAS float*)(lds + wave * 16384);
    int it = first + worker;
    if (it >= last) return;
    P0Item dA = p0_decode(P, it), dB = dA; P0Regs rA, rB; p0_load(dA, lane, rA);
    for (;;) {
        int nx = it + nworkers; bool more = nx < last;
        if (more) { dB = p0_decode(P, nx); p0_load(dB, lane, rB); }
        p0_finish(dA, rA, scr, lane);
        if (!more) break;
        it = nx; nx = it + nworkers; more = nx < last;
        if (more) { dA = p0_decode(P, nx); p0_load(dA, lane, rA); }
        p0_finish(dB, rB, scr, lane);
        if (!more) break;
        it = nx;
    }
}
__device__ __forceinline__ void p0_prologue(const Ptrs& P, LAS unsigned char* lds, int gw, int NGW, int wave, int lane) {
    bf16* H = (bf16*)((unsigned char*)P.out + DO_H); unsigned char* H8 = P.ws + WS_H8;
    f32x4 va[4], vb[4];
    { const int m = gw, m2 = m + NGW < M ? m + NGW : m;
      const GAS f32x4* xa = (const GAS f32x4*)(P.in[0] + (size_t)m * DM) + lane; const GAS f32x4* xb = (const GAS f32x4*)(P.in[0] + (size_t)m2 * DM) + lane;
#pragma unroll
      for (int j = 0; j < 4; ++j) { va[j] = xa[64 * j]; vb[j] = xb[64 * j]; } }
    p0_items(P, lds, 0, P0_EARLY, gw, NGW, wave, lane);
#define P0_ROWS_LOAD(VA, VB, MM) { const int m_ = (MM), m2_ = m_ + NGW < M ? m_ + NGW : m_; \
        const GAS f32x4* xa_ = (const GAS f32x4*)(P.in[0] + (size_t)m_ * DM) + lane; const GAS f32x4* xb_ = (const GAS f32x4*)(P.in[0] + (size_t)m2_ * DM) + lane; \
        _Pragma("unroll") for (int j = 0; j < 4; ++j) { VA[j] = xa_[64 * j]; VB[j] = xb_[64 * j]; } }
#define P0_ROWS_DO(VA, VB, MM) { const int mr_ = (MM), mr2_ = mr_ + NGW < M ? mr_ + NGW : mr_; \
        const GAS f32x4* gr = (const GAS f32x4*)P.in[1] + lane; float sa = 0.f, sb = 0.f; \
        _Pragma("unroll") for (int j = 0; j < 4; ++j) { sa += (VA[j].x * VA[j].x + VA[j].y * VA[j].y) + (VA[j].z * VA[j].z + VA[j].w * VA[j].w); sb += (VB[j].x * VB[j].x + VB[j].y * VB[j].y) + (VB[j].z * VB[j].z + VB[j].w * VB[j].w); } \
        const float ra = rsqrtf(wave_sum(sa) * (1.f / DM) + RMS_EPS), rb = rsqrtf(wave_sum(sb) * (1.f / DM) + RMS_EPS); \
        GAS unsigned long long* oa = (GAS unsigned long long*)(H + (size_t)mr_ * DM) + lane; GAS unsigned long long* ob = (GAS unsigned long long*)(H + (size_t)mr2_ * DM) + lane; \
        GAS unsigned* qa = (GAS unsigned*)(H8 + (size_t)mr_ * DM) + lane; GAS unsigned* qb = (GAS unsigned*)(H8 + (size_t)mr2_ * DM) + lane; \
        _Pragma("unroll") for (int j = 0; j < 4; ++j) { const f32x4 gg = gr[64 * j]; \
            oa[64 * j] = (unsigned long long)pk2(VA[j].x * ra * gg.x, VA[j].y * ra * gg.y) | ((unsigned long long)pk2(VA[j].z * ra * gg.z, VA[j].w * ra * gg.w) << 32); \
            qa[64 * j] = pg8::cvt4_fp8c(VA[j].x * ra * gg.x, VA[j].y * ra * gg.y, VA[j].z * ra * gg.z, VA[j].w * ra * gg.w); \
            if (mr2_ != mr_) { ob[64 * j] = (unsigned long long)pk2(VB[j].x * rb * gg.x, VB[j].y * rb * gg.y) | ((unsigned long long)pk2(VB[j].z * rb * gg.z, VB[j].w * rb * gg.w) << 32); \
                qb[64 * j] = pg8::cvt4_fp8c(VB[j].x * rb * gg.x, VB[j].y * rb * gg.y, VB[j].z * rb * gg.z, VB[j].w * rb * gg.w); } } }
    f32x4 na[4], nb[4];
    for (int m = gw; m < M; ) {
        int mn = m + 2 * NGW;
        if (mn < M) P0_ROWS_LOAD(na, nb, mn)
        P0_ROWS_DO(va, vb, m)
        if (mn >= M) break;
        m = mn; mn = m + 2 * NGW;
        if (mn < M) P0_ROWS_LOAD(va, vb, mn)
        P0_ROWS_DO(na, nb, m)
        if (mn >= M) break;
        m = mn;
    }
#undef P0_ROWS_LOAD
#undef P0_ROWS_DO
}

__device__ __forceinline__ float gelu_tanh(float x) { const float u = 0.7978845608028654f * (x + 0.044715f * x * x * x); return 0.5f * x * (1.0f + tanhf(u)); }

__device__ __forceinline__ void latent_group(const Ptrs& P, int grp, int lane) {
    const int r32 = lane & 31, hi = lane >> 5; const int tok = 32 * grp + r32;
    const bf16* PROJ = (const bf16*)(P.ws + WS_PROJ); const bf16* WLT = (const bf16*)(P.ws + WS_WLT);
    unsigned char* dob = (unsigned char*)P.out; bf16* KA = (bf16*)(dob + DO_KA); bf16* VAT = (bf16*)(dob + DO_VAT);
    bf16x8 cb[8]; float ss = 0.f;
    const bf16* cp = PROJ + (size_t)tok * PITCH + C_CA + hi * 8;
#pragma unroll
    for (int ks = 0; ks < 8; ++ks) { const v4u w = *(const GAS v4u*)(cp + ks * 16); cb[ks] = __builtin_bit_cast(bf16x8, w); float f[8]; unpack8(w, f);
#pragma unroll
        for (int j = 0; j < 8; ++j) ss += f[j] * f[j]; }
    ss = xhalf_sum(ss);
    const float rstd = rsqrtf(ss * (1.f / 128.f) + RMS_EPS);
    f32x16 acc[4];
#pragma unroll
    for (int nb = 0; nb < 4; ++nb) {
#pragma unroll
        for (int r = 0; r < 16; ++r) acc[nb][r] = 0.f;
#pragma unroll
        for (int ks = 0; ks < 8; ++ks) { const bf16x8 a = *(const GAS bf16x8*)(WLT + (size_t)(32 * nb + r32) * 128 + ks * 16 + hi * 8); acc[nb] = __builtin_amdgcn_mfma_f32_32x32x16_bf16(a, cb[ks], acc[nb], 0, 0, 0); } }
    float sk = 0.f;
#pragma unroll
    for (int nb = 0; nb < 2; ++nb)
#pragma unroll
        for (int r = 0; r < 16; ++r) { const float v = acc[nb][r] * rstd; sk += v * v; }
    sk = xhalf_sum(sk);
    const float kr = rsqrtf(sk * (1.f / 64.f) + RMS_EPS) * rstd;
    const float* gk = P.in[4];
#pragma unroll
    for (int nb = 0; nb < 2; ++nb)
#pragma unroll
        for (int a = 0; a < 4; ++a) { const int n0 = 32 * nb + 8 * a + 4 * hi; const f32x4 gg = *(const GAS f32x4*)(gk + n0);
            pg8::u32x2 w; w.x = pg8::cvt_pk_bf16(acc[nb][4 * a] * kr * gg[0], acc[nb][4 * a + 1] * kr * gg[1]); w.y = pg8::cvt_pk_bf16(acc[nb][4 * a + 2] * kr * gg[2], acc[nb][4 * a + 3] * kr * gg[3]);
            *(GAS pg8::u32x2*)(KA + (size_t)tok * 64 + n0) = w; }
    const int b = tok / SEQ, s = tok % SEQ;
#pragma unroll
    for (int nb = 2; nb < 4; ++nb)
#pragma unroll
        for (int r = 0; r < 16; ++r) { const int d = 32 * (nb - 2) + (r & 3) + 8 * (r >> 2) + 4 * hi; VAT[((size_t)b * 64 + d) * SEQ + s] = (bf16)f2bf(acc[nb][r] * rstd); }
}
__device__ __forceinline__ void compress_unit(const Ptrs& P, LAS unsigned char* lds, int unit, int tid, int wave, int lane) {
    const int cbk = unit & 3, kh = (unit >> 2) & 1, b = (unit >> 3) & 7, kv = unit >> 6;
    const int r32 = lane & 31, hi = lane >> 5, nb = wave & 3, kq = wave >> 2;
    const bf16* PROJ = (const bf16*)(P.ws + WS_PROJ);
    const bf16* W1T = (const bf16*)(P.ws + WS_W1T) + (size_t)kv * 128 * 2048; const bf16* W2T = (const bf16*)(P.ws + WS_W2T) + (size_t)kv * 64 * 128;
    unsigned char* dob = (unsigned char*)P.out; bf16* KC = (bf16*)(dob + DO_KC); bf16* VCT = (bf16*)(dob + DO_VCT);
    const bf16* src = PROJ + (size_t)(b * SEQ) * PITCH + (kv ? C_VC : C_KC) + kh * 64;
    const float* pe = P.in[12];
    const int c = 32 * cbk + r32;
    LAS float* red = (LAS float*)lds;
    LAS float* peL = (LAS float*)(lds + 32768);
    for (int i = tid; i < 2048; i += NWAVES * 64) peL[i] = pe[i];
    __syncthreads();
    LAS unsigned char* hidL = lds + 16384;
    f32x16 acc;
#pragma unroll
    for (int r = 0; r < 16; ++r) acc[r] = 0.f;
    const bf16* w1p = W1T + (size_t)(32 * nb + r32) * 2048 + hi * 8;
#pragma unroll 8
    for (int ks = 64 * kq; ks < 64 * kq + 64; ++ks) {
        const int l = ks >> 2, d = 16 * (ks & 3) + 8 * hi; int tokn = 16 * c + l; tokn = tokn > SEQ - 1 ? SEQ - 1 : tokn;
        const v4u raw = *(const GAS v4u*)(src + (size_t)tokn * PITCH + d); float a8[8]; unpack8(raw, a8);
        const f32x4 p0 = *(LAS const f32x4*)(peL + l * 64 + d), p1 = *(LAS const f32x4*)(peL + l * 64 + d + 4);
        pg8::u32x4 aw; aw.x = cvt2(a8[0] + p0[0], a8[1] + p0[1]); aw.y = cvt2(a8[2] + p0[2], a8[3] + p0[3]); aw.z = cvt2(a8[4] + p1[0], a8[5] + p1[1]); aw.w = cvt2(a8[6] + p1[2], a8[7] + p1[3]);
        const bf16x8 bw = *(const GAS bf16x8*)(w1p + ks * 16);
        acc = __builtin_amdgcn_mfma_f32_32x32x16_bf16(__builtin_bit_cast(bf16x8, aw), bw, acc, 0, 0, 0);
    }
    if (kq == 1) {
#pragma unroll
        for (int r = 0; r < 16; ++r) red[(nb * 16 + r) * 64 + lane] = acc[r]; }
    __syncthreads();
    if (kq == 0) {
#pragma unroll
        for (int r = 0; r < 16; ++r) { const float h = gelu_tanh(acc[r] + red[(nb * 16 + r) * 64 + lane]); const int cr = (r & 3) + 8 * (r >> 2) + 4 * hi;
            *(LAS bf16*)(hidL + cr * 272 + (32 * nb + r32) * 2) = (bf16)f2bf(h); } }
    __syncthreads();
    if (wave == 0) {
        f32x16 o2[2];
#pragma unroll
        for (int db = 0; db < 2; ++db) {
#pragma unroll
            for (int r = 0; r < 16; ++r) o2[db][r] = 0.f;
#pragma unroll
            for (int ks = 0; ks < 8; ++ks) { const bf16x8 a = *(const GAS bf16x8*)(W2T + (size_t)(32 * db + r32) * 128 + ks * 16 + hi * 8);
                const bf16x8 hb = *(LAS const bf16x8*)(hidL + r32 * 272 + (ks * 16 + hi * 8) * 2);
                o2[db] = __builtin_amdgcn_mfma_f32_32x32x16_bf16(a, hb, o2[db], 0, 0, 0); } }
        const size_t bk = (size_t)(b * 2 + kh);
        if (kv == 0) {
            float sk = 0.f;
#pragma unroll
            for (int db = 0; db < 2; ++db)
#pragma unroll
                for (int r = 0; r < 16; ++r) sk += o2[db][r] * o2[db][r];
            sk = xhalf_sum(sk);
            const float kr = (c < NCMP) ? rsqrtf(sk * (1.f / 64.f) + RMS_EPS) : 0.f;
            const float* gkc = P.in[9];
#pragma unroll
            for (int db = 0; db < 2; ++db)
#pragma unroll
                for (int a = 0; a < 4; ++a) { const int d0 = 32 * db + 8 * a + 4 * hi; const f32x4 gg = *(const GAS f32x4*)(gkc + d0);
                    pg8::u32x2 w; w.x = pg8::cvt_pk_bf16(o2[db][4 * a] * kr * gg[0], o2[db][4 * a + 1] * kr * gg[1]); w.y = pg8::cvt_pk_bf16(o2[db][4 * a + 2] * kr * gg[2], o2[db][4 * a + 3] * kr * gg[3]);
                    *(GAS pg8::u32x2*)(KC + (bk * 128 + c) * 64 + d0) = w; }
        } else {
            const float z = (c < NCMP) ? 1.f : 0.f;
#pragma unroll
            for (int db = 0; db < 2; ++db)
#pragma unroll
                for (int r = 0; r < 16; ++r) { const int d = 32 * db + (r & 3) + 8 * (r >> 2) + 4 * hi; VCT[(bk * 64 + d) * 128 + c] = (bf16)f2bf(o2[db][r] * z); }
        }
    }
    __syncthreads();
}
__device__ __forceinline__ void p2_fast(const Ptrs& P, LAS unsigned char* lds, int vcu, int G, int tid, int wave, int lane) {
    for (int u = vcu; u < 128; u += G) compress_unit(P, lds, u, tid, wave, lane);
    for (int grp = G * NWAVES - 1 - (vcu * NWAVES + wave); grp < M / 32; grp += G * NWAVES) latent_group(P, grp, lane);
}

__device__ __forceinline__ unsigned ord_u32(float f) { const unsigned u = __float_as_uint(f); return (u & 0x80000000u) ? ~u : (u | 0x80000000u); }

__device__ __forceinline__ float inv_ord_u32(unsigned u) { return __uint_as_float((u & 0x80000000u) ? (u ^ 0x80000000u) : ~u); }
template <int CTRL> __device__ __forceinline__ unsigned dpp_mov(unsigned x) { return (unsigned)__builtin_amdgcn_update_dpp(0, (int)x, CTRL, 0xf, 0xf, true); }
__device__ __forceinline__ unsigned wave_umax(unsigned x) {
    unsigned y = dpp_mov<0xB1>(x); x = x > y ? x : y; y = dpp_mov<0x4E>(x); x = x > y ? x : y; y = dpp_mov<0x141>(x); x = x > y ? x : y; y = dpp_mov<0x140>(x); x = x > y ? x : y;
    const unsigned a = __builtin_amdgcn_readlane(x, 0), b = __builtin_amdgcn_readlane(x, 16), c = __builtin_amdgcn_readlane(x, 32), d = __builtin_amdgcn_readlane(x, 48);
    const unsigned ab = a > b ? a : b, cd = c > d ? c : d; return ab > cd ? ab : cd;
}
__device__ __forceinline__ unsigned wave_umin(unsigned x) {
    unsigned y = dpp_mov<0xB1>(x); x = x < y ? x : y; y = dpp_mov<0x4E>(x); x = x < y ? x : y; y = dpp_mov<0x141>(x); x = x < y ? x : y; y = dpp_mov<0x140>(x); x = x < y ? x : y;
    const unsigned a = __builtin_amdgcn_readlane(x, 0), b = __builtin_amdgcn_readlane(x, 16), c = __builtin_amdgcn_readlane(x, 32), d = __builtin_amdgcn_readlane(x, 48);
    const unsigned ab = a < b ? a : b, cd = c < d ? c : d; return ab < cd ? ab : cd;
}
__device__ __forceinline__ unsigned wave_usum(unsigned x) {
    x += dpp_mov<0xB1>(x); x += dpp_mov<0x4E>(x); x += dpp_mov<0x141>(x); x += dpp_mov<0x140>(x);
    return (__builtin_amdgcn_readlane(x, 0) + __builtin_amdgcn_readlane(x, 16)) + (__builtin_amdgcn_readlane(x, 32) + __builtin_amdgcn_readlane(x, 48));
}

constexpr int KT_STRIDE = 144, VT_STRIDE = 144;
constexpr int KT_BYTES = 64 * KT_STRIDE, VT_BYTES = 64 * VT_STRIDE, TILE_BYTES = KT_BYTES + VT_BYTES;
constexpr int A_TILE0 = 0, A_TILE1 = TILE_BYTES, A_STG = 36864, A_IMP = 69632, A_EFF = 102400, A_SEL = 110592;
constexpr int D_MASK = 131072, A_WSC = 139264;
constexpr int D_KMAX = 143360;
constexpr int D_M8 = 36864, M8_STRIDE = 2064;
constexpr int SROW = 2048;


__device__ __forceinline__ float max3f(float a, float b, float c) { float r; asm("v_max3_f32 %0, %1, %2, %3" : "=v"(r) : "v"(a), "v"(b), "v"(c)); return r; }
struct TileRegs { v4u k, v; };
__device__ __forceinline__ TileRegs tile_fetch(const bf16* Kb, size_t kpitch, const bf16* Vb, size_t vpitch, int tid) {
    const int row = tid >> 3, ch = tid & 7; TileRegs r;
    r.k = *(const GAS v4u*)(Kb + (size_t)row * kpitch + ch * 8);
    r.v = *(const GAS v4u*)(Vb + (size_t)row * vpitch + ch * 8);
    return r;
}
__device__ __forceinline__ void tile_store(LAS unsigned char* buf, const TileRegs& r, int tid) {
    const int row = tid >> 3, ch = tid & 7;
    *(LAS v4u*)(buf + row * KT_STRIDE + ch * 16) = r.k;
    LAS u64* vp = (LAS u64*)(buf + KT_BYTES + row * VT_STRIDE + (ch >> 1) * 32 + (ch & 1) * 8);
    vp[0] = (u64)r.v.x | ((u64)r.v.y << 32); vp[2] = (u64)r.v.z | ((u64)r.v.w << 32);
}
struct AttnState { f32x16 o0, o1, la; pg8::u32x4 qx; float m; bool started; };
struct KxOps { pg8::u32x4 k0, k1; };
__device__ __forceinline__ KxOps kx_ops(int r32, int hi) {
    KxOps k; k.k0 = (pg8::u32x4){0u, 0u, 0u, 0u}; k.k1 = k.k0;
    if (hi == 0) { const unsigned v0 = f2bf((float)r32), v1 = f2bf((float)(r32 + 32)); k.k0.y = v0 * 0x10001u; k.k1.y = v1 * 0x10001u; k.k0.z = k.k0.w = k.k1.z = k.k1.w = 0x3F803F80u; }
    return k;
}
__device__ __forceinline__ void attn_init(AttnState& s, float slope2, int hi) {
#pragma unroll
    for (int r = 0; r < 16; ++r) { s.o0[r] = 0.f; s.o1[r] = 0.f; s.la[r] = 0.f; }
    s.qx = (pg8::u32x4){0u, 0u, 0u, 0u};
    if (hi == 0) { const unsigned sh = f2bf(slope2); const unsigned sl = f2bf(slope2 - __uint_as_float(sh << 16)); s.qx.x = sh | (sl << 16); s.qx.y = s.qx.x; }
    s.m = 0.f; s.started = false;
}
__device__ __forceinline__ void attn_init_fixed(AttnState& s, float slope2, float m0, int hi) {
    attn_init(s, slope2, hi); s.m = m0; s.started = true;
    const float nm = -m0; const unsigned m1 = f2bf(nm); const float r1 = nm - __uint_as_float(m1 << 16); const unsigned m2 = f2bf(r1); const float r2 = r1 - __uint_as_float(m2 << 16); const unsigned m3 = f2bf(r2);
    if (hi == 0) { s.qx.z = m1 | (m2 << 16); s.qx.w = m3; }
}
__device__ __forceinline__ bf16x8 pack8(const f32x16& p, int b0) {
    pg8::u32x4 w; w.x = cvt2(p[b0], p[b0 + 1]); w.y = cvt2(p[b0 + 2], p[b0 + 3]); w.z = cvt2(p[b0 + 4], p[b0 + 5]); w.w = cvt2(p[b0 + 6], p[b0 + 7]);
    return __builtin_bit_cast(bf16x8, w);
}
constexpr float ATT_THR = 8.0f;
struct MaskMM { pg8::i32x8 a0, a1; LAS const unsigned char* row; };
template <bool BITS, bool IMP, bool QLDS, bool FIXM = false>
__device__ __forceinline__ void tile_compute(AttnState& st, const bf16x8 (&qf)[4], LAS const unsigned char* qlds, KxOps& KX, float koff, bool active, bool all_active, LAS const unsigned char* buf, LAS float* wsc,
                                             bool need_mask, int lo, int hi_, unsigned mw0, unsigned mw1, f32x16& oimp, int c0, int r32, int hi, const MaskMM* mm = nullptr) {
    f32x16 p0, p1;
    { const unsigned kw = (hi == 0) ? f2bf(koff) * 0x10001u : 0u; KX.k0.x = kw; KX.k1.x = kw;
      pg8::u32x4 q = st.qx; if (!all_active) q.w = (q.w & 0xffffu) | ((active || hi != 0) ? 0u : 0xff800000u);
#pragma unroll
      for (int r = 0; r < 16; ++r) { p0[r] = 0.f; p1[r] = 0.f; }
      if (BITS) {
          const pg8::i32x8 mb = *(LAS const pg8::i32x8*)(mm->row + mw0);
          p0 = __builtin_amdgcn_mfma_scale_f32_32x32x64_f8f6f4(mm->a0, mb, p0, 0, 0, 0, 0x7F7F7F7F, 0, (int)0x93939393u);
          p1 = __builtin_amdgcn_mfma_scale_f32_32x32x64_f8f6f4(mm->a1, mb, p1, 0, 0, 0, 0x7F7F7F7F, 0, (int)0x93939393u); }
      p0 = __builtin_amdgcn_mfma_f32_32x32x16_bf16(__builtin_bit_cast(bf16x8, KX.k0), __builtin_bit_cast(bf16x8, q), p0, 0, 0, 0);
      p1 = __builtin_amdgcn_mfma_f32_32x32x16_bf16(__builtin_bit_cast(bf16x8, KX.k1), __builtin_bit_cast(bf16x8, q), p1, 0, 0, 0); }
    { LAS const unsigned char* kp = buf + r32 * KT_STRIDE + hi * 16;
#pragma unroll
      for (int ds = 0; ds < 4; ++ds) {
          const bf16x8 k0 = *(LAS const bf16x8*)(kp + ds * 32);
          const bf16x8 k1 = *(LAS const bf16x8*)(kp + 32 * KT_STRIDE + ds * 32);
          const bf16x8 qv = QLDS ? *(LAS const bf16x8*)(qlds + (((2 * ds + hi) ^ (r32 & 7)) * 16)) : qf[ds];
          p0 = __builtin_amdgcn_mfma_f32_32x32x16_bf16(k0, qv, p0, 0, 0, 0);
          p1 = __builtin_amdgcn_mfma_f32_32x32x16_bf16(k1, qv, p1, 0, 0, 0); } }
    if (BITS) { }
    else if (need_mask) { const int lo2 = lo - 4 * hi, hi2 = hi_ - 4 * hi;
#pragma unroll
        for (int r = 0; r < 16; ++r) { const int c = (r & 3) + 8 * (r >> 2); if (c < lo2 || c > hi2) p0[r] = -INFINITY; if (c + 32 < lo2 || c + 32 > hi2) p1[r] = -INFINITY; } }
    if (!FIXM) {
    asm volatile("s_nop 15\n\ts_nop 7" : "+v"(p0), "+v"(p1));
    float rm;
    { float a = max3f(p0[0], p0[1], p1[0]), b = max3f(p0[2], p0[3], p1[1]); a = max3f(a, p1[2], p1[3]);
#pragma unroll
      for (int r = 4; r < 16; r += 4) { a = max3f(a, p0[r], p0[r + 1]); b = max3f(b, p0[r + 2], p0[r + 3]); a = max3f(a, p1[r], p1[r + 1]); b = max3f(b, p1[r + 2], p1[r + 3]); }
      rm = max3f(a, b, b); }
    rm = xhalf_max(rm);
    const bool need = st.started ? (rm > ATT_THR) : (rm > -1e8f);
    if (__any(need)) {
        const float dl = need ? rm : 0.f; const float f = st.started ? __builtin_amdgcn_exp2f(-dl) : 1.0f;
        st.m += dl; st.started = st.started || need;
        { const float nm = -st.m; const unsigned m1 = f2bf(nm); const float r1 = nm - __uint_as_float(m1 << 16); const unsigned m2 = f2bf(r1); const float r2 = r1 - __uint_as_float(m2 << 16); const unsigned m3 = f2bf(r2);
          if (hi == 0) { st.qx.z = m1 | (m2 << 16); st.qx.w = m3; } }
#pragma unroll
        for (int r = 0; r < 16; ++r) { p0[r] -= dl; p1[r] -= dl; }
        if (hi == 0) wsc[r32] = f;
        LDS_WAIT();
#pragma unroll
        for (int a = 0; a < 4; ++a) { const f32x4 av = *(LAS const f32x4*)(wsc + 8 * a + 4 * hi);
#pragma unroll
            for (int i = 0; i < 4; ++i) { st.o0[4 * a + i] *= av[i]; st.o1[4 * a + i] *= av[i]; st.la[4 * a + i] *= av[i]; if (IMP) oimp[4 * a + i] *= av[i]; } }
        LDS_WAIT();
    }
    }
#pragma unroll
    for (int r = 0; r < 16; ++r) { p0[r] = __builtin_amdgcn_exp2f(p0[r]); p1[r] = __builtin_amdgcn_exp2f(p1[r]); }
    bf16x8 pa[4]; pa[0] = pack8(p0, 0); pa[1] = pack8(p0, 8); pa[2] = pack8(p1, 0); pa[3] = pack8(p1, 8);
    { LAS const unsigned char* vp = buf + KT_BYTES + r32 * VT_STRIDE + hi * 16;
#pragma unroll
      for (int s = 0; s < 4; ++s) {
          const v4u x0 = *(LAS const v4u*)(vp + s * 32), x1 = *(LAS const v4u*)(vp + 32 * VT_STRIDE + s * 32);
          st.o0 = __builtin_amdgcn_mfma_f32_32x32x16_bf16(pa[s], __builtin_bit_cast(bf16x8, x0), st.o0, 0, 0, 0);
          st.o1 = __builtin_amdgcn_mfma_f32_32x32x16_bf16(pa[s], __builtin_bit_cast(bf16x8, x1), st.o1, 0, 0, 0);
          st.la = __builtin_amdgcn_mfma_f32_32x32x16_bf16(pa[s], __builtin_bit_cast(bf16x8, (pg8::u32x4){0x3F803F80u, 0x3F803F80u, 0x3F803F80u, 0x3F803F80u}), st.la, 0, 0, 0); } }
    if (IMP) {
#pragma unroll
        for (int s = 0; s < 4; ++s) { bf16x8 ov;
#pragma unroll
            for (int e = 0; e < 8; ++e) { const int c = c0 + 16 * s + 8 * (e >> 2) + 4 * hi + (e & 3); ov[e] = (c >= 4 * r32 - 1 && c <= 4 * r32 + 3) ? (short)0x3F80 : (short)0; }
            oimp = __builtin_amdgcn_mfma_f32_32x32x16_bf16(pa[s], ov, oimp, 0, 0, 0); } }
}
__device__ __forceinline__ void attn_accum(f32x16& out0, f32x16& out1, const AttnState& st, float gate, LAS float* wsc, int r32, int hi) {
    if (hi == 0) wsc[r32] = gate;
    LDS_WAIT();
#pragma unroll
    for (int a = 0; a < 4; ++a) { const f32x4 av = *(LAS const f32x4*)(wsc + 8 * a + 4 * hi);
#pragma unroll
        for (int i = 0; i < 4; ++i) { const float l = st.la[4 * a + i]; const float f = l > 0.f ? av[i] * __builtin_amdgcn_rcpf(l) : 0.f; out0[4 * a + i] += st.o0[4 * a + i] * f; out1[4 * a + i] += st.o1[4 * a + i] * f; } }
    LDS_WAIT();
}
__device__ __forceinline__ void store_tile_fp8(const f32x16& out0, const f32x16& out1, LAS unsigned char* stg, unsigned char* dst, size_t pitch, int lane, int r32, int hi) {
#pragma unroll
    for (int r = 0; r < 16; ++r) { const int q = (r & 3) + 8 * (r >> 2) + 4 * hi;
        const unsigned w = (unsigned)__builtin_amdgcn_cvt_pk_fp8_f32(__builtin_amdgcn_fmed3f(out0[r] * 16.f, -448.f, 448.f), __builtin_amdgcn_fmed3f(out1[r] * 16.f, -448.f, 448.f), 0, false);
        stg[q * 64 + r32] = (unsigned char)(w & 0xffu); stg[q * 64 + 32 + r32] = (unsigned char)((w >> 8) & 0xffu); }
    LDS_WAIT();
#pragma unroll
    for (int i = 0; i < 2; ++i) { const int row = i * 16 + (lane >> 2), ch = lane & 3; const v4u v = *(LAS const v4u*)(stg + row * 64 + ch * 16); *(GAS v4u*)(dst + (size_t)row * pitch + ch * 16) = v; }
    LDS_WAIT();
}


#define TILE_PIPELINE(FIRST, AFTER, FETCH, COMPUTE) do { \
        int jc_ = (FIRST); int jn_ = AFTER(jc_); int jnn_; TileRegs rA_ = FETCH(jc_), rB_; \
        tile_store(buf0, rA_, tid); if (jn_ >= 0) rB_ = FETCH(jn_); \
        __syncthreads(); \
        for (;;) { \
            jnn_ = jn_ >= 0 ? AFTER(jn_) : -1; if (jnn_ >= 0) rA_ = FETCH(jnn_); \
            COMPUTE(jc_, buf0); \
            if (jn_ < 0) break; \
            tile_store(buf1, rB_, tid); __syncthreads(); jc_ = jn_; jn_ = jnn_; \
            jnn_ = jn_ >= 0 ? AFTER(jn_) : -1; if (jnn_ >= 0) rB_ = FETCH(jnn_); \
            COMPUTE(jc_, buf1); \
            if (jn_ < 0) break; \
            tile_store(buf0, rA_, tid); __syncthreads(); jc_ = jn_; jn_ = jnn_; \
        } } while (0)
__device__ __forceinline__ void nsa_unit(const Ptrs& P, LAS unsigned char* lds, int b, int kh, int qb, int tid, int wave, int lane) {
    asm volatile("" : "+v"(tid), "+v"(lane));
    const int r32 = lane & 31, hi = lane >> 5, th = wave >> 2, g = th ? 3 - (wave & 3) : (wave & 3);
    bf16* PROJ = (bf16*)(P.ws + WS_PROJ);
    unsigned char* dob = (unsigned char*)P.out;
    const bf16* KCb = (const bf16*)(dob + DO_KC) + (size_t)(b * 2 + kh) * 128 * 64; const bf16* VCTb = (const bf16*)(dob + DO_VCT) + (size_t)(b * 2 + kh) * 64 * 128;
    const bf16* VSTb = (const bf16*)(dob + DO_VST) + (size_t)(b * 2 + kh) * 64 * SEQ; const bf16* VWTb = (const bf16*)(dob + DO_VWT) + (size_t)(b * 2 + kh) * 64 * SEQ;
    LAS unsigned char* buf0 = lds + A_TILE0; LAS unsigned char* buf1 = lds + A_TILE1;
    LAS float* wsc = (LAS float*)(lds + A_WSC) + wave * 64;
    LAS float* impL = (LAS float*)(lds + A_IMP); LAS float* effL = (LAS float*)(lds + A_EFF); LAS unsigned* selL = (LAS unsigned*)(lds + A_SEL);
    const int tq = 64 * qb + 32 * th + r32;
    const bf16* prow = PROJ + (size_t)(b * SEQ + tq) * PITCH;
    const float slope2 = exp2f(-(float)(kh * 4 + g + 1)) * LOG2E;
    bf16x8 qf[4];
#pragma unroll
    for (int ds = 0; ds < 4; ++ds) qf[ds] = *(const GAS bf16x8*)(prow + C_QB + (kh * 4 + g) * 64 + ds * 16 + hi * 8);
    KxOps KX = kx_ops(r32, hi);
    float qkb;
    { const float gq = fabsf(P.in[8][lane]); const float gk = fmaxf(fmaxf(fabsf(P.in[9][lane]), fabsf(P.in[10][lane])), fabsf(P.in[11][lane]));
      qkb = 64.0f * QSCALE * 1.02f * __uint_as_float(wave_umax(__float_as_uint(gq))) * __uint_as_float(wave_umax(__float_as_uint(gk))) + 0.25f; }
    const float cutthr = 2.0f * qkb + 40.0f;
    const int jcut = qb - (int)ceilf((cutthr / slope2 + (float)(63 - 32 * th)) * (1.0f / 64.0f));
    const int jdrop = qb - (int)ceilf((cutthr / (exp2f(-(float)(kh * 4 + 4)) * LOG2E) + 63.0f) * (1.0f / 64.0f));
    LAS unsigned char* qlds = lds + A_STG + wave * 4096 + r32 * 128;
#pragma unroll
    for (int ds = 0; ds < 4; ++ds) *(LAS bf16x8*)(qlds + (((2 * ds + hi) ^ (r32 & 7)) * 16)) = qf[ds];
#define NSA_GATE(i) pg8::sigm(bf2f(PROJ[(size_t)(b * SEQ + tq) * PITCH + C_GB + (kh * 4 + g) * 3 + (i)]))
    f32x16 oimp;
#pragma unroll
    for (int r = 0; r < 16; ++r) oimp[r] = 0.f;
    float* slab = (float*)(P.ws + WS_OUTSCR) + ((size_t)blockIdx.x * NWAVES + wave) * 2048;
    AttnState st;
    {
        TileRegs tr = tile_fetch(KCb, 64, VCTb, 128, tid); tile_store(buf0, tr, tid);
        tr = tile_fetch(KCb + 64 * 64, 64, VCTb + 64, 128, tid); tile_store(buf1, tr, tid);
        if (tid < 64) selL[tid] = 0u;
        __syncthreads();
        attn_init_fixed(st, 0.f, qkb, hi);
        const int hc = (tq - 31) >> 4;
#pragma unroll 1
        for (int ct = 0; ct < 2; ++ct) { tile_compute<false, true, true, true>(st, qf, qlds, KX, 0.f, true, true, ct ? buf1 : buf0, wsc, true, -(1 << 20), hc - 64 * ct, 0u, 0u, oimp, 64 * ct, r32, hi); __builtin_amdgcn_sched_barrier(0); }
        { f32x16 o0, o1;
#pragma unroll
          for (int r = 0; r < 16; ++r) { o0[r] = 0.f; o1[r] = 0.f; }
          attn_accum(o0, o1, st, NSA_GATE(0), wsc, r32, hi);
#pragma unroll
          for (int r = 0; r < 16; ++r) { slab[r * 64 + lane] = o0[r]; slab[(16 + r) * 64 + lane] = o1[r]; } }
#pragma unroll
        for (int a = 0; a < 4; ++a)
#pragma unroll
            for (int i = 0; i < 4; ++i) { const int q = 8 * a + 4 * hi + i; const float l = st.la[4 * a + i]; impL[(wave * 32 + q) * 32 + r32] = l > 0.f ? oimp[4 * a + i] * __builtin_amdgcn_rcpf(l) : 0.f; }
        LDS_WAIT();
        __syncthreads();
        const int tk = tid >> 3, th2 = tk >> 5, q2 = tk & 31, sub = tid & 7;
        float e[4];
#pragma unroll
        for (int i = 0; i < 4; ++i) { const int j = sub * 4 + i; float imp = 0.f;
#pragma unroll
            for (int g2 = 0; g2 < 4; ++g2) imp += impL[((th2 * 4 + g2) * 32 + q2) * 32 + j];
            const bool forced = (j == 0) || (j == qb) || (j == qb - 1);
            e[i] = (j > qb) ? -INFINITY : (imp + (forced ? 1e6f : 0.f)); effL[tk * 32 + j] = e[i]; }
        __syncthreads();
        int rank[4] = {0, 0, 0, 0};
#pragma unroll 1
        for (int jp = 0; jp < 32; ++jp) { const float e2 = effL[tk * 32 + jp];
#pragma unroll
            for (int i = 0; i < 4; ++i) rank[i] += (e2 > e[i] || (e2 == e[i] && jp < sub * 4 + i)) ? 1 : 0; }
        unsigned bits = 0u;
#pragma unroll
        for (int i = 0; i < 4; ++i) if (rank[i] < 16 && sub * 4 + i <= qb) bits |= 1u << (sub * 4 + i);
        if (bits) __hip_atomic_fetch_or(selL + tk, bits, __ATOMIC_RELAXED, __HIP_MEMORY_SCOPE_WORKGROUP);
        __syncthreads();
    }
    unsigned U = 0u;
#pragma unroll
    for (int k = 0; k < 16; ++k) { const v4u w = *(LAS const v4u*)(selL + 4 * k); U |= (w.x | w.y) | (w.z | w.w); }
    U = __builtin_amdgcn_readfirstlane(U);
    if (jdrop >= 0) U &= ~((2u << jdrop) - 1u);
    const unsigned msk = selL[32 * th + r32];
    {
        const bf16* Kb = PROJ + (size_t)b * SEQ * PITCH + C_KS + kh * 64;
        attn_init_fixed(st, slope2, slope2 * (float)tq + qkb, hi);
#define SEL_AFTER(j) ((U & ((1u << (j)) - 1u)) ? 31 - __builtin_clz(U & ((1u << (j)) - 1u)) : -1)
#define SEL_FETCH(j) tile_fetch(Kb + (size_t)(64 * (j)) * PITCH, PITCH, VSTb + 64 * (j), SEQ, tid)
#define SEL_COMPUTE(j, buf) { const bool rowsel = (msk >> (j)) & 1u; const int dq = tq - 64 * (j); \
            if ((j) > jcut && __any(rowsel)) tile_compute<false, false, false, true>(st, qf, qlds, KX, (float)(64 * (j)), rowsel, __all(rowsel) != 0, buf, wsc, (j) == qb, -(1 << 20), dq, 0u, 0u, oimp, 0, r32, hi); }
        TILE_PIPELINE(31 - __builtin_clz(U), SEL_AFTER, SEL_FETCH, SEL_COMPUTE);
#undef SEL_AFTER
#undef SEL_FETCH
#undef SEL_COMPUTE
        { f32x16 o0, o1;
#pragma unroll
          for (int r = 0; r < 16; ++r) { o0[r] = slab[r * 64 + lane]; o1[r] = slab[(16 + r) * 64 + lane]; }
          attn_accum(o0, o1, st, NSA_GATE(1), wsc, r32, hi);
#pragma unroll
          for (int r = 0; r < 16; ++r) { slab[r * 64 + lane] = o0[r]; slab[(16 + r) * 64 + lane] = o1[r]; } }
        __syncthreads();
    }
    f32x16 out0, out1;
    {
        const bf16* Kb = PROJ + (size_t)b * SEQ * PITCH + C_KW + kh * 64;
        attn_init_fixed(st, slope2, slope2 * (float)tq + qkb, hi);
        int jlo = qb - 8 < 0 ? 0 : qb - 8; jlo = jdrop + 1 > jlo ? jdrop + 1 : jlo;
#define WIN_AFTER(j) ((j) > jlo ? (j) - 1 : -1)
#define WIN_FETCH(j) tile_fetch(Kb + (size_t)(64 * (j)) * PITCH, PITCH, VWTb + 64 * (j), SEQ, tid)
#define WIN_COMPUTE(j, buf) if ((j) > jcut) { const int dq = tq - 64 * (j); \
            tile_compute<false, false, false, true>(st, qf, qlds, KX, (float)(64 * (j)), true, true, buf, wsc, ((j) == qb) || ((j) == qb - 8), dq - 511, dq, 0u, 0u, oimp, 0, r32, hi); }
        TILE_PIPELINE(qb, WIN_AFTER, WIN_FETCH, WIN_COMPUTE);
#undef WIN_AFTER
#undef WIN_FETCH
#undef WIN_COMPUTE
#pragma unroll
        for (int r = 0; r < 16; ++r) { out0[r] = slab[r * 64 + lane]; out1[r] = slab[(16 + r) * 64 + lane]; }
        attn_accum(out0, out1, st, NSA_GATE(2), wsc, r32, hi);
    }
    store_tile_fp8(out0, out1, lds + A_STG + wave * 4096, dob + DO_O + (size_t)(b * SEQ + 64 * qb + 32 * th) * DM + 512 + (kh * 4 + g) * 64, DM, lane, r32, hi);
    __syncthreads();
}


__device__ __forceinline__ void dsa_unit(const Ptrs& P, LAS unsigned char* lds, int b, int ti, int tid, int wave, int lane) {
    asm volatile("" : "+v"(tid), "+v"(lane));
    const int r32 = lane & 31, hi = lane >> 5, fr = lane & 15, fq = lane >> 4;
    bf16* PROJ = (bf16*)(P.ws + WS_PROJ);
    unsigned char* dob = (unsigned char*)P.out;
    const bf16* Kb = (const bf16*)(dob + DO_KA) + (size_t)b * SEQ * 64; const bf16* VTb = (const bf16*)(dob + DO_VAT) + (size_t)b * 64 * SEQ;
    const bf16* PB = PROJ + (size_t)b * SEQ * PITCH;
    LAS float* scL = (LAS float*)lds; LAS unsigned* maskL = (LAS unsigned*)(lds + D_MASK);
    LAS float* wsc = (LAS float*)(lds + A_WSC) + wave * 64;
    const int t0 = 32 * ti;
    bf16x8 qaN[8]; v4u wvN[4];
    const bf16* kbase = PB + (size_t)fr * PITCH + C_KI + fq * 8;
#define DSA_LOAD_HALF(H) { const int th0_ = t0 + 16 * (H); const bf16* qrow_ = PB + (size_t)(th0_ + fr) * PITCH + C_QI + fq * 8; \
        _Pragma("unroll") for (int hh = 0; hh < 8; ++hh) qaN[hh] = *(const GAS bf16x8*)(qrow_ + hh * 32); \
        _Pragma("unroll") for (int i = 0; i < 4; ++i) wvN[i] = *(const GAS v4u*)(PB + (size_t)(th0_ + 4 * fq + i) * PITCH + C_WI); \
        }
    DSA_LOAD_HALF(0)
    for (int half_ = 0; half_ < 2 * PROBE_DPRE; ++half_) {
        const int half = half_ & 1;
        const int th0 = t0 + 16 * half; const int ntile = (th0 >> 4) + 1;
        {
            bf16x8 qa[8];
#pragma unroll
            for (int hh = 0; hh < 8; ++hh) qa[hh] = qaN[hh];
            float wv[4][8];
#pragma unroll
            for (int i = 0; i < 4; ++i) unpack8(wvN[i], wv[i]);
            bf16x8 kbn[4];
#pragma unroll
            for (int q4 = 0; q4 < 4; ++q4) { int kt = wave + 8 * q4; kt = kt < ntile ? kt : ntile - 1; kbn[q4] = *(const GAS bf16x8*)(kbase + (size_t)(16 * kt) * PITCH); }
            for (int rep_ = 0; rep_ < PROBE_DIDX; ++rep_)
            for (int kt0 = wave; kt0 < ntile; kt0 += 32) {
                bf16x8 kbc[4];
#pragma unroll
                for (int q4 = 0; q4 < 4; ++q4) kbc[q4] = kbn[q4];
                if (kt0 + 32 < ntile) {
#pragma unroll
                    for (int q4 = 0; q4 < 4; ++q4) { int kt = kt0 + 32 + 8 * q4; kt = kt < ntile ? kt : ntile - 1; kbn[q4] = *(const GAS bf16x8*)(kbase + (size_t)(16 * kt) * PITCH); } }
#pragma unroll
                for (int q4 = 0; q4 < 4; ++q4) { const int kt = kt0 + 8 * q4;
                    if (kt < ntile) {
                        float sc[4] = {0.f, 0.f, 0.f, 0.f};
                        f32x4 acc8[8];
#pragma unroll
                        for (int hh = 0; hh < 8; ++hh) { const f32x4 z = {0.f, 0.f, 0.f, 0.f}; acc8[hh] = __builtin_amdgcn_mfma_f32_16x16x32_bf16(qa[hh], kbc[q4], z, 0, 0, 0); }
                        __builtin_amdgcn_sched_barrier(0);
#pragma unroll
                        for (int hh = 0; hh < 8; ++hh)
#pragma unroll
                            for (int i = 0; i < 4; ++i) { const int rb = __float_as_int(acc8[hh][i]); sc[i] += __int_as_float(rb > 0 ? rb : 0) * wv[i][hh]; }
#pragma unroll
                        for (int i = 0; i < 4; ++i) scL[(4 * fq + i) * SROW + 16 * kt + fr] = sc[i] + 0.0f;
                    } }
            }
        }
        __syncthreads();
        if (half_ + 1 < 2 * PROBE_DPRE) DSA_LOAD_HALF((half_ + 1) & 1)
        for (int rep_ = 0; rep_ < PROBE_DTHR; ++rep_) {
            const int rowA = 2 * wave, rowB = rowA + 1; const int tA = th0 + rowA, tB = tA + 1;
            unsigned uA[32], uB[32];
#pragma unroll
            for (int i = 0; i < 32; ++i) { const int s = lane + 64 * i; const float xa = scL[rowA * SROW + (s & (SROW - 1))], xb = scL[rowB * SROW + (s & (SROW - 1))]; uA[i] = ord_u32(xa); uB[i] = ord_u32(xb); }
            const int nvA = lane <= tA ? ((tA - lane) >> 6) + 1 : 0, nvB = lane <= tB ? ((tB - lane) >> 6) + 1 : 0;
            unsigned candA = nvA >= 32 ? 0xffffffffu : ((1u << nvA) - 1u), candB = nvB >= 32 ? 0xffffffffu : ((1u << nvB) - 1u);
            unsigned selA = candA, selB = candB;
            if (tB + 1 > TOPK) {
#define DSA_TSTAGE(U, J, MSK) _Pragma("unroll") for (int k0 = 0; k0 < 32; k0 += 2 * (J)) _Pragma("unroll") for (int k1 = 0; k1 < (J); ++k1) { const int k = k0 + k1; \
                    const unsigned a_ = U[k], b_ = U[k + (J)]; U[k] = ((MSK) & a_) | (~(MSK) & (b_ << (J))); U[k + (J)] = ((MSK) & (a_ >> (J))) | (~(MSK) & b_); }
#define DSA_PSTAGE(U, J, S_LO, S_HI) _Pragma("unroll") for (int k0 = 0; k0 < 32; k0 += 2 * (J)) _Pragma("unroll") for (int k1 = 0; k1 < (J); ++k1) { const int k = k0 + k1; \
                    const unsigned a_ = U[k], b_ = U[k + (J)]; U[k] = __builtin_amdgcn_perm(b_, a_, S_LO); U[k + (J)] = __builtin_amdgcn_perm(b_, a_, S_HI); }
                DSA_PSTAGE(uA, 16, 0x05040100u, 0x07060302u) DSA_PSTAGE(uA, 8, 0x06020400u, 0x07030501u) DSA_TSTAGE(uA, 4, 0x0f0f0f0fu) DSA_TSTAGE(uA, 2, 0x33333333u) DSA_TSTAGE(uA, 1, 0x55555555u)
                DSA_PSTAGE(uB, 16, 0x05040100u, 0x07060302u) DSA_PSTAGE(uB, 8, 0x06020400u, 0x07030501u) DSA_TSTAGE(uB, 4, 0x0f0f0f0fu) DSA_TSTAGE(uB, 2, 0x33333333u) DSA_TSTAGE(uB, 1, 0x55555555u)
#undef DSA_PSTAGE
#undef DSA_TSTAGE
#pragma unroll
                for (int k = 0; k < 32; k += 8) {
                    asm volatile("" : "+v"(uA[k]), "+v"(uA[k + 1]), "+v"(uA[k + 2]), "+v"(uA[k + 3]), "+v"(uA[k + 4]), "+v"(uA[k + 5]), "+v"(uA[k + 6]), "+v"(uA[k + 7]));
                    asm volatile("" : "+v"(uB[k]), "+v"(uB[k + 1]), "+v"(uB[k + 2]), "+v"(uB[k + 3]), "+v"(uB[k + 4]), "+v"(uB[k + 5]), "+v"(uB[k + 6]), "+v"(uB[k + 7])); }
                unsigned aboveA = 0u, aboveB = 0u; int needA = TOPK, needB = TOPK, ccA = tA + 1, ccB = tB + 1; bool doneA = false, doneB = false;
                if (ccA <= TOPK) { aboveA = candA; candA = 0u; needA = 0; ccA = 0; doneA = true; }
#pragma unroll
                for (int bb = 31; bb >= 0; --bb) {
                    if (!(doneA && doneB)) {
                        const unsigned onesA = candA & uA[bb], onesB = candB & uB[bb];
                        const unsigned S = wave_usum((unsigned)__builtin_popcount(onesA) | ((unsigned)__builtin_popcount(onesB) << 16));
                        const int c1A = (int)(S & 0xffffu), c1B = (int)(S >> 16);
                        { const bool take = c1A >= needA; aboveA = take ? aboveA : (aboveA | onesA); candA = take ? onesA : (candA & ~uA[bb]); needA = take ? needA : needA - c1A; ccA = take ? c1A : ccA - c1A;
                          const bool fin = ccA == needA; aboveA = fin ? (aboveA | candA) : aboveA; candA = fin ? 0u : candA; needA = fin ? 0 : needA; ccA = fin ? 0 : ccA; doneA = doneA || fin; }
                        { const bool take = c1B >= needB; aboveB = take ? aboveB : (aboveB | onesB); candB = take ? onesB : (candB & ~uB[bb]); needB = take ? needB : needB - c1B; ccB = take ? c1B : ccB - c1B;
                          const bool fin = ccB == needB; aboveB = fin ? (aboveB | candB) : aboveB; candB = fin ? 0u : candB; needB = fin ? 0 : needB; ccB = fin ? 0 : ccB; doneB = doneB || fin; }
                    }
                }
                selA = aboveA; selB = aboveB;
                if (!doneA) {
                    int ties = 0; const u64 ltm = (1ull << lane) - 1ull;
#pragma unroll 1
                    for (int i = 0; i < 32; ++i) { const bool eq = (candA >> i) & 1u; const u64 meq = __ballot(eq); const int myrank = ties + __popcll(meq & ltm); selA |= (unsigned)(eq && myrank < needA) << i; ties += __popcll(meq); }
                }
                if (!doneB) {
                    int ties = 0; const u64 ltm = (1ull << lane) - 1ull;
#pragma unroll 1
                    for (int i = 0; i < 32; ++i) { const bool eq = (candB >> i) & 1u; const u64 meq = __ballot(eq); const int myrank = ties + __popcll(meq & ltm); selB |= (unsigned)(eq && myrank < needB) << i; ties += __popcll(meq); }
                }
            }
            {
                LAS unsigned* mrA = maskL + (16 * half + rowA) * 64; LAS unsigned* mrB = mrA + 64;
                unsigned wloA = 0u, whiA = 0u, wloB = 0u, whiB = 0u;
#pragma unroll
                for (int i = 0; i < 32; ++i) { const u64 ma = __ballot((selA >> i) & 1u), mb = __ballot((selB >> i) & 1u);
                    wloA = (lane == i) ? (unsigned)ma : wloA; whiA = (lane == i) ? (unsigned)(ma >> 32) : whiA; wloB = (lane == i) ? (unsigned)mb : wloB; whiB = (lane == i) ? (unsigned)(mb >> 32) : whiB; }
                if (lane < 32) { mrA[2 * lane] = wloA; mrA[2 * lane + 1] = whiA; mrB[2 * lane] = wloB; mrB[2 * lane + 1] = whiB; }
                const unsigned kA = wave_umax(selA ? (unsigned)(lane + 64 * (31 - __builtin_clz(selA))) + 1u : 0u), kB = wave_umax(selB ? (unsigned)(lane + 64 * (31 - __builtin_clz(selB))) + 1u : 0u);
                if (lane == 0) { LAS int* km = (LAS int*)(lds + D_KMAX); km[16 * half + rowA] = (int)kA - 1; km[16 * half + rowB] = (int)kB - 1; }
            }
        }
        __syncthreads();
    }
    {
    int tid_b = tid, lane_b = lane; asm volatile("" : "+v"(tid_b), "+v"(lane_b));
    const int tid = tid_b, lane = lane_b, r32 = lane & 31, hi = lane >> 5;
    {
        LAS unsigned char* m8 = lds + D_M8; const int nw = 2 * (((t0 + 31) >> 6) + 1); const int row = tid >> 4;
        for (int w = tid & 15; w < nw; w += 16) { const unsigned bits = maskL[row * 64 + w]; v4u o[2];
#pragma unroll
            for (int n = 0; n < 8; ++n) { const unsigned x = (bits >> (4 * n)) & 15u; const unsigned y = ((x * 0x00204081u) & 0x01010101u) ^ 0x01010101u; o[n >> 2][n & 3] = y * 0xFEu; }
            *(LAS v4u*)(m8 + row * M8_STRIDE + 32 * w) = o[0]; *(LAS v4u*)(m8 + row * M8_STRIDE + 32 * w + 16) = o[1]; }
    }
    MaskMM MM;
    { const unsigned one = 0x38u << (8 * (r32 & 3));
#pragma unroll
      for (int w = 0; w < 8; ++w) { const unsigned x = ((r32 >> 2) == w) ? one : 0u; MM.a0[w] = (hi == 0) ? (int)x : 0; MM.a1[w] = (hi == 1) ? (int)x : 0; }
      MM.row = lds + D_M8 + r32 * M8_STRIDE + 32 * hi; }
    const int tq = t0 + r32; const int h = wave;
    const bf16* prow = PB + (size_t)tq * PITCH;
    bf16x8 qf[4];
#pragma unroll
    for (int ds = 0; ds < 4; ++ds) qf[ds] = *(const GAS bf16x8*)(prow + C_QA + h * 64 + ds * 16 + hi * 8);
    const float slope2 = exp2f(-(float)(h + 1)) * LOG2E;
    int jcutD; float qkbD; const int kmaxrow = ((LAS const int*)(lds + D_KMAX))[r32];
    { const float gq = fabsf(P.in[3][lane]), gk = fabsf(P.in[4][lane]);
      qkbD = 64.0f * QSCALE * 1.02f * __uint_as_float(wave_umax(__float_as_uint(gq))) * __uint_as_float(wave_umax(__float_as_uint(gk))) + 0.25f;
      const int kmin = (int)wave_umin((unsigned)(kmaxrow + 1)) - 1;
      const int dcut = (int)ceilf((2.0f * qkbD + 40.0f) / slope2);
      const int num = kmin - dcut - 63; jcutD = num >= 0 ? (num >> 6) : -1; }
    KxOps KX = kx_ops(r32, hi);
    LAS unsigned char* buf0 = lds + A_TILE0; LAS unsigned char* buf1 = lds + A_TILE1;
    AttnState st;
    f32x16 dummy;
#pragma unroll
    for (int r = 0; r < 16; ++r) dummy[r] = 0.f;
    for (int rep = 0; rep < PROBE_DATT; ++rep) {
    attn_init_fixed(st, slope2, slope2 * (float)kmaxrow + qkbD, hi);
#define DSA_AFTER(j) ((j) - 1)
#define DSA_FETCH(j) tile_fetch(Kb + (size_t)(64 * (j)) * 64, 64, VTb + 64 * (j), SEQ, tid)
#define DSA_COMPUTE(j, buf) if ((j) > jcutD) tile_compute<true, false, false, true>(st, qf, nullptr, KX, (float)(64 * (j)), true, true, buf, wsc, false, 0, 0, (unsigned)(64 * (j)), 0u, dummy, 0, r32, hi, &MM)
    TILE_PIPELINE((t0 + 31) >> 6, DSA_AFTER, DSA_FETCH, DSA_COMPUTE);
#undef DSA_AFTER
#undef DSA_FETCH
#undef DSA_COMPUTE
    __syncthreads();
    }
    f32x16 out0, out1;
#pragma unroll
    for (int r = 0; r < 16; ++r) { out0[r] = 0.f; out1[r] = 0.f; }
    attn_accum(out0, out1, st, 1.0f, wsc, r32, hi);
    __syncthreads();
    store_tile_fp8(out0, out1, lds + A_TILE0 + wave * 2048, dob + DO_O + (size_t)(b * SEQ + t0) * DM + h * 64, DM, lane, r32, hi);
    __syncthreads();
    }
}

__device__ __forceinline__ int nsa_tbl(int i, unsigned long long c0, unsigned long long c1, unsigned long long c2, unsigned long long c3) { const unsigned long long c = (i & 16) ? ((i & 8) ? c3 : c2) : ((i & 8) ? c1 : c0); return (int)((c >> (8 * (i & 7))) & 0xffull); }
__device__ __forceinline__ int nsa_ua(int i) { return nsa_tbl(i, 0x38393a3b3c3d3e3full, 0x3031323334353637ull, 0x28292a2b2c2d2e2full, 0x130c12110d0e0f10ull); }
__device__ __forceinline__ int nsa_ub(int i) { return nsa_tbl(i, 0x1c1e090807250504ull, 0x2303220221012000ull, 0x1b270a1d1f260624ull, 0x1415160b1a191817ull); }
__device__ __forceinline__ void p3_fast(const Ptrs& P, LAS unsigned char* lds, int vcu, int G, int tid, int wave, int lane) {
    for (int u = vcu; u < 256; u += G)
        for (int k = 0; k < 2; ++k) { const int b = u >> 5, p = u & 31; dsa_unit(P, lds, b, k ? p : 63 - p, tid, wave, lane); }
    asm volatile("" ::: "memory");
    for (int u = vcu; u < 256; u += G)
        for (int k = 0; k < 2 * PROBE_NSA; ++k) { const int b = u >> 5, i = u & 31;
            const int c = (k & 1) ? nsa_ub(i) : nsa_ua(i); nsa_unit(P, lds, b, c >> 5, c & 31, tid, wave, lane); }
}

struct Args { Ptrs p; };
__global__ void __launch_bounds__(NWAVES * 64, 2) fwd_kernel(Args args) {
    extern __shared__ __attribute__((aligned(16))) unsigned char lds_raw[];
    LAS unsigned char* lds = (LAS unsigned char*)lds_raw;
    const Ptrs& P = args.p;
    const int tid = threadIdx.x, lane = tid & 63, wave = __builtin_amdgcn_readfirstlane(tid >> 6);
    const int G = gridDim.x; const int bx = blockIdx.x; const int vcu = (G % 8 == 0) ? (bx % 8) * (G / 8) + bx / 8 : bx;
    const int gw = vcu * NWAVES + wave, NGW = G * NWAVES;
    volatile LAS unsigned* MISC = (volatile LAS unsigned*)(lds + MISC_OFF);
    for (int u = tid; u < (LDS_BYTES - RING_BYTES) / 4; u += NWAVES * 64) ((LAS unsigned*)(lds + RING_BYTES))[u] = 0u;
    __syncthreads();
    unsigned* ctl = (unsigned*)(P.ws + WS_CTL);
    XcdBarrier bar = xcd_barrier_post(ctl + CW_BAR, MISC + 8);
#if PROBE_BAR
    int pb_k = 0;
#define GRIDBAR() do { const unsigned long long t0_ = __builtin_amdgcn_s_memrealtime(); xcd_barrier(bar); const unsigned long long t1_ = __builtin_amdgcn_s_memrealtime(); \
        if (tid == 0) { const unsigned w_ = (unsigned)(t1_ - t0_); atomicMax(ctl + 8192 + 64 * pb_k, 0x7fffffffu - w_); atomicMax(ctl + 8192 + 1024 + 64 * pb_k, w_); } ++pb_k; } while (0)
#elif PROBE_SPAN
    int pb_k = 0; unsigned long long sp_prev = __builtin_amdgcn_s_memrealtime(), sp_acc = 0;
#define GRIDBAR() do { xcd_barrier(bar); const unsigned long long t_ = __builtin_amdgcn_s_memrealtime(); if ((PROBE_SPAN >> pb_k) & 1) sp_acc += t_ - sp_prev; sp_prev = t_; ++pb_k; } while (0)
#else
#define GRIDBAR() xcd_barrier(bar)
#endif

    bf16* H = (bf16*)((unsigned char*)P.out + DO_H);
    bf16* PROJ = (bf16*)(P.ws + WS_PROJ); bf16* HID = (bf16*)(P.ws + WS_PROJ);
    bf16* MERGED = (bf16*)(P.ws + WS_MERGED); bf16* X1B = (bf16*)(P.ws + WS_X1B); float* PARTS = (float*)(P.ws + WS_PARTS);

    for (int rep = 0; rep < PROBE_P0; ++rep) p0_prologue(P, lds, gw, NGW, wave, lane);
    GRIDBAR();
    for (int rep = 0; rep < PROBE_P1; ++rep) {
        pg8::Gemm g{H, (const bf16*)(P.ws + WS_WIN), M, 1024, DM, DM}; pg8::StaticOrder S; S.init(M, 1024, G, bx);
        pg8::EpiProj E{PROJ, PITCH, P.in[3], P.in[8], P.in[10], P.in[11], (bf16*)((unsigned char*)P.out + DO_VST), (bf16*)((unsigned char*)P.out + DO_VWT), QSCALE, RMS_EPS, SEQ, (bf16*)(P.ws + WS_GT)};
        pg8::gemm_phase<pg8::EpiProj, pg8::StaticOrder, true>(lds, g, S, E);
        {
            pg8::Gemm g8{(const bf16*)(P.ws + WS_H8), (const bf16*)(P.ws + WS_WIN8C), M, 3072, DM / 2, DM / 2}; pg8::StaticOrder S8; S8.init(M, 3072, G, bx);
            pg8::EpiProjGate8 E8{pg8::EpiProjT<1>{PROJ, PITCH, P.in[3], P.in[8], P.in[10], P.in[11], (bf16*)((unsigned char*)P.out + DO_VST), (bf16*)((unsigned char*)P.out + DO_VWT), QSCALE, RMS_EPS, SEQ, (bf16*)(P.ws + WS_GT)}, pg8::EpiGateSig{P.ws + WS_GT}};
            pg8::gemm_phase<pg8::EpiProjGate8, pg8::StaticOrder, true>(lds, g8, S8, E8);
        }
        if (rep == 0 && G != 256) { int lane2 = lane; asm volatile("" : "+v"(lane2)); const int rem = S.nwg % G;
            if (rem == 0) p0_items(P, lds, P0_EARLY, P0_ALL, bx * NWAVES + wave, G * NWAVES, wave, lane2);
            else if (bx >= rem) p0_items(P, lds, P0_EARLY, P0_ALL, (bx - rem) * NWAVES + wave, (G - rem) * NWAVES, wave, lane2); }
    }
    GRIDBAR();
    for (int rep = 0; rep < PROBE_P2; ++rep) {
        p2_fast(P, lds, vcu, G, tid, wave, lane);
        if (rep == 0 && G == 256 && vcu >= 192) { int lane2 = lane; asm volatile("" : "+v"(lane2));
            p0_items(P, lds, P0_EARLY, P0_ALL, (vcu - 192) * NWAVES + wave, 64 * NWAVES, wave, lane2); }
        {
            const bool idle64 = (G == 256);
            if (!idle64 || (vcu >= 128 && vcu < 192)) {
                pg8::Gemm g{(const bf16*)(P.ws + WS_H8), (const bf16*)(P.ws + WS_WIN8T - (size_t)8 * 256 * DM), M, 2304, DM / 2, DM / 2};
                pg8::ColTileOrder S{8, idle64 ? vcu - 128 : vcu, idle64 ? 64 : G, M / 256};
                pg8::EpiProjT<1> E{PROJ, PITCH, P.in[3], P.in[8], P.in[10], P.in[11], (bf16*)((unsigned char*)P.out + DO_VST), (bf16*)((unsigned char*)P.out + DO_VWT), QSCALE, RMS_EPS, SEQ, (bf16*)(P.ws + WS_GT)};
                pg8::gemm_phase<pg8::EpiProjT<1>, pg8::ColTileOrder, false>(lds, g, S, E);
            }
        }
    }
    GRIDBAR();
    for (int rep = 0; rep < PROBE_P3; ++rep) p3_fast(P, lds, vcu, G, tid, wave, lane);
    GRIDBAR();
    for (int rep = 0; rep < PROBE_P4; ++rep) {
        pg8::StaticOrder S; S.init(M, DM, G, bx);
        const bf16* OB = (const bf16*)((unsigned char*)P.out + DO_O);
        pg8::Gemm g{OB, (const bf16*)(P.ws + WS_WUPA), M, DM, DM / 2, DM / 2}; pg8::EpiGate2 E{(unsigned char*)MERGED, DM, P.ws + WS_GT};
        pg8::gemm_phase<pg8::EpiGate2, pg8::StaticOrder, true>(lds, g, S, E);
    }
    GRIDBAR();
    for (int rep = 0; rep < PROBE_P5; ++rep) {
        pg8::Gemm g{MERGED, (const bf16*)(P.ws + WS_WOUT), M, DM, DM / 2, DM / 2}; pg8::StaticOrder S; S.init(M, DM, G, bx);
        pg8::EpiOutRes E{P.in[0], P.out, X1B, DM, PARTS, P.ws + WS_OUTSCR};
        pg8::gemm_phase<pg8::EpiOutRes, pg8::StaticOrder, true>(lds, g, S, E);
    }
    GRIDBAR();
    for (int rep = 0; rep < PROBE_P6; ++rep) {
        pg8::Gemm g{(const bf16*)(P.ws + WS_OUTSCR), (const bf16*)(P.ws + WS_WFF1), M, FF, DM / 2, DM / 2}; pg8::StaticOrder S; S.init(M, FF, G, bx);
        pg8::EpiRelu2 E{(unsigned char*)HID, FF, PARTS, RMS_EPS, 1.0f / DM};
        pg8::gemm_phase<pg8::EpiRelu2, pg8::StaticOrder, true>(lds, g, S, E);
    }
    GRIDBAR();
    {
        pg8::Gemm g{HID, (const bf16*)(P.ws + WS_WFF2), M, DM, FF / 2, FF / 2}; pg8::StaticOrder S; S.init(M, DM, G, bx);
        pg8::EpiFinal E{P.out, X1B, DM};
        pg8::gemm_phase<pg8::EpiFinal, pg8::StaticOrder, true>(lds, g, S, E);
    }
#if PROBE_SPAN
    GRIDBAR();
    if (bx == 0) { const unsigned long long t0 = __builtin_amdgcn_s_memrealtime(); while (__builtin_amdgcn_s_memrealtime() - t0 < sp_acc) __builtin_amdgcn_s_sleep(8); }
#endif
#if PROBE_BAR
    xcd_barrier(bar);
    if (bx == 0 && tid == 0) { unsigned long long tot = 0;
        for (int k = 0; k < 7; ++k) { const unsigned a = __hip_atomic_load(ctl + 8192 + (PROBE_BAR == 1 ? 0 : 1024) + 64 * k, __ATOMIC_RELAXED, __HIP_MEMORY_SCOPE_AGENT); tot += (PROBE_BAR == 1) ? (0x7fffffffu - a) : a; }
        const unsigned long long t0 = __builtin_amdgcn_s_memrealtime(); while (__builtin_amdgcn_s_memrealtime() - t0 < 8ull * tot) __builtin_amdgcn_s_sleep(8); }
#endif
}

extern "C" void kernel_launch(void* const* d_in, const int* in_sizes, int n_in, void* d_out, int out_size, void* d_ws, size_t ws_size, hipStream_t stream) {
    static int grid = 0;
    if (grid == 0) {
        if (n_in != 23 || in_sizes[0] != M * DM || out_size != M * DM || ws_size < WS_END) { fprintf(stderr, "kernel_launch: unexpected shapes (n_in %d, in0 %d, out %d, ws %zu)\n", n_in, n_in > 0 ? in_sizes[0] : -1, out_size, ws_size); grid = -1; return; }
        int dev = 0, cus = 0, per_cu = 0;
        if (hipGetDevice(&dev) != hipSuccess || hipDeviceGetAttribute(&cus, hipDeviceAttributeMultiprocessorCount, dev) != hipSuccess) { grid = -1; return; }
        if (hipFuncSetAttribute((const void*)fwd_kernel, hipFuncAttributeMaxDynamicSharedMemorySize, LDS_BYTES) != hipSuccess) { fprintf(stderr, "kernel_launch: hipFuncSetAttribute failed\n"); grid = -1; return; }
        if (hipOccupancyMaxActiveBlocksPerMultiprocessor(&per_cu, (const void*)fwd_kernel, NWAVES * 64, LDS_BYTES) != hipSuccess || per_cu < 1) { fprintf(stderr, "kernel_launch: occupancy query reports %d blocks per CU\n", per_cu); }
        (void)hipGetLastError();
        grid = cus;
    }
    if (grid < 0) return;
    if (hipMemsetAsync((char*)d_ws + WS_CTL, 0, CTL_ZERO_BYTES, stream) != hipSuccess) { fprintf(stderr, "kernel_launch: memset failed\n"); return; }
    Args a{};
    for (int i = 0; i < 23; ++i) a.p.in[i] = (const float*)d_in[i];
    a.p.out = (float*)d_out; a.p.ws = (unsigned char*)d_ws;
    void* kargs[] = {&a};
    hipError_t e = hipLaunchCooperativeKernel((const void*)fwd_kernel, dim3(grid), dim3(NWAVES * 64), kargs, LDS_BYTES, stream);
    if (e != hipSuccess) fprintf(stderr, "kernel_launch: cooperative launch failed: %s (grid %d)\n", hipGetErrorString(e), grid);
}
```

```cpp
#include <hip/hip_runtime.h>
#include <cstdio>
#include <cstdint>

namespace pg8 {
#define PG8_LAS __attribute__((address_space(3)))
typedef unsigned short bf16_t;
typedef short bf16x8 __attribute__((ext_vector_type(8)));
typedef float f32x4 __attribute__((ext_vector_type(4)));
typedef unsigned u32x4 __attribute__((ext_vector_type(4)));
typedef unsigned u32x2 __attribute__((ext_vector_type(2)));
typedef int i32x8 __attribute__((ext_vector_type(8)));
constexpr int BM = 256, BK = 64, HALF = 128, HTB = HALF * BK * 2  , STAGE_BYTES = 8 * HTB, NXCD = 8, WGM = 8;

__host__ __device__ __forceinline__ int lds_byte(int r, int c) { const int st = (r >> 4) * 2 + (c >> 5), rr = r & 15, cc = c & 31, ob = rr * 64 + cc * 2; return st * 1024 + (ob ^ (((ob >> 9) & 1) << 5)); }
__host__ __device__ __forceinline__ void stage_rc(int b, int& R, int& C) { const int st = b / 1024, sb = b % 1024, swz = sb ^ (((sb >> 9) & 1) << 5); R = (st >> 1) * 16 + swz / 64; C = (st & 1) * 32 + (swz % 64) / 2; }
__host__ __device__ __forceinline__ int perm32(int rho) { const int n = rho >> 4, i = rho & 15; return 8 * (i >> 2) + 4 * n + (i & 3); }

struct Unit { int pm, pn; };
struct Gemm { const bf16_t* A; const bf16_t* Bt; int M, N, K, lda; };

struct StaticOrder {
    int nM, nN, nwg, G, c;
    __host__ __device__ void init(int M, int N, int G_, int c_) { nM = M / BM; nN = N / BM; nwg = nM * nN; G = G_; c = c_; }
    __host__ __device__ bool next(int i, Unit& u) const {
        const long L = (long)i * G + c; if (L >= nwg) return false;
        int wgid = (int)L; { const int q = nwg / NXCD, r = nwg % NXCD, xcd = wgid % NXCD, off = wgid / NXCD; wgid = (xcd < r ? xcd * (q + 1) : r * (q + 1) + (xcd - r) * q) + off; }
        const int nig = WGM * nN, gid = wgid / nig, fm = gid * WGM, gsz = (nM - fm) < WGM ? (nM - fm) : WGM;
        u.pm = fm + ((wgid % nig) % gsz); u.pn = (wgid % nig) / gsz; return true;
    }
};

struct ColTileOrder { int pn, first, stride, nM; __host__ __device__ bool next(int i, Unit& u) const { const int pm = first + i * stride; if (pm >= nM) return false; u.pm = pm; u.pn = pn; return true; } };

typedef float f32x2v __attribute__((ext_vector_type(2))); typedef __bf16 bf16x2v __attribute__((ext_vector_type(2)));
__device__ __forceinline__ unsigned cvt_pk_bf16(float lo, float hi) { const f32x2v v = {lo, hi}; const bf16x2v b = __builtin_convertvector(v, bf16x2v); return __builtin_bit_cast(unsigned, b); }
__device__ __forceinline__ unsigned cvt4_fp8(float a, float b, float c, float d) { int w = __builtin_amdgcn_cvt_pk_fp8_f32(a, b, 0, false); w = __builtin_amdgcn_cvt_pk_fp8_f32(c, d, w, true); return (unsigned)w; }
typedef float f32x2u __attribute__((ext_vector_type(2)));
__device__ __forceinline__ void unpack8_fp8(const u32x2 g, float (&o)[8]) { const f32x2u a = __builtin_amdgcn_cvt_pk_f32_fp8((int)g.x, false), b = __builtin_amdgcn_cvt_pk_f32_fp8((int)g.x, true), c = __builtin_amdgcn_cvt_pk_f32_fp8((int)g.y, false), d = __builtin_amdgcn_cvt_pk_f32_fp8((int)g.y, true);
    o[0] = a[0]; o[1] = a[1]; o[2] = b[0]; o[3] = b[1]; o[4] = c[0]; o[5] = c[1]; o[6] = d[0]; o[7] = d[1]; }
__device__ __forceinline__ float bflo(unsigned w) { return __uint_as_float(w << 16); }
__device__ __forceinline__ float bfhi(unsigned w) { return __uint_as_float(w & 0xffff0000u); }
__device__ __forceinline__ float sigm(float x) { return 1.0f / (1.0f + __expf(-x)); }
__device__ __forceinline__ float sigq(float x) { return fmaxf(sigm(x), 0.001953125f); }
__device__ __forceinline__ unsigned cvt4_fp8c(float a, float b, float c, float d) { return cvt4_fp8(__builtin_amdgcn_fmed3f(a, -448.f, 448.f), __builtin_amdgcn_fmed3f(b, -448.f, 448.f), __builtin_amdgcn_fmed3f(c, -448.f, 448.f), __builtin_amdgcn_fmed3f(d, -448.f, 448.f)); }

template <int F8_> struct EpiProjT {
    static constexpr bool PERM = true; static constexpr int F8 = F8_, F8W = 0x7A7A7A7A, F8A = 0x7F7F7F7F; static constexpr int MIDK = 0;
    bf16_t* O; int ldc; const float *gqa, *gqb, *gks, *gkw; bf16_t* VST; bf16_t* VWT; float qscale, eps; int seq; bf16_t* GT;
    __device__ __forceinline__ void operator()(const f32x4 (&acc)[2][2][4][2], const Unit& u, int wr, int wc, int fr, int fq) const {
        const int f0 = u.pn * BM + wc * 64;
        const float* g = nullptr; float sc = 1.f;
        if (f0 >= 1024 && f0 < 1536) { g = gqa; sc = qscale; } else if (f0 >= 320 && f0 < 832) { g = gqb; sc = qscale; } else if (f0 == 1792 || f0 == 1856) { g = gks; } else if (f0 == 2048 || f0 == 2112) { g = gkw; }
        bf16_t* VT = nullptr; int kh = 0;
        if (f0 == 1920 || f0 == 1984) { VT = VST; kh = (f0 - 1920) >> 6; } else if (f0 == 2176 || f0 == 2240) { VT = VWT; kh = (f0 - 2176) >> 6; }
        float gv[2][8];
#pragma unroll
        for (int bj = 0; bj < 2; ++bj)
#pragma unroll
            for (int k = 0; k < 8; ++k) gv[bj][k] = g ? g[32 * bj + 8 * fq + k] * sc : 1.f;
        const int row0 = u.pm * BM + wr * 64 + fr;
#pragma unroll
        for (int ai = 0; ai < 2; ++ai)
#pragma unroll
            for (int m = 0; m < 4; ++m) { const int row = row0 + ai * HALF + m * 16; bf16_t* rowp = O + (size_t)row * ldc + f0 + 8 * fq;
                float v[2][8];
#pragma unroll
                for (int bj = 0; bj < 2; ++bj) { const f32x4 v0 = acc[ai][bj][m][0], v1 = acc[ai][bj][m][1]; v[bj][0] = v0[0]; v[bj][1] = v0[1]; v[bj][2] = v0[2]; v[bj][3] = v0[3]; v[bj][4] = v1[0]; v[bj][5] = v1[1]; v[bj][6] = v1[2]; v[bj][7] = v1[3]; }
                if (g) { float ss = 0.f;
#pragma unroll
                    for (int bj = 0; bj < 2; ++bj)
#pragma unroll
                        for (int k = 0; k < 8; ++k) ss += v[bj][k] * v[bj][k];
                    ss += __shfl_xor(ss, 16); ss += __shfl_xor(ss, 32);
                    const float r = rsqrtf(ss * (1.f / 64.f) + eps);
#pragma unroll
                    for (int bj = 0; bj < 2; ++bj)
#pragma unroll
                        for (int k = 0; k < 8; ++k) v[bj][k] *= r * gv[bj][k]; }
#pragma unroll
                for (int bj = 0; bj < 2; ++bj) { u32x4 w; w.x = cvt_pk_bf16(v[bj][0], v[bj][1]); w.y = cvt_pk_bf16(v[bj][2], v[bj][3]); w.z = cvt_pk_bf16(v[bj][4], v[bj][5]); w.w = cvt_pk_bf16(v[bj][6], v[bj][7]);
                    *(u32x4*)(rowp + 32 * bj) = w;
                    if (VT) { const int b = row / seq, s = row % seq; bf16_t* tp = VT + ((size_t)(b * 2 + kh) * 64 + 32 * bj + 8 * fq) * seq + s;
                        tp[0] = (bf16_t)(w.x & 0xffffu); tp[seq] = (bf16_t)(w.x >> 16); tp[2 * seq] = (bf16_t)(w.y & 0xffffu); tp[3 * seq] = (bf16_t)(w.y >> 16);
                        tp[4 * seq] = (bf16_t)(w.z & 0xffffu); tp[5 * seq] = (bf16_t)(w.z >> 16); tp[6 * seq] = (bf16_t)(w.w & 0xffffu); tp[7 * seq] = (bf16_t)(w.w >> 16); } } }
    }
};
using EpiProj = EpiProjT<0>;

struct EpiGateSig {
    static constexpr bool PERM = true; static constexpr int F8 = 1, F8W = 0x7A7A7A7A, F8A = 0x7F7F7F7F; static constexpr int MIDK = 0;
    unsigned char* GT;
    __device__ __forceinline__ void operator()(const f32x4 (&acc)[2][2][4][2], const Unit& u, int wr, int wc, int fr, int fq) const {
        unsigned char* tp = GT + ((size_t)(u.pm * 8 + u.pn) * 65536) + ((size_t)(wr * 4 + wc) * 64 + fq * 16 + fr) * 8;
#pragma unroll
        for (int ai = 0; ai < 2; ++ai)
#pragma unroll
            for (int m = 0; m < 4; ++m)
#pragma unroll
                for (int bj = 0; bj < 2; ++bj) { const f32x4 v0 = acc[ai][bj][m][0], v1 = acc[ai][bj][m][1];
                    u32x2 w; w.x = cvt4_fp8(sigq(v0[0]), sigq(v0[1]), sigq(v0[2]), sigq(v0[3])); w.y = cvt4_fp8(sigq(v1[0]), sigq(v1[1]), sigq(v1[2]), sigq(v1[3]));
                    *(u32x2*)(tp + (size_t)(((ai * 4 + m) * 2 + bj) * 4096)) = w; }
    }
};

struct EpiProjGate8 {
    static constexpr bool PERM = true; static constexpr int F8 = 1, F8W = 0x7A7A7A7A, F8A = 0x7F7F7F7F; static constexpr int MIDK = 0;
    EpiProjT<1> ep; EpiGateSig eg;
    __device__ __forceinline__ void operator()(const f32x4 (&acc)[2][2][4][2], const Unit& u, int wr, int wc, int fr, int fq) const {
        Unit v = u;
        if (u.pn < 4) { v.pn = u.pn + 4; ep(acc, v, wr, wc, fr, fq); } else { v.pn = u.pn - 4; eg(acc, v, wr, wc, fr, fq); }
    }
};

struct EpiGate2 {
    static constexpr bool PERM = true; static constexpr int F8 = 1, F8W = 0x7A7A7A7A, F8A = 0x7B7B7B7B; static constexpr int MIDK = 4;
    unsigned char* O; int ldc; const unsigned char* GT;
    __device__ __forceinline__ void mid(f32x4 (&acc)[2][2][4][2], const Unit& u, int wr, int wc, int fr, int fq) const {
        asm volatile("" : "+v"(fr), "+v"(fq));
        const unsigned char* ta = GT + ((size_t)(u.pm * 8 + u.pn) * 65536) + ((size_t)(wr * 4 + wc) * 64 + fq * 16 + fr) * 8; const unsigned char* tb = ta + 4 * 65536;
        u32x2 ga[3][2], gb[3][2];
#define EG2_LOAD(slot, g) { _Pragma("unroll") for (int bj = 0; bj < 2; ++bj) { const int so = ((g) * 2 + bj) * 4096; ga[slot][bj] = *(const u32x2*)(ta + so); gb[slot][bj] = *(const u32x2*)(tb + so); } }
        EG2_LOAD(0, 0) EG2_LOAD(1, 1)
#pragma unroll
        for (int g = 0; g < 8; ++g) { const int ai = g >> 2, m = g & 3;
            if (g + 2 < 8) EG2_LOAD((g + 2) % 3, g + 2)
#pragma unroll
            for (int bj = 0; bj < 2; ++bj) { float fa[8], fb[8], r[8]; unpack8_fp8(ga[g % 3][bj], fa); unpack8_fp8(gb[g % 3][bj], fb);
#pragma unroll
                for (int e = 0; e < 8; ++e) r[e] = fa[e] / fmaxf(fb[e], 1e-30f);
#pragma unroll
                for (int e = 0; e < 4; ++e) { acc[ai][bj][m][0][e] *= r[e]; acc[ai][bj][m][1][e] *= r[4 + e]; } }
            asm volatile("" ::: "memory"); }
#undef EG2_LOAD
    }
    __device__ __forceinline__ void operator()(const f32x4 (&acc)[2][2][4][2], const Unit& u, int wr, int wc, int fr, int fq) const {
        const int row0 = u.pm * BM + wr * 64 + fr, col0 = u.pn * BM + wc * 32 + 8 * fq;
        const unsigned char* tb = GT + ((size_t)(u.pm * 8 + u.pn + 4) * 65536) + ((size_t)(wr * 4 + wc) * 64 + fq * 16 + fr) * 8;
#pragma unroll
        for (int ai = 0; ai < 2; ++ai)
#pragma unroll
            for (int m = 0; m < 4; ++m) { const size_t row = (size_t)(row0 + ai * HALF + m * 16); unsigned char* rowp = O + row * ldc + col0;
#pragma unroll
                for (int bj = 0; bj < 2; ++bj) { const f32x4 v0 = acc[ai][bj][m][0] * 16.f, v1 = acc[ai][bj][m][1] * 16.f;
                    float gg[8]; unpack8_fp8(*(const u32x2*)(tb + ((ai * 4 + m) * 2 + bj) * 4096), gg);
                    u32x2 w; w.x = cvt4_fp8c(v0[0] * gg[0], v0[1] * gg[1], v0[2] * gg[2], v0[3] * gg[3]);
                    w.y = cvt4_fp8c(v1[0] * gg[4], v1[1] * gg[5], v1[2] * gg[6], v1[3] * gg[7]);
                    *(u32x2*)(rowp + bj * HALF) = w; } }
    }
};
struct EpiRelu2 {
    static constexpr bool PERM = true; static constexpr int F8 = 1, F8W = 0x79797979, F8A = 0x7F7F7F7F; static constexpr int MIDK = 0;
    unsigned char* O; int ldc; const float* parts; float eps; float inv_n;
    __device__ __forceinline__ void operator()(const f32x4 (&acc)[2][2][4][2], const Unit& u, int wr, int wc, int fr, int fq) const {
        const int row0 = u.pm * BM + wr * 64 + fr, col0 = u.pn * BM + wc * 32 + 8 * fq;
#pragma unroll
        for (int ai = 0; ai < 2; ++ai)
#pragma unroll
            for (int m = 0; m < 4; ++m) { const size_t row = (size_t)(row0 + ai * HALF + m * 16); unsigned char* rowp = O + row * ldc + col0;
                const f32x4* pp = (const f32x4*)(parts + row * 16); const f32x4 p0 = pp[0], p1 = pp[1], p2 = pp[2], p3 = pp[3];
                const float ss = ((p0[0] + p0[1]) + (p0[2] + p0[3])) + ((p1[0] + p1[1]) + (p1[2] + p1[3])) + ((p2[0] + p2[1]) + (p2[2] + p2[3])) + ((p3[0] + p3[1]) + (p3[2] + p3[3]));
                const float rs = rsqrtf(ss * inv_n + eps) * 2.8284271247461903f;
#pragma unroll
                for (int bj = 0; bj < 2; ++bj) { const f32x4 v0 = acc[ai][bj][m][0], v1 = acc[ai][bj][m][1];
                    float o[8] = {v0[0], v0[1], v0[2], v0[3], v1[0], v1[1], v1[2], v1[3]};
#pragma unroll
                    for (int e = 0; e < 8; ++e) { const float t = fmaxf(o[e], 0.f) * rs; o[e] = fminf(t * t, 448.f); }
                    u32x2 w; w.x = cvt4_fp8(o[0], o[1], o[2], o[3]); w.y = cvt4_fp8(o[4], o[5], o[6], o[7]);
                    *(u32x2*)(rowp + bj * HALF) = w; } }
    }
};
struct EpiOutRes {
    static constexpr bool PERM = false; static constexpr int F8 = 1, F8W = 0x7A7A7A7A, F8A = 0x7B7B7B7B; static constexpr int MIDK = 0;
    const float* base; float* out; bf16_t* xb; int ldc; float* parts; unsigned char* x8;
    __device__ __forceinline__ void operator()(const f32x4 (&acc)[2][2][4][2], const Unit& u, int wr, int wc, int fr, int fq) const {
        const int col0 = u.pn * BM + wc * 32 + 4 * fq;
#pragma unroll
        for (int ai = 0; ai < 2; ++ai)
#pragma unroll
            for (int m = 0; m < 4; ++m) { const int r = u.pm * BM + ai * HALF + wr * 64 + m * 16 + fr; const size_t off = (size_t)r * ldc + col0; float ss = 0.f;
#pragma unroll
                for (int bj = 0; bj < 2; ++bj)
#pragma unroll
                    for (int n = 0; n < 2; ++n) { const f32x4 bs = *(const f32x4*)(base + off + bj * HALF + n * 16); const f32x4 o = bs + acc[ai][bj][m][n];
                        ss += (o[0] * o[0] + o[1] * o[1]) + (o[2] * o[2] + o[3] * o[3]);
                        u32x2 w; w.x = cvt_pk_bf16(o[0], o[1]); w.y = cvt_pk_bf16(o[2], o[3]); *(u32x2*)(xb + off + bj * HALF + n * 16) = w;
                        *(unsigned*)(x8 + off + bj * HALF + n * 16) = cvt4_fp8c(o[0], o[1], o[2], o[3]); }
                ss += __shfl_xor(ss, 16); ss += __shfl_xor(ss, 32);
                if (fq == 0) parts[(size_t)r * 16 + u.pn * 4 + wc] = ss; }
    }
};
struct EpiFinal {
    static constexpr bool PERM = false; static constexpr int F8 = 1, F8W = 0x78787878, F8A = 0x7C7C7C7C; static constexpr int MIDK = 0;
    float* out; const bf16_t* xb; int ldc;
    __device__ __forceinline__ void operator()(const f32x4 (&acc)[2][2][4][2], const Unit& u, int wr, int wc, int fr, int fq) const {
        const int col0 = u.pn * BM + wc * 32 + 4 * fq;
#pragma unroll
        for (int ai = 0; ai < 2; ++ai)
#pragma unroll
            for (int m = 0; m < 4; ++m) { const int r = u.pm * BM + ai * HALF + wr * 64 + m * 16 + fr; const size_t off = (size_t)r * ldc + col0;
#pragma unroll
                for (int bj = 0; bj < 2; ++bj)
#pragma unroll
                    for (int n = 0; n < 2; ++n) { const u32x2 w = *(const u32x2*)(xb + off + bj * HALF + n * 16); const f32x4 a = acc[ai][bj][m][n];
                        f32x4 o; o[0] = bflo(w.x) + a[0]; o[1] = bfhi(w.x) + a[1]; o[2] = bflo(w.y) + a[2]; o[3] = bfhi(w.y) + a[3];
                        *(f32x4*)(out + off + bj * HALF + n * 16) = o; } }
    }
};

template <class Epi, class Sched, bool ALIGN_EPI = false>
__device__ __forceinline__ void gemm_phase(PG8_LAS unsigned char* lds, const Gemm g, const Sched& S, const Epi& E) {
    int tid_ = threadIdx.x; asm volatile("" : "+v"(tid_));
    const int tid = tid_, wid = __builtin_amdgcn_readfirstlane(tid >> 6), lane = tid & 63, wr = wid >> 2, wc = wid & 3, fr = lane & 15, fq = lane >> 4;
    int K_ = g.K; asm volatile("" : "+s"(K_));
    const int K = K_, nt = K / BK;
    unsigned voffA[2], voffB[2];
#pragma unroll
    for (int i = 0; i < 2; ++i) { int R, C; stage_rc(tid * 16 + i * 8192, R, C); const int Rb = Epi::PERM ? ((R & ~31) + perm32(R & 31)) : R;
        voffA[i] = (unsigned)(R * g.lda + C) * 2u; voffB[i] = (unsigned)(Rb * K + C) * 2u; }
    const size_t kstep = (size_t)(BK * 2);
    const size_t hstepA = (size_t)HALF * g.lda * 2, hstepB = (size_t)HALF * K * 2;
    const size_t tstepA = 2 * hstepA, tstepB = 2 * hstepB;
    const unsigned ldsw = (unsigned)wid * 1024u;
    const int aoff = lds_byte(wr * 64 + fr, fq * 8), boff = lds_byte(wc * 32 + fr, fq * 8);
#define PG8_SA(b, h) (((b) * 2 + (h)) * HTB)
#define PG8_SB(b, h) ((4 + (b) * 2 + (h)) * HTB)
#define PG8_STAGE(bufoff, gbase, voff) do { _Pragma("unroll") for (int _i = 0; _i < 2; ++_i) \
        __builtin_amdgcn_global_load_lds((const unsigned*)((const char*)(gbase) + (voff)[_i]), (PG8_LAS unsigned*)(lds + (bufoff) + ldsw + _i * 8192), 16, 0, 0); } while (0)
#define PG8_LDA(dst, b, h) do { _Pragma("unroll") for (int m = 0; m < 4; ++m) _Pragma("unroll") for (int k = 0; k < 2; ++k) dst[m][k] = *(const PG8_LAS bf16x8*)(lds + PG8_SA(b, h) + aoff + m * 2048 + k * 1024); } while (0)
#define PG8_LDB(dst, b, h) do { _Pragma("unroll") for (int n = 0; n < 2; ++n) _Pragma("unroll") for (int k = 0; k < 2; ++k) dst[n][k] = *(const PG8_LAS bf16x8*)(lds + PG8_SB(b, h) + boff + n * 2048 + k * 1024); } while (0)
#define PG8_CAT(x) __builtin_bit_cast(i32x8, __builtin_shufflevector((x)[0], (x)[1], 0, 1, 2, 3, 4, 5, 6, 7, 8, 9, 10, 11, 12, 13, 14, 15))
#define PG8_MMA(ai, bj, At, Bt) do { __builtin_amdgcn_s_setprio(1); _Pragma("unroll") for (int m = 0; m < 4; ++m) _Pragma("unroll") for (int n = 0; n < 2; ++n) { \
        if constexpr (Epi::F8 != 0) asm volatile("v_mfma_scale_f32_16x16x128_f8f6f4 %0, %1, %2, %0, %3, %4 op_sel_hi:[0,0,0]" : "+v"(acc[ai][bj][m][n]) : "v"(PG8_CAT(Bt[n])), "v"(PG8_CAT(At[m])), "v"(f8w), "v"(f8a)); \
        else { _Pragma("unroll") for (int k = 0; k < 2; ++k) acc[ai][bj][m][n] = __builtin_amdgcn_mfma_f32_16x16x32_bf16(Bt[n][k], At[m][k], acc[ai][bj][m][n], 0, 0, 0); } } \
        __builtin_amdgcn_s_setprio(0); } while (0)
#define PG8_WAIT_V(n) asm volatile("s_waitcnt vmcnt(" #n ")" ::: "memory")
#define PG8_WAIT_L(n) asm volatile("s_waitcnt lgkmcnt(" #n ")" ::: "memory")
#define PG8_BAR __builtin_amdgcn_s_barrier()
#define PG8_SCHED __builtin_amdgcn_sched_barrier(0)
    Unit cur, nxt; int ui = 0;
    if (!S.next(0, cur)) return;
    int f8w = Epi::F8W, f8a = Epi::F8A; asm volatile("" : "+v"(f8w), "+v"(f8a));
    f32x4 acc[2][2][4][2];
#pragma unroll
    for (int a = 0; a < 2; ++a)
#pragma unroll
        for (int b = 0; b < 2; ++b)
#pragma unroll
            for (int m = 0; m < 4; ++m)
#pragma unroll
                for (int n = 0; n < 2; ++n) acc[a][b][m][n] = (f32x4){0.f, 0.f, 0.f, 0.f};
    bf16x8 At[4][2], B0[2][2], B1[2][2];
    const char* cA = (const char*)g.A + (size_t)cur.pm * tstepA; const char* cB = (const char*)g.Bt + (size_t)cur.pn * tstepB;
    PG8_STAGE(PG8_SB(0, 0), cB, voffB); PG8_STAGE(PG8_SB(0, 1), cB + hstepB, voffB); PG8_STAGE(PG8_SA(0, 0), cA, voffA); PG8_STAGE(PG8_SA(0, 1), cA + hstepA, voffA);
    if (wr == 1) PG8_BAR;
    PG8_WAIT_V(2); PG8_BAR;
    PG8_STAGE(PG8_SB(1, 0), cB + kstep, voffB); PG8_STAGE(PG8_SA(1, 0), cA + kstep, voffA); PG8_STAGE(PG8_SB(1, 1), cB + hstepB + kstep, voffB);
    PG8_WAIT_V(6); PG8_BAR;
    for (;;) {
        const bool has_next = S.next(ui + 1, nxt);
        const char* nA = has_next ? (const char*)g.A + (size_t)nxt.pm * tstepA : cA; const char* nB = has_next ? (const char*)g.Bt + (size_t)nxt.pn * tstepB : cB;
#pragma unroll 1
        for (int t = 0; t < nt; t += 2) {
            const bool last = (t == nt - 2);
            const char* a1 = cA + (size_t)(t + 1) * kstep;
            const char* a2 = last ? nA : cA + (size_t)(t + 2) * kstep; const char* b2 = last ? nB : cB + (size_t)(t + 2) * kstep;
            const char* a3 = a2 + kstep; const char* b3 = b2 + kstep;
            PG8_LDB(B0, 0, 0); PG8_LDB(B1, 0, 1); PG8_SCHED; PG8_LDA(At, 0, 0); PG8_STAGE(PG8_SA(1, 1), a1 + hstepA, voffA);
            PG8_WAIT_V(8); PG8_WAIT_L(0); PG8_BAR; PG8_MMA(0, 0, At, B0); PG8_MMA(0, 1, At, B1); PG8_BAR; PG8_SCHED;
            PG8_LDA(At, 0, 1); PG8_STAGE(PG8_SB(0, 0), b2, voffB); PG8_STAGE(PG8_SB(0, 1), b2 + hstepB, voffB); PG8_STAGE(PG8_SA(0, 0), a2, voffA);
            PG8_WAIT_V(8); PG8_WAIT_L(0); PG8_BAR; PG8_MMA(1, 0, At, B0); PG8_MMA(1, 1, At, B1); PG8_BAR; PG8_SCHED;
            PG8_LDB(B0, 1, 0); PG8_LDB(B1, 1, 1); PG8_SCHED; PG8_LDA(At, 1, 0); PG8_STAGE(PG8_SA(0, 1), a2 + hstepA, voffA);
            PG8_WAIT_V(8); PG8_WAIT_L(0); PG8_BAR; PG8_MMA(0, 0, At, B0); PG8_MMA(0, 1, At, B1); PG8_BAR; PG8_SCHED;
            PG8_LDA(At, 1, 1); PG8_STAGE(PG8_SB(1, 0), b3, voffB); PG8_STAGE(PG8_SB(1, 1), b3 + hstepB, voffB); PG8_STAGE(PG8_SA(1, 0), a3, voffA);
            PG8_WAIT_V(8); PG8_WAIT_L(0); PG8_BAR; PG8_MMA(1, 0, At, B0); PG8_MMA(1, 1, At, B1); PG8_BAR; PG8_SCHED;
            if constexpr (Epi::MIDK != 0) { if (t + 2 == Epi::MIDK) { if (wr == 0) PG8_BAR; if constexpr (Epi::F8 != 0) asm volatile("s_nop 15\n\ts_nop 7" ::: "memory"); E.mid(acc, cur, wr, wc, fr, fq); if constexpr (Epi::F8 != 0) asm volatile("s_nop 7" ::: "memory"); if (wr == 1) PG8_BAR; } }
        }
        if constexpr (ALIGN_EPI) { if (wr == 0) PG8_BAR; }
        if constexpr (Epi::F8 != 0) asm volatile("s_nop 15\n\ts_nop 7" ::: "memory");
        E(acc, cur, wr, wc, fr, fq);
        if (!has_next) break;
#pragma unroll
        for (int a = 0; a < 2; ++a)
#pragma unroll
            for (int b = 0; b < 2; ++b)
#pragma unroll
                for (int m = 0; m < 4; ++m)
#pragma unroll
                    for (int n = 0; n < 2; ++n) acc[a][b][m][n] = (f32x4){0.f, 0.f, 0.f, 0.f};
        cur = nxt; cA = nA; cB = nB; ++ui;
        if constexpr (ALIGN_EPI) { if (wr == 1) PG8_BAR; }
    }
    PG8_WAIT_V(0);
    if constexpr (!ALIGN_EPI) { if (wr == 0) PG8_BAR; }
    PG8_BAR;
#undef PG8_SA
#undef PG8_SB
#undef PG8_STAGE
#undef PG8_LDA
#undef PG8_LDB
#undef PG8_MMA
#undef PG8_CAT
#undef PG8_WAIT_V
#undef PG8_WAIT_L
#undef PG8_BAR
#undef PG8_SCHED
}
}

#ifndef PROBE_P3
#define PROBE_P3 1
#endif
#define PROBE_P0 1
#define PROBE_BAR 0
#ifndef PROBE_SPAN
#define PROBE_SPAN 0
#endif
#define PROBE_DPRE 1
#define PROBE_DIDX 1
#define PROBE_DTHR 1
#define PROBE_DATT 1
#define PROBE_NSA 1
#define PROBE_P1 1
#define PROBE_P2 1
#define PROBE_P4 1
#define PROBE_P5 1
#define PROBE_P6 1
constexpr int NWAVES = 8;
constexpr int BATCH = 8, SEQ = 2048, DM = 1024, M = BATCH * SEQ, FF = 4096;
constexpr int NPROJ = 4352;
constexpr int PITCH = 2304;
constexpr int C_QI = 0, C_KI = 256, C_WI = 288, C_GB = 296, C_QB = 320, C_KC = 832, C_QA = 1024, C_CA = 1536, C_VC = 1664, C_KS = 1792, C_VS = 1920, C_KW = 2048, C_VW = 2176, C_GM = 2304;
constexpr int NCMP = 127, TOPK = 256;
constexpr float RMS_EPS = 1e-6f;
constexpr float LOG2E = 1.4426950408889634f;
constexpr float QSCALE = 0.125f * LOG2E;

constexpr size_t MiB = 1u << 20;
constexpr size_t WS_CTL = 0, CTL_ZERO_BYTES = 64 * 1024;
constexpr size_t WS_WIN = 1 * MiB;
constexpr size_t WS_WIN8C = 3 * MiB;
constexpr size_t WS_WIN8T = 6 * MiB;
constexpr size_t WS_WLT = 9 * MiB + 512 * 1024;
constexpr size_t WS_W2T = WS_WLT + 64 * 1024;
constexpr size_t WS_W1T = 31 * MiB;
constexpr size_t WS_WUPA = 10 * MiB, WS_WUPB = 11 * MiB;
constexpr size_t WS_WOUT = 12 * MiB;
constexpr size_t WS_WFF1 = 14 * MiB;
constexpr size_t WS_WFF2 = 22 * MiB;
constexpr size_t WS_PARTS = 30 * MiB;
constexpr size_t WS_PROJ = 32 * MiB;
constexpr size_t WS_GT = 104 * MiB;
constexpr size_t WS_MERGED = 168 * MiB;
constexpr size_t WS_H8 = 184 * MiB;
constexpr size_t WS_X1B = 200 * MiB;
constexpr size_t WS_OUTSCR = 232 * MiB;
constexpr size_t WS_END = 248 * MiB;
constexpr size_t DO_H = 0;
constexpr size_t DO_O = 0;
constexpr size_t DO_KA = 32 * MiB;
constexpr size_t DO_VA = 34 * MiB;
constexpr size_t DO_VAT = 36 * MiB;
constexpr size_t DO_VST = 38 * MiB;
constexpr size_t DO_VWT = 42 * MiB;
constexpr size_t DO_KC = 46 * MiB;
constexpr size_t DO_VC = 47 * MiB;
constexpr size_t DO_VCT = 48 * MiB;

constexpr int CW_BAR = 4096;
constexpr int RING_BYTES = 131072;
constexpr int MISC_OFF = 141312 + 64;
constexpr int LDS_BYTES = 147456;

#define GAS __attribute__((address_space(1)))
#define LAS __attribute__((address_space(3)))
typedef unsigned short bf16;
typedef unsigned v4u __attribute__((ext_vector_type(4)));
typedef float f32x4 __attribute__((ext_vector_type(4)));
#define LDS_WAIT() asm volatile("s_waitcnt lgkmcnt(0)" ::: "memory")
typedef short bf16x8 __attribute__((ext_vector_type(8)));
typedef float f32x16 __attribute__((ext_vector_type(16)));
typedef unsigned long long u64;
typedef u64 u64x2 __attribute__((ext_vector_type(2)));

__device__ __forceinline__ unsigned f2bf(float f) { unsigned u = __builtin_bit_cast(unsigned, f); return (u + 0x7fffu + ((u >> 16) & 1u)) >> 16; }
__device__ __forceinline__ unsigned pk2(float lo, float hi) { return f2bf(lo) | (f2bf(hi) << 16); }
__device__ __forceinline__ float bf2f(bf16 b) { return __uint_as_float((unsigned)b << 16); }
__device__ __forceinline__ void unpack8(const v4u w, float* o) {
    o[0] = __uint_as_float(w.x << 16); o[1] = __uint_as_float(w.x & 0xffff0000u); o[2] = __uint_as_float(w.y << 16); o[3] = __uint_as_float(w.y & 0xffff0000u);
    o[4] = __uint_as_float(w.z << 16); o[5] = __uint_as_float(w.z & 0xffff0000u); o[6] = __uint_as_float(w.w << 16); o[7] = __uint_as_float(w.w & 0xffff0000u);
}
__device__ __forceinline__ float xhalf_max(float v) { auto rr = __builtin_amdgcn_permlane32_swap(__float_as_uint(v), __float_as_uint(v), false, false); return fmaxf(__uint_as_float(rr[0]), __uint_as_float(rr[1])); }
__device__ __forceinline__ float xhalf_sum(float v) { auto rr = __builtin_amdgcn_permlane32_swap(__float_as_uint(v), __float_as_uint(v), false, false); return __uint_as_float(rr[0]) + __uint_as_float(rr[1]); }
typedef float f32x2_t __attribute__((ext_vector_type(2))); typedef __bf16 bf16x2_t __attribute__((ext_vector_type(2)));
__device__ __forceinline__ unsigned cvt2(float lo, float hi) { const f32x2_t v = {lo, hi}; const bf16x2_t b = __builtin_convertvector(v, bf16x2_t); return __builtin_bit_cast(unsigned, b); }
__device__ __forceinline__ float wave_sum(float v) {
#pragma unroll
    for (int o = 1; o < 64; o <<= 1) v += __shfl_xor(v, o);
    return v;
}
__device__ __forceinline__ float wave_max(float v) {
#pragma unroll
    for (int o = 1; o < 64; o <<= 1) v = fmaxf(v, __shfl_xor(v, o));
    return v;
}
__device__ __forceinline__ int wave_sum_i(int v) {
#pragma unroll
    for (int o = 1; o < 64; o <<= 1) v += __shfl_xor(v, o);
    return v;
}

#define XB_TMO      128
#define XB_XCNT(j)  (256  + 64 * (j))
#define XB_XSUB(j)  (1280 + 64 * (j))
#define XB_XGEN(j)  (2304 + 64 * (j))
#define XB_TOP      3328
#define XB_TOPGEN   3392
#define XCD_BAR_WORDS 3456
#define XB_SPIN_CAP (1u << 23)

__device__ __forceinline__ unsigned xb_ld(unsigned* p)              { return __hip_atomic_load(p, __ATOMIC_RELAXED, __HIP_MEMORY_SCOPE_AGENT); }
__device__ __forceinline__ unsigned xb_add(unsigned* p, unsigned v) { return __hip_atomic_fetch_add(p, v, __ATOMIC_RELAXED, __HIP_MEMORY_SCOPE_AGENT); }
__device__ __forceinline__ unsigned xb_xcc_id() { return (unsigned)__builtin_amdgcn_s_getreg((3 << 11) | 20) & 0xFu; }
#define XB_SPIN(cond, bar) do { unsigned _sp = 0; while (cond) { __builtin_amdgcn_s_sleep(1); \
    if ((++_sp & 255u) == 0u) { if (xb_ld(&(bar)[XB_TMO])) break; if (_sp > XB_SPIN_CAP) { atomicAdd(&(bar)[XB_TMO], 1u); break; } } } } while (0)

struct XcdBarrier { unsigned* bar; unsigned x; volatile LAS unsigned* st; };

__device__ __forceinline__ XcdBarrier xcd_barrier_post(unsigned* bar, volatile LAS unsigned* st) {
    XcdBarrier b; b.bar = bar; b.x = xb_xcc_id(); b.st = st;
    if (threadIdx.x == 0) (void)xb_add(&bar[XB_XCNT(b.x)], 1u);
    return b;
}
__device__ __forceinline__ void xcd_barrier_complete(unsigned* bar, unsigned x, unsigned& nloc, unsigned& nx) {
    const unsigned G = gridDim.x * gridDim.y * gridDim.z;
    unsigned sum, cnt, mine, sp = 0u;
    for (;;) {
        sum = 0u; cnt = 0u; mine = 0u;
#pragma unroll
        for (unsigned j = 0; j < 16; ++j) { const unsigned c = xb_ld(&bar[XB_XCNT(j)]); sum += c; cnt += (c > 0u) ? 1u : 0u; mine = (j == x) ? c : mine; }
        if (sum == G) break;
        __builtin_amdgcn_s_sleep(1);
        if ((++sp & 255u) == 0u) { if (xb_ld(&bar[XB_TMO])) break; if (sp > XB_SPIN_CAP) { atomicAdd(&bar[XB_TMO], 1u); break; } }
    }
    nloc = mine > 0u ? mine : 1u; nx = cnt > 0u ? cnt : 1u;
}
__device__ __forceinline__ void xcd_barrier(const XcdBarrier& b) {
    asm volatile("s_waitcnt vmcnt(0)" ::: "memory");
    __syncthreads();
    if (threadIdx.x == 0) {
        unsigned* bar = b.bar;
        __builtin_amdgcn_s_waitcnt(0);
        unsigned nloc = b.st[0], nx = b.st[1];
        if (nloc == 0u) { xcd_barrier_complete(bar, b.x, nloc, nx); b.st[0] = nloc; b.st[1] = nx; }
        const unsigned old = xb_add(&bar[XB_XSUB(b.x)], 1u);
        const unsigned gen = old / nloc;
        if (old + 1u == (gen + 1u) * nloc) {
            __builtin_amdgcn_fence(__ATOMIC_RELEASE, "agent");
            asm volatile("s_waitcnt vmcnt(0)" ::: "memory");
            const unsigned og = xb_add(&bar[XB_TOP], 1u);
            const unsigned tg = og / nx;
            if (og + 1u == (tg + 1u) * nx) xb_add(&bar[XB_TOPGEN], 1u);
            else XB_SPIN(xb_ld(&bar[XB_TOPGEN]) == tg, bar);
            __builtin_amdgcn_fence(__ATOMIC_ACQUIRE, "agent");
            xb_add(&bar[XB_XGEN(b.x)], 1u);
            asm volatile("s_waitcnt vmcnt(0)" ::: "memory");
        } else {
            XB_SPIN(xb_ld(&bar[XB_XGEN(b.x)]) == gen, bar);
            __builtin_amdgcn_fence(__ATOMIC_ACQUIRE, "agent");
            asm volatile("s_waitcnt vmcnt(0)" ::: "memory");
        }
    }
    __syncthreads();
}

__device__ __forceinline__ int proj_src_col(int f) {
    if (f < 256) return 640 + f;
    if (f < 288) return 896 + (f - 256);
    if (f < 296) return 928 + (f - 288);
    if (f < 320) return 2216 + (f - 296);
    if (f < 832) return 936 + (f - 320);
    if (f < 960) return 1448 + (f - 832);
    if (f < 1024) return -1;
    if (f < 1536) return f - 1024;
    if (f < 1664) return 512 + (f - 1536);
    if (f < 1792) return 1576 + (f - 1664);
    if (f < 1920) return 1704 + (f - 1792);
    if (f < 2048) return 1832 + (f - 1920);
    if (f < 2176) return 1960 + (f - 2048);
    return 2088 + (f - 2176);
}
struct Ptrs {
    const float* in[23]; float* out; unsigned char* ws;
};

constexpr int I_IN = (DM / 64) * (1024 / 32), I_INB = (DM / 64) * (1024 / 32), I_IN8 = (DM / 64) * (256 / 32), I_ING = (DM / 64) * (2048 / 32), I_UP = (512 / 64) * (DM / 32), I_OUT = (DM / 64) * (DM / 32), I_F1 = (DM / 64) * (FF / 32), I_F2 = (FF / 64) * (DM / 32);
constexpr int I_LT = 4, I_P1 = (2048 / 64) * (128 / 32), I_P2 = 4;
constexpr int P0_EARLY = I_IN + I_INB + I_IN8 + I_ING + 2 * I_LT + 2 * I_P1 + 2 * I_P2, P0_ALL = P0_EARLY + 2 * I_UP + I_OUT + I_F1 + I_F2;
struct P0Item { const float* W; const float* gk; unsigned char* WT; int N, Ndest, dpitch, koff, r, dnoff; float f8s; bool projmap; };
__device__ __forceinline__ P0Item p0_decode(const Ptrs& P, int it) {
    P0Item d; d.gk = nullptr; d.koff = 0; d.f8s = 0.f; d.projmap = false; d.dnoff = 0; int r = it;
    do {
        if (r < I_IN) { d.W = P.in[2]; d.N = 4288; d.Ndest = 1024; d.WT = P.ws + WS_WIN; d.dpitch = DM; d.projmap = true; break; } r -= I_IN;
        if (r < I_INB) { d.W = P.in[2]; d.N = 4288; d.Ndest = 1024; d.WT = P.ws + WS_WIN8C; d.dpitch = DM; d.projmap = true; d.dnoff = 1024; d.f8s = 32.f; break; } r -= I_INB;
        if (r < I_IN8) { d.W = P.in[2]; d.N = 4288; d.Ndest = 256; d.WT = P.ws + WS_WIN8T; d.dpitch = DM; d.projmap = true; d.dnoff = 2048; d.f8s = 32.f; break; } r -= I_IN8;
        if (r < I_ING) { d.W = P.in[2] + 2240; d.N = 4288; d.Ndest = 2048; d.WT = P.ws + WS_WIN8C + (size_t)1024 * 1024; d.dpitch = DM; d.f8s = 32.f; break; } r -= I_ING;
        if (r < I_LT) { d.W = P.in[6]; d.N = 64; d.Ndest = 64; d.WT = P.ws + WS_WLT; d.dpitch = 128; d.gk = P.in[5]; break; } r -= I_LT;
        if (r < I_LT) { d.W = P.in[7]; d.N = 64; d.Ndest = 64; d.WT = P.ws + WS_WLT + 64 * 128 * 2; d.dpitch = 128; d.gk = P.in[5]; break; } r -= I_LT;
        if (r < I_P1) { d.W = P.in[13]; d.N = 128; d.Ndest = 128; d.WT = P.ws + WS_W1T; d.dpitch = 2048; break; } r -= I_P1;
        if (r < I_P1) { d.W = P.in[15]; d.N = 128; d.Ndest = 128; d.WT = P.ws + WS_W1T + 128 * 2048 * 2; d.dpitch = 2048; break; } r -= I_P1;
        if (r < I_P2) { d.W = P.in[14]; d.N = 64; d.Ndest = 64; d.WT = P.ws + WS_W2T; d.dpitch = 128; break; } r -= I_P2;
        if (r < I_P2) { d.W = P.in[16]; d.N = 64; d.Ndest = 64; d.WT = P.ws + WS_W2T + 64 * 128 * 2; d.dpitch = 128; break; } r -= I_P2;
        if (r < I_UP) { d.W = P.in[17]; d.N = DM; d.Ndest = DM; d.WT = P.ws + WS_WUPA; d.dpitch = DM; d.f8s = 32.f; break; } r -= I_UP;
        if (r < I_UP) { d.W = P.in[18]; d.N = DM; d.Ndest = DM; d.WT = P.ws + WS_WUPA; d.dpitch = DM; d.koff = 512; d.f8s = 32.f; break; } r -= I_UP;
        if (r < I_OUT) { d.W = P.in[19]; d.N = DM; d.Ndest = DM; d.WT = P.ws + WS_WOUT; d.dpitch = DM; d.f8s = 32.f; break; } r -= I_OUT;
        if (r < I_F1) { d.W = P.in[21]; d.N = FF; d.Ndest = FF; d.WT = P.ws + WS_WFF1; d.dpitch = DM; d.gk = P.in[20]; d.f8s = 64.f; break; } r -= I_F1;
        d.W = P.in[22]; d.N = DM; d.Ndest = DM; d.WT = P.ws + WS_WFF2; d.dpitch = FF; d.f8s = 128.f;
    } while (0);
    d.r = r; return d;
}
struct P0Regs { float tv[32]; f32x4 g0, g1; };
__device__ __forceinline__ void p0_load(const P0Item& d, int lane, P0Regs& R) {
    const int nblk = d.Ndest / 32, kb = d.r / nblk, nb = d.r % nblk, k0 = 64 * kb, n0 = 32 * nb;
    const int dn = n0 + (lane & 31); const int dg = dn + d.dnoff; const int cl = dg & 255; const int sc = d.projmap ? proj_src_col((dg & ~255) + ((cl >> 5) & 3) * 64 + (cl >> 7) * 32 + (cl & 31)) : dn;
    const float* wp = d.W + (size_t)(k0 + (lane >> 5)) * d.N + (sc >= 0 ? sc : 0);
#pragma unroll
    for (int i = 0; i < 32; ++i) R.tv[i] = wp[(size_t)(2 * i) * d.N];
    if (sc < 0) {
#pragma unroll
        for (int i = 0; i < 32; ++i) R.tv[i] = 0.f; }
    if (d.gk) { const GAS f32x4* gp = (const GAS f32x4*)(d.gk + k0 + 8 * (lane & 7)); R.g0 = gp[0]; R.g1 = gp[1]; } else { R.g0 = (f32x4){1.f, 1.f, 1.f, 1.f}; R.g1 = R.g0; }
}
__device__ __forceinline__ void p0_finish(const P0Item& d, const P0Regs& R, LAS float* scr, int lane) {
    const int nblk = d.Ndest / 32, kb = d.r / nblk, nb = d.r % nblk, k0 = 64 * kb, n0 = 32 * nb;
#pragma unroll
    for (int i = 0; i < 32; ++i) { const int kk = 2 * i + (lane >> 5); scr[kk * 33 + (lane & 31)] = R.tv[i]; }
    LDS_WAIT();
    const int c = lane & 7; const float f = d.f8s != 0.f ? d.f8s : 1.f;
    const float m0 = R.g0[0] * f, m1 = R.g0[1] * f, m2 = R.g0[2] * f, m3 = R.g0[3] * f, m4 = R.g1[0] * f, m5 = R.g1[1] * f, m6 = R.g1[2] * f, m7 = R.g1[3] * f;
#pragma unroll
    for (int j = 0; j < 4; ++j) { const int n = (lane >> 3) + 8 * j; const LAS float* s = scr + (8 * c) * 33 + n;
        const float v0 = s[0 * 33] * m0, v1 = s[1 * 33] * m1, v2 = s[2 * 33] * m2, v3 = s[3 * 33] * m3, v4 = s[4 * 33] * m4, v5 = s[5 * 33] * m5, v6 = s[6 * 33] * m6, v7 = s[7 * 33] * m7;
        const size_t eo = (size_t)(n0 + n) * d.dpitch + d.koff + k0 + 8 * c;
        if (d.f8s != 0.f) { pg8::u32x2 o; o.x = pg8::cvt4_fp8(v0, v1, v2, v3); o.y = pg8::cvt4_fp8(v4, v5, v6, v7); *(GAS pg8::u32x2*)(d.WT + eo) = o; }
        else { v4u o; o.x = pk2(v0, v1); o.y = pk2(v2, v3); o.z = pk2(v4, v5); o.w = pk2(v6, v7); *(GAS v4u*)(d.WT + 2 * eo) = o; } }
    LDS_WAIT();
}
__device__ __forceinline__ void p0_items(const Ptrs& P, LAS unsigned char* lds, int first, int last, int worker, int nworkers, int wave, int lane) {
    LAS float* scr = (LAS float*)(lds + wave * 16384);
    int it = first + worker;
    if (it >= last) return;
    P0Item dA = p0_decode(P, it), dB = dA; P0Regs rA, rB; p0_load(dA, lane, rA);
    for (;;) {
        int nx = it + nworkers; bool more = nx < last;
        if (more) { dB = p0_decode(P, nx); p0_load(dB, lane, rB); }
        p0_finish(dA, rA, scr, lane);
        if (!more) break;
        it = nx; nx = it + nworkers; more = nx < last;
        if (more) { dA = p0_decode(P, nx); p0_load(dA, lane, rA); }
        p0_finish(dB, rB, scr, lane);
        if (!more) break;
        it = nx;
    }
}
__device__ __forceinline__ void p0_prologue(const Ptrs& P, LAS unsigned char* lds, int gw, int NGW, int wave, int lane) {
    bf16* H = (bf16*)((unsigned char*)P.out + DO_H); unsigned char* H8 = P.ws + WS_H8;
    f32x4 va[4], vb[4];
    { const int m = gw, m2 = m + NGW < M ? m + NGW : m;
      const GAS f32x4* xa = (const GAS f32x4*)(P.in[0] + (size_t)m * DM) + lane; const GAS f32x4* xb = (const GAS f32x4*)(P.in[0] + (size_t)m2 * DM) + lane;
#pragma unroll
      for (int j = 0; j < 4; ++j) { va[j] = xa[64 * j]; vb[j] = xb[64 * j]; } }
    p0_items(P, lds, 0, P0_EARLY, gw, NGW, wave, lane);
#define P0_ROWS_LOAD(VA, VB, MM) { const int m_ = (MM), m2_ = m_ + NGW < M ? m_ + NGW : m_; \
        const GAS f32x4* xa_ = (const GAS f32x4*)(P.in[0] + (size_t)m_ * DM) + lane; const GAS f32x4* xb_ = (const GAS f32x4*)(P.in[0] + (size_t)m2_ * DM) + lane; \
        _Pragma("unroll") for (int j = 0; j < 4; ++j) { VA[j] = xa_[64 * j]; VB[j] = xb_[64 * j]; } }
#define P0_ROWS_DO(VA, VB, MM) { const int mr_ = (MM), mr2_ = mr_ + NGW < M ? mr_ + NGW : mr_; \
        const GAS f32x4* gr = (const GAS f32x4*)P.in[1] + lane; float sa = 0.f, sb = 0.f; \
        _Pragma("unroll") for (int j = 0; j < 4; ++j) { sa += (VA[j].x * VA[j].x + VA[j].y * VA[j].y) + (VA[j].z * VA[j].z + VA[j].w * VA[j].w); sb += (VB[j].x * VB[j].x + VB[j].y * VB[j].y) + (VB[j].z * VB[j].z + VB[j].w * VB[j].w); } \
        const float ra = rsqrtf(wave_sum(sa) * (1.f / DM) + RMS_EPS), rb = rsqrtf(wave_sum(sb) * (1.f / DM) + RMS_EPS); \
        GAS unsigned long long* oa = (GAS unsigned long long*)(H + (size_t)mr_ * DM) + lane; GAS unsigned long long* ob = (GAS unsigned long long*)(H + (size_t)mr2_ * DM) + lane; \
        GAS unsigned* qa = (GAS unsigned*)(H8 + (size_t)mr_ * DM) + lane; GAS unsigned* qb = (GAS unsigned*)(H8 + (size_t)mr2_ * DM) + lane; \
        _Pragma("unroll") for (int j = 0; j < 4; ++j) { const f32x4 gg = gr[64 * j]; \
            oa[64 * j] = (unsigned long long)pk2(VA[j].x * ra * gg.x, VA[j].y * ra * gg.y) | ((unsigned long long)pk2(VA[j].z * ra * gg.z, VA[j].w * ra * gg.w) << 32); \
            qa[64 * j] = pg8::cvt4_fp8(VA[j].x * ra * gg.x, VA[j].y * ra * gg.y, VA[j].z * ra * gg.z, VA[j].w * ra * gg.w); \
            if (mr2_ != mr_) { ob[64 * j] = (unsigned long long)pk2(VB[j].x * rb * gg.x, VB[j].y * rb * gg.y) | ((unsigned long long)pk2(VB[j].z * rb * gg.z, VB[j].w * rb * gg.w) << 32); \
                qb[64 * j] = pg8::cvt4_fp8(VB[j].x * rb * gg.x, VB[j].y * rb * gg.y, VB[j].z * rb * gg.z, VB[j].w * rb * gg.w); } } }
    f32x4 na[4], nb[4];
    for (int m = gw; m < M; ) {
        int mn = m + 2 * NGW;
        if (mn < M) P0_ROWS_LOAD(na, nb, mn)
        P0_ROWS_DO(va, vb, m)
        if (mn >= M) break;
        m = mn; mn = m + 2 * NGW;
        if (mn < M) P0_ROWS_LOAD(va, vb, mn)
        P0_ROWS_DO(na, nb, m)
        if (mn >= M) break;
        m = mn;
    }
#undef P0_ROWS_LOAD
#undef P0_ROWS_DO
}

__device__ __forceinline__ float gelu_tanh(float x) { const float u = 0.7978845608028654f * (x + 0.044715f * x * x * x); return 0.5f * x * (1.0f + tanhf(u)); }

__device__ __forceinline__ void latent_group(const Ptrs& P, int grp, int lane) {
    const int r32 = lane & 31, hi = lane >> 5; const int tok = 32 * grp + r32;
    const bf16* PROJ = (const bf16*)(P.ws + WS_PROJ); const bf16* WLT = (const bf16*)(P.ws + WS_WLT);
    unsigned char* dob = (unsigned char*)P.out; bf16* KA = (bf16*)(dob + DO_KA); bf16* VAT = (bf16*)(dob + DO_VAT);
    bf16x8 cb[8]; float ss = 0.f;
    const bf16* cp = PROJ + (size_t)tok * PITCH + C_CA + hi * 8;
#pragma unroll
    for (int ks = 0; ks < 8; ++ks) { const v4u w = *(const GAS v4u*)(cp + ks * 16); cb[ks] = __builtin_bit_cast(bf16x8, w); float f[8]; unpack8(w, f);
#pragma unroll
        for (int j = 0; j < 8; ++j) ss += f[j] * f[j]; }
    ss = xhalf_sum(ss);
    const float rstd = rsqrtf(ss * (1.f / 128.f) + RMS_EPS);
    f32x16 acc[4];
#pragma unroll
    for (int nb = 0; nb < 4; ++nb) {
#pragma unroll
        for (int r = 0; r < 16; ++r) acc[nb][r] = 0.f;
#pragma unroll
        for (int ks = 0; ks < 8; ++ks) { const bf16x8 a = *(const GAS bf16x8*)(WLT + (size_t)(32 * nb + r32) * 128 + ks * 16 + hi * 8); acc[nb] = __builtin_amdgcn_mfma_f32_32x32x16_bf16(a, cb[ks], acc[nb], 0, 0, 0); } }
    float sk = 0.f;
#pragma unroll
    for (int nb = 0; nb < 2; ++nb)
#pragma unroll
        for (int r = 0; r < 16; ++r) { const float v = acc[nb][r] * rstd; sk += v * v; }
    sk = xhalf_sum(sk);
    const float kr = rsqrtf(sk * (1.f / 64.f) + RMS_EPS) * rstd;
    const float* gk = P.in[4];
#pragma unroll
    for (int nb = 0; nb < 2; ++nb)
#pragma unroll
        for (int a = 0; a < 4; ++a) { const int n0 = 32 * nb + 8 * a + 4 * hi; const f32x4 gg = *(const GAS f32x4*)(gk + n0);
            pg8::u32x2 w; w.x = pg8::cvt_pk_bf16(acc[nb][4 * a] * kr * gg[0], acc[nb][4 * a + 1] * kr * gg[1]); w.y = pg8::cvt_pk_bf16(acc[nb][4 * a + 2] * kr * gg[2], acc[nb][4 * a + 3] * kr * gg[3]);
            *(GAS pg8::u32x2*)(KA + (size_t)tok * 64 + n0) = w; }
    const int b = tok / SEQ, s = tok % SEQ;
#pragma unroll
    for (int nb = 2; nb < 4; ++nb)
#pragma unroll
        for (int r = 0; r < 16; ++r) { const int d = 32 * (nb - 2) + (r & 3) + 8 * (r >> 2) + 4 * hi; VAT[((size_t)b * 64 + d) * SEQ + s] = (bf16)f2bf(acc[nb][r] * rstd); }
}
__device__ __forceinline__ void compress_unit(const Ptrs& P, LAS unsigned char* lds, int unit, int tid, int wave, int lane) {
    const int cbk = unit & 3, kh = (unit >> 2) & 1, b = (unit >> 3) & 7, kv = unit >> 6;
    const int r32 = lane & 31, hi = lane >> 5, nb = wave & 3, kq = wave >> 2;
    const bf16* PROJ = (const bf16*)(P.ws + WS_PROJ);
    const bf16* W1T = (const bf16*)(P.ws + WS_W1T) + (size_t)kv * 128 * 2048; const bf16* W2T = (const bf16*)(P.ws + WS_W2T) + (size_t)kv * 64 * 128;
    unsigned char* dob = (unsigned char*)P.out; bf16* KC = (bf16*)(dob + DO_KC); bf16* VCT = (bf16*)(dob + DO_VCT);
    const bf16* src = PROJ + (size_t)(b * SEQ) * PITCH + (kv ? C_VC : C_KC) + kh * 64;
    const float* pe = P.in[12];
    const int c = 32 * cbk + r32;
    LAS float* red = (LAS float*)lds;
    LAS float* peL = (LAS float*)(lds + 32768);
    for (int i = tid; i < 2048; i += NWAVES * 64) peL[i] = pe[i];
    __syncthreads();
    LAS unsigned char* hidL = lds + 16384;
    f32x16 acc;
#pragma unroll
    for (int r = 0; r < 16; ++r) acc[r] = 0.f;
    const bf16* w1p = W1T + (size_t)(32 * nb + r32) * 2048 + hi * 8;
#pragma unroll 8
    for (int ks = 64 * kq; ks < 64 * kq + 64; ++ks) {
        const int l = ks >> 2, d = 16 * (ks & 3) + 8 * hi; int tokn = 16 * c + l; tokn = tokn > SEQ - 1 ? SEQ - 1 : tokn;
        const v4u raw = *(const GAS v4u*)(src + (size_t)tokn * PITCH + d); float a8[8]; unpack8(raw, a8);
        const f32x4 p0 = *(LAS const f32x4*)(peL + l * 64 + d), p1 = *(LAS const f32x4*)(peL + l * 64 + d + 4);
        pg8::u32x4 aw; aw.x = cvt2(a8[0] + p0[0], a8[1] + p0[1]); aw.y = cvt2(a8[2] + p0[2], a8[3] + p0[3]); aw.z = cvt2(a8[4] + p1[0], a8[5] + p1[1]); aw.w = cvt2(a8[6] + p1[2], a8[7] + p1[3]);
        const bf16x8 bw = *(const GAS bf16x8*)(w1p + ks * 16);
        acc = __builtin_amdgcn_mfma_f32_32x32x16_bf16(__builtin_bit_cast(bf16x8, aw), bw, acc, 0, 0, 0);
    }
    if (kq == 1) {
#pragma unroll
        for (int r = 0; r < 16; ++r) red[(nb * 16 + r) * 64 + lane] = acc[r]; }
    __syncthreads();
    if (kq == 0) {
#pragma unroll
        for (int r = 0; r < 16; ++r) { const float h = gelu_tanh(acc[r] + red[(nb * 16 + r) * 64 + lane]); const int cr = (r & 3) + 8 * (r >> 2) + 4 * hi;
            *(LAS bf16*)(hidL + cr * 272 + (32 * nb + r32) * 2) = (bf16)f2bf(h); } }
    __syncthreads();
    if (wave == 0) {
        f32x16 o2[2];
#pragma unroll
        for (int db = 0; db < 2; ++db) {
#pragma unroll
            for (int r = 0; r < 16; ++r) o2[db][r] = 0.f;
#pragma unroll
            for (int ks = 0; ks < 8; ++ks) { const bf16x8 a = *(const GAS bf16x8*)(W2T + (size_t)(32 * db + r32) * 128 + ks * 16 + hi * 8);
                const bf16x8 hb = *(LAS const bf16x8*)(hidL + r32 * 272 + (ks * 16 + hi * 8) * 2);
                o2[db] = __builtin_amdgcn_mfma_f32_32x32x16_bf16(a, hb, o2[db], 0, 0, 0); } }
        const size_t bk = (size_t)(b * 2 + kh);
        if (kv == 0) {
            float sk = 0.f;
#pragma unroll
            for (int db = 0; db < 2; ++db)
#pragma unroll
                for (int r = 0; r < 16; ++r) sk += o2[db][r] * o2[db][r];
            sk = xhalf_sum(sk);
            const float kr = (c < NCMP) ? rsqrtf(sk * (1.f / 64.f) + RMS_EPS) : 0.f;
            const float* gkc = P.in[9];
#pragma unroll
            for (int db = 0; db < 2; ++db)
#pragma unroll
                for (int a = 0; a < 4; ++a) { const int d0 = 32 * db + 8 * a + 4 * hi; const f32x4 gg = *(const GAS f32x4*)(gkc + d0);
                    pg8::u32x2 w; w.x = pg8::cvt_pk_bf16(o2[db][4 * a] * kr * gg[0], o2[db][4 * a + 1] * kr * gg[1]); w.y = pg8::cvt_pk_bf16(o2[db][4 * a + 2] * kr * gg[2], o2[db][4 * a + 3] * kr * gg[3]);
                    *(GAS pg8::u32x2*)(KC + (bk * 128 + c) * 64 + d0) = w; }
        } else {
            const float z = (c < NCMP) ? 1.f : 0.f;
#pragma unroll
            for (int db = 0; db < 2; ++db)
#pragma unroll
                for (int r = 0; r < 16; ++r) { const int d = 32 * db + (r & 3) + 8 * (r >> 2) + 4 * hi; VCT[(bk * 64 + d) * 128 + c] = (bf16)f2bf(o2[db][r] * z); }
        }
    }
    __syncthreads();
}
__device__ __forceinline__ void p2_fast(const Ptrs& P, LAS unsigned char* lds, int vcu, int G, int tid, int wave, int lane) {
    for (int u = vcu; u < 128; u += G) compress_unit(P, lds, u, tid, wave, lane);
    for (int grp = G * NWAVES - 1 - (vcu * NWAVES + wave); grp < M / 32; grp += G * NWAVES) latent_group(P, grp, lane);
}

__device__ __forceinline__ unsigned ord_u32(float f) { const unsigned u = __float_as_uint(f); return (u & 0x80000000u) ? ~u : (u | 0x80000000u); }

__device__ __forceinline__ float inv_ord_u32(unsigned u) { return __uint_as_float((u & 0x80000000u) ? (u ^ 0x80000000u) : ~u); }
template <int CTRL> __device__ __forceinline__ unsigned dpp_mov(unsigned x) { return (unsigned)__builtin_amdgcn_update_dpp(0, (int)x, CTRL, 0xf, 0xf, true); }
__device__ __forceinline__ unsigned wave_umax(unsigned x) {
    unsigned y = dpp_mov<0xB1>(x); x = x > y ? x : y; y = dpp_mov<0x4E>(x); x = x > y ? x : y; y = dpp_mov<0x141>(x); x = x > y ? x : y; y = dpp_mov<0x140>(x); x = x > y ? x : y;
    const unsigned a = __builtin_amdgcn_readlane(x, 0), b = __builtin_amdgcn_readlane(x, 16), c = __builtin_amdgcn_readlane(x, 32), d = __builtin_amdgcn_readlane(x, 48);
    const unsigned ab = a > b ? a : b, cd = c > d ? c : d; return ab > cd ? ab : cd;
}
__device__ __forceinline__ unsigned wave_umin(unsigned x) {
    unsigned y = dpp_mov<0xB1>(x); x = x < y ? x : y; y = dpp_mov<0x4E>(x); x = x < y ? x : y; y = dpp_mov<0x141>(x); x = x < y ? x : y; y = dpp_mov<0x140>(x); x = x < y ? x : y;
    const unsigned a = __builtin_amdgcn_readlane(x, 0), b = __builtin_amdgcn_readlane(x, 16), c = __builtin_amdgcn_readlane(x, 32), d = __builtin_amdgcn_readlane(x, 48);
    const unsigned ab = a < b ? a : b, cd = c < d ? c : d; return ab < cd ? ab : cd;
}
__device__ __forceinline__ unsigned wave_usum(unsigned x) {
    x += dpp_mov<0xB1>(x); x += dpp_mov<0x4E>(x); x += dpp_mov<0x141>(x); x += dpp_mov<0x140>(x);
    return (__builtin_amdgcn_readlane(x, 0) + __builtin_amdgcn_readlane(x, 16)) + (__builtin_amdgcn_readlane(x, 32) + __builtin_amdgcn_readlane(x, 48));
}

constexpr int KT_STRIDE = 144, VT_STRIDE = 144;
constexpr int KT_BYTES = 64 * KT_STRIDE, VT_BYTES = 64 * VT_STRIDE, TILE_BYTES = KT_BYTES + VT_BYTES;
constexpr int A_TILE0 = 0, A_TILE1 = TILE_BYTES, A_STG = 36864, A_IMP = 69632, A_EFF = 102400, A_SEL = 110592;
constexpr int D_MASK = 131072, A_WSC = 139264;
constexpr int D_KMAX = 143360;
constexpr int D_M8 = 36864, M8_STRIDE = 2064;
constexpr int SROW = 2048;


__device__ __forceinline__ float max3f(float a, float b, float c) { float r; asm("v_max3_f32 %0, %1, %2, %3" : "=v"(r) : "v"(a), "v"(b), "v"(c)); return r; }
struct TileRegs { v4u k, v; };
__device__ __forceinline__ TileRegs tile_fetch(const bf16* Kb, size_t kpitch, const bf16* Vb, size_t vpitch, int tid) {
    const int row = tid >> 3, ch = tid & 7; TileRegs r;
    r.k = *(const GAS v4u*)(Kb + (size_t)row * kpitch + ch * 8);
    r.v = *(const GAS v4u*)(Vb + (size_t)row * vpitch + ch * 8);
    return r;
}
__device__ __forceinline__ void tile_store(LAS unsigned char* buf, const TileRegs& r, int tid) {
    const int row = tid >> 3, ch = tid & 7;
    *(LAS v4u*)(buf + row * KT_STRIDE + ch * 16) = r.k;
    LAS u64* vp = (LAS u64*)(buf + KT_BYTES + row * VT_STRIDE + (ch >> 1) * 32 + (ch & 1) * 8);
    vp[0] = (u64)r.v.x | ((u64)r.v.y << 32); vp[2] = (u64)r.v.z | ((u64)r.v.w << 32);
}
struct AttnState { f32x16 o0, o1, la; pg8::u32x4 qx; float m; bool started; };
struct KxOps { pg8::u32x4 k0, k1; };
__device__ __forceinline__ KxOps kx_ops(int r32, int hi) {
    KxOps k; k.k0 = (pg8::u32x4){0u, 0u, 0u, 0u}; k.k1 = k.k0;
    if (hi == 0) { const unsigned v0 = f2bf((float)r32), v1 = f2bf((float)(r32 + 32)); k.k0.y = v0 * 0x10001u; k.k1.y = v1 * 0x10001u; k.k0.z = k.k0.w = k.k1.z = k.k1.w = 0x3F803F80u; }
    return k;
}
__device__ __forceinline__ void attn_init(AttnState& s, float slope2, int hi) {
#pragma unroll
    for (int r = 0; r < 16; ++r) { s.o0[r] = 0.f; s.o1[r] = 0.f; s.la[r] = 0.f; }
    s.qx = (pg8::u32x4){0u, 0u, 0u, 0u};
    if (hi == 0) { const unsigned sh = f2bf(slope2); const unsigned sl = f2bf(slope2 - __uint_as_float(sh << 16)); s.qx.x = sh | (sl << 16); s.qx.y = s.qx.x; }
    s.m = 0.f; s.started = false;
}
__device__ __forceinline__ void attn_init_fixed(AttnState& s, float slope2, float m0, int hi) {
    attn_init(s, slope2, hi); s.m = m0; s.started = true;
    const float nm = -m0; const unsigned m1 = f2bf(nm); const float r1 = nm - __uint_as_float(m1 << 16); const unsigned m2 = f2bf(r1); const float r2 = r1 - __uint_as_float(m2 << 16); const unsigned m3 = f2bf(r2);
    if (hi == 0) { s.qx.z = m1 | (m2 << 16); s.qx.w = m3; }
}
__device__ __forceinline__ bf16x8 pack8(const f32x16& p, int b0) {
    pg8::u32x4 w; w.x = cvt2(p[b0], p[b0 + 1]); w.y = cvt2(p[b0 + 2], p[b0 + 3]); w.z = cvt2(p[b0 + 4], p[b0 + 5]); w.w = cvt2(p[b0 + 6], p[b0 + 7]);
    return __builtin_bit_cast(bf16x8, w);
}
constexpr float ATT_THR = 8.0f;
struct MaskMM { pg8::i32x8 a0, a1; LAS const unsigned char* row; };
template <bool BITS, bool IMP, bool QLDS, bool FIXM = false>
__device__ __forceinline__ void tile_compute(AttnState& st, const bf16x8 (&qf)[4], LAS const unsigned char* qlds, KxOps& KX, float koff, bool active, bool all_active, LAS const unsigned char* buf, LAS float* wsc,
                                             bool need_mask, int lo, int hi_, unsigned mw0, unsigned mw1, f32x16& oimp, int c0, int r32, int hi, const MaskMM* mm = nullptr) {
    f32x16 p0, p1;
    { const unsigned kw = (hi == 0) ? f2bf(koff) * 0x10001u : 0u; KX.k0.x = kw; KX.k1.x = kw;
      pg8::u32x4 q = st.qx; if (!all_active) q.w = (q.w & 0xffffu) | ((active || hi != 0) ? 0u : 0xff800000u);
#pragma unroll
      for (int r = 0; r < 16; ++r) { p0[r] = 0.f; p1[r] = 0.f; }
      if (BITS) {
          const pg8::i32x8 mb = *(LAS const pg8::i32x8*)(mm->row + mw0);
          p0 = __builtin_amdgcn_mfma_scale_f32_32x32x64_f8f6f4(mm->a0, mb, p0, 0, 0, 0, 0x7F7F7F7F, 0, (int)0x93939393u);
          p1 = __builtin_amdgcn_mfma_scale_f32_32x32x64_f8f6f4(mm->a1, mb, p1, 0, 0, 0, 0x7F7F7F7F, 0, (int)0x93939393u); }
      p0 = __builtin_amdgcn_mfma_f32_32x32x16_bf16(__builtin_bit_cast(bf16x8, KX.k0), __builtin_bit_cast(bf16x8, q), p0, 0, 0, 0);
      p1 = __builtin_amdgcn_mfma_f32_32x32x16_bf16(__builtin_bit_cast(bf16x8, KX.k1), __builtin_bit_cast(bf16x8, q), p1, 0, 0, 0); }
    { LAS const unsigned char* kp = buf + r32 * KT_STRIDE + hi * 16;
#pragma unroll
      for (int ds = 0; ds < 4; ++ds) {
          const bf16x8 k0 = *(LAS const bf16x8*)(kp + ds * 32);
          const bf16x8 k1 = *(LAS const bf16x8*)(kp + 32 * KT_STRIDE + ds * 32);
          const bf16x8 qv = QLDS ? *(LAS const bf16x8*)(qlds + (((2 * ds + hi) ^ (r32 & 7)) * 16)) : qf[ds];
          p0 = __builtin_amdgcn_mfma_f32_32x32x16_bf16(k0, qv, p0, 0, 0, 0);
          p1 = __builtin_amdgcn_mfma_f32_32x32x16_bf16(k1, qv, p1, 0, 0, 0); } }
    if (BITS) { }
    else if (need_mask) { const int lo2 = lo - 4 * hi, hi2 = hi_ - 4 * hi;
#pragma unroll
        for (int r = 0; r < 16; ++r) { const int c = (r & 3) + 8 * (r >> 2); if (c < lo2 || c > hi2) p0[r] = -INFINITY; if (c + 32 < lo2 || c + 32 > hi2) p1[r] = -INFINITY; } }
    if (!FIXM) {
    asm volatile("s_nop 15\n\ts_nop 7" : "+v"(p0), "+v"(p1));
    float rm;
    { float a = max3f(p0[0], p0[1], p1[0]), b = max3f(p0[2], p0[3], p1[1]); a = max3f(a, p1[2], p1[3]);
#pragma unroll
      for (int r = 4; r < 16; r += 4) { a = max3f(a, p0[r], p0[r + 1]); b = max3f(b, p0[r + 2], p0[r + 3]); a = max3f(a, p1[r], p1[r + 1]); b = max3f(b, p1[r + 2], p1[r + 3]); }
      rm = max3f(a, b, b); }
    rm = xhalf_max(rm);
    const bool need = st.started ? (rm > ATT_THR) : (rm > -1e8f);
    if (__any(need)) {
        const float dl = need ? rm : 0.f; const float f = st.started ? __builtin_amdgcn_exp2f(-dl) : 1.0f;
        st.m += dl; st.started = st.started || need;
        { const float nm = -st.m; const unsigned m1 = f2bf(nm); const float r1 = nm - __uint_as_float(m1 << 16); const unsigned m2 = f2bf(r1); const float r2 = r1 - __uint_as_float(m2 << 16); const unsigned m3 = f2bf(r2);
          if (hi == 0) { st.qx.z = m1 | (m2 << 16); st.qx.w = m3; } }
#pragma unroll
        for (int r = 0; r < 16; ++r) { p0[r] -= dl; p1[r] -= dl; }
        if (hi == 0) wsc[r32] = f;
        LDS_WAIT();
#pragma unroll
        for (int a = 0; a < 4; ++a) { const f32x4 av = *(LAS const f32x4*)(wsc + 8 * a + 4 * hi);
#pragma unroll
            for (int i = 0; i < 4; ++i) { st.o0[4 * a + i] *= av[i]; st.o1[4 * a + i] *= av[i]; st.la[4 * a + i] *= av[i]; if (IMP) oimp[4 * a + i] *= av[i]; } }
        LDS_WAIT();
    }
    }
#pragma unroll
    for (int r = 0; r < 16; ++r) { p0[r] = __builtin_amdgcn_exp2f(p0[r]); p1[r] = __builtin_amdgcn_exp2f(p1[r]); }
    bf16x8 pa[4]; pa[0] = pack8(p0, 0); pa[1] = pack8(p0, 8); pa[2] = pack8(p1, 0); pa[3] = pack8(p1, 8);
    { LAS const unsigned char* vp = buf + KT_BYTES + r32 * VT_STRIDE + hi * 16;
#pragma unroll
      for (int s = 0; s < 4; ++s) {
          const v4u x0 = *(LAS const v4u*)(vp + s * 32), x1 = *(LAS const v4u*)(vp + 32 * VT_STRIDE + s * 32);
          st.o0 = __builtin_amdgcn_mfma_f32_32x32x16_bf16(pa[s], __builtin_bit_cast(bf16x8, x0), st.o0, 0, 0, 0);
          st.o1 = __builtin_amdgcn_mfma_f32_32x32x16_bf16(pa[s], __builtin_bit_cast(bf16x8, x1), st.o1, 0, 0, 0);
          st.la = __builtin_amdgcn_mfma_f32_32x32x16_bf16(pa[s], __builtin_bit_cast(bf16x8, (pg8::u32x4){0x3F803F80u, 0x3F803F80u, 0x3F803F80u, 0x3F803F80u}), st.la, 0, 0, 0); } }
    if (IMP) {
#pragma unroll
        for (int s = 0; s < 4; ++s) { bf16x8 ov;
#pragma unroll
            for (int e = 0; e < 8; ++e) { const int c = c0 + 16 * s + 8 * (e >> 2) + 4 * hi + (e & 3); ov[e] = (c >= 4 * r32 - 1 && c <= 4 * r32 + 3) ? (short)0x3F80 : (short)0; }
            oimp = __builtin_amdgcn_mfma_f32_32x32x16_bf16(pa[s], ov, oimp, 0, 0, 0); } }
}
__device__ __forceinline__ void attn_accum(f32x16& out0, f32x16& out1, const AttnState& st, float gate, LAS float* wsc, int r32, int hi) {
    if (hi == 0) wsc[r32] = gate;
    LDS_WAIT();
#pragma unroll
    for (int a = 0; a < 4; ++a) { const f32x4 av = *(LAS const f32x4*)(wsc + 8 * a + 4 * hi);
#pragma unroll
        for (int i = 0; i < 4; ++i) { const float l = st.la[4 * a + i]; const float f = l > 0.f ? av[i] * __builtin_amdgcn_rcpf(l) : 0.f; out0[4 * a + i] += st.o0[4 * a + i] * f; out1[4 * a + i] += st.o1[4 * a + i] * f; } }
    LDS_WAIT();
}
__device__ __forceinline__ void store_tile_fp8(const f32x16& out0, const f32x16& out1, LAS unsigned char* stg, unsigned char* dst, size_t pitch, int lane, int r32, int hi) {
#pragma unroll
    for (int r = 0; r < 16; ++r) { const int q = (r & 3) + 8 * (r >> 2) + 4 * hi;
        const unsigned w = (unsigned)__builtin_amdgcn_cvt_pk_fp8_f32(__builtin_amdgcn_fmed3f(out0[r] * 16.f, -448.f, 448.f), __builtin_amdgcn_fmed3f(out1[r] * 16.f, -448.f, 448.f), 0, false);
        stg[q * 64 + r32] = (unsigned char)(w & 0xffu); stg[q * 64 + 32 + r32] = (unsigned char)((w >> 8) & 0xffu); }
    LDS_WAIT();
#pragma unroll
    for (int i = 0; i < 2; ++i) { const int row = i * 16 + (lane >> 2), ch = lane & 3; const v4u v = *(LAS const v4u*)(stg + row * 64 + ch * 16); *(GAS v4u*)(dst + (size_t)row * pitch + ch * 16) = v; }
    LDS_WAIT();
}


#define TILE_PIPELINE(FIRST, AFTER, FETCH, COMPUTE) do { \
        int jc_ = (FIRST); int jn_ = AFTER(jc_); int jnn_; TileRegs rA_ = FETCH(jc_), rB_; \
        tile_store(buf0, rA_, tid); if (jn_ >= 0) rB_ = FETCH(jn_); \
        __syncthreads(); \
        for (;;) { \
            jnn_ = jn_ >= 0 ? AFTER(jn_) : -1; if (jnn_ >= 0) rA_ = FETCH(jnn_); \
            COMPUTE(jc_, buf0); \
            if (jn_ < 0) break; \
            tile_store(buf1, rB_, tid); __syncthreads(); jc_ = jn_; jn_ = jnn_; \
            jnn_ = jn_ >= 0 ? AFTER(jn_) : -1; if (jnn_ >= 0) rB_ = FETCH(jnn_); \
            COMPUTE(jc_, buf1); \
            if (jn_ < 0) break; \
            tile_store(buf0, rA_, tid); __syncthreads(); jc_ = jn_; jn_ = jnn_; \
        } } while (0)
__device__ __forceinline__ void nsa_unit(const Ptrs& P, LAS unsigned char* lds, int b, int kh, int qb, int tid, int wave, int lane) {
    asm volatile("" : "+v"(tid), "+v"(lane));
    const int r32 = lane & 31, hi = lane >> 5, th = wave >> 2, g = th ? 3 - (wave & 3) : (wave & 3);
    bf16* PROJ = (bf16*)(P.ws + WS_PROJ);
    unsigned char* dob = (unsigned char*)P.out;
    const bf16* KCb = (const bf16*)(dob + DO_KC) + (size_t)(b * 2 + kh) * 128 * 64; const bf16* VCTb = (const bf16*)(dob + DO_VCT) + (size_t)(b * 2 + kh) * 64 * 128;
    const bf16* VSTb = (const bf16*)(dob + DO_VST) + (size_t)(b * 2 + kh) * 64 * SEQ; const bf16* VWTb = (const bf16*)(dob + DO_VWT) + (size_t)(b * 2 + kh) * 64 * SEQ;
    LAS unsigned char* buf0 = lds + A_TILE0; LAS unsigned char* buf1 = lds + A_TILE1;
    LAS float* wsc = (LAS float*)(lds + A_WSC) + wave * 64;
    LAS float* impL = (LAS float*)(lds + A_IMP); LAS float* effL = (LAS float*)(lds + A_EFF); LAS unsigned* selL = (LAS unsigned*)(lds + A_SEL);
    const int tq = 64 * qb + 32 * th + r32;
    const bf16* prow = PROJ + (size_t)(b * SEQ + tq) * PITCH;
    const float slope2 = exp2f(-(float)(kh * 4 + g + 1)) * LOG2E;
    bf16x8 qf[4];
#pragma unroll
    for (int ds = 0; ds < 4; ++ds) qf[ds] = *(const GAS bf16x8*)(prow + C_QB + (kh * 4 + g) * 64 + ds * 16 + hi * 8);
    KxOps KX = kx_ops(r32, hi);
    float qkb;
    { const float gq = fabsf(P.in[8][lane]); const float gk = fmaxf(fmaxf(fabsf(P.in[9][lane]), fabsf(P.in[10][lane])), fabsf(P.in[11][lane]));
      qkb = 64.0f * QSCALE * 1.02f * __uint_as_float(wave_umax(__float_as_uint(gq))) * __uint_as_float(wave_umax(__float_as_uint(gk))) + 0.25f; }
    const float cutthr = 2.0f * qkb + 40.0f;
    const int jcut = qb - (int)ceilf((cutthr / slope2 + (float)(63 - 32 * th)) * (1.0f / 64.0f));
    const int jdrop = qb - (int)ceilf((cutthr / (exp2f(-(float)(kh * 4 + 4)) * LOG2E) + 63.0f) * (1.0f / 64.0f));
    LAS unsigned char* qlds = lds + A_STG + wave * 4096 + r32 * 128;
#pragma unroll
    for (int ds = 0; ds < 4; ++ds) *(LAS bf16x8*)(qlds + (((2 * ds + hi) ^ (r32 & 7)) * 16)) = qf[ds];
#define NSA_GATE(i) pg8::sigm(bf2f(PROJ[(size_t)(b * SEQ + tq) * PITCH + C_GB + (kh * 4 + g) * 3 + (i)]))
    f32x16 oimp;
#pragma unroll
    for (int r = 0; r < 16; ++r) oimp[r] = 0.f;
    float* slab = (float*)(P.ws + WS_OUTSCR) + ((size_t)blockIdx.x * NWAVES + wave) * 2048;
    AttnState st;
    {
        TileRegs tr = tile_fetch(KCb, 64, VCTb, 128, tid); tile_store(buf0, tr, tid);
        tr = tile_fetch(KCb + 64 * 64, 64, VCTb + 64, 128, tid); tile_store(buf1, tr, tid);
        if (tid < 64) selL[tid] = 0u;
        __syncthreads();
        attn_init_fixed(st, 0.f, qkb, hi);
        const int hc = (tq - 31) >> 4;
#pragma unroll 1
        for (int ct = 0; ct < 2; ++ct) { tile_compute<false, true, true, true>(st, qf, qlds, KX, 0.f, true, true, ct ? buf1 : buf0, wsc, true, -(1 << 20), hc - 64 * ct, 0u, 0u, oimp, 64 * ct, r32, hi); __builtin_amdgcn_sched_barrier(0); }
        { f32x16 o0, o1;
#pragma unroll
          for (int r = 0; r < 16; ++r) { o0[r] = 0.f; o1[r] = 0.f; }
          attn_accum(o0, o1, st, NSA_GATE(0), wsc, r32, hi);
#pragma unroll
          for (int r = 0; r < 16; ++r) { slab[r * 64 + lane] = o0[r]; slab[(16 + r) * 64 + lane] = o1[r]; } }
#pragma unroll
        for (int a = 0; a < 4; ++a)
#pragma unroll
            for (int i = 0; i < 4; ++i) { const int q = 8 * a + 4 * hi + i; const float l = st.la[4 * a + i]; impL[(wave * 32 + q) * 32 + r32] = l > 0.f ? oimp[4 * a + i] * __builtin_amdgcn_rcpf(l) : 0.f; }
        LDS_WAIT();
        __syncthreads();
        const int tk = tid >> 3, th2 = tk >> 5, q2 = tk & 31, sub = tid & 7;
        float e[4];
#pragma unroll
        for (int i = 0; i < 4; ++i) { const int j = sub * 4 + i; float imp = 0.f;
#pragma unroll
            for (int g2 = 0; g2 < 4; ++g2) imp += impL[((th2 * 4 + g2) * 32 + q2) * 32 + j];
            const bool forced = (j == 0) || (j == qb) || (j == qb - 1);
            e[i] = (j > qb) ? -INFINITY : (imp + (forced ? 1e6f : 0.f)); effL[tk * 32 + j] = e[i]; }
        __syncthreads();
        int rank[4] = {0, 0, 0, 0};
#pragma unroll 1
        for (int jp = 0; jp < 32; ++jp) { const float e2 = effL[tk * 32 + jp];
#pragma unroll
            for (int i = 0; i < 4; ++i) rank[i] += (e2 > e[i] || (e2 == e[i] && jp < sub * 4 + i)) ? 1 : 0; }
        unsigned bits = 0u;
#pragma unroll
        for (int i = 0; i < 4; ++i) if (rank[i] < 16 && sub * 4 + i <= qb) bits |= 1u << (sub * 4 + i);
        if (bits) __hip_atomic_fetch_or(selL + tk, bits, __ATOMIC_RELAXED, __HIP_MEMORY_SCOPE_WORKGROUP);
        __syncthreads();
    }
    unsigned U = 0u;
#pragma unroll
    for (int k = 0; k < 16; ++k) { const v4u w = *(LAS const v4u*)(selL + 4 * k); U |= (w.x | w.y) | (w.z | w.w); }
    U = __builtin_amdgcn_readfirstlane(U);
    if (jdrop >= 0) U &= ~((2u << jdrop) - 1u);
    const unsigned msk = selL[32 * th + r32];
    {
        const bf16* Kb = PROJ + (size_t)b * SEQ * PITCH + C_KS + kh * 64;
        attn_init_fixed(st, slope2, slope2 * (float)tq + qkb, hi);
#define SEL_AFTER(j) ((U & ((1u << (j)) - 1u)) ? 31 - __builtin_clz(U & ((1u << (j)) - 1u)) : -1)
#define SEL_FETCH(j) tile_fetch(Kb + (size_t)(64 * (j)) * PITCH, PITCH, VSTb + 64 * (j), SEQ, tid)
#define SEL_COMPUTE(j, buf) { const bool rowsel = (msk >> (j)) & 1u; const int dq = tq - 64 * (j); \
            if ((j) > jcut && __any(rowsel)) tile_compute<false, false, false, true>(st, qf, qlds, KX, (float)(64 * (j)), rowsel, __all(rowsel) != 0, buf, wsc, (j) == qb, -(1 << 20), dq, 0u, 0u, oimp, 0, r32, hi); }
        TILE_PIPELINE(31 - __builtin_clz(U), SEL_AFTER, SEL_FETCH, SEL_COMPUTE);
#undef SEL_AFTER
#undef SEL_FETCH
#undef SEL_COMPUTE
        { f32x16 o0, o1;
#pragma unroll
          for (int r = 0; r < 16; ++r) { o0[r] = slab[r * 64 + lane]; o1[r] = slab[(16 + r) * 64 + lane]; }
          attn_accum(o0, o1, st, NSA_GATE(1), wsc, r32, hi);
#pragma unroll
          for (int r = 0; r < 16; ++r) { slab[r * 64 + lane] = o0[r]; slab[(16 + r) * 64 + lane] = o1[r]; } }
        __syncthreads();
    }
    f32x16 out0, out1;
    {
        const bf16* Kb = PROJ + (size_t)b * SEQ * PITCH + C_KW + kh * 64;
        attn_init_fixed(st, slope2, slope2 * (float)tq + qkb, hi);
        int jlo = qb - 8 < 0 ? 0 : qb - 8; jlo = jdrop + 1 > jlo ? jdrop + 1 : jlo;
#define WIN_AFTER(j) ((j) > jlo ? (j) - 1 : -1)
#define WIN_FETCH(j) tile_fetch(Kb + (size_t)(64 * (j)) * PITCH, PITCH, VWTb + 64 * (j), SEQ, tid)
#define WIN_COMPUTE(j, buf) if ((j) > jcut) { const int dq = tq - 64 * (j); \
            tile_compute<false, false, false, true>(st, qf, qlds, KX, (float)(64 * (j)), true, true, buf, wsc, ((j) == qb) || ((j) == qb - 8), dq - 511, dq, 0u, 0u, oimp, 0, r32, hi); }
        TILE_PIPELINE(qb, WIN_AFTER, WIN_FETCH, WIN_COMPUTE);
#undef WIN_AFTER
#undef WIN_FETCH
#undef WIN_COMPUTE
#pragma unroll
        for (int r = 0; r < 16; ++r) { out0[r] = slab[r * 64 + lane]; out1[r] = slab[(16 + r) * 64 + lane]; }
        attn_accum(out0, out1, st, NSA_GATE(2), wsc, r32, hi);
    }
    store_tile_fp8(out0, out1, lds + A_STG + wave * 4096, dob + DO_O + (size_t)(b * SEQ + 64 * qb + 32 * th) * DM + 512 + (kh * 4 + g) * 64, DM, lane, r32, hi);
    __syncthreads();
}


__device__ __forceinline__ void dsa_unit(const Ptrs& P, LAS unsigned char* lds, int b, int ti, int tid, int wave, int lane) {
    asm volatile("" : "+v"(tid), "+v"(lane));
    const int r32 = lane & 31, hi = lane >> 5, fr = lane & 15, fq = lane >> 4;
    bf16* PROJ = (bf16*)(P.ws + WS_PROJ);
    unsigned char* dob = (unsigned char*)P.out;
    const bf16* Kb = (const bf16*)(dob + DO_KA) + (size_t)b * SEQ * 64; const bf16* VTb = (const bf16*)(dob + DO_VAT) + (size_t)b * 64 * SEQ;
    const bf16* PB = PROJ + (size_t)b * SEQ * PITCH;
    LAS float* scL = (LAS float*)lds; LAS unsigned* maskL = (LAS unsigned*)(lds + D_MASK);
    LAS float* wsc = (LAS float*)(lds + A_WSC) + wave * 64;
    const int t0 = 32 * ti;
    bf16x8 qaN[8]; v4u wvN[4];
    const bf16* kbase = PB + (size_t)fr * PITCH + C_KI + fq * 8;
#define DSA_LOAD_HALF(H) { const int th0_ = t0 + 16 * (H); const bf16* qrow_ = PB + (size_t)(th0_ + fr) * PITCH + C_QI + fq * 8; \
        _Pragma("unroll") for (int hh = 0; hh < 8; ++hh) qaN[hh] = *(const GAS bf16x8*)(qrow_ + hh * 32); \
        _Pragma("unroll") for (int i = 0; i < 4; ++i) wvN[i] = *(const GAS v4u*)(PB + (size_t)(th0_ + 4 * fq + i) * PITCH + C_WI); \
        }
    DSA_LOAD_HALF(0)
    for (int half_ = 0; half_ < 2 * PROBE_DPRE; ++half_) {
        const int half = half_ & 1;
        const int th0 = t0 + 16 * half; const int ntile = (th0 >> 4) + 1;
        {
            bf16x8 qa[8];
#pragma unroll
            for (int hh = 0; hh < 8; ++hh) qa[hh] = qaN[hh];
            float wv[4][8];
#pragma unroll
            for (int i = 0; i < 4; ++i) unpack8(wvN[i], wv[i]);
            bf16x8 kbn[4];
#pragma unroll
            for (int q4 = 0; q4 < 4; ++q4) { int kt = wave + 8 * q4; kt = kt < ntile ? kt : ntile - 1; kbn[q4] = *(const GAS bf16x8*)(kbase + (size_t)(16 * kt) * PITCH); }
            for (int rep_ = 0; rep_ < PROBE_DIDX; ++rep_)
            for (int kt0 = wave; kt0 < ntile; kt0 += 32) {
                bf16x8 kbc[4];
#pragma unroll
                for (int q4 = 0; q4 < 4; ++q4) kbc[q4] = kbn[q4];
                if (kt0 + 32 < ntile) {
#pragma unroll
                    for (int q4 = 0; q4 < 4; ++q4) { int kt = kt0 + 32 + 8 * q4; kt = kt < ntile ? kt : ntile - 1; kbn[q4] = *(const GAS bf16x8*)(kbase + (size_t)(16 * kt) * PITCH); } }
#pragma unroll
                for (int q4 = 0; q4 < 4; ++q4) { const int kt = kt0 + 8 * q4;
                    if (kt < ntile) {
                        float sc[4] = {0.f, 0.f, 0.f, 0.f};
                        f32x4 acc8[8];
#pragma unroll
                        for (int hh = 0; hh < 8; ++hh) { const f32x4 z = {0.f, 0.f, 0.f, 0.f}; acc8[hh] = __builtin_amdgcn_mfma_f32_16x16x32_bf16(qa[hh], kbc[q4], z, 0, 0, 0); }
                        __builtin_amdgcn_sched_barrier(0);
#pragma unroll
                        for (int hh = 0; hh < 8; ++hh)
#pragma unroll
                            for (int i = 0; i < 4; ++i) { const int rb = __float_as_int(acc8[hh][i]); sc[i] += __int_as_float(rb > 0 ? rb : 0) * wv[i][hh]; }
#pragma unroll
                        for (int i = 0; i < 4; ++i) scL[(4 * fq + i) * SROW + 16 * kt + fr] = sc[i] + 0.0f;
                    } }
            }
        }
        __syncthreads();
        if (half_ + 1 < 2 * PROBE_DPRE) DSA_LOAD_HALF((half_ + 1) & 1)
        for (int rep_ = 0; rep_ < PROBE_DTHR; ++rep_) {
            const int rowA = 2 * wave, rowB = rowA + 1; const int tA = th0 + rowA, tB = tA + 1;
            unsigned uA[32], uB[32];
#pragma unroll
            for (int i = 0; i < 32; ++i) { const int s = lane + 64 * i; const float xa = scL[rowA * SROW + (s & (SROW - 1))], xb = scL[rowB * SROW + (s & (SROW - 1))]; uA[i] = ord_u32(xa); uB[i] = ord_u32(xb); }
            const int nvA = lane <= tA ? ((tA - lane) >> 6) + 1 : 0, nvB = lane <= tB ? ((tB - lane) >> 6) + 1 : 0;
            unsigned candA = nvA >= 32 ? 0xffffffffu : ((1u << nvA) - 1u), candB = nvB >= 32 ? 0xffffffffu : ((1u << nvB) - 1u);
            unsigned selA = candA, selB = candB;
            if (tB + 1 > TOPK) {
#define DSA_TSTAGE(U, J, MSK) _Pragma("unroll") for (int k0 = 0; k0 < 32; k0 += 2 * (J)) _Pragma("unroll") for (int k1 = 0; k1 < (J); ++k1) { const int k = k0 + k1; \
                    const unsigned a_ = U[k], b_ = U[k + (J)]; U[k] = ((MSK) & a_) | (~(MSK) & (b_ << (J))); U[k + (J)] = ((MSK) & (a_ >> (J))) | (~(MSK) & b_); }
#define DSA_PSTAGE(U, J, S_LO, S_HI) _Pragma("unroll") for (int k0 = 0; k0 < 32; k0 += 2 * (J)) _Pragma("unroll") for (int k1 = 0; k1 < (J); ++k1) { const int k = k0 + k1; \
                    const unsigned a_ = U[k], b_ = U[k + (J)]; U[k] = __builtin_amdgcn_perm(b_, a_, S_LO); U[k + (J)] = __builtin_amdgcn_perm(b_, a_, S_HI); }
                DSA_PSTAGE(uA, 16, 0x05040100u, 0x07060302u) DSA_PSTAGE(uA, 8, 0x06020400u, 0x07030501u) DSA_TSTAGE(uA, 4, 0x0f0f0f0fu) DSA_TSTAGE(uA, 2, 0x33333333u) DSA_TSTAGE(uA, 1, 0x55555555u)
                DSA_PSTAGE(uB, 16, 0x05040100u, 0x07060302u) DSA_PSTAGE(uB, 8, 0x06020400u, 0x07030501u) DSA_TSTAGE(uB, 4, 0x0f0f0f0fu) DSA_TSTAGE(uB, 2, 0x33333333u) DSA_TSTAGE(uB, 1, 0x55555555u)
#undef DSA_PSTAGE
#undef DSA_TSTAGE
#pragma unroll
                for (int k = 0; k < 32; k += 8) {
                    asm volatile("" : "+v"(uA[k]), "+v"(uA[k + 1]), "+v"(uA[k + 2]), "+v"(uA[k + 3]), "+v"(uA[k + 4]), "+v"(uA[k + 5]), "+v"(uA[k + 6]), "+v"(uA[k + 7]));
                    asm volatile("" : "+v"(uB[k]), "+v"(uB[k + 1]), "+v"(uB[k + 2]), "+v"(uB[k + 3]), "+v"(uB[k + 4]), "+v"(uB[k + 5]), "+v"(uB[k + 6]), "+v"(uB[k + 7])); }
                unsigned aboveA = 0u, aboveB = 0u; int needA = TOPK, needB = TOPK, ccA = tA + 1, ccB = tB + 1; bool doneA = false, doneB = false;
                if (ccA <= TOPK) { aboveA = candA; candA = 0u; needA = 0; ccA = 0; doneA = true; }
#pragma unroll
                for (int bb = 31; bb >= 0; --bb) {
                    if (!(doneA && doneB)) {
                        const unsigned onesA = candA & uA[bb], onesB = candB & uB[bb];
                        const unsigned S = wave_usum((unsigned)__builtin_popcount(onesA) | ((unsigned)__builtin_popcount(onesB) << 16));
                        const int c1A = (int)(S & 0xffffu), c1B = (int)(S >> 16);
                        { const bool take = c1A >= needA; aboveA = take ? aboveA : (aboveA | onesA); candA = take ? onesA : (candA & ~uA[bb]); needA = take ? needA : needA - c1A; ccA = take ? c1A : ccA - c1A;
                          const bool fin = ccA == needA; aboveA = fin ? (aboveA | candA) : aboveA; candA = fin ? 0u : candA; needA = fin ? 0 : needA; ccA = fin ? 0 : ccA; doneA = doneA || fin; }
                        { const bool take = c1B >= needB; aboveB = take ? aboveB : (aboveB | onesB); candB = take ? onesB : (candB & ~uB[bb]); needB = take ? needB : needB - c1B; ccB = take ? c1B : ccB - c1B;
                          const bool fin = ccB == needB; aboveB = fin ? (aboveB | candB) : aboveB; candB = fin ? 0u : candB; needB = fin ? 0 : needB; ccB = fin ? 0 : ccB; doneB = doneB || fin; }
                    }
                }
                selA = aboveA; selB = aboveB;
                if (!doneA) {
                    int ties = 0; const u64 ltm = (1ull << lane) - 1ull;
#pragma unroll 1
                    for (int i = 0; i < 32; ++i) { const bool eq = (candA >> i) & 1u; const u64 meq = __ballot(eq); const int myrank = ties + __popcll(meq & ltm); selA |= (unsigned)(eq && myrank < needA) << i; ties += __popcll(meq); }
                }
                if (!doneB) {
                    int ties = 0; const u64 ltm = (1ull << lane) - 1ull;
#pragma unroll 1
                    for (int i = 0; i < 32; ++i) { const bool eq = (candB >> i) & 1u; const u64 meq = __ballot(eq); const int myrank = ties + __popcll(meq & ltm); selB |= (unsigned)(eq && myrank < needB) << i; ties += __popcll(meq); }
                }
            }
            {
                LAS unsigned* mrA = maskL + (16 * half + rowA) * 64; LAS unsigned* mrB = mrA + 64;
                unsigned wloA = 0u, whiA = 0u, wloB = 0u, whiB = 0u;
#pragma unroll
                for (int i = 0; i < 32; ++i) { const u64 ma = __ballot((selA >> i) & 1u), mb = __ballot((selB >> i) & 1u);
                    wloA = (lane == i) ? (unsigned)ma : wloA; whiA = (lane == i) ? (unsigned)(ma >> 32) : whiA; wloB = (lane == i) ? (unsigned)mb : wloB; whiB = (lane == i) ? (unsigned)(mb >> 32) : whiB; }
                if (lane < 32) { mrA[2 * lane] = wloA; mrA[2 * lane + 1] = whiA; mrB[2 * lane] = wloB; mrB[2 * lane + 1] = whiB; }
                const unsigned kA = wave_umax(selA ? (unsigned)(lane + 64 * (31 - __builtin_clz(selA))) + 1u : 0u), kB = wave_umax(selB ? (unsigned)(lane + 64 * (31 - __builtin_clz(selB))) + 1u : 0u);
                if (lane == 0) { LAS int* km = (LAS int*)(lds + D_KMAX); km[16 * half + rowA] = (int)kA - 1; km[16 * half + rowB] = (int)kB - 1; }
            }
        }
        __syncthreads();
    }
    {
    int tid_b = tid, lane_b = lane; asm volatile("" : "+v"(tid_b), "+v"(lane_b));
    const int tid = tid_b, lane = lane_b, r32 = lane & 31, hi = lane >> 5;
    {
        LAS unsigned char* m8 = lds + D_M8; const int nw = 2 * (((t0 + 31) >> 6) + 1); const int row = tid >> 4;
        for (int w = tid & 15; w < nw; w += 16) { const unsigned bits = maskL[row * 64 + w]; v4u o[2];
#pragma unroll
            for (int n = 0; n < 8; ++n) { const unsigned x = (bits >> (4 * n)) & 15u; const unsigned y = ((x * 0x00204081u) & 0x01010101u) ^ 0x01010101u; o[n >> 2][n & 3] = y * 0xFEu; }
            *(LAS v4u*)(m8 + row * M8_STRIDE + 32 * w) = o[0]; *(LAS v4u*)(m8 + row * M8_STRIDE + 32 * w + 16) = o[1]; }
    }
    MaskMM MM;
    { const unsigned one = 0x38u << (8 * (r32 & 3));
#pragma unroll
      for (int w = 0; w < 8; ++w) { const unsigned x = ((r32 >> 2) == w) ? one : 0u; MM.a0[w] = (hi == 0) ? (int)x : 0; MM.a1[w] = (hi == 1) ? (int)x : 0; }
      MM.row = lds + D_M8 + r32 * M8_STRIDE + 32 * hi; }
    const int tq = t0 + r32; const int h = wave;
    const bf16* prow = PB + (size_t)tq * PITCH;
    bf16x8 qf[4];
#pragma unroll
    for (int ds = 0; ds < 4; ++ds) qf[ds] = *(const GAS bf16x8*)(prow + C_QA + h * 64 + ds * 16 + hi * 8);
    const float slope2 = exp2f(-(float)(h + 1)) * LOG2E;
    int jcutD; float qkbD; const int kmaxrow = ((LAS const int*)(lds + D_KMAX))[r32];
    { const float gq = fabsf(P.in[3][lane]), gk = fabsf(P.in[4][lane]);
      qkbD = 64.0f * QSCALE * 1.02f * __uint_as_float(wave_umax(__float_as_uint(gq))) * __uint_as_float(wave_umax(__float_as_uint(gk))) + 0.25f;
      const int kmin = (int)wave_umin((unsigned)(kmaxrow + 1)) - 1;
      const int dcut = (int)ceilf((2.0f * qkbD + 40.0f) / slope2);
      const int num = kmin - dcut - 63; jcutD = num >= 0 ? (num >> 6) : -1; }
    KxOps KX = kx_ops(r32, hi);
    LAS unsigned char* buf0 = lds + A_TILE0; LAS unsigned char* buf1 = lds + A_TILE1;
    AttnState st;
    f32x16 dummy;
#pragma unroll
    for (int r = 0; r < 16; ++r) dummy[r] = 0.f;
    for (int rep = 0; rep < PROBE_DATT; ++rep) {
    attn_init_fixed(st, slope2, slope2 * (float)kmaxrow + qkbD, hi);
#define DSA_AFTER(j) ((j) - 1)
#define DSA_FETCH(j) tile_fetch(Kb + (size_t)(64 * (j)) * 64, 64, VTb + 64 * (j), SEQ, tid)
#define DSA_COMPUTE(j, buf) if ((j) > jcutD) tile_compute<true, false, false, true>(st, qf, nullptr, KX, (float)(64 * (j)), true, true, buf, wsc, false, 0, 0, (unsigned)(64 * (j)), 0u, dummy, 0, r32, hi, &MM)
    TILE_PIPELINE((t0 + 31) >> 6, DSA_AFTER, DSA_FETCH, DSA_COMPUTE);
#undef DSA_AFTER
#undef DSA_FETCH
#undef DSA_COMPUTE
    __syncthreads();
    }
    f32x16 out0, out1;
#pragma unroll
    for (int r = 0; r < 16; ++r) { out0[r] = 0.f; out1[r] = 0.f; }
    attn_accum(out0, out1, st, 1.0f, wsc, r32, hi);
    __syncthreads();
    store_tile_fp8(out0, out1, lds + A_TILE0 + wave * 2048, dob + DO_O + (size_t)(b * SEQ + t0) * DM + h * 64, DM, lane, r32, hi);
    __syncthreads();
    }
}

__device__ __forceinline__ int nsa_tbl(int i, unsigned long long c0, unsigned long long c1, unsigned long long c2, unsigned long long c3) { const unsigned long long c = (i & 16) ? ((i & 8) ? c3 : c2) : ((i & 8) ? c1 : c0); return (int)((c >> (8 * (i & 7))) & 0xffull); }
__device__ __forceinline__ int nsa_ua(int i) { return nsa_tbl(i, 0x38393a3b3c3d3e3full, 0x3031323334353637ull, 0x28292a2b2c2d2e2full, 0x130c12110d0e0f10ull); }
__device__ __forceinline__ int nsa_ub(int i) { return nsa_tbl(i, 0x1c1e090807250504ull, 0x2303220221012000ull, 0x1b270a1d1f260624ull, 0x1415160b1a191817ull); }
__device__ __forceinline__ void p3_fast(const Ptrs& P, LAS unsigned char* lds, int vcu, int G, int tid, int wave, int lane) {
    for (int u = vcu; u < 256; u += G)
        for (int k = 0; k < 2; ++k) { const int b = u >> 5, p = u & 31; dsa_unit(P, lds, b, k ? p : 63 - p, tid, wave, lane); }
    asm volatile("" ::: "memory");
    for (int u = vcu; u < 256; u += G)
        for (int k = 0; k < 2 * PROBE_NSA; ++k) { const int b = u >> 5, i = u & 31;
            const int c = (k & 1) ? nsa_ub(i) : nsa_ua(i); nsa_unit(P, lds, b, c >> 5, c & 31, tid, wave, lane); }
}

struct Args { Ptrs p; };
__global__ void __launch_bounds__(NWAVES * 64, 2) fwd_kernel(Args args) {
    extern __shared__ __attribute__((aligned(16))) unsigned char lds_raw[];
    LAS unsigned char* lds = (LAS unsigned char*)lds_raw;
    const Ptrs& P = args.p;
    const int tid = threadIdx.x, lane = tid & 63, wave = __builtin_amdgcn_readfirstlane(tid >> 6);
    const int G = gridDim.x; const int bx = blockIdx.x; const int vcu = (G % 8 == 0) ? (bx % 8) * (G / 8) + bx / 8 : bx;
    const int gw = vcu * NWAVES + wave, NGW = G * NWAVES;
    volatile LAS unsigned* MISC = (volatile LAS unsigned*)(lds + MISC_OFF);
    for (int u = tid; u < (LDS_BYTES - RING_BYTES) / 4; u += NWAVES * 64) ((LAS unsigned*)(lds + RING_BYTES))[u] = 0u;
    __syncthreads();
    unsigned* ctl = (unsigned*)(P.ws + WS_CTL);
    XcdBarrier bar = xcd_barrier_post(ctl + CW_BAR, MISC + 8);
#if PROBE_BAR
    int pb_k = 0;
#define GRIDBAR() do { const unsigned long long t0_ = __builtin_amdgcn_s_memrealtime(); xcd_barrier(bar); const unsigned long long t1_ = __builtin_amdgcn_s_memrealtime(); \
        if (tid == 0) { const unsigned w_ = (unsigned)(t1_ - t0_); atomicMax(ctl + 8192 + 64 * pb_k, 0x7fffffffu - w_); atomicMax(ctl + 8192 + 1024 + 64 * pb_k, w_); } ++pb_k; } while (0)
#elif PROBE_SPAN
    int pb_k = 0; unsigned long long sp_prev = __builtin_amdgcn_s_memrealtime(), sp_acc = 0;
#define GRIDBAR() do { xcd_barrier(bar); const unsigned long long t_ = __builtin_amdgcn_s_memrealtime(); if ((PROBE_SPAN >> pb_k) & 1) sp_acc += t_ - sp_prev; sp_prev = t_; ++pb_k; } while (0)
#else
#define GRIDBAR() xcd_barrier(bar)
#endif

    bf16* H = (bf16*)((unsigned char*)P.out + DO_H);
    bf16* PROJ = (bf16*)(P.ws + WS_PROJ); bf16* HID = (bf16*)(P.ws + WS_PROJ);
    bf16* MERGED = (bf16*)(P.ws + WS_MERGED); bf16* X1B = (bf16*)(P.ws + WS_X1B); float* PARTS = (float*)(P.ws + WS_PARTS);

    for (int rep = 0; rep < PROBE_P0; ++rep) p0_prologue(P, lds, gw, NGW, wave, lane);
    GRIDBAR();
    for (int rep = 0; rep < PROBE_P1; ++rep) {
        pg8::Gemm g{H, (const bf16*)(P.ws + WS_WIN), M, 1024, DM, DM}; pg8::StaticOrder S; S.init(M, 1024, G, bx);
        pg8::EpiProj E{PROJ, PITCH, P.in[3], P.in[8], P.in[10], P.in[11], (bf16*)((unsigned char*)P.out + DO_VST), (bf16*)((unsigned char*)P.out + DO_VWT), QSCALE, RMS_EPS, SEQ, (bf16*)(P.ws + WS_GT)};
        pg8::gemm_phase<pg8::EpiProj, pg8::StaticOrder, true>(lds, g, S, E);
        {
            pg8::Gemm g8{(const bf16*)(P.ws + WS_H8), (const bf16*)(P.ws + WS_WIN8C), M, 3072, DM / 2, DM / 2}; pg8::StaticOrder S8; S8.init(M, 3072, G, bx);
            pg8::EpiProjGate8 E8{pg8::EpiProjT<1>{PROJ, PITCH, P.in[3], P.in[8], P.in[10], P.in[11], (bf16*)((unsigned char*)P.out + DO_VST), (bf16*)((unsigned char*)P.out + DO_VWT), QSCALE, RMS_EPS, SEQ, (bf16*)(P.ws + WS_GT)}, pg8::EpiGateSig{P.ws + WS_GT}};
            pg8::gemm_phase<pg8::EpiProjGate8, pg8::StaticOrder, true>(lds, g8, S8, E8);
        }
        if (rep == 0 && G != 256) { int lane2 = lane; asm volatile("" : "+v"(lane2)); const int rem = S.nwg % G;
            if (rem == 0) p0_items(P, lds, P0_EARLY, P0_ALL, bx * NWAVES + wave, G * NWAVES, wave, lane2);
            else if (bx >= rem) p0_items(P, lds, P0_EARLY, P0_ALL, (bx - rem) * NWAVES + wave, (G - rem) * NWAVES, wave, lane2); }
    }
    GRIDBAR();
    for (int rep = 0; rep < PROBE_P2; ++rep) {
        p2_fast(P, lds, vcu, G, tid, wave, lane);
        if (rep == 0 && G == 256 && vcu >= 192) { int lane2 = lane; asm volatile("" : "+v"(lane2));
            p0_items(P, lds, P0_EARLY, P0_ALL, (vcu - 192) * NWAVES + wave, 64 * NWAVES, wave, lane2); }
        {
            const bool idle64 = (G == 256);
            if (!idle64 || (vcu >= 128 && vcu < 192)) {
                pg8::Gemm g{(const bf16*)(P.ws + WS_H8), (const bf16*)(P.ws + WS_WIN8T - (size_t)8 * 256 * DM), M, 2304, DM / 2, DM / 2};
                pg8::ColTileOrder S{8, idle64 ? vcu - 128 : vcu, idle64 ? 64 : G, M / 256};
                pg8::EpiProjT<1> E{PROJ, PITCH, P.in[3], P.in[8], P.in[10], P.in[11], (bf16*)((unsigned char*)P.out + DO_VST), (bf16*)((unsigned char*)P.out + DO_VWT), QSCALE, RMS_EPS, SEQ, (bf16*)(P.ws + WS_GT)};
                pg8::gemm_phase<pg8::EpiProjT<1>, pg8::ColTileOrder, false>(lds, g, S, E);
            }
        }
    }
    GRIDBAR();
    for (int rep = 0; rep < PROBE_P3; ++rep) p3_fast(P, lds, vcu, G, tid, wave, lane);
    GRIDBAR();
    for (int rep = 0; rep < PROBE_P4; ++rep) {
        pg8::StaticOrder S; S.init(M, DM, G, bx);
        const bf16* OB = (const bf16*)((unsigned char*)P.out + DO_O);
        pg8::Gemm g{OB, (const bf16*)(P.ws + WS_WUPA), M, DM, DM / 2, DM / 2}; pg8::EpiGate2 E{(unsigned char*)MERGED, DM, P.ws + WS_GT};
        pg8::gemm_phase<pg8::EpiGate2, pg8::StaticOrder, true>(lds, g, S, E);
    }
    GRIDBAR();
    for (int rep = 0; rep < PROBE_P5; ++rep) {
        pg8::Gemm g{MERGED, (const bf16*)(P.ws + WS_WOUT), M, DM, DM / 2, DM / 2}; pg8::StaticOrder S; S.init(M, DM, G, bx);
        pg8::EpiOutRes E{P.in[0], P.out, X1B, DM, PARTS, P.ws + WS_OUTSCR};
        pg8::gemm_phase<pg8::EpiOutRes, pg8::StaticOrder, true>(lds, g, S, E);
    }
    GRIDBAR();
    for (int rep = 0; rep < PROBE_P6; ++rep) {
        pg8::Gemm g{(const bf16*)(P.ws + WS_OUTSCR), (const bf16*)(P.ws + WS_WFF1), M, FF, DM / 2, DM / 2}; pg8::StaticOrder S; S.init(M, FF, G, bx);
        pg8::EpiRelu2 E{(unsigned char*)HID, FF, PARTS, RMS_EPS, 1.0f / DM};
        pg8::gemm_phase<pg8::EpiRelu2, pg8::StaticOrder, true>(lds, g, S, E);
    }
    GRIDBAR();
    {
        pg8::Gemm g{HID, (const bf16*)(P.ws + WS_WFF2), M, DM, FF / 2, FF / 2}; pg8::StaticOrder S; S.init(M, DM, G, bx);
        pg8::EpiFinal E{P.out, X1B, DM};
        pg8::gemm_phase<pg8::EpiFinal, pg8::StaticOrder, true>(lds, g, S, E);
    }
#if PROBE_SPAN
    GRIDBAR();
    if (bx == 0) { const unsigned long long t0 = __builtin_amdgcn_s_memrealtime(); while (__builtin_amdgcn_s_memrealtime() - t0 < sp_acc) __builtin_amdgcn_s_sleep(8); }
#endif
#if PROBE_BAR
    xcd_barrier(bar);
    if (bx == 0 && tid == 0) { unsigned long long tot = 0;
        for (int k = 0; k < 7; ++k) { const unsigned a = __hip_atomic_load(ctl + 8192 + (PROBE_BAR == 1 ? 0 : 1024) + 64 * k, __ATOMIC_RELAXED, __HIP_MEMORY_SCOPE_AGENT); tot += (PROBE_BAR == 1) ? (0x7fffffffu - a) : a; }
        const unsigned long long t0 = __builtin_amdgcn_s_memrealtime(); while (__builtin_amdgcn_s_memrealtime() - t0 < 8ull * tot) __builtin_amdgcn_s_sleep(8); }
#endif
}

extern "C" void kernel_launch(void* const* d_in, const int* in_sizes, int n_in, void* d_out, int out_size, void* d_ws, size_t ws_size, hipStream_t stream) {
    static int grid = 0;
    if (grid == 0) {
        if (n_in != 23 || in_sizes[0] != M * DM || out_size != M * DM || ws_size < WS_END) { fprintf(stderr, "kernel_launch: unexpected shapes (n_in %d, in0 %d, out %d, ws %zu)\n", n_in, n_in > 0 ? in_sizes[0] : -1, out_size, ws_size); grid = -1; return; }
        int dev = 0, cus = 0, per_cu = 0;
        if (hipGetDevice(&dev) != hipSuccess || hipDeviceGetAttribute(&cus, hipDeviceAttributeMultiprocessorCount, dev) != hipSuccess) { grid = -1; return; }
        if (hipFuncSetAttribute((const void*)fwd_kernel, hipFuncAttributeMaxDynamicSharedMemorySize, LDS_BYTES) != hipSuccess) { fprintf(stderr, "kernel_launch: hipFuncSetAttribute failed\n"); grid = -1; return; }
        if (hipOccupancyMaxActiveBlocksPerMultiprocessor(&per_cu, (const void*)fwd_kernel, NWAVES * 64, LDS_BYTES) != hipSuccess || per_cu < 1) { fprintf(stderr, "kernel_launch: occupancy query reports %d blocks per CU\n", per_cu); }
        (void)hipGetLastError();
        grid = cus;
    }
    if (grid < 0) return;
    if (hipMemsetAsync((char*)d_ws + WS_CTL, 0, CTL_ZERO_BYTES, stream) != hipSuccess) { fprintf(stderr, "kernel_launch: memset failed\n"); return; }
    Args a{};
    for (int i = 0; i < 23; ++i) a.p.in[i] = (const float*)d_in[i];
    a.p.out = (float*)d_out; a.p.ws = (unsigned char*)d_ws;
    void* kargs[] = {&a};
    hipError_t e = hipLaunchCooperativeKernel((const void*)fwd_kernel, dim3(grid), dim3(NWAVES * 64), kargs, LDS_BYTES, stream);
    if (e != hipSuccess) fprintf(stderr, "kernel_launch: cooperative launch failed: %s (grid %d)\n", hipGetErrorString(e), grid);
}
```

```cpp
#include <hip/hip_runtime.h>
#include <cstdio>
#include <cstdint>

namespace pg8 {
#define PG8_LAS __attribute__((address_space(3)))
typedef unsigned short bf16_t;
typedef short bf16x8 __attribute__((ext_vector_type(8)));
typedef float f32x4 __attribute__((ext_vector_type(4)));
typedef unsigned u32x4 __attribute__((ext_vector_type(4)));
typedef unsigned u32x2 __attribute__((ext_vector_type(2)));
typedef int i32x8 __attribute__((ext_vector_type(8)));
constexpr int BM = 256, BK = 64, HALF = 128, HTB = HALF * BK * 2  , STAGE_BYTES = 8 * HTB, NXCD = 8, WGM = 8;

__host__ __device__ __forceinline__ int lds_byte(int r, int c) { const int st = (r >> 4) * 2 + (c >> 5), rr = r & 15, cc = c & 31, ob = rr * 64 + cc * 2; return st * 1024 + (ob ^ (((ob >> 9) & 1) << 5)); }
__host__ __device__ __forceinline__ void stage_rc(int b, int& R, int& C) { const int st = b / 1024, sb = b % 1024, swz = sb ^ (((sb >> 9) & 1) << 5); R = (st >> 1) * 16 + swz / 64; C = (st & 1) * 32 + (swz % 64) / 2; }
__host__ __device__ __forceinline__ int perm32(int rho) { const int n = rho >> 4, i = rho & 15; return 8 * (i >> 2) + 4 * n + (i & 3); }

struct Unit { int pm, pn; };
struct Gemm { const bf16_t* A; const bf16_t* Bt; int M, N, K, lda; };

struct StaticOrder {
    int nM, nN, nwg, G, c;
    __host__ __device__ void init(int M, int N, int G_, int c_) { nM = M / BM; nN = N / BM; nwg = nM * nN; G = G_; c = c_; }
    __host__ __device__ __forceinline__ bool next(int i, Unit& u) const {
        const long L = (long)i * G + c; if (L >= nwg) return false;
        int wgid = (int)L; { const int q = nwg / NXCD, r = nwg % NXCD, xcd = wgid % NXCD, off = wgid / NXCD; wgid = (xcd < r ? xcd * (q + 1) : r * (q + 1) + (xcd - r) * q) + off; }
        const int nig = WGM * nN, gid = wgid / nig, fm = gid * WGM, gsz = (nM - fm) < WGM ? (nM - fm) : WGM;
        u.pm = fm + ((wgid % nig) % gsz); u.pn = (wgid % nig) / gsz; return true;
    }
};

struct ColTileOrder { int pn, first, stride, nM; __host__ __device__ bool next(int i, Unit& u) const { const int pm = first + i * stride; if (pm >= nM) return false; u.pm = pm; u.pn = pn; return true; } };

typedef float f32x2v __attribute__((ext_vector_type(2))); typedef __bf16 bf16x2v __attribute__((ext_vector_type(2)));
__device__ __forceinline__ unsigned cvt_pk_bf16(float lo, float hi) { const f32x2v v = {lo, hi}; const bf16x2v b = __builtin_convertvector(v, bf16x2v); return __builtin_bit_cast(unsigned, b); }
__device__ __forceinline__ unsigned cvt4_fp8(float a, float b, float c, float d) { int w = __builtin_amdgcn_cvt_pk_fp8_f32(a, b, 0, false); w = __builtin_amdgcn_cvt_pk_fp8_f32(c, d, w, true); return (unsigned)w; }
typedef float f32x2u __attribute__((ext_vector_type(2)));
__device__ __forceinline__ void unpack8_fp8(const u32x2 g, float (&o)[8]) { const f32x2u a = __builtin_amdgcn_cvt_pk_f32_fp8((int)g.x, false), b = __builtin_amdgcn_cvt_pk_f32_fp8((int)g.x, true), c = __builtin_amdgcn_cvt_pk_f32_fp8((int)g.y, false), d = __builtin_amdgcn_cvt_pk_f32_fp8((int)g.y, true);
    o[0] = a[0]; o[1] = a[1]; o[2] = b[0]; o[3] = b[1]; o[4] = c[0]; o[5] = c[1]; o[6] = d[0]; o[7] = d[1]; }
__device__ __forceinline__ float bflo(unsigned w) { return __uint_as_float(w << 16); }
__device__ __forceinline__ float bfhi(unsigned w) { return __uint_as_float(w & 0xffff0000u); }
__device__ __forceinline__ float sigm(float x) { return 1.0f / (1.0f + __expf(-x)); }
__device__ __forceinline__ float sigq(float x) { return fmaxf(sigm(x), 0.001953125f); }
__device__ __forceinline__ unsigned cvt4_fp8c(float a, float b, float c, float d) { return cvt4_fp8(__builtin_amdgcn_fmed3f(a, -448.f, 448.f), __builtin_amdgcn_fmed3f(b, -448.f, 448.f), __builtin_amdgcn_fmed3f(c, -448.f, 448.f), __builtin_amdgcn_fmed3f(d, -448.f, 448.f)); }

template <int F8_> struct EpiProjT {
    static constexpr bool PERM = true; static constexpr int F8 = F8_, F8W = 0x7A7A7A7A, F8A = 0x7F7F7F7F; static constexpr int MIDK = 0;
    bf16_t* O; int ldc; const float *gqa, *gqb, *gks, *gkw; bf16_t* VST; bf16_t* VWT; float qscale, eps; int seq; bf16_t* GT;
    __device__ __forceinline__ void operator()(const f32x4 (&acc)[2][2][4][2], const Unit& u, int wr, int wc, int fr, int fq) const {
        const int f0 = u.pn * BM + wc * 64;
        const float* g = nullptr; float sc = 1.f;
        if (f0 >= 1024 && f0 < 1536) { g = gqa; sc = qscale; } else if (f0 >= 320 && f0 < 832) { g = gqb; sc = qscale; } else if (f0 == 1792 || f0 == 1856) { g = gks; } else if (f0 == 2048 || f0 == 2112) { g = gkw; }
        bf16_t* VT = nullptr; int kh = 0;
        if (f0 == 1920 || f0 == 1984) { VT = VST; kh = (f0 - 1920) >> 6; } else if (f0 == 2176 || f0 == 2240) { VT = VWT; kh = (f0 - 2176) >> 6; }
        float gv[2][8];
#pragma unroll
        for (int bj = 0; bj < 2; ++bj)
#pragma unroll
            for (int k = 0; k < 8; ++k) gv[bj][k] = g ? g[32 * bj + 8 * fq + k] * sc : 1.f;
        const int row0 = u.pm * BM + wr * 64 + fr;
#pragma unroll
        for (int ai = 0; ai < 2; ++ai)
#pragma unroll
            for (int m = 0; m < 4; ++m) { const int row = row0 + ai * HALF + m * 16; bf16_t* rowp = O + (size_t)row * ldc + f0 + 8 * fq;
                float v[2][8];
#pragma unroll
                for (int bj = 0; bj < 2; ++bj) { const f32x4 v0 = acc[ai][bj][m][0], v1 = acc[ai][bj][m][1]; v[bj][0] = v0[0]; v[bj][1] = v0[1]; v[bj][2] = v0[2]; v[bj][3] = v0[3]; v[bj][4] = v1[0]; v[bj][5] = v1[1]; v[bj][6] = v1[2]; v[bj][7] = v1[3]; }
                if (g) { float ss = 0.f;
#pragma unroll
                    for (int bj = 0; bj < 2; ++bj)
#pragma unroll
                        for (int k = 0; k < 8; ++k) ss += v[bj][k] * v[bj][k];
                    ss += __shfl_xor(ss, 16); ss += __shfl_xor(ss, 32);
                    const float r = rsqrtf(ss * (1.f / 64.f) + eps);
#pragma unroll
                    for (int bj = 0; bj < 2; ++bj)
#pragma unroll
                        for (int k = 0; k < 8; ++k) v[bj][k] *= r * gv[bj][k]; }
#pragma unroll
                for (int bj = 0; bj < 2; ++bj) { u32x4 w; w.x = cvt_pk_bf16(v[bj][0], v[bj][1]); w.y = cvt_pk_bf16(v[bj][2], v[bj][3]); w.z = cvt_pk_bf16(v[bj][4], v[bj][5]); w.w = cvt_pk_bf16(v[bj][6], v[bj][7]);
                    *(u32x4*)(rowp + 32 * bj) = w;
                    if (VT) { const int b = row / seq, s = row % seq; bf16_t* tp = VT + ((size_t)(b * 2 + kh) * 64 + 32 * bj + 8 * fq) * seq + s;
                        tp[0] = (bf16_t)(w.x & 0xffffu); tp[seq] = (bf16_t)(w.x >> 16); tp[2 * seq] = (bf16_t)(w.y & 0xffffu); tp[3 * seq] = (bf16_t)(w.y >> 16);
                        tp[4 * seq] = (bf16_t)(w.z & 0xffffu); tp[5 * seq] = (bf16_t)(w.z >> 16); tp[6 * seq] = (bf16_t)(w.w & 0xffffu); tp[7 * seq] = (bf16_t)(w.w >> 16); } } }
    }
};
using EpiProj = EpiProjT<0>;

struct EpiGateSig {
    static constexpr bool PERM = true; static constexpr int F8 = 1, F8W = 0x7A7A7A7A, F8A = 0x7F7F7F7F; static constexpr int MIDK = 0;
    unsigned char* GT;
    __device__ __forceinline__ void operator()(const f32x4 (&acc)[2][2][4][2], const Unit& u, int wr, int wc, int fr, int fq) const {
        unsigned char* tp = GT + ((size_t)(u.pm * 8 + u.pn) * 65536) + ((size_t)(wr * 4 + wc) * 64 + fq * 16 + fr) * 8;
#pragma unroll
        for (int ai = 0; ai < 2; ++ai)
#pragma unroll
            for (int m = 0; m < 4; ++m)
#pragma unroll
                for (int bj = 0; bj < 2; ++bj) { const f32x4 v0 = acc[ai][bj][m][0], v1 = acc[ai][bj][m][1];
                    u32x2 w; w.x = cvt4_fp8(sigq(v0[0]), sigq(v0[1]), sigq(v0[2]), sigq(v0[3])); w.y = cvt4_fp8(sigq(v1[0]), sigq(v1[1]), sigq(v1[2]), sigq(v1[3]));
                    *(u32x2*)(tp + (size_t)(((ai * 4 + m) * 2 + bj) * 4096)) = w; }
    }
};

struct EpiProjGate8 {
    static constexpr bool PERM = true; static constexpr int F8 = 1, F8W = 0x7A7A7A7A, F8A = 0x7F7F7F7F; static constexpr int MIDK = 0;
    EpiProjT<1> ep; EpiGateSig eg;
    __device__ __forceinline__ void operator()(const f32x4 (&acc)[2][2][4][2], const Unit& u, int wr, int wc, int fr, int fq) const {
        Unit v = u;
        if (u.pn < 4) { v.pn = u.pn + 4; ep(acc, v, wr, wc, fr, fq); } else { v.pn = u.pn - 4; eg(acc, v, wr, wc, fr, fq); }
    }
};

struct EpiGate2 {
    static constexpr bool PERM = true; static constexpr int F8 = 1, F8W = 0x7A7A7A7A, F8A = 0x7B7B7B7B; static constexpr int MIDK = 4;
    unsigned char* O; int ldc; const unsigned char* GT;
    __device__ __forceinline__ void mid(f32x4 (&acc)[2][2][4][2], const Unit& u, int wr, int wc, int fr, int fq) const {
        asm volatile("" : "+v"(fr), "+v"(fq));
        const unsigned char* ta = GT + ((size_t)(u.pm * 8 + u.pn) * 65536) + ((size_t)(wr * 4 + wc) * 64 + fq * 16 + fr) * 8; const unsigned char* tb = ta + 4 * 65536;
        u32x2 ga[3][2], gb[3][2];
#define EG2_LOAD(slot, g) { _Pragma("unroll") for (int bj = 0; bj < 2; ++bj) { const int so = ((g) * 2 + bj) * 4096; ga[slot][bj] = *(const u32x2*)(ta + so); gb[slot][bj] = *(const u32x2*)(tb + so); } }
        EG2_LOAD(0, 0) EG2_LOAD(1, 1)
#pragma unroll
        for (int g = 0; g < 8; ++g) { const int ai = g >> 2, m = g & 3;
            if (g + 2 < 8) EG2_LOAD((g + 2) % 3, g + 2)
#pragma unroll
            for (int bj = 0; bj < 2; ++bj) { float fa[8], fb[8], r[8]; unpack8_fp8(ga[g % 3][bj], fa); unpack8_fp8(gb[g % 3][bj], fb);
#pragma unroll
                for (int e = 0; e < 8; ++e) r[e] = fa[e] / fmaxf(fb[e], 1e-30f);
#pragma unroll
                for (int e = 0; e < 4; ++e) { acc[ai][bj][m][0][e] *= r[e]; acc[ai][bj][m][1][e] *= r[4 + e]; } }
            asm volatile("" ::: "memory"); }
#undef EG2_LOAD
    }
    __device__ __forceinline__ void operator()(const f32x4 (&acc)[2][2][4][2], const Unit& u, int wr, int wc, int fr, int fq) const {
        const int row0 = u.pm * BM + wr * 64 + fr, col0 = u.pn * BM + wc * 32 + 8 * fq;
        const unsigned char* tb = GT + ((size_t)(u.pm * 8 + u.pn + 4) * 65536) + ((size_t)(wr * 4 + wc) * 64 + fq * 16 + fr) * 8;
#pragma unroll
        for (int ai = 0; ai < 2; ++ai)
#pragma unroll
            for (int m = 0; m < 4; ++m) { const size_t row = (size_t)(row0 + ai * HALF + m * 16); unsigned char* rowp = O + row * ldc + col0;
#pragma unroll
                for (int bj = 0; bj < 2; ++bj) { const f32x4 v0 = acc[ai][bj][m][0] * 16.f, v1 = acc[ai][bj][m][1] * 16.f;
                    float gg[8]; unpack8_fp8(*(const u32x2*)(tb + ((ai * 4 + m) * 2 + bj) * 4096), gg);
                    u32x2 w; w.x = cvt4_fp8c(v0[0] * gg[0], v0[1] * gg[1], v0[2] * gg[2], v0[3] * gg[3]);
                    w.y = cvt4_fp8c(v1[0] * gg[4], v1[1] * gg[5], v1[2] * gg[6], v1[3] * gg[7]);
                    *(u32x2*)(rowp + bj * HALF) = w; } }
    }
};
struct EpiRelu2 {
    static constexpr bool PERM = true; static constexpr int F8 = 1, F8W = 0x79797979, F8A = 0x7F7F7F7F; static constexpr int MIDK = 0;
    unsigned char* O; int ldc; const PG8_LAS float* rstdL; int pm0, pm1, pm2;
    __device__ __forceinline__ void operator()(const f32x4 (&acc)[2][2][4][2], const Unit& u, int wr, int wc, int fr, int fq) const {
        const int row0 = u.pm * BM + wr * 64 + fr, col0 = u.pn * BM + wc * 32 + 8 * fq;
        const PG8_LAS float* rl = rstdL + (u.pm == pm0 ? 0 : (u.pm == pm1 ? 256 : (u.pm == pm2 ? 512 : 768))) + wr * 64 + fr;
#pragma unroll
        for (int ai = 0; ai < 2; ++ai)
#pragma unroll
            for (int m = 0; m < 4; ++m) { const size_t row = (size_t)(row0 + ai * HALF + m * 16); unsigned char* rowp = O + row * ldc + col0;
                const float rs = rl[ai * HALF + m * 16];
#pragma unroll
                for (int bj = 0; bj < 2; ++bj) { const f32x4 v0 = acc[ai][bj][m][0], v1 = acc[ai][bj][m][1];
                    float o[8] = {v0[0], v0[1], v0[2], v0[3], v1[0], v1[1], v1[2], v1[3]};
#pragma unroll
                    for (int e = 0; e < 8; ++e) { const int ob = __float_as_int(o[e]); const float t = __int_as_float(ob > 0 ? ob : 0) * rs; o[e] = fminf(t * t, 448.f); }
                    u32x2 w; w.x = cvt4_fp8(o[0], o[1], o[2], o[3]); w.y = cvt4_fp8(o[4], o[5], o[6], o[7]);
                    *(u32x2*)(rowp + bj * HALF) = w; } }
    }
};
struct EpiOutRes {
    static constexpr bool PERM = false; static constexpr int F8 = 1, F8W = 0x7A7A7A7A, F8A = 0x7B7B7B7B; static constexpr int MIDK = 0;
    const float* base; float* out; bf16_t* xb; int ldc; float* parts; unsigned char* x8;
    __device__ __forceinline__ void operator()(const f32x4 (&acc)[2][2][4][2], const Unit& u, int wr, int wc, int fr, int fq) const {
        const int col0 = u.pn * BM + wc * 32 + 4 * fq;
#pragma unroll
        for (int ai = 0; ai < 2; ++ai)
#pragma unroll
            for (int m = 0; m < 4; ++m) { const int r = u.pm * BM + ai * HALF + wr * 64 + m * 16 + fr; const size_t off = (size_t)r * ldc + col0; float ss = 0.f;
#pragma unroll
                for (int bj = 0; bj < 2; ++bj)
#pragma unroll
                    for (int n = 0; n < 2; ++n) { const f32x4 bs = *(const f32x4*)(base + off + bj * HALF + n * 16); const f32x4 o = bs + acc[ai][bj][m][n];
                        ss += (o[0] * o[0] + o[1] * o[1]) + (o[2] * o[2] + o[3] * o[3]);
                        u32x2 w; w.x = cvt_pk_bf16(o[0], o[1]); w.y = cvt_pk_bf16(o[2], o[3]); *(u32x2*)(xb + off + bj * HALF + n * 16) = w;
                        *(unsigned*)(x8 + off + bj * HALF + n * 16) = cvt4_fp8c(o[0], o[1], o[2], o[3]); }
                ss += __shfl_xor(ss, 16); ss += __shfl_xor(ss, 32);
                if (fq == 0) parts[(size_t)r * 16 + u.pn * 4 + wc] = ss; }
    }
};
struct EpiFinal {
    static constexpr bool PERM = false; static constexpr int F8 = 1, F8W = 0x78787878, F8A = 0x7C7C7C7C; static constexpr int MIDK = 0;
    float* out; const bf16_t* xb; int ldc;
    __device__ __forceinline__ void operator()(const f32x4 (&acc)[2][2][4][2], const Unit& u, int wr, int wc, int fr, int fq) const {
        const int col0 = u.pn * BM + wc * 32 + 4 * fq;
#pragma unroll
        for (int ai = 0; ai < 2; ++ai)
#pragma unroll
            for (int m = 0; m < 4; ++m) { const int r = u.pm * BM + ai * HALF + wr * 64 + m * 16 + fr; const size_t off = (size_t)r * ldc + col0;
#pragma unroll
                for (int bj = 0; bj < 2; ++bj)
#pragma unroll
                    for (int n = 0; n < 2; ++n) { const u32x2 w = *(const u32x2*)(xb + off + bj * HALF + n * 16); const f32x4 a = acc[ai][bj][m][n];
                        f32x4 o; o[0] = bflo(w.x) + a[0]; o[1] = bfhi(w.x) + a[1]; o[2] = bflo(w.y) + a[2]; o[3] = bfhi(w.y) + a[3];
                        *(f32x4*)(out + off + bj * HALF + n * 16) = o; } }
    }
};

template <class Epi, class Sched, bool ALIGN_EPI = false>
__device__ __forceinline__ void gemm_phase(PG8_LAS unsigned char* lds, const Gemm g, const Sched& S, const Epi& E) {
    int tid_ = threadIdx.x; asm volatile("" : "+v"(tid_));
    const int tid = tid_, wid = __builtin_amdgcn_readfirstlane(tid >> 6), lane = tid & 63, wr = wid >> 2, wc = wid & 3, fr = lane & 15, fq = lane >> 4;
    int K_ = g.K; asm volatile("" : "+s"(K_));
    const int K = K_, nt = K / BK;
    unsigned voffA[2], voffB[2];
#pragma unroll
    for (int i = 0; i < 2; ++i) { int R, C; stage_rc(tid * 16 + i * 8192, R, C); const int Rb = Epi::PERM ? ((R & ~31) + perm32(R & 31)) : R;
        voffA[i] = (unsigned)(R * g.lda + C) * 2u; voffB[i] = (unsigned)(Rb * K + C) * 2u; }
    const size_t kstep = (size_t)(BK * 2);
    const size_t hstepA = (size_t)HALF * g.lda * 2, hstepB = (size_t)HALF * K * 2;
    const size_t tstepA = 2 * hstepA, tstepB = 2 * hstepB;
    const unsigned ldsw = (unsigned)wid * 1024u;
    const int aoff = lds_byte(wr * 64 + fr, fq * 8), boff = lds_byte(wc * 32 + fr, fq * 8);
#define PG8_SA(b, h) (((b) * 2 + (h)) * HTB)
#define PG8_SB(b, h) ((4 + (b) * 2 + (h)) * HTB)
#define PG8_STAGE(bufoff, gbase, voff) do { _Pragma("unroll") for (int _i = 0; _i < 2; ++_i) \
        __builtin_amdgcn_global_load_lds((const unsigned*)((const char*)(gbase) + (voff)[_i]), (PG8_LAS unsigned*)(lds + (bufoff) + ldsw + _i * 8192), 16, 0, 0); } while (0)
#define PG8_LDA(dst, b, h) do { _Pragma("unroll") for (int m = 0; m < 4; ++m) _Pragma("unroll") for (int k = 0; k < 2; ++k) dst[m][k] = *(const PG8_LAS bf16x8*)(lds + PG8_SA(b, h) + aoff + m * 2048 + k * 1024); } while (0)
#define PG8_LDB(dst, b, h) do { _Pragma("unroll") for (int n = 0; n < 2; ++n) _Pragma("unroll") for (int k = 0; k < 2; ++k) dst[n][k] = *(const PG8_LAS bf16x8*)(lds + PG8_SB(b, h) + boff + n * 2048 + k * 1024); } while (0)
#define PG8_CAT(x) __builtin_bit_cast(i32x8, __builtin_shufflevector((x)[0], (x)[1], 0, 1, 2, 3, 4, 5, 6, 7, 8, 9, 10, 11, 12, 13, 14, 15))
#define PG8_MMA(ai, bj, At, Bt) do { __builtin_amdgcn_s_setprio(1); _Pragma("unroll") for (int m = 0; m < 4; ++m) _Pragma("unroll") for (int n = 0; n < 2; ++n) { \
        if constexpr (Epi::F8 != 0) asm volatile("v_mfma_scale_f32_16x16x128_f8f6f4 %0, %1, %2, %0, %3, %4 op_sel_hi:[0,0,0]" : "+v"(acc[ai][bj][m][n]) : "v"(PG8_CAT(Bt[n])), "v"(PG8_CAT(At[m])), "v"(f8w), "v"(f8a)); \
        else { _Pragma("unroll") for (int k = 0; k < 2; ++k) acc[ai][bj][m][n] = __builtin_amdgcn_mfma_f32_16x16x32_bf16(Bt[n][k], At[m][k], acc[ai][bj][m][n], 0, 0, 0); } } \
        __builtin_amdgcn_s_setprio(0); } while (0)
#define PG8_WAIT_V(n) asm volatile("s_waitcnt vmcnt(" #n ")" ::: "memory")
#define PG8_WAIT_L(n) asm volatile("s_waitcnt lgkmcnt(" #n ")" ::: "memory")
#define PG8_BAR __builtin_amdgcn_s_barrier()
#define PG8_SCHED __builtin_amdgcn_sched_barrier(0)
    Unit cur, nxt; int ui = 0;
    if (!S.next(0, cur)) return;
    int f8w = Epi::F8W, f8a = Epi::F8A; asm volatile("" : "+v"(f8w), "+v"(f8a));
    f32x4 acc[2][2][4][2];
#pragma unroll
    for (int a = 0; a < 2; ++a)
#pragma unroll
        for (int b = 0; b < 2; ++b)
#pragma unroll
            for (int m = 0; m < 4; ++m)
#pragma unroll
                for (int n = 0; n < 2; ++n) acc[a][b][m][n] = (f32x4){0.f, 0.f, 0.f, 0.f};
    bf16x8 At[4][2], B0[2][2], B1[2][2];
    const char* cA = (const char*)g.A + (size_t)cur.pm * tstepA; const char* cB = (const char*)g.Bt + (size_t)cur.pn * tstepB;
    PG8_STAGE(PG8_SB(0, 0), cB, voffB); PG8_STAGE(PG8_SB(0, 1), cB + hstepB, voffB); PG8_STAGE(PG8_SA(0, 0), cA, voffA); PG8_STAGE(PG8_SA(0, 1), cA + hstepA, voffA);
    if (wr == 1) PG8_BAR;
    PG8_WAIT_V(2); PG8_BAR;
    PG8_STAGE(PG8_SB(1, 0), cB + kstep, voffB); PG8_STAGE(PG8_SA(1, 0), cA + kstep, voffA); PG8_STAGE(PG8_SB(1, 1), cB + hstepB + kstep, voffB);
    PG8_WAIT_V(6); PG8_BAR;
    for (;;) {
        const bool has_next = S.next(ui + 1, nxt);
        const char* nA = has_next ? (const char*)g.A + (size_t)nxt.pm * tstepA : cA; const char* nB = has_next ? (const char*)g.Bt + (size_t)nxt.pn * tstepB : cB;
#pragma unroll 1
        for (int t = 0; t < nt; t += 2) {
            const bool last = (t == nt - 2);
            const char* a1 = cA + (size_t)(t + 1) * kstep;
            const char* a2 = last ? nA : cA + (size_t)(t + 2) * kstep; const char* b2 = last ? nB : cB + (size_t)(t + 2) * kstep;
            const char* a3 = a2 + kstep; const char* b3 = b2 + kstep;
            PG8_LDB(B0, 0, 0); PG8_LDB(B1, 0, 1); PG8_SCHED; PG8_LDA(At, 0, 0); PG8_STAGE(PG8_SA(1, 1), a1 + hstepA, voffA);
            PG8_WAIT_V(8); PG8_WAIT_L(0); PG8_BAR; PG8_MMA(0, 0, At, B0); PG8_MMA(0, 1, At, B1); PG8_BAR; PG8_SCHED;
            PG8_LDA(At, 0, 1); PG8_STAGE(PG8_SB(0, 0), b2, voffB); PG8_STAGE(PG8_SB(0, 1), b2 + hstepB, voffB); PG8_STAGE(PG8_SA(0, 0), a2, voffA);
            PG8_WAIT_V(8); PG8_WAIT_L(0); PG8_BAR; PG8_MMA(1, 0, At, B0); PG8_MMA(1, 1, At, B1); PG8_BAR; PG8_SCHED;
            PG8_LDB(B0, 1, 0); PG8_LDB(B1, 1, 1); PG8_SCHED; PG8_LDA(At, 1, 0); PG8_STAGE(PG8_SA(0, 1), a2 + hstepA, voffA);
            PG8_WAIT_V(8); PG8_WAIT_L(0); PG8_BAR; PG8_MMA(0, 0, At, B0); PG8_MMA(0, 1, At, B1); PG8_BAR; PG8_SCHED;
            PG8_LDA(At, 1, 1); PG8_STAGE(PG8_SB(1, 0), b3, voffB); PG8_STAGE(PG8_SB(1, 1), b3 + hstepB, voffB); PG8_STAGE(PG8_SA(1, 0), a3, voffA);
            PG8_WAIT_V(8); PG8_WAIT_L(0); PG8_BAR; PG8_MMA(1, 0, At, B0); PG8_MMA(1, 1, At, B1); PG8_BAR; PG8_SCHED;
            if constexpr (Epi::MIDK != 0) { if (t + 2 == Epi::MIDK) { if (wr == 0) PG8_BAR; if constexpr (Epi::F8 != 0) asm volatile("s_nop 15\n\ts_nop 7" ::: "memory"); E.mid(acc, cur, wr, wc, fr, fq); if constexpr (Epi::F8 != 0) asm volatile("s_nop 7" ::: "memory"); if (wr == 1) PG8_BAR; } }
        }
        if constexpr (ALIGN_EPI) { if (wr == 0) PG8_BAR; }
        if constexpr (Epi::F8 != 0) asm volatile("s_nop 15\n\ts_nop 7" ::: "memory");
        E(acc, cur, wr, wc, fr, fq);
        if (!has_next) break;
#pragma unroll
        for (int a = 0; a < 2; ++a)
#pragma unroll
            for (int b = 0; b < 2; ++b)
#pragma unroll
                for (int m = 0; m < 4; ++m)
#pragma unroll
                    for (int n = 0; n < 2; ++n) acc[a][b][m][n] = (f32x4){0.f, 0.f, 0.f, 0.f};
        cur = nxt; cA = nA; cB = nB; ++ui;
        if constexpr (ALIGN_EPI) { if (wr == 1) PG8_BAR; }
    }
    PG8_WAIT_V(0);
    if constexpr (!ALIGN_EPI) { if (wr == 0) PG8_BAR; }
    PG8_BAR;
#undef PG8_SA
#undef PG8_SB
#undef PG8_STAGE
#undef PG8_LDA
#undef PG8_LDB
#undef PG8_MMA
#undef PG8_CAT
#undef PG8_WAIT_V
#undef PG8_WAIT_L
#undef PG8_BAR
#undef PG8_SCHED
}
}

#ifndef PROBE_P3
#define PROBE_P3 1
#endif
#define PROBE_P0 1
#define PROBE_BAR 0
#ifndef PROBE_SPAN
#define PROBE_SPAN 0
#endif
#define PROBE_DPRE 1
#define PROBE_DIDX 1
#define PROBE_DTHR 1
#define PROBE_DATT 1
#define PROBE_NSA 1
#define PROBE_P1 1
#define PROBE_P2 1
#define PROBE_P4 1
#define PROBE_P5 1
#define PROBE_P6 1
constexpr int NWAVES = 8;
constexpr int BATCH = 8, SEQ = 2048, DM = 1024, M = BATCH * SEQ, FF = 4096;
constexpr int NPROJ = 4352;
constexpr int PITCH = 2304;
constexpr int C_QI = 0, C_KI = 256, C_WI = 288, C_GB = 296, C_QB = 320, C_KC = 832, C_QA = 1024, C_CA = 1536, C_VC = 1664, C_KS = 1792, C_VS = 1920, C_KW = 2048, C_VW = 2176, C_GM = 2304;
constexpr int NCMP = 127, TOPK = 256;
constexpr float RMS_EPS = 1e-6f;
constexpr float LOG2E = 1.4426950408889634f;
constexpr float QSCALE = 0.125f * LOG2E;

constexpr size_t MiB = 1u << 20;
constexpr size_t WS_CTL = 0, CTL_ZERO_BYTES = 64 * 1024;
constexpr size_t WS_WIN = 1 * MiB;
constexpr size_t WS_WIN8C = 3 * MiB;
constexpr size_t WS_WIN8T = 6 * MiB;
constexpr size_t WS_WLT = 9 * MiB + 512 * 1024;
constexpr size_t WS_W2T = WS_WLT + 64 * 1024;
constexpr size_t WS_W1T = 31 * MiB;
constexpr size_t WS_WUPA = 10 * MiB, WS_WUPB = 11 * MiB;
constexpr size_t WS_WOUT = 12 * MiB;
constexpr size_t WS_WFF1 = 14 * MiB;
constexpr size_t WS_WFF2 = 22 * MiB;
constexpr size_t WS_PARTS = 30 * MiB;
constexpr size_t WS_PROJ = 32 * MiB;
constexpr size_t WS_GT = 104 * MiB;
constexpr size_t WS_MERGED = 168 * MiB;
constexpr size_t WS_H8 = 184 * MiB;
constexpr size_t WS_X1B = 200 * MiB;
constexpr size_t WS_OUTSCR = 232 * MiB;
constexpr size_t WS_END = 248 * MiB;
constexpr size_t DO_H = 0;
constexpr size_t DO_O = 0;
constexpr size_t DO_KA = 32 * MiB;
constexpr size_t DO_VA = 34 * MiB;
constexpr size_t DO_VAT = 36 * MiB;
constexpr size_t DO_VST = 38 * MiB;
constexpr size_t DO_VWT = 42 * MiB;
constexpr size_t DO_KC = 46 * MiB;
constexpr size_t DO_VC = 47 * MiB;
constexpr size_t DO_VCT = 48 * MiB;

constexpr int CW_BAR = 4096;
constexpr int RING_BYTES = 131072;
constexpr int MISC_OFF = 141312 + 64;
constexpr int LDS_BYTES = 147456;

#define GAS __attribute__((address_space(1)))
#define LAS __attribute__((address_space(3)))
typedef unsigned short bf16;
typedef unsigned v4u __attribute__((ext_vector_type(4)));
typedef float f32x4 __attribute__((ext_vector_type(4)));
#define LDS_WAIT() asm volatile("s_waitcnt lgkmcnt(0)" ::: "memory")
typedef short bf16x8 __attribute__((ext_vector_type(8)));
typedef float f32x16 __attribute__((ext_vector_type(16)));
typedef unsigned long long u64;
typedef u64 u64x2 __attribute__((ext_vector_type(2)));

__device__ __forceinline__ unsigned f2bf(float f) { unsigned u = __builtin_bit_cast(unsigned, f); return (u + 0x7fffu + ((u >> 16) & 1u)) >> 16; }
__device__ __forceinline__ unsigned pk2(float lo, float hi) { return f2bf(lo) | (f2bf(hi) << 16); }
__device__ __forceinline__ float bf2f(bf16 b) { return __uint_as_float((unsigned)b << 16); }
__device__ __forceinline__ void unpack8(const v4u w, float* o) {
    o[0] = __uint_as_float(w.x << 16); o[1] = __uint_as_float(w.x & 0xffff0000u); o[2] = __uint_as_float(w.y << 16); o[3] = __uint_as_float(w.y & 0xffff0000u);
    o[4] = __uint_as_float(w.z << 16); o[5] = __uint_as_float(w.z & 0xffff0000u); o[6] = __uint_as_float(w.w << 16); o[7] = __uint_as_float(w.w & 0xffff0000u);
}
__device__ __forceinline__ float xhalf_max(float v) { auto rr = __builtin_amdgcn_permlane32_swap(__float_as_uint(v), __float_as_uint(v), false, false); return fmaxf(__uint_as_float(rr[0]), __uint_as_float(rr[1])); }
__device__ __forceinline__ float xhalf_sum(float v) { auto rr = __builtin_amdgcn_permlane32_swap(__float_as_uint(v), __float_as_uint(v), false, false); return __uint_as_float(rr[0]) + __uint_as_float(rr[1]); }
typedef float f32x2_t __attribute__((ext_vector_type(2))); typedef __bf16 bf16x2_t __attribute__((ext_vector_type(2)));
__device__ __forceinline__ unsigned cvt2(float lo, float hi) { const f32x2_t v = {lo, hi}; const bf16x2_t b = __builtin_convertvector(v, bf16x2_t); return __builtin_bit_cast(unsigned, b); }
__device__ __forceinline__ float wave_sum(float v) {
#pragma unroll
    for (int o = 1; o < 64; o <<= 1) v += __shfl_xor(v, o);
    return v;
}
__device__ __forceinline__ float wave_max(float v) {
#pragma unroll
    for (int o = 1; o < 64; o <<= 1) v = fmaxf(v, __shfl_xor(v, o));
    return v;
}
__device__ __forceinline__ int wave_sum_i(int v) {
#pragma unroll
    for (int o = 1; o < 64; o <<= 1) v += __shfl_xor(v, o);
    return v;
}

#define XB_TMO      128
#define XB_XCNT(j)  (256  + 64 * (j))
#define XB_XSUB(j)  (1280 + 64 * (j))
#define XB_XGEN(j)  (2304 + 64 * (j))
#define XB_TOP      3328
#define XB_TOPGEN   3392
#define XCD_BAR_WORDS 3456
#define XB_SPIN_CAP (1u << 23)

__device__ __forceinline__ unsigned xb_ld(unsigned* p)              { return __hip_atomic_load(p, __ATOMIC_RELAXED, __HIP_MEMORY_SCOPE_AGENT); }
__device__ __forceinline__ unsigned xb_add(unsigned* p, unsigned v) { return __hip_atomic_fetch_add(p, v, __ATOMIC_RELAXED, __HIP_MEMORY_SCOPE_AGENT); }
__device__ __forceinline__ unsigned xb_xcc_id() { return (unsigned)__builtin_amdgcn_s_getreg((3 << 11) | 20) & 0xFu; }
#define XB_SPIN(cond, bar) do { unsigned _sp = 0; while (cond) { __builtin_amdgcn_s_sleep(1); \
    if ((++_sp & 255u) == 0u) { if (xb_ld(&(bar)[XB_TMO])) break; if (_sp > XB_SPIN_CAP) { atomicAdd(&(bar)[XB_TMO], 1u); break; } } } } while (0)

struct XcdBarrier { unsigned* bar; unsigned x; volatile LAS unsigned* st; };

__device__ __forceinline__ XcdBarrier xcd_barrier_post(unsigned* bar, volatile LAS unsigned* st) {
    XcdBarrier b; b.bar = bar; b.x = xb_xcc_id(); b.st = st;
    if (threadIdx.x == 0) (void)xb_add(&bar[XB_XCNT(b.x)], 1u);
    return b;
}
__device__ __forceinline__ void xcd_barrier_complete(unsigned* bar, unsigned x, unsigned& nloc, unsigned& nx) {
    const unsigned G = gridDim.x * gridDim.y * gridDim.z;
    unsigned sum, cnt, mine, sp = 0u;
    for (;;) {
        sum = 0u; cnt = 0u; mine = 0u;
#pragma unroll
        for (unsigned j = 0; j < 16; ++j) { const unsigned c = xb_ld(&bar[XB_XCNT(j)]); sum += c; cnt += (c > 0u) ? 1u : 0u; mine = (j == x) ? c : mine; }
        if (sum == G) break;
        __builtin_amdgcn_s_sleep(1);
        if ((++sp & 255u) == 0u) { if (xb_ld(&bar[XB_TMO])) break; if (sp > XB_SPIN_CAP) { atomicAdd(&bar[XB_TMO], 1u); break; } }
    }
    nloc = mine > 0u ? mine : 1u; nx = cnt > 0u ? cnt : 1u;
}
__device__ __forceinline__ void xcd_barrier(const XcdBarrier& b) {
    asm volatile("s_waitcnt vmcnt(0)" ::: "memory");
    __syncthreads();
    if (threadIdx.x == 0) {
        unsigned* bar = b.bar;
        __builtin_amdgcn_s_waitcnt(0);
        unsigned nloc = b.st[0], nx = b.st[1];
        if (nloc == 0u) { xcd_barrier_complete(bar, b.x, nloc, nx); b.st[0] = nloc; b.st[1] = nx; }
        const unsigned old = xb_add(&bar[XB_XSUB(b.x)], 1u);
        const unsigned gen = old / nloc;
        if (old + 1u == (gen + 1u) * nloc) {
            __builtin_amdgcn_fence(__ATOMIC_RELEASE, "agent");
            asm volatile("s_waitcnt vmcnt(0)" ::: "memory");
            const unsigned og = xb_add(&bar[XB_TOP], 1u);
            const unsigned tg = og / nx;
            if (og + 1u == (tg + 1u) * nx) xb_add(&bar[XB_TOPGEN], 1u);
            else XB_SPIN(xb_ld(&bar[XB_TOPGEN]) == tg, bar);
            __builtin_amdgcn_fence(__ATOMIC_ACQUIRE, "agent");
            xb_add(&bar[XB_XGEN(b.x)], 1u);
            asm volatile("s_waitcnt vmcnt(0)" ::: "memory");
        } else {
            XB_SPIN(xb_ld(&bar[XB_XGEN(b.x)]) == gen, bar);
            __builtin_amdgcn_fence(__ATOMIC_ACQUIRE, "agent");
            asm volatile("s_waitcnt vmcnt(0)" ::: "memory");
        }
    }
    __syncthreads();
}

__device__ __forceinline__ int proj_src_col(int f) {
    if (f < 256) return 640 + f;
    if (f < 288) return 896 + (f - 256);
    if (f < 296) return 928 + (f - 288);
    if (f < 320) return 2216 + (f - 296);
    if (f < 832) return 936 + (f - 320);
    if (f < 960) return 1448 + (f - 832);
    if (f < 1024) return -1;
    if (f < 1536) return f - 1024;
    if (f < 1664) return 512 + (f - 1536);
    if (f < 1792) return 1576 + (f - 1664);
    if (f < 1920) return 1704 + (f - 1792);
    if (f < 2048) return 1832 + (f - 1920);
    if (f < 2176) return 1960 + (f - 2048);
    return 2088 + (f - 2176);
}
struct Ptrs {
    const float* in[23]; float* out; unsigned char* ws;
};

constexpr int I_IN = (DM / 64) * (1024 / 32), I_INB = (DM / 64) * (1024 / 32), I_IN8 = (DM / 64) * (256 / 32), I_ING = (DM / 64) * (2048 / 32), I_UP = (512 / 64) * (DM / 32), I_OUT = (DM / 64) * (DM / 32), I_F1 = (DM / 64) * (FF / 32), I_F2 = (FF / 64) * (DM / 32);
constexpr int I_LT = 4, I_P1 = (2048 / 64) * (128 / 32), I_P2 = 4;
constexpr int P0_EARLY = I_IN + I_INB + I_IN8 + I_ING + 2 * I_LT + 2 * I_P1 + 2 * I_P2, P0_ALL = P0_EARLY + 2 * I_UP + I_OUT + I_F1 + I_F2;
struct P0Item { const float* W; const float* gk; unsigned char* WT; int N, Ndest, dpitch, koff, r, dnoff; float f8s; bool projmap; };
__device__ __forceinline__ P0Item p0_decode(const Ptrs& P, int it) {
    P0Item d; d.gk = nullptr; d.koff = 0; d.f8s = 0.f; d.projmap = false; d.dnoff = 0; int r = it;
    do {
        if (r < I_IN) { d.W = P.in[2]; d.N = 4288; d.Ndest = 1024; d.WT = P.ws + WS_WIN; d.dpitch = DM; d.projmap = true; break; } r -= I_IN;
        if (r < I_INB) { d.W = P.in[2]; d.N = 4288; d.Ndest = 1024; d.WT = P.ws + WS_WIN8C; d.dpitch = DM; d.projmap = true; d.dnoff = 1024; d.f8s = 32.f; break; } r -= I_INB;
        if (r < I_IN8) { d.W = P.in[2]; d.N = 4288; d.Ndest = 256; d.WT = P.ws + WS_WIN8T; d.dpitch = DM; d.projmap = true; d.dnoff = 2048; d.f8s = 32.f; break; } r -= I_IN8;
        if (r < I_ING) { d.W = P.in[2] + 2240; d.N = 4288; d.Ndest = 2048; d.WT = P.ws + WS_WIN8C + (size_t)1024 * 1024; d.dpitch = DM; d.f8s = 32.f; break; } r -= I_ING;
        if (r < I_LT) { d.W = P.in[6]; d.N = 64; d.Ndest = 64; d.WT = P.ws + WS_WLT; d.dpitch = 128; d.gk = P.in[5]; break; } r -= I_LT;
        if (r < I_LT) { d.W = P.in[7]; d.N = 64; d.Ndest = 64; d.WT = P.ws + WS_WLT + 64 * 128 * 2; d.dpitch = 128; d.gk = P.in[5]; break; } r -= I_LT;
        if (r < I_P1) { d.W = P.in[13]; d.N = 128; d.Ndest = 128; d.WT = P.ws + WS_W1T; d.dpitch = 2048; break; } r -= I_P1;
        if (r < I_P1) { d.W = P.in[15]; d.N = 128; d.Ndest = 128; d.WT = P.ws + WS_W1T + 128 * 2048 * 2; d.dpitch = 2048; break; } r -= I_P1;
        if (r < I_P2) { d.W = P.in[14]; d.N = 64; d.Ndest = 64; d.WT = P.ws + WS_W2T; d.dpitch = 128; break; } r -= I_P2;
        if (r < I_P2) { d.W = P.in[16]; d.N = 64; d.Ndest = 64; d.WT = P.ws + WS_W2T + 64 * 128 * 2; d.dpitch = 128; break; } r -= I_P2;
        if (r < I_UP) { d.W = P.in[17]; d.N = DM; d.Ndest = DM; d.WT = P.ws + WS_WUPA; d.dpitch = DM; d.f8s = 32.f; break; } r -= I_UP;
        if (r < I_UP) { d.W = P.in[18]; d.N = DM; d.Ndest = DM; d.WT = P.ws + WS_WUPA; d.dpitch = DM; d.koff = 512; d.f8s = 32.f; break; } r -= I_UP;
        if (r < I_OUT) { d.W = P.in[19]; d.N = DM; d.Ndest = DM; d.WT = P.ws + WS_WOUT; d.dpitch = DM; d.f8s = 32.f; break; } r -= I_OUT;
        if (r < I_F1) { d.W = P.in[21]; d.N = FF; d.Ndest = FF; d.WT = P.ws + WS_WFF1; d.dpitch = DM; d.gk = P.in[20]; d.f8s = 64.f; break; } r -= I_F1;
        d.W = P.in[22]; d.N = DM; d.Ndest = DM; d.WT = P.ws + WS_WFF2; d.dpitch = FF; d.f8s = 128.f;
    } while (0);
    d.r = r; return d;
}
struct P0Regs { float tv[32]; f32x4 g0, g1; };
__device__ __forceinline__ void p0_load(const P0Item& d, int lane, P0Regs& R) {
    const int nblk = d.Ndest / 32, kb = d.r / nblk, nb = d.r % nblk, k0 = 64 * kb, n0 = 32 * nb;
    const int dn = n0 + (lane & 31); const int dg = dn + d.dnoff; const int cl = dg & 255; const int sc = d.projmap ? proj_src_col((dg & ~255) + ((cl >> 5) & 3) * 64 + (cl >> 7) * 32 + (cl & 31)) : dn;
    const float* wp = d.W + (size_t)(k0 + (lane >> 5)) * d.N + (sc >= 0 ? sc : 0);
#pragma unroll
    for (int i = 0; i < 32; ++i) R.tv[i] = wp[(size_t)(2 * i) * d.N];
    if (sc < 0) {
#pragma unroll
        for (int i = 0; i < 32; ++i) R.tv[i] = 0.f; }
    if (d.gk) { const GAS f32x4* gp = (const GAS f32x4*)(d.gk + k0 + 8 * (lane & 7)); R.g0 = gp[0]; R.g1 = gp[1]; } else { R.g0 = (f32x4){1.f, 1.f, 1.f, 1.f}; R.g1 = R.g0; }
}
__device__ __forceinline__ void p0_finish(const P0Item& d, const P0Regs& R, LAS float* scr, int lane) {
    const int nblk = d.Ndest / 32, kb = d.r / nblk, nb = d.r % nblk, k0 = 64 * kb, n0 = 32 * nb;
#pragma unroll
    for (int i = 0; i < 32; ++i) { const int kk = 2 * i + (lane >> 5); scr[kk * 33 + (lane & 31)] = R.tv[i]; }
    LDS_WAIT();
    const int c = lane & 7; const float f = d.f8s != 0.f ? d.f8s : 1.f;
    const float m0 = R.g0[0] * f, m1 = R.g0[1] * f, m2 = R.g0[2] * f, m3 = R.g0[3] * f, m4 = R.g1[0] * f, m5 = R.g1[1] * f, m6 = R.g1[2] * f, m7 = R.g1[3] * f;
#pragma unroll
    for (int j = 0; j < 4; ++j) { const int n = (lane >> 3) + 8 * j; const LAS float* s = scr + (8 * c) * 33 + n;
        const float v0 = s[0 * 33] * m0, v1 = s[1 * 33] * m1, v2 = s[2 * 33] * m2, v3 = s[3 * 33] * m3, v4 = s[4 * 33] * m4, v5 = s[5 * 33] * m5, v6 = s[6 * 33] * m6, v7 = s[7 * 33] * m7;
        const size_t eo = (size_t)(n0 + n) * d.dpitch + d.koff + k0 + 8 * c;
        if (d.f8s != 0.f) { pg8::u32x2 o; o.x = pg8::cvt4_fp8(v0, v1, v2, v3); o.y = pg8::cvt4_fp8(v4, v5, v6, v7); *(GAS pg8::u32x2*)(d.WT + eo) = o; }
        else { v4u o; o.x = pk2(v0, v1); o.y = pk2(v2, v3); o.z = pk2(v4, v5); o.w = pk2(v6, v7); *(GAS v4u*)(d.WT + 2 * eo) = o; } }
    LDS_WAIT();
}
__device__ __forceinline__ void p0_items(const Ptrs& P, LAS unsigned char* lds, int first, int last, int worker, int nworkers, int wave, int lane) {
    LAS float* scr = (LAS float*)(lds + wave * 16384);
    int it = first + worker;
    if (it >= last) return;
    P0Item dA = p0_decode(P, it), dB = dA; P0Regs rA, rB; p0_load(dA, lane, rA);
    for (;;) {
        int nx = it + nworkers; bool more = nx < last;
        if (more) { dB = p0_decode(P, nx); p0_load(dB, lane, rB); }
        p0_finish(dA, rA, scr, lane);
        if (!more) break;
        it = nx; nx = it + nworkers; more = nx < last;
        if (more) { dA = p0_decode(P, nx); p0_load(dA, lane, rA); }
        p0_finish(dB, rB, scr, lane);
        if (!more) break;
        it = nx;
    }
}
__device__ __forceinline__ void p0_prologue(const Ptrs& P, LAS unsigned char* lds, int gw, int NGW, int wave, int lane) {
    bf16* H = (bf16*)((unsigned char*)P.out + DO_H); unsigned char* H8 = P.ws + WS_H8;
    f32x4 va[4], vb[4];
    { const int m = gw, m2 = m + NGW < M ? m + NGW : m;
      const GAS f32x4* xa = (const GAS f32x4*)(P.in[0] + (size_t)m * DM) + lane; const GAS f32x4* xb = (const GAS f32x4*)(P.in[0] + (size_t)m2 * DM) + lane;
#pragma unroll
      for (int j = 0; j < 4; ++j) { va[j] = xa[64 * j]; vb[j] = xb[64 * j]; } }
    p0_items(P, lds, 0, P0_EARLY, gw, NGW, wave, lane);
#define P0_ROWS_LOAD(VA, VB, MM) { const int m_ = (MM), m2_ = m_ + NGW < M ? m_ + NGW : m_; \
        const GAS f32x4* xa_ = (const GAS f32x4*)(P.in[0] + (size_t)m_ * DM) + lane; const GAS f32x4* xb_ = (const GAS f32x4*)(P.in[0] + (size_t)m2_ * DM) + lane; \
        _Pragma("unroll") for (int j = 0; j < 4; ++j) { VA[j] = xa_[64 * j]; VB[j] = xb_[64 * j]; } }
#define P0_ROWS_DO(VA, VB, MM) { const int mr_ = (MM), mr2_ = mr_ + NGW < M ? mr_ + NGW : mr_; \
        const GAS f32x4* gr = (const GAS f32x4*)P.in[1] + lane; float sa = 0.f, sb = 0.f; \
        _Pragma("unroll") for (int j = 0; j < 4; ++j) { sa += (VA[j].x * VA[j].x + VA[j].y * VA[j].y) + (VA[j].z * VA[j].z + VA[j].w * VA[j].w); sb += (VB[j].x * VB[j].x + VB[j].y * VB[j].y) + (VB[j].z * VB[j].z + VB[j].w * VB[j].w); } \
        const float ra = rsqrtf(wave_sum(sa) * (1.f / DM) + RMS_EPS), rb = rsqrtf(wave_sum(sb) * (1.f / DM) + RMS_EPS); \
        GAS unsigned long long* oa = (GAS unsigned long long*)(H + (size_t)mr_ * DM) + lane; GAS unsigned long long* ob = (GAS unsigned long long*)(H + (size_t)mr2_ * DM) + lane; \
        GAS unsigned* qa = (GAS unsigned*)(H8 + (size_t)mr_ * DM) + lane; GAS unsigned* qb = (GAS unsigned*)(H8 + (size_t)mr2_ * DM) + lane; \
        _Pragma("unroll") for (int j = 0; j < 4; ++j) { const f32x4 gg = gr[64 * j]; \
            oa[64 * j] = (unsigned long long)pk2(VA[j].x * ra * gg.x, VA[j].y * ra * gg.y) | ((unsigned long long)pk2(VA[j].z * ra * gg.z, VA[j].w * ra * gg.w) << 32); \
            qa[64 * j] = pg8::cvt4_fp8(VA[j].x * ra * gg.x, VA[j].y * ra * gg.y, VA[j].z * ra * gg.z, VA[j].w * ra * gg.w); \
            if (mr2_ != mr_) { ob[64 * j] = (unsigned long long)pk2(VB[j].x * rb * gg.x, VB[j].y * rb * gg.y) | ((unsigned long long)pk2(VB[j].z * rb * gg.z, VB[j].w * rb * gg.w) << 32); \
                qb[64 * j] = pg8::cvt4_fp8(VB[j].x * rb * gg.x, VB[j].y * rb * gg.y, VB[j].z * rb * gg.z, VB[j].w * rb * gg.w); } } }
    f32x4 na[4], nb[4];
    for (int m = gw; m < M; ) {
        int mn = m + 2 * NGW;
        if (mn < M) P0_ROWS_LOAD(na, nb, mn)
        P0_ROWS_DO(va, vb, m)
        if (mn >= M) break;
        m = mn; mn = m + 2 * NGW;
        if (mn < M) P0_ROWS_LOAD(va, vb, mn)
        P0_ROWS_DO(na, nb, m)
        if (mn >= M) break;
        m = mn;
    }
#undef P0_ROWS_LOAD
#undef P0_ROWS_DO
}

__device__ __forceinline__ float gelu_tanh(float x) { const float u = 0.7978845608028654f * (x + 0.044715f * x * x * x); return 0.5f * x * (1.0f + tanhf(u)); }

__device__ __forceinline__ void latent_group(const Ptrs& P, int grp, int lane) {
    const int r32 = lane & 31, hi = lane >> 5; const int tok = 32 * grp + r32;
    const bf16* PROJ = (const bf16*)(P.ws + WS_PROJ); const bf16* WLT = (const bf16*)(P.ws + WS_WLT);
    unsigned char* dob = (unsigned char*)P.out; bf16* KA = (bf16*)(dob + DO_KA); bf16* VAT = (bf16*)(dob + DO_VAT);
    bf16x8 cb[8]; float ss = 0.f;
    const bf16* cp = PROJ + (size_t)tok * PITCH + C_CA + hi * 8;
#pragma unroll
    for (int ks = 0; ks < 8; ++ks) { const v4u w = *(const GAS v4u*)(cp + ks * 16); cb[ks] = __builtin_bit_cast(bf16x8, w); float f[8]; unpack8(w, f);
#pragma unroll
        for (int j = 0; j < 8; ++j) ss += f[j] * f[j]; }
    ss = xhalf_sum(ss);
    const float rstd = rsqrtf(ss * (1.f / 128.f) + RMS_EPS);
    f32x16 acc[4];
#pragma unroll
    for (int nb = 0; nb < 4; ++nb) {
#pragma unroll
        for (int r = 0; r < 16; ++r) acc[nb][r] = 0.f;
#pragma unroll
        for (int ks = 0; ks < 8; ++ks) { const bf16x8 a = *(const GAS bf16x8*)(WLT + (size_t)(32 * nb + r32) * 128 + ks * 16 + hi * 8); acc[nb] = __builtin_amdgcn_mfma_f32_32x32x16_bf16(a, cb[ks], acc[nb], 0, 0, 0); } }
    float sk = 0.f;
#pragma unroll
    for (int nb = 0; nb < 2; ++nb)
#pragma unroll
        for (int r = 0; r < 16; ++r) { const float v = acc[nb][r] * rstd; sk += v * v; }
    sk = xhalf_sum(sk);
    const float kr = rsqrtf(sk * (1.f / 64.f) + RMS_EPS) * rstd;
    const float* gk = P.in[4];
#pragma unroll
    for (int nb = 0; nb < 2; ++nb)
#pragma unroll
        for (int a = 0; a < 4; ++a) { const int n0 = 32 * nb + 8 * a + 4 * hi; const f32x4 gg = *(const GAS f32x4*)(gk + n0);
            pg8::u32x2 w; w.x = pg8::cvt_pk_bf16(acc[nb][4 * a] * kr * gg[0], acc[nb][4 * a + 1] * kr * gg[1]); w.y = pg8::cvt_pk_bf16(acc[nb][4 * a + 2] * kr * gg[2], acc[nb][4 * a + 3] * kr * gg[3]);
            *(GAS pg8::u32x2*)(KA + (size_t)tok * 64 + n0) = w; }
    const int b = tok / SEQ, s = tok % SEQ;
#pragma unroll
    for (int nb = 2; nb < 4; ++nb)
#pragma unroll
        for (int r = 0; r < 16; ++r) { const int d = 32 * (nb - 2) + (r & 3) + 8 * (r >> 2) + 4 * hi; VAT[((size_t)b * 64 + d) * SEQ + s] = (bf16)f2bf(acc[nb][r] * rstd); }
}
__device__ __forceinline__ void compress_unit(const Ptrs& P, LAS unsigned char* lds, int unit, int tid, int wave, int lane) {
    const int cbk = unit & 3, kh = (unit >> 2) & 1, b = (unit >> 3) & 7, kv = unit >> 6;
    const int r32 = lane & 31, hi = lane >> 5, nb = wave & 3, kq = wave >> 2;
    const bf16* PROJ = (const bf16*)(P.ws + WS_PROJ);
    const bf16* W1T = (const bf16*)(P.ws + WS_W1T) + (size_t)kv * 128 * 2048; const bf16* W2T = (const bf16*)(P.ws + WS_W2T) + (size_t)kv * 64 * 128;
    unsigned char* dob = (unsigned char*)P.out; bf16* KC = (bf16*)(dob + DO_KC); bf16* VCT = (bf16*)(dob + DO_VCT);
    const bf16* src = PROJ + (size_t)(b * SEQ) * PITCH + (kv ? C_VC : C_KC) + kh * 64;
    const float* pe = P.in[12];
    const int c = 32 * cbk + r32;
    LAS float* red = (LAS float*)lds;
    LAS float* peL = (LAS float*)(lds + 32768);
    for (int i = tid; i < 2048; i += NWAVES * 64) peL[i] = pe[i];
    __syncthreads();
    LAS unsigned char* hidL = lds + 16384;
    f32x16 acc;
#pragma unroll
    for (int r = 0; r < 16; ++r) acc[r] = 0.f;
    const bf16* w1p = W1T + (size_t)(32 * nb + r32) * 2048 + hi * 8;
#pragma unroll 8
    for (int ks = 64 * kq; ks < 64 * kq + 64; ++ks) {
        const int l = ks >> 2, d = 16 * (ks & 3) + 8 * hi; int tokn = 16 * c + l; tokn = tokn > SEQ - 1 ? SEQ - 1 : tokn;
        const v4u raw = *(const GAS v4u*)(src + (size_t)tokn * PITCH + d); float a8[8]; unpack8(raw, a8);
        const f32x4 p0 = *(LAS const f32x4*)(peL + l * 64 + d), p1 = *(LAS const f32x4*)(peL + l * 64 + d + 4);
        pg8::u32x4 aw; aw.x = cvt2(a8[0] + p0[0], a8[1] + p0[1]); aw.y = cvt2(a8[2] + p0[2], a8[3] + p0[3]); aw.z = cvt2(a8[4] + p1[0], a8[5] + p1[1]); aw.w = cvt2(a8[6] + p1[2], a8[7] + p1[3]);
        const bf16x8 bw = *(const GAS bf16x8*)(w1p + ks * 16);
        acc = __builtin_amdgcn_mfma_f32_32x32x16_bf16(__builtin_bit_cast(bf16x8, aw), bw, acc, 0, 0, 0);
    }
    if (kq == 1) {
#pragma unroll
        for (int r = 0; r < 16; ++r) red[(nb * 16 + r) * 64 + lane] = acc[r]; }
    __syncthreads();
    if (kq == 0) {
#pragma unroll
        for (int r = 0; r < 16; ++r) { const float h = gelu_tanh(acc[r] + red[(nb * 16 + r) * 64 + lane]); const int cr = (r & 3) + 8 * (r >> 2) + 4 * hi;
            *(LAS bf16*)(hidL + cr * 272 + (32 * nb + r32) * 2) = (bf16)f2bf(h); } }
    __syncthreads();
    if (wave == 0) {
        f32x16 o2[2];
#pragma unroll
        for (int db = 0; db < 2; ++db) {
#pragma unroll
            for (int r = 0; r < 16; ++r) o2[db][r] = 0.f;
#pragma unroll
            for (int ks = 0; ks < 8; ++ks) { const bf16x8 a = *(const GAS bf16x8*)(W2T + (size_t)(32 * db + r32) * 128 + ks * 16 + hi * 8);
                const bf16x8 hb = *(LAS const bf16x8*)(hidL + r32 * 272 + (ks * 16 + hi * 8) * 2);
                o2[db] = __builtin_amdgcn_mfma_f32_32x32x16_bf16(a, hb, o2[db], 0, 0, 0); } }
        const size_t bk = (size_t)(b * 2 + kh);
        if (kv == 0) {
            float sk = 0.f;
#pragma unroll
            for (int db = 0; db < 2; ++db)
#pragma unroll
                for (int r = 0; r < 16; ++r) sk += o2[db][r] * o2[db][r];
            sk = xhalf_sum(sk);
            const float kr = (c < NCMP) ? rsqrtf(sk * (1.f / 64.f) + RMS_EPS) : 0.f;
            const float* gkc = P.in[9];
#pragma unroll
            for (int db = 0; db < 2; ++db)
#pragma unroll
                for (int a = 0; a < 4; ++a) { const int d0 = 32 * db + 8 * a + 4 * hi; const f32x4 gg = *(const GAS f32x4*)(gkc + d0);
                    pg8::u32x2 w; w.x = pg8::cvt_pk_bf16(o2[db][4 * a] * kr * gg[0], o2[db][4 * a + 1] * kr * gg[1]); w.y = pg8::cvt_pk_bf16(o2[db][4 * a + 2] * kr * gg[2], o2[db][4 * a + 3] * kr * gg[3]);
                    *(GAS pg8::u32x2*)(KC + (bk * 128 + c) * 64 + d0) = w; }
        } else {
            const float z = (c < NCMP) ? 1.f : 0.f;
#pragma unroll
            for (int db = 0; db < 2; ++db)
#pragma unroll
                for (int r = 0; r < 16; ++r) { const int d = 32 * db + (r & 3) + 8 * (r >> 2) + 4 * hi; VCT[(bk * 64 + d) * 128 + c] = (bf16)f2bf(o2[db][r] * z); }
        }
    }
    __syncthreads();
}
__device__ __forceinline__ void p2_fast(const Ptrs& P, LAS unsigned char* lds, int vcu, int G, int tid, int wave, int lane) {
    for (int u = vcu; u < 128; u += G) compress_unit(P, lds, u, tid, wave, lane);
    for (int grp = G * NWAVES - 1 - (vcu * NWAVES + wave); grp < M / 32; grp += G * NWAVES) latent_group(P, grp, lane);
}

__device__ __forceinline__ unsigned ord_u32(float f) { const unsigned u = __float_as_uint(f); return (u & 0x80000000u) ? ~u : (u | 0x80000000u); }

__device__ __forceinline__ float inv_ord_u32(unsigned u) { return __uint_as_float((u & 0x80000000u) ? (u ^ 0x80000000u) : ~u); }
template <int CTRL> __device__ __forceinline__ unsigned dpp_mov(unsigned x) { return (unsigned)__builtin_amdgcn_update_dpp(0, (int)x, CTRL, 0xf, 0xf, true); }
__device__ __forceinline__ unsigned wave_umax(unsigned x) {
    unsigned y = dpp_mov<0xB1>(x); x = x > y ? x : y; y = dpp_mov<0x4E>(x); x = x > y ? x : y; y = dpp_mov<0x141>(x); x = x > y ? x : y; y = dpp_mov<0x140>(x); x = x > y ? x : y;
    const unsigned a = __builtin_amdgcn_readlane(x, 0), b = __builtin_amdgcn_readlane(x, 16), c = __builtin_amdgcn_readlane(x, 32), d = __builtin_amdgcn_readlane(x, 48);
    const unsigned ab = a > b ? a : b, cd = c > d ? c : d; return ab > cd ? ab : cd;
}
__device__ __forceinline__ unsigned wave_umin(unsigned x) {
    unsigned y = dpp_mov<0xB1>(x); x = x < y ? x : y; y = dpp_mov<0x4E>(x); x = x < y ? x : y; y = dpp_mov<0x141>(x); x = x < y ? x : y; y = dpp_mov<0x140>(x); x = x < y ? x : y;
    const unsigned a = __builtin_amdgcn_readlane(x, 0), b = __builtin_amdgcn_readlane(x, 16), c = __builtin_amdgcn_readlane(x, 32), d = __builtin_amdgcn_readlane(x, 48);
    const unsigned ab = a < b ? a : b, cd = c < d ? c : d; return ab < cd ? ab : cd;
}
__device__ __forceinline__ unsigned wave_usum(unsigned x) {
    x += dpp_mov<0xB1>(x); x += dpp_mov<0x4E>(x); x += dpp_mov<0x141>(x); x += dpp_mov<0x140>(x);
    return (__builtin_amdgcn_readlane(x, 0) + __builtin_amdgcn_readlane(x, 16)) + (__builtin_amdgcn_readlane(x, 32) + __builtin_amdgcn_readlane(x, 48));
}

constexpr int KT_STRIDE = 144, VT_STRIDE = 144;
constexpr int KT_BYTES = 64 * KT_STRIDE, VT_BYTES = 64 * VT_STRIDE, TILE_BYTES = KT_BYTES + VT_BYTES;
constexpr int A_TILE0 = 0, A_TILE1 = TILE_BYTES, A_STG = 36864, A_IMP = 69632, A_EFF = 102400, A_SEL = 110592;
constexpr int D_MASK = 131072, A_WSC = 139264;
constexpr int D_KMAX = 143360;
constexpr int D_M8 = 36864, M8_STRIDE = 2064;
constexpr int SROW = 2048;


__device__ __forceinline__ float max3f(float a, float b, float c) { float r; asm("v_max3_f32 %0, %1, %2, %3" : "=v"(r) : "v"(a), "v"(b), "v"(c)); return r; }
struct TileRegs { v4u k, v; };
__device__ __forceinline__ TileRegs tile_fetch(const bf16* Kb, size_t kpitch, const bf16* Vb, size_t vpitch, int tid) {
    const int row = tid >> 3, ch = tid & 7; TileRegs r;
    r.k = *(const GAS v4u*)(Kb + (size_t)row * kpitch + ch * 8);
    r.v = *(const GAS v4u*)(Vb + (size_t)row * vpitch + ch * 8);
    return r;
}
__device__ __forceinline__ void tile_store(LAS unsigned char* buf, const TileRegs& r, int tid) {
    const int row = tid >> 3, ch = tid & 7;
    *(LAS v4u*)(buf + row * KT_STRIDE + ch * 16) = r.k;
    LAS u64* vp = (LAS u64*)(buf + KT_BYTES + row * VT_STRIDE + (ch >> 1) * 32 + (ch & 1) * 8);
    vp[0] = (u64)r.v.x | ((u64)r.v.y << 32); vp[2] = (u64)r.v.z | ((u64)r.v.w << 32);
}
struct AttnState { f32x16 o0, o1, la; pg8::u32x4 qx; float m; bool started; };
struct KxOps { pg8::u32x4 k0, k1; };
__device__ __forceinline__ KxOps kx_ops(int r32, int hi) {
    KxOps k; k.k0 = (pg8::u32x4){0u, 0u, 0u, 0u}; k.k1 = k.k0;
    if (hi == 0) { const unsigned v0 = f2bf((float)r32), v1 = f2bf((float)(r32 + 32)); k.k0.y = v0 * 0x10001u; k.k1.y = v1 * 0x10001u; k.k0.z = k.k0.w = k.k1.z = k.k1.w = 0x3F803F80u; }
    return k;
}
__device__ __forceinline__ void attn_init(AttnState& s, float slope2, int hi) {
#pragma unroll
    for (int r = 0; r < 16; ++r) { s.o0[r] = 0.f; s.o1[r] = 0.f; s.la[r] = 0.f; }
    s.qx = (pg8::u32x4){0u, 0u, 0u, 0u};
    if (hi == 0) { const unsigned sh = f2bf(slope2); const unsigned sl = f2bf(slope2 - __uint_as_float(sh << 16)); s.qx.x = sh | (sl << 16); s.qx.y = s.qx.x; }
    s.m = 0.f; s.started = false;
}
__device__ __forceinline__ void attn_init_fixed(AttnState& s, float slope2, float m0, int hi) {
    attn_init(s, slope2, hi); s.m = m0; s.started = true;
    const float nm = -m0; const unsigned m1 = f2bf(nm); const float r1 = nm - __uint_as_float(m1 << 16); const unsigned m2 = f2bf(r1); const float r2 = r1 - __uint_as_float(m2 << 16); const unsigned m3 = f2bf(r2);
    if (hi == 0) { s.qx.z = m1 | (m2 << 16); s.qx.w = m3; }
}
__device__ __forceinline__ bf16x8 pack8(const f32x16& p, int b0) {
    pg8::u32x4 w; w.x = cvt2(p[b0], p[b0 + 1]); w.y = cvt2(p[b0 + 2], p[b0 + 3]); w.z = cvt2(p[b0 + 4], p[b0 + 5]); w.w = cvt2(p[b0 + 6], p[b0 + 7]);
    return __builtin_bit_cast(bf16x8, w);
}
constexpr float ATT_THR = 8.0f;
struct MaskMM { pg8::i32x8 a0, a1; LAS const unsigned char* row; };
template <bool BITS, bool IMP, bool QLDS, bool FIXM = false>
__device__ __forceinline__ void tile_compute(AttnState& st, const bf16x8 (&qf)[4], LAS const unsigned char* qlds, KxOps& KX, float koff, bool active, bool all_active, LAS const unsigned char* buf, LAS float* wsc,
                                             bool need_mask, int lo, int hi_, unsigned mw0, unsigned mw1, f32x16& oimp, int c0, int r32, int hi, const MaskMM* mm = nullptr) {
    f32x16 p0, p1;
    { const unsigned kw = (hi == 0) ? f2bf(koff) * 0x10001u : 0u; KX.k0.x = kw; KX.k1.x = kw;
      pg8::u32x4 q = st.qx; if (!all_active) q.w = (q.w & 0xffffu) | ((active || hi != 0) ? 0u : 0xff800000u);
#pragma unroll
      for (int r = 0; r < 16; ++r) { p0[r] = 0.f; p1[r] = 0.f; }
      if (BITS) {
          const pg8::i32x8 mb = *(LAS const pg8::i32x8*)(mm->row + mw0);
          p0 = __builtin_amdgcn_mfma_scale_f32_32x32x64_f8f6f4(mm->a0, mb, p0, 0, 0, 0, 0x7F7F7F7F, 0, (int)0x93939393u);
          p1 = __builtin_amdgcn_mfma_scale_f32_32x32x64_f8f6f4(mm->a1, mb, p1, 0, 0, 0, 0x7F7F7F7F, 0, (int)0x93939393u); }
      p0 = __builtin_amdgcn_mfma_f32_32x32x16_bf16(__builtin_bit_cast(bf16x8, KX.k0), __builtin_bit_cast(bf16x8, q), p0, 0, 0, 0);
      p1 = __builtin_amdgcn_mfma_f32_32x32x16_bf16(__builtin_bit_cast(bf16x8, KX.k1), __builtin_bit_cast(bf16x8, q), p1, 0, 0, 0); }
    { LAS const unsigned char* kp = buf + r32 * KT_STRIDE + hi * 16;
#pragma unroll
      for (int ds = 0; ds < 4; ++ds) {
          const bf16x8 k0 = *(LAS const bf16x8*)(kp + ds * 32);
          const bf16x8 k1 = *(LAS const bf16x8*)(kp + 32 * KT_STRIDE + ds * 32);
          const bf16x8 qv = QLDS ? *(LAS const bf16x8*)(qlds + (((2 * ds + hi) ^ (r32 & 7)) * 16)) : qf[ds];
          p0 = __builtin_amdgcn_mfma_f32_32x32x16_bf16(k0, qv, p0, 0, 0, 0);
          p1 = __builtin_amdgcn_mfma_f32_32x32x16_bf16(k1, qv, p1, 0, 0, 0); } }
    if (BITS) { }
    else if (need_mask) { const int lo2 = lo - 4 * hi, hi2 = hi_ - 4 * hi;
#pragma unroll
        for (int r = 0; r < 16; ++r) { const int c = (r & 3) + 8 * (r >> 2); if (c < lo2 || c > hi2) p0[r] = -INFINITY; if (c + 32 < lo2 || c + 32 > hi2) p1[r] = -INFINITY; } }
    if (!FIXM) {
    asm volatile("s_nop 15\n\ts_nop 7" : "+v"(p0), "+v"(p1));
    float rm;
    { float a = max3f(p0[0], p0[1], p1[0]), b = max3f(p0[2], p0[3], p1[1]); a = max3f(a, p1[2], p1[3]);
#pragma unroll
      for (int r = 4; r < 16; r += 4) { a = max3f(a, p0[r], p0[r + 1]); b = max3f(b, p0[r + 2], p0[r + 3]); a = max3f(a, p1[r], p1[r + 1]); b = max3f(b, p1[r + 2], p1[r + 3]); }
      rm = max3f(a, b, b); }
    rm = xhalf_max(rm);
    const bool need = st.started ? (rm > ATT_THR) : (rm > -1e8f);
    if (__any(need)) {
        const float dl = need ? rm : 0.f; const float f = st.started ? __builtin_amdgcn_exp2f(-dl) : 1.0f;
        st.m += dl; st.started = st.started || need;
        { const float nm = -st.m; const unsigned m1 = f2bf(nm); const float r1 = nm - __uint_as_float(m1 << 16); const unsigned m2 = f2bf(r1); const float r2 = r1 - __uint_as_float(m2 << 16); const unsigned m3 = f2bf(r2);
          if (hi == 0) { st.qx.z = m1 | (m2 << 16); st.qx.w = m3; } }
#pragma unroll
        for (int r = 0; r < 16; ++r) { p0[r] -= dl; p1[r] -= dl; }
        if (hi == 0) wsc[r32] = f;
        LDS_WAIT();
#pragma unroll
        for (int a = 0; a < 4; ++a) { const f32x4 av = *(LAS const f32x4*)(wsc + 8 * a + 4 * hi);
#pragma unroll
            for (int i = 0; i < 4; ++i) { st.o0[4 * a + i] *= av[i]; st.o1[4 * a + i] *= av[i]; st.la[4 * a + i] *= av[i]; if (IMP) oimp[4 * a + i] *= av[i]; } }
        LDS_WAIT();
    }
    }
#pragma unroll
    for (int r = 0; r < 16; ++r) { p0[r] = __builtin_amdgcn_exp2f(p0[r]); p1[r] = __builtin_amdgcn_exp2f(p1[r]); }
    bf16x8 pa[4]; pa[0] = pack8(p0, 0); pa[1] = pack8(p0, 8); pa[2] = pack8(p1, 0); pa[3] = pack8(p1, 8);
    { LAS const unsigned char* vp = buf + KT_BYTES + r32 * VT_STRIDE + hi * 16;
#pragma unroll
      for (int s = 0; s < 4; ++s) {
          const v4u x0 = *(LAS const v4u*)(vp + s * 32), x1 = *(LAS const v4u*)(vp + 32 * VT_STRIDE + s * 32);
          st.o0 = __builtin_amdgcn_mfma_f32_32x32x16_bf16(pa[s], __builtin_bit_cast(bf16x8, x0), st.o0, 0, 0, 0);
          st.o1 = __builtin_amdgcn_mfma_f32_32x32x16_bf16(pa[s], __builtin_bit_cast(bf16x8, x1), st.o1, 0, 0, 0);
          st.la = __builtin_amdgcn_mfma_f32_32x32x16_bf16(pa[s], __builtin_bit_cast(bf16x8, (pg8::u32x4){0x3F803F80u, 0x3F803F80u, 0x3F803F80u, 0x3F803F80u}), st.la, 0, 0, 0); } }
    if (IMP) {
#pragma unroll
        for (int s = 0; s < 4; ++s) { bf16x8 ov;
#pragma unroll
            for (int e = 0; e < 8; ++e) { const int c = c0 + 16 * s + 8 * (e >> 2) + 4 * hi + (e & 3); ov[e] = (c >= 4 * r32 - 1 && c <= 4 * r32 + 3) ? (short)0x3F80 : (short)0; }
            oimp = __builtin_amdgcn_mfma_f32_32x32x16_bf16(pa[s], ov, oimp, 0, 0, 0); } }
}
__device__ __forceinline__ void attn_accum(f32x16& out0, f32x16& out1, const AttnState& st, float gate, LAS float* wsc, int r32, int hi) {
    if (hi == 0) wsc[r32] = gate;
    LDS_WAIT();
#pragma unroll
    for (int a = 0; a < 4; ++a) { const f32x4 av = *(LAS const f32x4*)(wsc + 8 * a + 4 * hi);
#pragma unroll
        for (int i = 0; i < 4; ++i) { const float l = st.la[4 * a + i]; const float f = l > 0.f ? av[i] * __builtin_amdgcn_rcpf(l) : 0.f; out0[4 * a + i] += st.o0[4 * a + i] * f; out1[4 * a + i] += st.o1[4 * a + i] * f; } }
    LDS_WAIT();
}
__device__ __forceinline__ void store_tile_fp8(const f32x16& out0, const f32x16& out1, LAS unsigned char* stg, unsigned char* dst, size_t pitch, int lane, int r32, int hi) {
#pragma unroll
    for (int r = 0; r < 16; ++r) { const int q = (r & 3) + 8 * (r >> 2) + 4 * hi;
        const unsigned w = (unsigned)__builtin_amdgcn_cvt_pk_fp8_f32(__builtin_amdgcn_fmed3f(out0[r] * 16.f, -448.f, 448.f), __builtin_amdgcn_fmed3f(out1[r] * 16.f, -448.f, 448.f), 0, false);
        stg[q * 64 + r32] = (unsigned char)(w & 0xffu); stg[q * 64 + 32 + r32] = (unsigned char)((w >> 8) & 0xffu); }
    LDS_WAIT();
#pragma unroll
    for (int i = 0; i < 2; ++i) { const int row = i * 16 + (lane >> 2), ch = lane & 3; const v4u v = *(LAS const v4u*)(stg + row * 64 + ch * 16); *(GAS v4u*)(dst + (size_t)row * pitch + ch * 16) = v; }
    LDS_WAIT();
}


#define TILE_PIPELINE(FIRST, AFTER, FETCH, COMPUTE) do { \
        int jc_ = (FIRST); int jn_ = AFTER(jc_); int jnn_; TileRegs rA_ = FETCH(jc_), rB_; \
        tile_store(buf0, rA_, tid); if (jn_ >= 0) rB_ = FETCH(jn_); \
        __syncthreads(); \
        for (;;) { \
            jnn_ = jn_ >= 0 ? AFTER(jn_) : -1; if (jnn_ >= 0) rA_ = FETCH(jnn_); \
            COMPUTE(jc_, buf0); \
            if (jn_ < 0) break; \
            tile_store(buf1, rB_, tid); __syncthreads(); jc_ = jn_; jn_ = jnn_; \
            jnn_ = jn_ >= 0 ? AFTER(jn_) : -1; if (jnn_ >= 0) rB_ = FETCH(jnn_); \
            COMPUTE(jc_, buf1); \
            if (jn_ < 0) break; \
            tile_store(buf0, rA_, tid); __syncthreads(); jc_ = jn_; jn_ = jnn_; \
        } } while (0)
__device__ __forceinline__ void nsa_unit(const Ptrs& P, LAS unsigned char* lds, int b, int kh, int qb, int tid, int wave, int lane) {
    asm volatile("" : "+v"(tid), "+v"(lane));
    const int r32 = lane & 31, hi = lane >> 5, th = wave >> 2, g = th ? 3 - (wave & 3) : (wave & 3);
    bf16* PROJ = (bf16*)(P.ws + WS_PROJ);
    unsigned char* dob = (unsigned char*)P.out;
    const bf16* KCb = (const bf16*)(dob + DO_KC) + (size_t)(b * 2 + kh) * 128 * 64; const bf16* VCTb = (const bf16*)(dob + DO_VCT) + (size_t)(b * 2 + kh) * 64 * 128;
    const bf16* VSTb = (const bf16*)(dob + DO_VST) + (size_t)(b * 2 + kh) * 64 * SEQ; const bf16* VWTb = (const bf16*)(dob + DO_VWT) + (size_t)(b * 2 + kh) * 64 * SEQ;
    LAS unsigned char* buf0 = lds + A_TILE0; LAS unsigned char* buf1 = lds + A_TILE1;
    LAS float* wsc = (LAS float*)(lds + A_WSC) + wave * 64;
    LAS float* impL = (LAS float*)(lds + A_IMP); LAS float* effL = (LAS float*)(lds + A_EFF); LAS unsigned* selL = (LAS unsigned*)(lds + A_SEL);
    const int tq = 64 * qb + 32 * th + r32;
    const bf16* prow = PROJ + (size_t)(b * SEQ + tq) * PITCH;
    const float slope2 = exp2f(-(float)(kh * 4 + g + 1)) * LOG2E;
    bf16x8 qf[4];
#pragma unroll
    for (int ds = 0; ds < 4; ++ds) qf[ds] = *(const GAS bf16x8*)(prow + C_QB + (kh * 4 + g) * 64 + ds * 16 + hi * 8);
    KxOps KX = kx_ops(r32, hi);
    float qkb;
    { const float gq = fabsf(P.in[8][lane]); const float gk = fmaxf(fmaxf(fabsf(P.in[9][lane]), fabsf(P.in[10][lane])), fabsf(P.in[11][lane]));
      qkb = 64.0f * QSCALE * 1.02f * __uint_as_float(wave_umax(__float_as_uint(gq))) * __uint_as_float(wave_umax(__float_as_uint(gk))) + 0.25f; }
    const float cutthr = 2.0f * qkb + 40.0f;
    const int jcut = qb - (int)ceilf((cutthr / slope2 + (float)(63 - 32 * th)) * (1.0f / 64.0f));
    const int jdrop = qb - (int)ceilf((cutthr / (exp2f(-(float)(kh * 4 + 4)) * LOG2E) + 63.0f) * (1.0f / 64.0f));
    LAS unsigned char* qlds = lds + A_STG + wave * 4096 + r32 * 128;
#pragma unroll
    for (int ds = 0; ds < 4; ++ds) *(LAS bf16x8*)(qlds + (((2 * ds + hi) ^ (r32 & 7)) * 16)) = qf[ds];
#define NSA_GATE(i) pg8::sigm(bf2f(PROJ[(size_t)(b * SEQ + tq) * PITCH + C_GB + (kh * 4 + g) * 3 + (i)]))
    f32x16 oimp;
#pragma unroll
    for (int r = 0; r < 16; ++r) oimp[r] = 0.f;
    float* slab = (float*)(P.ws + WS_OUTSCR) + ((size_t)blockIdx.x * NWAVES + wave) * 2048;
    AttnState st;
    {
        TileRegs tr = tile_fetch(KCb, 64, VCTb, 128, tid); tile_store(buf0, tr, tid);
        tr = tile_fetch(KCb + 64 * 64, 64, VCTb + 64, 128, tid); tile_store(buf1, tr, tid);
        if (tid < 64) selL[tid] = 0u;
        __syncthreads();
        attn_init_fixed(st, 0.f, qkb, hi);
        const int hc = (tq - 31) >> 4;
#pragma unroll 1
        for (int ct = 0; ct < 2; ++ct) { tile_compute<false, true, true, true>(st, qf, qlds, KX, 0.f, true, true, ct ? buf1 : buf0, wsc, true, -(1 << 20), hc - 64 * ct, 0u, 0u, oimp, 64 * ct, r32, hi); __builtin_amdgcn_sched_barrier(0); }
        { f32x16 o0, o1;
#pragma unroll
          for (int r = 0; r < 16; ++r) { o0[r] = 0.f; o1[r] = 0.f; }
          attn_accum(o0, o1, st, NSA_GATE(0), wsc, r32, hi);
#pragma unroll
          for (int r = 0; r < 16; ++r) { slab[r * 64 + lane] = o0[r]; slab[(16 + r) * 64 + lane] = o1[r]; } }
#pragma unroll
        for (int a = 0; a < 4; ++a)
#pragma unroll
            for (int i = 0; i < 4; ++i) { const int q = 8 * a + 4 * hi + i; const float l = st.la[4 * a + i]; impL[(wave * 32 + q) * 32 + r32] = l > 0.f ? oimp[4 * a + i] * __builtin_amdgcn_rcpf(l) : 0.f; }
        LDS_WAIT();
        __syncthreads();
        const int tk = tid >> 3, th2 = tk >> 5, q2 = tk & 31, sub = tid & 7;
        float e[4];
#pragma unroll
        for (int i = 0; i < 4; ++i) { const int j = sub * 4 + i; float imp = 0.f;
#pragma unroll
            for (int g2 = 0; g2 < 4; ++g2) imp += impL[((th2 * 4 + g2) * 32 + q2) * 32 + j];
            const bool forced = (j == 0) || (j == qb) || (j == qb - 1);
            e[i] = (j > qb) ? -INFINITY : (imp + (forced ? 1e6f : 0.f)); effL[tk * 32 + j] = e[i]; }
        __syncthreads();
        int rank[4] = {0, 0, 0, 0};
#pragma unroll 1
        for (int jp = 0; jp < 32; ++jp) { const float e2 = effL[tk * 32 + jp];
#pragma unroll
            for (int i = 0; i < 4; ++i) rank[i] += (e2 > e[i] || (e2 == e[i] && jp < sub * 4 + i)) ? 1 : 0; }
        unsigned bits = 0u;
#pragma unroll
        for (int i = 0; i < 4; ++i) if (rank[i] < 16 && sub * 4 + i <= qb) bits |= 1u << (sub * 4 + i);
        if (bits) __hip_atomic_fetch_or(selL + tk, bits, __ATOMIC_RELAXED, __HIP_MEMORY_SCOPE_WORKGROUP);
        __syncthreads();
    }
    unsigned U = 0u;
#pragma unroll
    for (int k = 0; k < 16; ++k) { const v4u w = *(LAS const v4u*)(selL + 4 * k); U |= (w.x | w.y) | (w.z | w.w); }
    U = __builtin_amdgcn_readfirstlane(U);
    if (jdrop >= 0) U &= ~((2u << jdrop) - 1u);
    const unsigned msk = selL[32 * th + r32];
    {
        const bf16* Kb = PROJ + (size_t)b * SEQ * PITCH + C_KS + kh * 64;
        attn_init_fixed(st, slope2, slope2 * (float)tq + qkb, hi);
#define SEL_AFTER(j) ((U & ((1u << (j)) - 1u)) ? 31 - __builtin_clz(U & ((1u << (j)) - 1u)) : -1)
#define SEL_FETCH(j) tile_fetch(Kb + (size_t)(64 * (j)) * PITCH, PITCH, VSTb + 64 * (j), SEQ, tid)
#define SEL_COMPUTE(j, buf) { const bool rowsel = (msk >> (j)) & 1u; const int dq = tq - 64 * (j); \
            if ((j) > jcut && __any(rowsel)) tile_compute<false, false, false, true>(st, qf, qlds, KX, (float)(64 * (j)), rowsel, __all(rowsel) != 0, buf, wsc, (j) == qb, -(1 << 20), dq, 0u, 0u, oimp, 0, r32, hi); }
        TILE_PIPELINE(31 - __builtin_clz(U), SEL_AFTER, SEL_FETCH, SEL_COMPUTE);
#undef SEL_AFTER
#undef SEL_FETCH
#undef SEL_COMPUTE
        { f32x16 o0, o1;
#pragma unroll
          for (int r = 0; r < 16; ++r) { o0[r] = slab[r * 64 + lane]; o1[r] = slab[(16 + r) * 64 + lane]; }
          attn_accum(o0, o1, st, NSA_GATE(1), wsc, r32, hi);
#pragma unroll
          for (int r = 0; r < 16; ++r) { slab[r * 64 + lane] = o0[r]; slab[(16 + r) * 64 + lane] = o1[r]; } }
        __syncthreads();
    }
    f32x16 out0, out1;
    {
        const bf16* Kb = PROJ + (size_t)b * SEQ * PITCH + C_KW + kh * 64;
        attn_init_fixed(st, slope2, slope2 * (float)tq + qkb, hi);
        int jlo = qb - 8 < 0 ? 0 : qb - 8; jlo = jdrop + 1 > jlo ? jdrop + 1 : jlo;
#define WIN_AFTER(j) ((j) > jlo ? (j) - 1 : -1)
#define WIN_FETCH(j) tile_fetch(Kb + (size_t)(64 * (j)) * PITCH, PITCH, VWTb + 64 * (j), SEQ, tid)
#define WIN_COMPUTE(j, buf) if ((j) > jcut) { const int dq = tq - 64 * (j); \
            tile_compute<false, false, false, true>(st, qf, qlds, KX, (float)(64 * (j)), true, true, buf, wsc, ((j) == qb) || ((j) == qb - 8), dq - 511, dq, 0u, 0u, oimp, 0, r32, hi); }
        TILE_PIPELINE(qb, WIN_AFTER, WIN_FETCH, WIN_COMPUTE);
#undef WIN_AFTER
#undef WIN_FETCH
#undef WIN_COMPUTE
#pragma unroll
        for (int r = 0; r < 16; ++r) { out0[r] = slab[r * 64 + lane]; out1[r] = slab[(16 + r) * 64 + lane]; }
        attn_accum(out0, out1, st, NSA_GATE(2), wsc, r32, hi);
    }
    store_tile_fp8(out0, out1, lds + A_STG + wave * 4096, dob + DO_O + (size_t)(b * SEQ + 64 * qb + 32 * th) * DM + 512 + (kh * 4 + g) * 64, DM, lane, r32, hi);
    __syncthreads();
}


__device__ __forceinline__ void dsa_unit(const Ptrs& P, LAS unsigned char* lds, int b, int ti, int tid, int wave, int lane) {
    asm volatile("" : "+v"(tid), "+v"(lane));
    const int r32 = lane & 31, hi = lane >> 5, fr = lane & 15, fq = lane >> 4;
    bf16* PROJ = (bf16*)(P.ws + WS_PROJ);
    unsigned char* dob = (unsigned char*)P.out;
    const bf16* Kb = (const bf16*)(dob + DO_KA) + (size_t)b * SEQ * 64; const bf16* VTb = (const bf16*)(dob + DO_VAT) + (size_t)b * 64 * SEQ;
    const bf16* PB = PROJ + (size_t)b * SEQ * PITCH;
    LAS float* scL = (LAS float*)lds; LAS unsigned* maskL = (LAS unsigned*)(lds + D_MASK);
    LAS float* wsc = (LAS float*)(lds + A_WSC) + wave * 64;
    const int t0 = 32 * ti;
    bf16x8 qaN[8]; v4u wvN[4];
    const bf16* kbase = PB + (size_t)fr * PITCH + C_KI + fq * 8;
#define DSA_LOAD_HALF(H) { const int th0_ = t0 + 16 * (H); const bf16* qrow_ = PB + (size_t)(th0_ + fr) * PITCH + C_QI + fq * 8; \
        _Pragma("unroll") for (int hh = 0; hh < 8; ++hh) qaN[hh] = *(const GAS bf16x8*)(qrow_ + hh * 32); \
        _Pragma("unroll") for (int i = 0; i < 4; ++i) wvN[i] = *(const GAS v4u*)(PB + (size_t)(th0_ + 4 * fq + i) * PITCH + C_WI); \
        }
    DSA_LOAD_HALF(0)
    for (int half_ = 0; half_ < 2 * PROBE_DPRE; ++half_) {
        const int half = half_ & 1;
        const int th0 = t0 + 16 * half; const int ntile = (th0 >> 4) + 1;
        {
            bf16x8 qa[8];
#pragma unroll
            for (int hh = 0; hh < 8; ++hh) qa[hh] = qaN[hh];
            float wv[4][8];
#pragma unroll
            for (int i = 0; i < 4; ++i) unpack8(wvN[i], wv[i]);
            bf16x8 kbn[4];
#pragma unroll
            for (int q4 = 0; q4 < 4; ++q4) { int kt = wave + 8 * q4; kt = kt < ntile ? kt : ntile - 1; kbn[q4] = *(const GAS bf16x8*)(kbase + (size_t)(16 * kt) * PITCH); }
            for (int rep_ = 0; rep_ < PROBE_DIDX; ++rep_)
            for (int kt0 = wave; kt0 < ntile; kt0 += 32) {
                bf16x8 kbc[4];
#pragma unroll
                for (int q4 = 0; q4 < 4; ++q4) kbc[q4] = kbn[q4];
                if (kt0 + 32 < ntile) {
#pragma unroll
                    for (int q4 = 0; q4 < 4; ++q4) { int kt = kt0 + 32 + 8 * q4; kt = kt < ntile ? kt : ntile - 1; kbn[q4] = *(const GAS bf16x8*)(kbase + (size_t)(16 * kt) * PITCH); } }
#pragma unroll
                for (int q4 = 0; q4 < 4; ++q4) { const int kt = kt0 + 8 * q4;
                    if (kt < ntile) {
                        float sc[4] = {0.f, 0.f, 0.f, 0.f};
                        f32x4 acc8[8];
#pragma unroll
                        for (int hh = 0; hh < 8; ++hh) { const f32x4 z = {0.f, 0.f, 0.f, 0.f}; acc8[hh] = __builtin_amdgcn_mfma_f32_16x16x32_bf16(qa[hh], kbc[q4], z, 0, 0, 0); }
                        __builtin_amdgcn_sched_barrier(0);
#pragma unroll
                        for (int hh = 0; hh < 8; ++hh)
#pragma unroll
                            for (int i = 0; i < 4; ++i) { const int rb = __float_as_int(acc8[hh][i]); sc[i] += __int_as_float(rb > 0 ? rb : 0) * wv[i][hh]; }
#pragma unroll
                        for (int i = 0; i < 4; ++i) scL[(4 * fq + i) * SROW + 16 * kt + fr] = sc[i] + 0.0f;
                    } }
            }
        }
        __syncthreads();
        if (half_ + 1 < 2 * PROBE_DPRE) DSA_LOAD_HALF((half_ + 1) & 1)
        for (int rep_ = 0; rep_ < PROBE_DTHR; ++rep_) {
            const int rowA = 2 * wave, rowB = rowA + 1; const int tA = th0 + rowA, tB = tA + 1;
            unsigned uA[32], uB[32];
#pragma unroll
            for (int i = 0; i < 32; ++i) { const int s = lane + 64 * i; const float xa = scL[rowA * SROW + (s & (SROW - 1))], xb = scL[rowB * SROW + (s & (SROW - 1))]; uA[i] = ord_u32(xa); uB[i] = ord_u32(xb); }
            const int nvA = lane <= tA ? ((tA - lane) >> 6) + 1 : 0, nvB = lane <= tB ? ((tB - lane) >> 6) + 1 : 0;
            unsigned candA = nvA >= 32 ? 0xffffffffu : ((1u << nvA) - 1u), candB = nvB >= 32 ? 0xffffffffu : ((1u << nvB) - 1u);
            unsigned selA = candA, selB = candB;
            if (tB + 1 > TOPK) {
#define DSA_TSTAGE(U, J, MSK) _Pragma("unroll") for (int k0 = 0; k0 < 32; k0 += 2 * (J)) _Pragma("unroll") for (int k1 = 0; k1 < (J); ++k1) { const int k = k0 + k1; \
                    const unsigned a_ = U[k], b_ = U[k + (J)]; U[k] = ((MSK) & a_) | (~(MSK) & (b_ << (J))); U[k + (J)] = ((MSK) & (a_ >> (J))) | (~(MSK) & b_); }
#define DSA_PSTAGE(U, J, S_LO, S_HI) _Pragma("unroll") for (int k0 = 0; k0 < 32; k0 += 2 * (J)) _Pragma("unroll") for (int k1 = 0; k1 < (J); ++k1) { const int k = k0 + k1; \
                    const unsigned a_ = U[k], b_ = U[k + (J)]; U[k] = __builtin_amdgcn_perm(b_, a_, S_LO); U[k + (J)] = __builtin_amdgcn_perm(b_, a_, S_HI); }
                DSA_PSTAGE(uA, 16, 0x05040100u, 0x07060302u) DSA_PSTAGE(uA, 8, 0x06020400u, 0x07030501u) DSA_TSTAGE(uA, 4, 0x0f0f0f0fu) DSA_TSTAGE(uA, 2, 0x33333333u) DSA_TSTAGE(uA, 1, 0x55555555u)
                DSA_PSTAGE(uB, 16, 0x05040100u, 0x07060302u) DSA_PSTAGE(uB, 8, 0x06020400u, 0x07030501u) DSA_TSTAGE(uB, 4, 0x0f0f0f0fu) DSA_TSTAGE(uB, 2, 0x33333333u) DSA_TSTAGE(uB, 1, 0x55555555u)
#undef DSA_PSTAGE
#undef DSA_TSTAGE
#pragma unroll
                for (int k = 0; k < 32; k += 8) {
                    asm volatile("" : "+v"(uA[k]), "+v"(uA[k + 1]), "+v"(uA[k + 2]), "+v"(uA[k + 3]), "+v"(uA[k + 4]), "+v"(uA[k + 5]), "+v"(uA[k + 6]), "+v"(uA[k + 7]));
                    asm volatile("" : "+v"(uB[k]), "+v"(uB[k + 1]), "+v"(uB[k + 2]), "+v"(uB[k + 3]), "+v"(uB[k + 4]), "+v"(uB[k + 5]), "+v"(uB[k + 6]), "+v"(uB[k + 7])); }
                unsigned aboveA = 0u, aboveB = 0u; int needA = TOPK, needB = TOPK, ccA = tA + 1, ccB = tB + 1; bool doneA = false, doneB = false;
                if (ccA <= TOPK) { aboveA = candA; candA = 0u; needA = 0; ccA = 0; doneA = true; }
#pragma unroll
                for (int bb = 31; bb >= 0; --bb) {
                    if (!(doneA && doneB)) {
                        const unsigned onesA = candA & uA[bb], onesB = candB & uB[bb];
                        const unsigned S = wave_usum((unsigned)__builtin_popcount(onesA) | ((unsigned)__builtin_popcount(onesB) << 16));
                        const int c1A = (int)(S & 0xffffu), c1B = (int)(S >> 16);
                        { const bool take = c1A >= needA; aboveA = take ? aboveA : (aboveA | onesA); candA = take ? onesA : (candA & ~uA[bb]); needA = take ? needA : needA - c1A; ccA = take ? c1A : ccA - c1A;
                          const bool fin = ccA == needA; aboveA = fin ? (aboveA | candA) : aboveA; candA = fin ? 0u : candA; needA = fin ? 0 : needA; ccA = fin ? 0 : ccA; doneA = doneA || fin; }
                        { const bool take = c1B >= needB; aboveB = take ? aboveB : (aboveB | onesB); candB = take ? onesB : (candB & ~uB[bb]); needB = take ? needB : needB - c1B; ccB = take ? c1B : ccB - c1B;
                          const bool fin = ccB == needB; aboveB = fin ? (aboveB | candB) : aboveB; candB = fin ? 0u : candB; needB = fin ? 0 : needB; ccB = fin ? 0 : ccB; doneB = doneB || fin; }
                    }
                }
                selA = aboveA; selB = aboveB;
                if (!doneA) {
                    int ties = 0; const u64 ltm = (1ull << lane) - 1ull;
#pragma unroll 1
                    for (int i = 0; i < 32; ++i) { const bool eq = (candA >> i) & 1u; const u64 meq = __ballot(eq); const int myrank = ties + __popcll(meq & ltm); selA |= (unsigned)(eq && myrank < needA) << i; ties += __popcll(meq); }
                }
                if (!doneB) {
                    int ties = 0; const u64 ltm = (1ull << lane) - 1ull;
#pragma unroll 1
                    for (int i = 0; i < 32; ++i) { const bool eq = (candB >> i) & 1u; const u64 meq = __ballot(eq); const int myrank = ties + __popcll(meq & ltm); selB |= (unsigned)(eq && myrank < needB) << i; ties += __popcll(meq); }
                }
            }
            {
                LAS unsigned* mrA = maskL + (16 * half + rowA) * 64; LAS unsigned* mrB = mrA + 64;
                unsigned wloA = 0u, whiA = 0u, wloB = 0u, whiB = 0u;
#pragma unroll
                for (int i = 0; i < 32; ++i) { const u64 ma = __ballot((selA >> i) & 1u), mb = __ballot((selB >> i) & 1u);
                    wloA = (lane == i) ? (unsigned)ma : wloA; whiA = (lane == i) ? (unsigned)(ma >> 32) : whiA; wloB = (lane == i) ? (unsigned)mb : wloB; whiB = (lane == i) ? (unsigned)(mb >> 32) : whiB; }
                if (lane < 32) { mrA[2 * lane] = wloA; mrA[2 * lane + 1] = whiA; mrB[2 * lane] = wloB; mrB[2 * lane + 1] = whiB; }
                const unsigned kA = wave_umax(selA ? (unsigned)(lane + 64 * (31 - __builtin_clz(selA))) + 1u : 0u), kB = wave_umax(selB ? (unsigned)(lane + 64 * (31 - __builtin_clz(selB))) + 1u : 0u);
                if (lane == 0) { LAS int* km = (LAS int*)(lds + D_KMAX); km[16 * half + rowA] = (int)kA - 1; km[16 * half + rowB] = (int)kB - 1; }
            }
        }
        __syncthreads();
    }
    {
    int tid_b = tid, lane_b = lane; asm volatile("" : "+v"(tid_b), "+v"(lane_b));
    const int tid = tid_b, lane = lane_b, r32 = lane & 31, hi = lane >> 5;
    {
        LAS unsigned char* m8 = lds + D_M8; const int nw = 2 * (((t0 + 31) >> 6) + 1); const int row = tid >> 4;
        for (int w = tid & 15; w < nw; w += 16) { const unsigned bits = maskL[row * 64 + w]; v4u o[2];
#pragma unroll
            for (int n = 0; n < 8; ++n) { const unsigned x = (bits >> (4 * n)) & 15u; const unsigned y = ((x * 0x00204081u) & 0x01010101u) ^ 0x01010101u; o[n >> 2][n & 3] = y * 0xFEu; }
            *(LAS v4u*)(m8 + row * M8_STRIDE + 32 * w) = o[0]; *(LAS v4u*)(m8 + row * M8_STRIDE + 32 * w + 16) = o[1]; }
    }
    MaskMM MM;
    { const unsigned one = 0x38u << (8 * (r32 & 3));
#pragma unroll
      for (int w = 0; w < 8; ++w) { const unsigned x = ((r32 >> 2) == w) ? one : 0u; MM.a0[w] = (hi == 0) ? (int)x : 0; MM.a1[w] = (hi == 1) ? (int)x : 0; }
      MM.row = lds + D_M8 + r32 * M8_STRIDE + 32 * hi; }
    const int tq = t0 + r32; const int h = wave;
    const bf16* prow = PB + (size_t)tq * PITCH;
    bf16x8 qf[4];
#pragma unroll
    for (int ds = 0; ds < 4; ++ds) qf[ds] = *(const GAS bf16x8*)(prow + C_QA + h * 64 + ds * 16 + hi * 8);
    const float slope2 = exp2f(-(float)(h + 1)) * LOG2E;
    int jcutD; float qkbD; const int kmaxrow = ((LAS const int*)(lds + D_KMAX))[r32];
    { const float gq = fabsf(P.in[3][lane]), gk = fabsf(P.in[4][lane]);
      qkbD = 64.0f * QSCALE * 1.02f * __uint_as_float(wave_umax(__float_as_uint(gq))) * __uint_as_float(wave_umax(__float_as_uint(gk))) + 0.25f;
      const int kmin = (int)wave_umin((unsigned)(kmaxrow + 1)) - 1;
      const int dcut = (int)ceilf((2.0f * qkbD + 40.0f) / slope2);
      const int num = kmin - dcut - 63; jcutD = num >= 0 ? (num >> 6) : -1; }
    KxOps KX = kx_ops(r32, hi);
    LAS unsigned char* buf0 = lds + A_TILE0; LAS unsigned char* buf1 = lds + A_TILE1;
    AttnState st;
    f32x16 dummy;
#pragma unroll
    for (int r = 0; r < 16; ++r) dummy[r] = 0.f;
    for (int rep = 0; rep < PROBE_DATT; ++rep) {
    attn_init_fixed(st, slope2, slope2 * (float)kmaxrow + qkbD, hi);
#define DSA_AFTER(j) ((j) - 1)
#define DSA_FETCH(j) tile_fetch(Kb + (size_t)(64 * (j)) * 64, 64, VTb + 64 * (j), SEQ, tid)
#define DSA_COMPUTE(j, buf) if ((j) > jcutD) tile_compute<true, false, false, true>(st, qf, nullptr, KX, (float)(64 * (j)), true, true, buf, wsc, false, 0, 0, (unsigned)(64 * (j)), 0u, dummy, 0, r32, hi, &MM)
    TILE_PIPELINE((t0 + 31) >> 6, DSA_AFTER, DSA_FETCH, DSA_COMPUTE);
#undef DSA_AFTER
#undef DSA_FETCH
#undef DSA_COMPUTE
    __syncthreads();
    }
    f32x16 out0, out1;
#pragma unroll
    for (int r = 0; r < 16; ++r) { out0[r] = 0.f; out1[r] = 0.f; }
    attn_accum(out0, out1, st, 1.0f, wsc, r32, hi);
    __syncthreads();
    store_tile_fp8(out0, out1, lds + A_TILE0 + wave * 2048, dob + DO_O + (size_t)(b * SEQ + t0) * DM + h * 64, DM, lane, r32, hi);
    __syncthreads();
    }
}

__device__ __forceinline__ int nsa_tbl(int i, unsigned long long c0, unsigned long long c1, unsigned long long c2, unsigned long long c3) { const unsigned long long c = (i & 16) ? ((i & 8) ? c3 : c2) : ((i & 8) ? c1 : c0); return (int)((c >> (8 * (i & 7))) & 0xffull); }
__device__ __forceinline__ int nsa_ua(int i) { return nsa_tbl(i, 0x38393a3b3c3d3e3full, 0x3031323334353637ull, 0x28292a2b2c2d2e2full, 0x130c12110d0e0f10ull); }
__device__ __forceinline__ int nsa_ub(int i) { return nsa_tbl(i, 0x1c1e090807250504ull, 0x2303220221012000ull, 0x1b270a1d1f260624ull, 0x1415160b1a191817ull); }
__device__ __forceinline__ void p3_fast(const Ptrs& P, LAS unsigned char* lds, int vcu, int G, int tid, int wave, int lane) {
    for (int u = vcu; u < 256; u += G)
        for (int k = 0; k < 2; ++k) { const int b = u >> 5, p = u & 31; dsa_unit(P, lds, b, k ? p : 63 - p, tid, wave, lane); }
    asm volatile("" ::: "memory");
    for (int u = vcu; u < 256; u += G)
        for (int k = 0; k < 2 * PROBE_NSA; ++k) { const int b = u >> 5, i = u & 31;
            const int c = (k & 1) ? nsa_ub(i) : nsa_ua(i); nsa_unit(P, lds, b, c >> 5, c & 31, tid, wave, lane); }
}

struct Args { Ptrs p; };
__global__ void __launch_bounds__(NWAVES * 64, 2) fwd_kernel(Args args) {
    extern __shared__ __attribute__((aligned(16))) unsigned char lds_raw[];
    LAS unsigned char* lds = (LAS unsigned char*)lds_raw;
    const Ptrs& P = args.p;
    const int tid = threadIdx.x, lane = tid & 63, wave = __builtin_amdgcn_readfirstlane(tid >> 6);
    const int G = gridDim.x; const int bx = blockIdx.x; const int vcu = (G % 8 == 0) ? (bx % 8) * (G / 8) + bx / 8 : bx;
    const int gw = vcu * NWAVES + wave, NGW = G * NWAVES;
    volatile LAS unsigned* MISC = (volatile LAS unsigned*)(lds + MISC_OFF);
    for (int u = tid; u < (LDS_BYTES - RING_BYTES) / 4; u += NWAVES * 64) ((LAS unsigned*)(lds + RING_BYTES))[u] = 0u;
    __syncthreads();
    unsigned* ctl = (unsigned*)(P.ws + WS_CTL);
    XcdBarrier bar = xcd_barrier_post(ctl + CW_BAR, MISC + 8);
#if PROBE_BAR
    int pb_k = 0;
#define GRIDBAR() do { const unsigned long long t0_ = __builtin_amdgcn_s_memrealtime(); xcd_barrier(bar); const unsigned long long t1_ = __builtin_amdgcn_s_memrealtime(); \
        if (tid == 0) { const unsigned w_ = (unsigned)(t1_ - t0_); atomicMax(ctl + 8192 + 64 * pb_k, 0x7fffffffu - w_); atomicMax(ctl + 8192 + 1024 + 64 * pb_k, w_); } ++pb_k; } while (0)
#elif PROBE_SPAN
    int pb_k = 0; unsigned long long sp_prev = __builtin_amdgcn_s_memrealtime(), sp_acc = 0;
#define GRIDBAR() do { xcd_barrier(bar); const unsigned long long t_ = __builtin_amdgcn_s_memrealtime(); if ((PROBE_SPAN >> pb_k) & 1) sp_acc += t_ - sp_prev; sp_prev = t_; ++pb_k; } while (0)
#else
#define GRIDBAR() xcd_barrier(bar)
#endif

    bf16* H = (bf16*)((unsigned char*)P.out + DO_H);
    bf16* PROJ = (bf16*)(P.ws + WS_PROJ); bf16* HID = (bf16*)(P.ws + WS_PROJ);
    bf16* MERGED = (bf16*)(P.ws + WS_MERGED); bf16* X1B = (bf16*)(P.ws + WS_X1B); float* PARTS = (float*)(P.ws + WS_PARTS);

    for (int rep = 0; rep < PROBE_P0; ++rep) p0_prologue(P, lds, gw, NGW, wave, lane);
    GRIDBAR();
    for (int rep = 0; rep < PROBE_P1; ++rep) {
        pg8::Gemm g{H, (const bf16*)(P.ws + WS_WIN), M, 1024, DM, DM}; pg8::StaticOrder S; S.init(M, 1024, G, bx);
        pg8::EpiProj E{PROJ, PITCH, P.in[3], P.in[8], P.in[10], P.in[11], (bf16*)((unsigned char*)P.out + DO_VST), (bf16*)((unsigned char*)P.out + DO_VWT), QSCALE, RMS_EPS, SEQ, (bf16*)(P.ws + WS_GT)};
        pg8::gemm_phase<pg8::EpiProj, pg8::StaticOrder, true>(lds, g, S, E);
        {
            pg8::Gemm g8{(const bf16*)(P.ws + WS_H8), (const bf16*)(P.ws + WS_WIN8C), M, 3072, DM / 2, DM / 2}; pg8::StaticOrder S8; S8.init(M, 3072, G, bx);
            pg8::EpiProjGate8 E8{pg8::EpiProjT<1>{PROJ, PITCH, P.in[3], P.in[8], P.in[10], P.in[11], (bf16*)((unsigned char*)P.out + DO_VST), (bf16*)((unsigned char*)P.out + DO_VWT), QSCALE, RMS_EPS, SEQ, (bf16*)(P.ws + WS_GT)}, pg8::EpiGateSig{P.ws + WS_GT}};
            pg8::gemm_phase<pg8::EpiProjGate8, pg8::StaticOrder, true>(lds, g8, S8, E8);
        }
        if (rep == 0 && G != 256) { int lane2 = lane; asm volatile("" : "+v"(lane2)); const int rem = S.nwg % G;
            if (rem == 0) p0_items(P, lds, P0_EARLY, P0_ALL, bx * NWAVES + wave, G * NWAVES, wave, lane2);
            else if (bx >= rem) p0_items(P, lds, P0_EARLY, P0_ALL, (bx - rem) * NWAVES + wave, (G - rem) * NWAVES, wave, lane2); }
    }
    GRIDBAR();
    for (int rep = 0; rep < PROBE_P2; ++rep) {
        p2_fast(P, lds, vcu, G, tid, wave, lane);
        if (rep == 0 && G == 256 && vcu >= 192) { int lane2 = lane; asm volatile("" : "+v"(lane2));
            p0_items(P, lds, P0_EARLY, P0_ALL, (vcu - 192) * NWAVES + wave, 64 * NWAVES, wave, lane2); }
        {
            const bool idle64 = (G == 256);
            if (!idle64 || (vcu >= 128 && vcu < 192)) {
                pg8::Gemm g{(const bf16*)(P.ws + WS_H8), (const bf16*)(P.ws + WS_WIN8T - (size_t)8 * 256 * DM), M, 2304, DM / 2, DM / 2};
                pg8::ColTileOrder S{8, idle64 ? vcu - 128 : vcu, idle64 ? 64 : G, M / 256};
                pg8::EpiProjT<1> E{PROJ, PITCH, P.in[3], P.in[8], P.in[10], P.in[11], (bf16*)((unsigned char*)P.out + DO_VST), (bf16*)((unsigned char*)P.out + DO_VWT), QSCALE, RMS_EPS, SEQ, (bf16*)(P.ws + WS_GT)};
                pg8::gemm_phase<pg8::EpiProjT<1>, pg8::ColTileOrder, false>(lds, g, S, E);
            }
        }
    }
    GRIDBAR();
    for (int rep = 0; rep < PROBE_P3; ++rep) p3_fast(P, lds, vcu, G, tid, wave, lane);
    GRIDBAR();
    for (int rep = 0; rep < PROBE_P4; ++rep) {
        pg8::StaticOrder S; S.init(M, DM, G, bx);
        const bf16* OB = (const bf16*)((unsigned char*)P.out + DO_O);
        pg8::Gemm g{OB, (const bf16*)(P.ws + WS_WUPA), M, DM, DM / 2, DM / 2}; pg8::EpiGate2 E{(unsigned char*)MERGED, DM, P.ws + WS_GT};
        pg8::gemm_phase<pg8::EpiGate2, pg8::StaticOrder, true>(lds, g, S, E);
    }
    GRIDBAR();
    for (int rep = 0; rep < PROBE_P5; ++rep) {
        pg8::Gemm g{MERGED, (const bf16*)(P.ws + WS_WOUT), M, DM, DM / 2, DM / 2}; pg8::StaticOrder S; S.init(M, DM, G, bx);
        pg8::EpiOutRes E{P.in[0], P.out, X1B, DM, PARTS, P.ws + WS_OUTSCR};
        pg8::gemm_phase<pg8::EpiOutRes, pg8::StaticOrder, true>(lds, g, S, E);
    }
    GRIDBAR();
    for (int rep = 0; rep < PROBE_P6; ++rep) {
        pg8::Gemm g{(const bf16*)(P.ws + WS_OUTSCR), (const bf16*)(P.ws + WS_WFF1), M, FF, DM / 2, DM / 2}; pg8::StaticOrder S; S.init(M, FF, G, bx);
        LAS float* rstdL = (LAS float*)(lds + RING_BYTES);
        int pmA = -1, pmB = -1, pmC = -1, pmD = -1;
        { pg8::Unit uu; if (S.next(0, uu)) pmA = uu.pm; if (S.next(1, uu)) pmB = uu.pm; if (S.next(2, uu)) pmC = uu.pm; if (S.next(3, uu)) pmD = uu.pm; }
        __syncthreads();
#pragma unroll
        for (int i = 0; i < 2; ++i) { const int idx = tid + 512 * i, slot = idx >> 8, r = idx & 255; const int pmv = slot == 0 ? pmA : (slot == 1 ? pmB : (slot == 2 ? pmC : pmD));
            if (pmv >= 0) { const f32x4* pp = (const f32x4*)(PARTS + (size_t)(pmv * 256 + r) * 16); const f32x4 p0 = pp[0], p1 = pp[1], p2 = pp[2], p3 = pp[3];
                const float ss = ((p0[0] + p0[1]) + (p0[2] + p0[3])) + ((p1[0] + p1[1]) + (p1[2] + p1[3])) + ((p2[0] + p2[1]) + (p2[2] + p2[3])) + ((p3[0] + p3[1]) + (p3[2] + p3[3]));
                rstdL[idx] = rsqrtf(ss * (1.0f / DM) + RMS_EPS) * 2.8284271247461903f; } }
        __syncthreads();
        pg8::EpiRelu2 E{(unsigned char*)HID, FF, rstdL, pmA, pmB, pmC};
        pg8::gemm_phase<pg8::EpiRelu2, pg8::StaticOrder, true>(lds, g, S, E);
    }
    GRIDBAR();
    {
        pg8::Gemm g{HID, (const bf16*)(P.ws + WS_WFF2), M, DM, FF / 2, FF / 2}; pg8::StaticOrder S; S.init(M, DM, G, bx);
        pg8::EpiFinal E{P.out, X1B, DM};
        pg8::gemm_phase<pg8::EpiFinal, pg8::StaticOrder, true>(lds, g, S, E);
    }
#if PROBE_SPAN
    GRIDBAR();
    if (bx == 0) { const unsigned long long t0 = __builtin_amdgcn_s_memrealtime(); while (__builtin_amdgcn_s_memrealtime() - t0 < sp_acc) __builtin_amdgcn_s_sleep(8); }
#endif
#if PROBE_BAR
    xcd_barrier(bar);
    if (bx == 0 && tid == 0) { unsigned long long tot = 0;
        for (int k = 0; k < 7; ++k) { const unsigned a = __hip_atomic_load(ctl + 8192 + (PROBE_BAR == 1 ? 0 : 1024) + 64 * k, __ATOMIC_RELAXED, __HIP_MEMORY_SCOPE_AGENT); tot += (PROBE_BAR == 1) ? (0x7fffffffu - a) : a; }
        const unsigned long long t0 = __builtin_amdgcn_s_memrealtime(); while (__builtin_amdgcn_s_memrealtime() - t0 < 8ull * tot) __builtin_amdgcn_s_sleep(8); }
#endif
}

extern "C" void kernel_launch(void* const* d_in, const int* in_sizes, int n_in, void* d_out, int out_size, void* d_ws, size_t ws_size, hipStream_t stream) {
    static int grid = 0;
    if (grid == 0) {
        if (n_in != 23 || in_sizes[0] != M * DM || out_size != M * DM || ws_size < WS_END) { fprintf(stderr, "kernel_launch: unexpected shapes (n_in %d, in0 %d, out %d, ws %zu)\n", n_in, n_in > 0 ? in_sizes[0] : -1, out_size, ws_size); grid = -1; return; }
        int dev = 0, cus = 0, per_cu = 0;
        if (hipGetDevice(&dev) != hipSuccess || hipDeviceGetAttribute(&cus, hipDeviceAttributeMultiprocessorCount, dev) != hipSuccess) { grid = -1; return; }
        if (hipFuncSetAttribute((const void*)fwd_kernel, hipFuncAttributeMaxDynamicSharedMemorySize, LDS_BYTES) != hipSuccess) { fprintf(stderr, "kernel_launch: hipFuncSetAttribute failed\n"); grid = -1; return; }
        if (hipOccupancyMaxActiveBlocksPerMultiprocessor(&per_cu, (const void*)fwd_kernel, NWAVES * 64, LDS_BYTES) != hipSuccess || per_cu < 1) { fprintf(stderr, "kernel_launch: occupancy query reports %d blocks per CU\n", per_cu); }
        (void)hipGetLastError();
        grid = cus;
    }
    if (grid < 0) return;
    if (hipMemsetAsync((char*)d_ws + WS_CTL, 0, CTL_ZERO_BYTES, stream) != hipSuccess) { fprintf(stderr, "kernel_launch: memset failed\n"); return; }
    Args a{};
    for (int i = 0; i < 23; ++i) a.p.in[i] = (const float*)d_in[i];
    a.p.out = (float*)d_out; a.p.ws = (unsigned char*)d_ws;
    void* kargs[] = {&a};
    hipError_t e = hipLaunchCooperativeKernel((const void*)fwd_kernel, dim3(grid), dim3(NWAVES * 64), kargs, LDS_BYTES, stream);
    if (e != hipSuccess) fprintf(stderr, "kernel_launch: cooperative launch failed: %s (grid %d)\n", hipGetErrorString(e), grid);
}
```

```cpp
#include <hip/hip_runtime.h>
#include <cstdio>
#include <cstdint>

namespace pg8 {
#define PG8_LAS __attribute__((address_space(3)))
typedef unsigned short bf16_t;
typedef short bf16x8 __attribute__((ext_vector_type(8)));
typedef float f32x4 __attribute__((ext_vector_type(4)));
typedef unsigned u32x4 __attribute__((ext_vector_type(4)));
typedef unsigned u32x2 __attribute__((ext_vector_type(2)));
typedef int i32x8 __attribute__((ext_vector_type(8)));
constexpr int BM = 256, BK = 64, HALF = 128, HTB = HALF * BK * 2  , STAGE_BYTES = 8 * HTB, NXCD = 8, WGM = 8;

__host__ __device__ __forceinline__ int lds_byte(int r, int c) { const int st = (r >> 4) * 2 + (c >> 5), rr = r & 15, cc = c & 31, ob = rr * 64 + cc * 2; return st * 1024 + (ob ^ (((ob >> 9) & 1) << 5)); }
__host__ __device__ __forceinline__ void stage_rc(int b, int& R, int& C) { const int st = b / 1024, sb = b % 1024, swz = sb ^ (((sb >> 9) & 1) << 5); R = (st >> 1) * 16 + swz / 64; C = (st & 1) * 32 + (swz % 64) / 2; }
__host__ __device__ __forceinline__ int perm32(int rho) { const int n = rho >> 4, i = rho & 15; return 8 * (i >> 2) + 4 * n + (i & 3); }

struct Unit { int pm, pn; };
struct Gemm { const bf16_t* A; const bf16_t* Bt; int M, N, K, lda; };

struct StaticOrder {
    int nM, nN, nwg, G, c, tr;
    __host__ __device__ void init(int M, int N, int G_, int c_) { nM = M / BM; nN = N / BM; nwg = nM * nN; G = G_; c = c_; tr = 0; }
    __host__ __device__ __forceinline__ bool next(int i, Unit& u) const {
        const long L = (long)i * G + c; if (L >= nwg) return false;
        int wgid = (int)L; { const int q = nwg / NXCD, r = nwg % NXCD, xcd = wgid % NXCD, off = wgid / NXCD; wgid = (xcd < r ? xcd * (q + 1) : r * (q + 1) + (xcd - r) * q) + off; }
        const int nig = WGM * nN, gid = wgid / nig, fm = gid * WGM, gsz = (nM - fm) < WGM ? (nM - fm) : WGM;
        u.pm = fm + ((wgid % nig) % gsz); u.pn = (wgid % nig) / gsz; if (tr) u.pm = (u.pm & 7) * 8 + (u.pm >> 3); return true;
    }
};

struct ColTileOrder { int pn, first, stride, nM; __host__ __device__ bool next(int i, Unit& u) const { const int pm = first + i * stride; if (pm >= nM) return false; u.pm = pm; u.pn = pn; return true; } };

typedef float f32x2v __attribute__((ext_vector_type(2))); typedef __bf16 bf16x2v __attribute__((ext_vector_type(2)));
__device__ __forceinline__ unsigned cvt_pk_bf16(float lo, float hi) { const f32x2v v = {lo, hi}; const bf16x2v b = __builtin_convertvector(v, bf16x2v); return __builtin_bit_cast(unsigned, b); }
__device__ __forceinline__ unsigned cvt4_fp8(float a, float b, float c, float d) { int w = __builtin_amdgcn_cvt_pk_fp8_f32(a, b, 0, false); w = __builtin_amdgcn_cvt_pk_fp8_f32(c, d, w, true); return (unsigned)w; }
typedef float f32x2u __attribute__((ext_vector_type(2)));
__device__ __forceinline__ void unpack8_fp8(const u32x2 g, float (&o)[8]) { const f32x2u a = __builtin_amdgcn_cvt_pk_f32_fp8((int)g.x, false), b = __builtin_amdgcn_cvt_pk_f32_fp8((int)g.x, true), c = __builtin_amdgcn_cvt_pk_f32_fp8((int)g.y, false), d = __builtin_amdgcn_cvt_pk_f32_fp8((int)g.y, true);
    o[0] = a[0]; o[1] = a[1]; o[2] = b[0]; o[3] = b[1]; o[4] = c[0]; o[5] = c[1]; o[6] = d[0]; o[7] = d[1]; }
__device__ __forceinline__ float bflo(unsigned w) { return __uint_as_float(w << 16); }
__device__ __forceinline__ float bfhi(unsigned w) { return __uint_as_float(w & 0xffff0000u); }
__device__ __forceinline__ float sigm(float x) { return __builtin_amdgcn_rcpf(1.0f + __expf(-x)); }
__device__ __forceinline__ float sigq(float x) { return fmaxf(sigm(x), 0.001953125f); }
__device__ __forceinline__ unsigned cvt4_fp8c(float a, float b, float c, float d) { return cvt4_fp8(__builtin_amdgcn_fmed3f(a, -448.f, 448.f), __builtin_amdgcn_fmed3f(b, -448.f, 448.f), __builtin_amdgcn_fmed3f(c, -448.f, 448.f), __builtin_amdgcn_fmed3f(d, -448.f, 448.f)); }

template <int F8_> struct EpiProjT {
    static constexpr bool PERM = true; static constexpr int F8 = F8_, F8W = 0x7A7A7A7A, F8A = 0x7F7F7F7F; static constexpr int MIDK = 0;
    bf16_t* O; int ldc; const float *gqa, *gqb, *gks, *gkw; bf16_t* VST; bf16_t* VWT; float qscale, eps; int seq; bf16_t* GT;
    __device__ __forceinline__ void operator()(const f32x4 (&acc)[2][2][4][2], const Unit& u, int wr, int wc, int fr, int fq) const {
        const int f0 = u.pn * BM + wc * 64;
        const float* g = nullptr; float sc = 1.f;
        if (f0 >= 1024 && f0 < 1536) { g = gqa; sc = qscale; } else if (f0 >= 320 && f0 < 832) { g = gqb; sc = qscale; } else if (f0 == 1792 || f0 == 1856) { g = gks; } else if (f0 == 2048 || f0 == 2112) { g = gkw; }
        bf16_t* VT = nullptr; int kh = 0;
        if (f0 == 1920 || f0 == 1984) { VT = VST; kh = (f0 - 1920) >> 6; } else if (f0 == 2176 || f0 == 2240) { VT = VWT; kh = (f0 - 2176) >> 6; }
        float gv[2][8];
#pragma unroll
        for (int bj = 0; bj < 2; ++bj)
#pragma unroll
            for (int k = 0; k < 8; ++k) gv[bj][k] = g ? g[32 * bj + 8 * fq + k] * sc : 1.f;
        const int row0 = u.pm * BM + wr * 64 + fr;
#pragma unroll
        for (int ai = 0; ai < 2; ++ai)
#pragma unroll
            for (int m = 0; m < 4; ++m) { const int row = row0 + ai * HALF + m * 16; bf16_t* rowp = O + (size_t)row * ldc + f0 + 8 * fq;
                float v[2][8];
#pragma unroll
                for (int bj = 0; bj < 2; ++bj) { const f32x4 v0 = acc[ai][bj][m][0], v1 = acc[ai][bj][m][1]; v[bj][0] = v0[0]; v[bj][1] = v0[1]; v[bj][2] = v0[2]; v[bj][3] = v0[3]; v[bj][4] = v1[0]; v[bj][5] = v1[1]; v[bj][6] = v1[2]; v[bj][7] = v1[3]; }
                if (g) { float ss = 0.f;
#pragma unroll
                    for (int bj = 0; bj < 2; ++bj)
#pragma unroll
                        for (int k = 0; k < 8; ++k) ss += v[bj][k] * v[bj][k];
                    ss += __shfl_xor(ss, 16); ss += __shfl_xor(ss, 32);
                    const float r = rsqrtf(ss * (1.f / 64.f) + eps);
#pragma unroll
                    for (int bj = 0; bj < 2; ++bj)
#pragma unroll
                        for (int k = 0; k < 8; ++k) v[bj][k] *= r * gv[bj][k]; }
#pragma unroll
                for (int bj = 0; bj < 2; ++bj) { u32x4 w; w.x = cvt_pk_bf16(v[bj][0], v[bj][1]); w.y = cvt_pk_bf16(v[bj][2], v[bj][3]); w.z = cvt_pk_bf16(v[bj][4], v[bj][5]); w.w = cvt_pk_bf16(v[bj][6], v[bj][7]);
                    *(u32x4*)(rowp + 32 * bj) = w;
                    if (VT) { const int b = row / seq, s = row % seq; bf16_t* tp = VT + ((size_t)(b * 2 + kh) * 64 + 32 * bj + 8 * fq) * seq + s;
                        tp[0] = (bf16_t)(w.x & 0xffffu); tp[seq] = (bf16_t)(w.x >> 16); tp[2 * seq] = (bf16_t)(w.y & 0xffffu); tp[3 * seq] = (bf16_t)(w.y >> 16);
                        tp[4 * seq] = (bf16_t)(w.z & 0xffffu); tp[5 * seq] = (bf16_t)(w.z >> 16); tp[6 * seq] = (bf16_t)(w.w & 0xffffu); tp[7 * seq] = (bf16_t)(w.w >> 16); } } }
    }
};
using EpiProj = EpiProjT<0>;

struct EpiGateSig {
    static constexpr bool PERM = true; static constexpr int F8 = 1, F8W = 0x7A7A7A7A, F8A = 0x7F7F7F7F; static constexpr int MIDK = 0;
    unsigned char* GT;
    __device__ __forceinline__ void operator()(const f32x4 (&acc)[2][2][4][2], const Unit& u, int wr, int wc, int fr, int fq) const {
        unsigned char* tp = GT + ((size_t)(u.pm * 8 + u.pn) * 65536) + ((size_t)(wr * 4 + wc) * 64 + fq * 16 + fr) * 8;
#pragma unroll
        for (int ai = 0; ai < 2; ++ai)
#pragma unroll
            for (int m = 0; m < 4; ++m)
#pragma unroll
                for (int bj = 0; bj < 2; ++bj) { const f32x4 v0 = acc[ai][bj][m][0], v1 = acc[ai][bj][m][1];
                    u32x2 w; w.x = cvt4_fp8(sigq(v0[0]), sigq(v0[1]), sigq(v0[2]), sigq(v0[3])); w.y = cvt4_fp8(sigq(v1[0]), sigq(v1[1]), sigq(v1[2]), sigq(v1[3]));
                    *(u32x2*)(tp + (size_t)(((ai * 4 + m) * 2 + bj) * 4096)) = w; }
    }
};

struct EpiProjGate8 {
    static constexpr bool PERM = true; static constexpr int F8 = 1, F8W = 0x7A7A7A7A, F8A = 0x7F7F7F7F; static constexpr int MIDK = 0;
    EpiProjT<1> ep; EpiGateSig eg;
    __device__ __forceinline__ void operator()(const f32x4 (&acc)[2][2][4][2], const Unit& u, int wr, int wc, int fr, int fq) const {
        Unit v = u;
        if (u.pn < 4) { v.pn = u.pn + 4; ep(acc, v, wr, wc, fr, fq); } else { v.pn = u.pn - 4; eg(acc, v, wr, wc, fr, fq); }
    }
};

struct EpiGate2 {
    static constexpr bool PERM = true; static constexpr int F8 = 1, F8W = 0x7A7A7A7A, F8A = 0x7B7B7B7B; static constexpr int MIDK = 4;
    unsigned char* O; int ldc; const unsigned char* GT;
    __device__ __forceinline__ void mid(f32x4 (&acc)[2][2][4][2], const Unit& u, int wr, int wc, int fr, int fq) const {
        asm volatile("" : "+v"(fr), "+v"(fq));
        const unsigned char* ta = GT + ((size_t)(u.pm * 8 + u.pn) * 65536) + ((size_t)(wr * 4 + wc) * 64 + fq * 16 + fr) * 8; const unsigned char* tb = ta + 4 * 65536;
        u32x2 ga[3][2], gb[3][2];
#define EG2_LOAD(slot, g) { _Pragma("unroll") for (int bj = 0; bj < 2; ++bj) { const int so = ((g) * 2 + bj) * 4096; ga[slot][bj] = *(const u32x2*)(ta + so); gb[slot][bj] = *(const u32x2*)(tb + so); } }
        EG2_LOAD(0, 0) EG2_LOAD(1, 1)
#pragma unroll
        for (int g = 0; g < 8; ++g) { const int ai = g >> 2, m = g & 3;
            if (g + 2 < 8) EG2_LOAD((g + 2) % 3, g + 2)
#pragma unroll
            for (int bj = 0; bj < 2; ++bj) { float fa[8], fb[8], r[8]; unpack8_fp8(ga[g % 3][bj], fa); unpack8_fp8(gb[g % 3][bj], fb);
#pragma unroll
                for (int e = 0; e < 8; ++e) r[e] = fa[e] * __builtin_amdgcn_rcpf(fb[e]);
#pragma unroll
                for (int e = 0; e < 4; ++e) { acc[ai][bj][m][0][e] *= r[e]; acc[ai][bj][m][1][e] *= r[4 + e]; } }
            asm volatile("" ::: "memory"); }
#undef EG2_LOAD
    }
    __device__ __forceinline__ void operator()(const f32x4 (&acc)[2][2][4][2], const Unit& u, int wr, int wc, int fr, int fq) const {
        const int row0 = u.pm * BM + wr * 64 + fr, col0 = u.pn * BM + wc * 64 + 16 * fq;
        const unsigned char* tb = GT + ((size_t)(u.pm * 8 + u.pn + 4) * 65536) + ((size_t)(wr * 4 + wc) * 64 + fq * 16 + fr) * 8;
#pragma unroll
        for (int ai = 0; ai < 2; ++ai)
#pragma unroll
            for (int m = 0; m < 4; ++m) { const size_t row = (size_t)(row0 + ai * HALF + m * 16); unsigned char* rowp = O + row * ldc + col0;
                u32x4 w;
#pragma unroll
                for (int bj = 0; bj < 2; ++bj) { const f32x4 v0 = acc[ai][bj][m][0] * 16.f, v1 = acc[ai][bj][m][1] * 16.f;
                    float gg[8]; unpack8_fp8(*(const u32x2*)(tb + ((ai * 4 + m) * 2 + bj) * 4096), gg);
                    w[2 * bj] = cvt4_fp8c(v0[0] * gg[0], v0[1] * gg[1], v0[2] * gg[2], v0[3] * gg[3]);
                    w[2 * bj + 1] = cvt4_fp8c(v1[0] * gg[4], v1[1] * gg[5], v1[2] * gg[6], v1[3] * gg[7]); }
                *(u32x4*)rowp = w; }
    }
};
struct EpiRelu2 {
    static constexpr bool PERM = true; static constexpr int F8 = 1, F8W = 0x79797979, F8A = 0x7F7F7F7F; static constexpr int MIDK = 0;
    unsigned char* O; int ldc; const PG8_LAS float* rstdL; int pm0, pm1, pm2;
    __device__ __forceinline__ void operator()(const f32x4 (&acc)[2][2][4][2], const Unit& u, int wr, int wc, int fr, int fq) const {
        const int row0 = u.pm * BM + wr * 64 + fr, col0 = u.pn * BM + wc * 64 + 16 * fq;
        const PG8_LAS float* rl = rstdL + (u.pm == pm0 ? 0 : (u.pm == pm1 ? 256 : (u.pm == pm2 ? 512 : 768))) + wr * 64 + fr;
#pragma unroll
        for (int ai = 0; ai < 2; ++ai)
#pragma unroll
            for (int m = 0; m < 4; ++m) { const size_t row = (size_t)(row0 + ai * HALF + m * 16); unsigned char* rowp = O + row * ldc + col0;
                const float rs = rl[ai * HALF + m * 16];
                u32x4 w;
#pragma unroll
                for (int bj = 0; bj < 2; ++bj) { const f32x4 v0 = acc[ai][bj][m][0], v1 = acc[ai][bj][m][1];
                    float o[8] = {v0[0], v0[1], v0[2], v0[3], v1[0], v1[1], v1[2], v1[3]};
#pragma unroll
                    for (int e = 0; e < 8; ++e) { const int ob = __float_as_int(o[e]); const float t = __int_as_float(ob > 0 ? ob : 0) * rs; o[e] = fminf(t * t, 448.f); }
                    w[2 * bj] = cvt4_fp8(o[0], o[1], o[2], o[3]); w[2 * bj + 1] = cvt4_fp8(o[4], o[5], o[6], o[7]); }
                *(u32x4*)rowp = w; }
    }
};
struct EpiOutRes {
    static constexpr bool PERM = true; static constexpr int F8 = 1, F8W = 0x7A7A7A7A, F8A = 0x7B7B7B7B; static constexpr int MIDK = 0;
    const float* base; float* out; bf16_t* xb; int ldc; float* parts; unsigned char* x8;
    __device__ __forceinline__ void operator()(const f32x4 (&acc)[2][2][4][2], const Unit& u, int wr, int wc, int fr, int fq) const {
        const int col0 = u.pn * BM + wc * 32 + 8 * fq;
        const int colp = u.pn * BM + wc * 64 + 16 * fq;
#pragma unroll
        for (int ai = 0; ai < 2; ++ai)
#pragma unroll
            for (int m = 0; m < 4; ++m) { const int r = u.pm * BM + ai * HALF + wr * 64 + m * 16 + fr; const size_t off = (size_t)r * ldc + col0, offp = (size_t)r * ldc + colp; float ss = 0.f;
                u32x4 wb[2], q;
#pragma unroll
                for (int bj = 0; bj < 2; ++bj) { const f32x4 b0 = *(const f32x4*)(base + off + bj * HALF), b1 = *(const f32x4*)(base + off + bj * HALF + 4);
                    const f32x4 o0 = b0 + acc[ai][bj][m][0], o1 = b1 + acc[ai][bj][m][1];
                    ss += ((o0[0] * o0[0] + o0[1] * o0[1]) + (o0[2] * o0[2] + o0[3] * o0[3])) + ((o1[0] * o1[0] + o1[1] * o1[1]) + (o1[2] * o1[2] + o1[3] * o1[3]));
                    wb[bj].x = cvt_pk_bf16(o0[0], o0[1]); wb[bj].y = cvt_pk_bf16(o0[2], o0[3]); wb[bj].z = cvt_pk_bf16(o1[0], o1[1]); wb[bj].w = cvt_pk_bf16(o1[2], o1[3]);
                    q[2 * bj] = cvt4_fp8c(o0[0], o0[1], o0[2], o0[3]); q[2 * bj + 1] = cvt4_fp8c(o1[0], o1[1], o1[2], o1[3]); }
                *(u32x4*)(xb + offp) = wb[0]; *(u32x4*)(xb + offp + 8) = wb[1]; *(u32x4*)(x8 + offp) = q;
                ss += __shfl_xor(ss, 16); ss += __shfl_xor(ss, 32);
                if (fq == 0) parts[(size_t)r * 16 + u.pn * 4 + wc] = ss; }
    }
};
struct EpiFinal {
    static constexpr bool PERM = true; static constexpr int F8 = 1, F8W = 0x78787878, F8A = 0x7C7C7C7C; static constexpr int MIDK = 0;
    float* out; const bf16_t* xb; int ldc;
    __device__ __forceinline__ void operator()(const f32x4 (&acc)[2][2][4][2], const Unit& u, int wr, int wc, int fr, int fq) const {
        const int col0 = u.pn * BM + wc * 32 + 8 * fq;
        const int colp = u.pn * BM + wc * 64 + 16 * fq;
#pragma unroll
        for (int ai = 0; ai < 2; ++ai)
#pragma unroll
            for (int m = 0; m < 4; ++m) { const int r = u.pm * BM + ai * HALF + wr * 64 + m * 16 + fr; const size_t off = (size_t)r * ldc + col0, offp = (size_t)r * ldc + colp;
#pragma unroll
                for (int bj = 0; bj < 2; ++bj) { const u32x4 w = *(const u32x4*)(xb + offp + 8 * bj); const f32x4 a0 = acc[ai][bj][m][0], a1 = acc[ai][bj][m][1];
                    f32x4 o0, o1; o0[0] = bflo(w.x) + a0[0]; o0[1] = bfhi(w.x) + a0[1]; o0[2] = bflo(w.y) + a0[2]; o0[3] = bfhi(w.y) + a0[3];
                    o1[0] = bflo(w.z) + a1[0]; o1[1] = bfhi(w.z) + a1[1]; o1[2] = bflo(w.w) + a1[2]; o1[3] = bfhi(w.w) + a1[3];
                    *(f32x4*)(out + off + bj * HALF) = o0; *(f32x4*)(out + off + bj * HALF + 4) = o1; } }
    }
};

template <class Epi, class Sched, bool ALIGN_EPI = false>
__device__ __forceinline__ void gemm_phase(PG8_LAS unsigned char* lds, const Gemm g, const Sched& S, const Epi& E) {
    int tid_ = threadIdx.x; asm volatile("" : "+v"(tid_));
    const int tid = tid_, wid = __builtin_amdgcn_readfirstlane(tid >> 6), lane = tid & 63, wr = wid >> 2, wc = wid & 3, fr = lane & 15, fq = lane >> 4;
    int K_ = g.K; asm volatile("" : "+s"(K_));
    const int K = K_, nt = K / BK;
    unsigned voffA[2], voffB[2];
#pragma unroll
    for (int i = 0; i < 2; ++i) { int R, C; stage_rc(tid * 16 + i * 8192, R, C); const int Rb = Epi::PERM ? ((R & ~31) + perm32(R & 31)) : R;
        voffA[i] = (unsigned)(R * g.lda + C) * 2u; voffB[i] = (unsigned)(Rb * K + C) * 2u; }
    const size_t kstep = (size_t)(BK * 2);
    const size_t hstepA = (size_t)HALF * g.lda * 2, hstepB = (size_t)HALF * K * 2;
    const size_t tstepA = 2 * hstepA, tstepB = 2 * hstepB;
    const unsigned ldsw = (unsigned)wid * 1024u;
    const int aoff = lds_byte(wr * 64 + fr, fq * 8), boff = lds_byte(wc * 32 + fr, fq * 8);
#define PG8_SA(b, h) (((b) * 2 + (h)) * HTB)
#define PG8_SB(b, h) ((4 + (b) * 2 + (h)) * HTB)
#define PG8_STAGE(bufoff, gbase, voff) do { _Pragma("unroll") for (int _i = 0; _i < 2; ++_i) \
        __builtin_amdgcn_global_load_lds((const unsigned*)((const char*)(gbase) + (voff)[_i]), (PG8_LAS unsigned*)(lds + (bufoff) + ldsw + _i * 8192), 16, 0, 0); } while (0)
#define PG8_LDA(dst, b, h) do { _Pragma("unroll") for (int m = 0; m < 4; ++m) _Pragma("unroll") for (int k = 0; k < 2; ++k) dst[m][k] = *(const PG8_LAS bf16x8*)(lds + PG8_SA(b, h) + aoff + m * 2048 + k * 1024); } while (0)
#define PG8_LDB(dst, b, h) do { _Pragma("unroll") for (int n = 0; n < 2; ++n) _Pragma("unroll") for (int k = 0; k < 2; ++k) dst[n][k] = *(const PG8_LAS bf16x8*)(lds + PG8_SB(b, h) + boff + n * 2048 + k * 1024); } while (0)
#define PG8_CAT(x) __builtin_bit_cast(i32x8, __builtin_shufflevector((x)[0], (x)[1], 0, 1, 2, 3, 4, 5, 6, 7, 8, 9, 10, 11, 12, 13, 14, 15))
#define PG8_MMA(ai, bj, At, Bt) do { __builtin_amdgcn_s_setprio(1); _Pragma("unroll") for (int m = 0; m < 4; ++m) _Pragma("unroll") for (int n = 0; n < 2; ++n) { \
        if constexpr (Epi::F8 != 0) asm volatile("v_mfma_scale_f32_16x16x128_f8f6f4 %0, %1, %2, %0, %3, %4 op_sel_hi:[0,0,0]" : "+v"(acc[ai][bj][m][n]) : "v"(PG8_CAT(Bt[n])), "v"(PG8_CAT(At[m])), "v"(f8w), "v"(f8a)); \
        else { _Pragma("unroll") for (int k = 0; k < 2; ++k) acc[ai][bj][m][n] = __builtin_amdgcn_mfma_f32_16x16x32_bf16(Bt[n][k], At[m][k], acc[ai][bj][m][n], 0, 0, 0); } } \
        __builtin_amdgcn_s_setprio(0); } while (0)
#define PG8_WAIT_V(n) asm volatile("s_waitcnt vmcnt(" #n ")" ::: "memory")
#define PG8_WAIT_L(n) asm volatile("s_waitcnt lgkmcnt(" #n ")" ::: "memory")
#define PG8_BAR __builtin_amdgcn_s_barrier()
#define PG8_SCHED __builtin_amdgcn_sched_barrier(0)
    Unit cur, nxt; int ui = 0;
    if (!S.next(0, cur)) return;
    int f8w = Epi::F8W, f8a = Epi::F8A; asm volatile("" : "+v"(f8w), "+v"(f8a));
    f32x4 acc[2][2][4][2];
#pragma unroll
    for (int a = 0; a < 2; ++a)
#pragma unroll
        for (int b = 0; b < 2; ++b)
#pragma unroll
            for (int m = 0; m < 4; ++m)
#pragma unroll
                for (int n = 0; n < 2; ++n) acc[a][b][m][n] = (f32x4){0.f, 0.f, 0.f, 0.f};
    bf16x8 At[4][2], B0[2][2], B1[2][2];
    const char* cA = (const char*)g.A + (size_t)cur.pm * tstepA; const char* cB = (const char*)g.Bt + (size_t)cur.pn * tstepB;
    PG8_STAGE(PG8_SB(0, 0), cB, voffB); PG8_STAGE(PG8_SB(0, 1), cB + hstepB, voffB); PG8_STAGE(PG8_SA(0, 0), cA, voffA); PG8_STAGE(PG8_SA(0, 1), cA + hstepA, voffA);
    if (wr == 1) PG8_BAR;
    PG8_WAIT_V(2); PG8_BAR;
    PG8_STAGE(PG8_SB(1, 0), cB + kstep, voffB); PG8_STAGE(PG8_SA(1, 0), cA + kstep, voffA); PG8_STAGE(PG8_SB(1, 1), cB + hstepB + kstep, voffB);
    PG8_WAIT_V(6); PG8_BAR;
    for (;;) {
        const bool has_next = S.next(ui + 1, nxt);
        const char* nA = has_next ? (const char*)g.A + (size_t)nxt.pm * tstepA : cA; const char* nB = has_next ? (const char*)g.Bt + (size_t)nxt.pn * tstepB : cB;
#pragma unroll 1
        for (int t = 0; t < nt; t += 2) {
            const bool last = (t == nt - 2);
            const char* a1 = cA + (size_t)(t + 1) * kstep;
            const char* a2 = last ? nA : cA + (size_t)(t + 2) * kstep; const char* b2 = last ? nB : cB + (size_t)(t + 2) * kstep;
            const char* a3 = a2 + kstep; const char* b3 = b2 + kstep;
            PG8_LDB(B0, 0, 0); PG8_LDB(B1, 0, 1); PG8_SCHED; PG8_LDA(At, 0, 0); PG8_STAGE(PG8_SA(1, 1), a1 + hstepA, voffA);
            PG8_WAIT_V(8); PG8_WAIT_L(0); PG8_BAR; PG8_MMA(0, 0, At, B0); PG8_MMA(0, 1, At, B1); PG8_BAR; PG8_SCHED;
            PG8_LDA(At, 0, 1); PG8_STAGE(PG8_SB(0, 0), b2, voffB); PG8_STAGE(PG8_SB(0, 1), b2 + hstepB, voffB); PG8_STAGE(PG8_SA(0, 0), a2, voffA);
            PG8_WAIT_V(8); PG8_WAIT_L(0); PG8_BAR; PG8_MMA(1, 0, At, B0); PG8_MMA(1, 1, At, B1); PG8_BAR; PG8_SCHED;
            PG8_LDB(B0, 1, 0); PG8_LDB(B1, 1, 1); PG8_SCHED; PG8_LDA(At, 1, 0); PG8_STAGE(PG8_SA(0, 1), a2 + hstepA, voffA);
            PG8_WAIT_V(8); PG8_WAIT_L(0); PG8_BAR; PG8_MMA(0, 0, At, B0); PG8_MMA(0, 1, At, B1); PG8_BAR; PG8_SCHED;
            PG8_LDA(At, 1, 1); PG8_STAGE(PG8_SB(1, 0), b3, voffB); PG8_STAGE(PG8_SB(1, 1), b3 + hstepB, voffB); PG8_STAGE(PG8_SA(1, 0), a3, voffA);
            PG8_WAIT_V(8); PG8_WAIT_L(0); PG8_BAR; PG8_MMA(1, 0, At, B0); PG8_MMA(1, 1, At, B1); PG8_BAR; PG8_SCHED;
            if constexpr (Epi::MIDK != 0) { if (t + 2 == Epi::MIDK) { if (wr == 0) PG8_BAR; if constexpr (Epi::F8 != 0) asm volatile("s_nop 15\n\ts_nop 7" ::: "memory"); E.mid(acc, cur, wr, wc, fr, fq); if constexpr (Epi::F8 != 0) asm volatile("s_nop 7" ::: "memory"); if (wr == 1) PG8_BAR; } }
        }
        if constexpr (ALIGN_EPI) { if (wr == 0) PG8_BAR; }
        if constexpr (Epi::F8 != 0) asm volatile("s_nop 15\n\ts_nop 7" ::: "memory");
        E(acc, cur, wr, wc, fr, fq);
        if (!has_next) break;
#pragma unroll
        for (int a = 0; a < 2; ++a)
#pragma unroll
            for (int b = 0; b < 2; ++b)
#pragma unroll
                for (int m = 0; m < 4; ++m)
#pragma unroll
                    for (int n = 0; n < 2; ++n) acc[a][b][m][n] = (f32x4){0.f, 0.f, 0.f, 0.f};
        cur = nxt; cA = nA; cB = nB; ++ui;
        if constexpr (ALIGN_EPI) { if (wr == 1) PG8_BAR; }
    }
    PG8_WAIT_V(0);
    if constexpr (!ALIGN_EPI) { if (wr == 0) PG8_BAR; }
    PG8_BAR;
#undef PG8_SA
#undef PG8_SB
#undef PG8_STAGE
#undef PG8_LDA
#undef PG8_LDB
#undef PG8_MMA
#undef PG8_CAT
#undef PG8_WAIT_V
#undef PG8_WAIT_L
#undef PG8_BAR
#undef PG8_SCHED
}
}

#ifndef PROBE_P3
#define PROBE_P3 1
#endif
#define PROBE_P0 1
#define PROBE_BAR 0
#ifndef PROBE_SPAN
#define PROBE_SPAN 0
#endif
#define PROBE_DPRE 1
#define PROBE_DIDX 1
#define PROBE_DTHR 1
#define PROBE_DATT 1
#define PROBE_NSA 1
#define PROBE_P1 1
#define PROBE_P2 1
#define PROBE_P4 1
#define PROBE_P5 1
#define PROBE_P6 1
constexpr int NWAVES = 8;
constexpr int BATCH = 8, SEQ = 2048, DM = 1024, M = BATCH * SEQ, FF = 4096;
constexpr int NPROJ = 4352;
constexpr int PITCH = 2304;
constexpr int C_QI = 0, C_KI = 256, C_WI = 288, C_GB = 296, C_QB = 320, C_KC = 832, C_QA = 1024, C_CA = 1536, C_VC = 1664, C_KS = 1792, C_VS = 1920, C_KW = 2048, C_VW = 2176, C_GM = 2304;
constexpr int NCMP = 127, TOPK = 256;
constexpr float RMS_EPS = 1e-6f;
constexpr float LOG2E = 1.4426950408889634f;
constexpr float QSCALE = 0.125f * LOG2E;

constexpr size_t MiB = 1u << 20;
constexpr size_t WS_CTL = 0, CTL_ZERO_BYTES = 64 * 1024;
constexpr size_t WS_WIN = 1 * MiB;
constexpr size_t WS_WIN8C = 3 * MiB;
constexpr size_t WS_WIN8T = 6 * MiB;
constexpr size_t WS_WLT = 9 * MiB + 512 * 1024;
constexpr size_t WS_W2T = WS_WLT + 64 * 1024;
constexpr size_t WS_W1T = 31 * MiB;
constexpr size_t WS_WUPA = 10 * MiB, WS_WUPB = 11 * MiB;
constexpr size_t WS_WOUT = 12 * MiB;
constexpr size_t WS_WFF1 = 14 * MiB;
constexpr size_t WS_WFF2 = 22 * MiB;
constexpr size_t WS_PARTS = 30 * MiB;
constexpr size_t WS_PROJ = 32 * MiB;
constexpr size_t WS_GT = 104 * MiB;
constexpr size_t WS_MERGED = 168 * MiB;
constexpr size_t WS_H8 = 184 * MiB;
constexpr size_t WS_X1B = 200 * MiB;
constexpr size_t WS_OUTSCR = 232 * MiB;
constexpr size_t WS_END = 248 * MiB;
constexpr size_t DO_H = 0;
constexpr size_t DO_KA = 32 * MiB;
constexpr size_t DO_VA = 34 * MiB;
constexpr size_t DO_VAT = 36 * MiB;
constexpr size_t DO_VST = 38 * MiB;
constexpr size_t DO_VWT = 42 * MiB;
constexpr size_t DO_KC = 46 * MiB;
constexpr size_t DO_VC = 47 * MiB;
constexpr size_t DO_VCT = 48 * MiB;

constexpr int CW_BAR = 4096;
constexpr int RING_BYTES = 131072;
constexpr int MISC_OFF = 141312 + 64;
constexpr int LDS_BYTES = 147456;

#define GAS __attribute__((address_space(1)))
#define LAS __attribute__((address_space(3)))
typedef unsigned short bf16;
typedef unsigned v4u __attribute__((ext_vector_type(4)));
typedef float f32x4 __attribute__((ext_vector_type(4)));
#define LDS_WAIT() asm volatile("s_waitcnt lgkmcnt(0)" ::: "memory")
typedef short bf16x8 __attribute__((ext_vector_type(8)));
typedef float f32x16 __attribute__((ext_vector_type(16)));
typedef unsigned long long u64;
typedef u64 u64x2 __attribute__((ext_vector_type(2)));

__device__ __forceinline__ unsigned f2bf(float f) { return pg8::cvt_pk_bf16(f, 0.f) & 0xffffu; }
__device__ __forceinline__ unsigned pk2(float lo, float hi) { return pg8::cvt_pk_bf16(lo, hi); }
__device__ __forceinline__ float bf2f(bf16 b) { return __uint_as_float((unsigned)b << 16); }
__device__ __forceinline__ void unpack8(const v4u w, float* o) {
    o[0] = __uint_as_float(w.x << 16); o[1] = __uint_as_float(w.x & 0xffff0000u); o[2] = __uint_as_float(w.y << 16); o[3] = __uint_as_float(w.y & 0xffff0000u);
    o[4] = __uint_as_float(w.z << 16); o[5] = __uint_as_float(w.z & 0xffff0000u); o[6] = __uint_as_float(w.w << 16); o[7] = __uint_as_float(w.w & 0xffff0000u);
}
__device__ __forceinline__ float xhalf_max(float v) { auto rr = __builtin_amdgcn_permlane32_swap(__float_as_uint(v), __float_as_uint(v), false, false); return fmaxf(__uint_as_float(rr[0]), __uint_as_float(rr[1])); }
__device__ __forceinline__ float xhalf_sum(float v) { auto rr = __builtin_amdgcn_permlane32_swap(__float_as_uint(v), __float_as_uint(v), false, false); return __uint_as_float(rr[0]) + __uint_as_float(rr[1]); }
typedef float f32x2_t __attribute__((ext_vector_type(2))); typedef __bf16 bf16x2_t __attribute__((ext_vector_type(2)));
__device__ __forceinline__ unsigned cvt2(float lo, float hi) { const f32x2_t v = {lo, hi}; const bf16x2_t b = __builtin_convertvector(v, bf16x2_t); return __builtin_bit_cast(unsigned, b); }
__device__ __forceinline__ float wave_sum(float v) {
#pragma unroll
    for (int o = 1; o < 64; o <<= 1) v += __shfl_xor(v, o);
    return v;
}
__device__ __forceinline__ float wave_max(float v) {
#pragma unroll
    for (int o = 1; o < 64; o <<= 1) v = fmaxf(v, __shfl_xor(v, o));
    return v;
}
__device__ __forceinline__ int wave_sum_i(int v) {
#pragma unroll
    for (int o = 1; o < 64; o <<= 1) v += __shfl_xor(v, o);
    return v;
}

#define XB_TMO      128
#define XB_MIS      192
#define XB_XCNT(j)  (256  + 64 * (j))
#define XB_XSUB(j)  (1280 + 64 * (j))
#define XB_XGEN(j)  (2304 + 64 * (j))
#define XB_TOP      3328
#define XB_TOPGEN   3392
#define XCD_BAR_WORDS 3456
#define XB_GSUB(g)  (3456 + 32 * (g))
#define XB_GGEN(g)  (3456 + 32 * (g) + 16)
#define XB_SPIN_CAP (1u << 23)

__device__ __forceinline__ unsigned xb_ld(unsigned* p)              { return __hip_atomic_load(p, __ATOMIC_RELAXED, __HIP_MEMORY_SCOPE_AGENT); }
__device__ __forceinline__ unsigned xb_add(unsigned* p, unsigned v) { return __hip_atomic_fetch_add(p, v, __ATOMIC_RELAXED, __HIP_MEMORY_SCOPE_AGENT); }
__device__ __forceinline__ unsigned xb_xcc_id() { return (unsigned)__builtin_amdgcn_s_getreg((3 << 11) | 20) & 0xFu; }
#define XB_SPIN(cond, bar) do { unsigned _sp = 0; while (cond) { __builtin_amdgcn_s_sleep(1); \
    if ((++_sp & 255u) == 0u) { if (xb_ld(&(bar)[XB_TMO])) break; if (_sp > XB_SPIN_CAP) { atomicAdd(&(bar)[XB_TMO], 1u); break; } } } } while (0)

struct XcdBarrier { unsigned* bar; unsigned x; volatile LAS unsigned* st; };

__device__ __forceinline__ XcdBarrier xcd_barrier_post(unsigned* bar, volatile LAS unsigned* st) {
    XcdBarrier b; b.bar = bar; b.x = xb_xcc_id(); b.st = st;
    if (threadIdx.x == 0) (void)xb_add(&bar[XB_XCNT(b.x)], 1u);
    return b;
}
__device__ __forceinline__ void xcd_barrier_complete(unsigned* bar, unsigned x, unsigned& nloc, unsigned& nx) {
    const unsigned G = gridDim.x * gridDim.y * gridDim.z;
    unsigned sum, cnt, mine, sp = 0u;
    for (;;) {
        sum = 0u; cnt = 0u; mine = 0u;
#pragma unroll
        for (unsigned j = 0; j < 16; ++j) { const unsigned c = xb_ld(&bar[XB_XCNT(j)]); sum += c; cnt += (c > 0u) ? 1u : 0u; mine = (j == x) ? c : mine; }
        if (sum == G) break;
        __builtin_amdgcn_s_sleep(1);
        if ((++sp & 255u) == 0u) { if (xb_ld(&bar[XB_TMO])) break; if (sp > XB_SPIN_CAP) { atomicAdd(&bar[XB_TMO], 1u); break; } }
    }
    nloc = mine > 0u ? mine : 1u; nx = cnt > 0u ? cnt : 1u;
}
__device__ __forceinline__ void xcd_barrier(const XcdBarrier& b, int local = 0) {
    asm volatile("s_waitcnt vmcnt(0)" ::: "memory");
    __syncthreads();
    if (threadIdx.x == 0) {
        unsigned* bar = b.bar;
        __builtin_amdgcn_s_waitcnt(0);
        unsigned nloc = b.st[0], nx = b.st[1];
        const bool first = nloc == 0u;
        if (first) { xcd_barrier_complete(bar, b.x, nloc, nx); b.st[0] = nloc; b.st[1] = nx; }
        const bool loc = local != 0 && b.st[2] == 1u && gridDim.x == 256u;
        if (loc && local == 1) {
            const unsigned gi = (blockIdx.x & 7u) * 8u + ((blockIdx.x >> 3) & 7u);
            const unsigned oldg = xb_add(&bar[XB_GSUB(gi)], 1u), geng = oldg >> 2;
            if ((oldg & 3u) == 3u) xb_add(&bar[XB_GGEN(gi)], 1u);
            else XB_SPIN(xb_ld(&bar[XB_GGEN(gi)]) == geng, bar);
            __builtin_amdgcn_fence(__ATOMIC_ACQUIRE, "agent");
            asm volatile("s_waitcnt vmcnt(0)" ::: "memory");
        } else {
        const unsigned old = xb_add(&bar[XB_XSUB(b.x)], 1u);
        const unsigned gen = old / nloc;
        if (old + 1u == (gen + 1u) * nloc) {
            if (!loc) {
            __builtin_amdgcn_fence(__ATOMIC_RELEASE, "agent");
            asm volatile("s_waitcnt vmcnt(0)" ::: "memory");
            const unsigned og = xb_add(&bar[XB_TOP], 1u);
            const unsigned tg = og / nx;
            if (og + 1u == (tg + 1u) * nx) xb_add(&bar[XB_TOPGEN], 1u);
            else XB_SPIN(xb_ld(&bar[XB_TOPGEN]) == tg, bar);
            }
            __builtin_amdgcn_fence(__ATOMIC_ACQUIRE, "agent");
            xb_add(&bar[XB_XGEN(b.x)], 1u);
            asm volatile("s_waitcnt vmcnt(0)" ::: "memory");
        } else {
            XB_SPIN(xb_ld(&bar[XB_XGEN(b.x)]) == gen, bar);
            __builtin_amdgcn_fence(__ATOMIC_ACQUIRE, "agent");
            asm volatile("s_waitcnt vmcnt(0)" ::: "memory");
        }
        }
        if (first) { bool ok = true;
#pragma unroll
            for (unsigned j = 0; j < 8; ++j) { const unsigned w = xb_ld(&bar[XB_MIS + j]); ok = ok && w != 0u && (w & (w - 1u)) == 0u; }
            b.st[2] = (ok && xb_ld(&bar[XB_MIS + 8]) == 0u) ? 1u : 2u; }
    }
    __syncthreads();
}

__device__ __forceinline__ int proj_src_col(int f) {
    if (f < 256) return 640 + f;
    if (f < 288) return 896 + (f - 256);
    if (f < 296) return 928 + (f - 288);
    if (f < 320) return 2216 + (f - 296);
    if (f < 832) return 936 + (f - 320);
    if (f < 960) return 1448 + (f - 832);
    if (f < 1024) return -1;
    if (f < 1536) return f - 1024;
    if (f < 1664) return 512 + (f - 1536);
    if (f < 1792) return 1576 + (f - 1664);
    if (f < 1920) return 1704 + (f - 1792);
    if (f < 2048) return 1832 + (f - 1920);
    if (f < 2176) return 1960 + (f - 2048);
    return 2088 + (f - 2176);
}
__host__ __device__ __forceinline__ int kperm8(int c) { return (c & ~255) | (((c >> 5) & 3) << 6) | (((c >> 3) & 3) << 4) | (((c >> 7) & 1) << 3) | (c & 7); }
struct Ptrs {
    const float* in[23]; float* out; unsigned char* ws;
};

constexpr int I_IN = (DM / 64) * (1024 / 32), I_INB = (DM / 64) * (1024 / 32), I_IN8 = (DM / 64) * (256 / 32), I_ING = (DM / 64) * (2048 / 32), I_UP = (512 / 64) * (DM / 32), I_OUT = (DM / 64) * (DM / 32), I_F1 = (DM / 64) * (FF / 32), I_F2 = (FF / 64) * (DM / 32);
constexpr int I_LT = 4, I_P1 = (2048 / 64) * (128 / 32), I_P2 = 4;
constexpr int P0_EARLY = I_IN + I_INB + I_IN8 + I_ING + 2 * I_LT + 2 * I_P1 + 2 * I_P2, P0_ALL = P0_EARLY + 2 * I_UP + I_OUT + I_F1 + I_F2;
struct P0Item { const float* W; const float* gk; unsigned char* WT; int N, Ndest, dpitch, koff, r, dnoff; float f8s; bool projmap, kperm, frag; };
__device__ __forceinline__ P0Item p0_decode(const Ptrs& P, int it) {
    P0Item d; d.gk = nullptr; d.koff = 0; d.f8s = 0.f; d.projmap = false; d.kperm = false; d.frag = false; d.dnoff = 0; int r = it;
    do {
        if (r < I_IN) { d.W = P.in[2]; d.N = 4288; d.Ndest = 1024; d.WT = P.ws + WS_WIN; d.dpitch = DM; d.projmap = true; break; } r -= I_IN;
        if (r < I_INB) { d.W = P.in[2]; d.N = 4288; d.Ndest = 1024; d.WT = P.ws + WS_WIN8C; d.dpitch = DM; d.projmap = true; d.dnoff = 1024; d.f8s = 32.f; break; } r -= I_INB;
        if (r < I_IN8) { d.W = P.in[2]; d.N = 4288; d.Ndest = 256; d.WT = P.ws + WS_WIN8T; d.dpitch = DM; d.projmap = true; d.dnoff = 2048; d.f8s = 32.f; break; } r -= I_IN8;
        if (r < I_ING) { d.W = P.in[2] + 2240; d.N = 4288; d.Ndest = 2048; d.WT = P.ws + WS_WIN8C + (size_t)1024 * 1024; d.dpitch = DM; d.f8s = 32.f; break; } r -= I_ING;
        if (r < I_LT) { d.W = P.in[6]; d.N = 64; d.Ndest = 64; d.WT = P.ws + WS_WLT; d.dpitch = 128; d.gk = P.in[5]; break; } r -= I_LT;
        if (r < I_LT) { d.W = P.in[7]; d.N = 64; d.Ndest = 64; d.WT = P.ws + WS_WLT + 64 * 128 * 2; d.dpitch = 128; d.gk = P.in[5]; break; } r -= I_LT;
        if (r < I_P1) { d.W = P.in[13]; d.N = 128; d.Ndest = 128; d.WT = P.ws + WS_W1T; d.dpitch = 2048; d.frag = true; break; } r -= I_P1;
        if (r < I_P1) { d.W = P.in[15]; d.N = 128; d.Ndest = 128; d.WT = P.ws + WS_W1T + 128 * 2048 * 2; d.dpitch = 2048; d.frag = true; break; } r -= I_P1;
        if (r < I_P2) { d.W = P.in[14]; d.N = 64; d.Ndest = 64; d.WT = P.ws + WS_W2T; d.dpitch = 128; break; } r -= I_P2;
        if (r < I_P2) { d.W = P.in[16]; d.N = 64; d.Ndest = 64; d.WT = P.ws + WS_W2T + 64 * 128 * 2; d.dpitch = 128; break; } r -= I_P2;
        if (r < I_UP) { d.W = P.in[17]; d.N = DM; d.Ndest = DM; d.WT = P.ws + WS_WUPA; d.dpitch = DM; d.f8s = 32.f; break; } r -= I_UP;
        if (r < I_UP) { d.W = P.in[18]; d.N = DM; d.Ndest = DM; d.WT = P.ws + WS_WUPA; d.dpitch = DM; d.koff = 512; d.f8s = 32.f; break; } r -= I_UP;
        if (r < I_OUT) { d.W = P.in[19]; d.N = DM; d.Ndest = DM; d.WT = P.ws + WS_WOUT; d.dpitch = DM; d.f8s = 32.f; d.kperm = true; break; } r -= I_OUT;
        if (r < I_F1) { d.W = P.in[21]; d.N = FF; d.Ndest = FF; d.WT = P.ws + WS_WFF1; d.dpitch = DM; d.gk = P.in[20]; d.f8s = 64.f; d.kperm = true; break; } r -= I_F1;
        d.W = P.in[22]; d.N = DM; d.Ndest = DM; d.WT = P.ws + WS_WFF2; d.dpitch = FF; d.f8s = 128.f; d.kperm = true;
    } while (0);
    d.r = r; return d;
}
struct P0Regs { float tv[32]; f32x4 g0, g1; };
__device__ __forceinline__ void p0_load(const P0Item& d, int lane, P0Regs& R) {
    const int nblk = d.Ndest / 32, kb = d.r / nblk, nb = d.r % nblk, k0 = 64 * kb, n0 = 32 * nb;
    const int dn = n0 + (lane & 31); const int dg = dn + d.dnoff; const int cl = dg & 255; const int sc = d.projmap ? proj_src_col((dg & ~255) + ((cl >> 5) & 3) * 64 + (cl >> 7) * 32 + (cl & 31)) : dn;
    const float* wp = d.W + (size_t)(k0 + (lane >> 5)) * d.N + (sc >= 0 ? sc : 0);
#pragma unroll
    for (int i = 0; i < 32; ++i) R.tv[i] = wp[(size_t)(2 * i) * d.N];
    if (sc < 0) {
#pragma unroll
        for (int i = 0; i < 32; ++i) R.tv[i] = 0.f; }
    if (d.gk) { const GAS f32x4* gp = (const GAS f32x4*)(d.gk + k0 + 8 * (lane & 7)); R.g0 = gp[0]; R.g1 = gp[1]; } else { R.g0 = (f32x4){1.f, 1.f, 1.f, 1.f}; R.g1 = R.g0; }
}
__device__ __forceinline__ void p0_finish(const P0Item& d, const P0Regs& R, LAS float* scr, int lane) {
    const int nblk = d.Ndest / 32, kb = d.r / nblk, nb = d.r % nblk, k0 = 64 * kb, n0 = 32 * nb;
#pragma unroll
    for (int i = 0; i < 32; ++i) { const int kk = 2 * i + (lane >> 5); scr[kk * 33 + (lane & 31)] = R.tv[i]; }
    LDS_WAIT();
    const int c = lane & 7; const float f = d.f8s != 0.f ? d.f8s : 1.f;
    const float m0 = R.g0[0] * f, m1 = R.g0[1] * f, m2 = R.g0[2] * f, m3 = R.g0[3] * f, m4 = R.g1[0] * f, m5 = R.g1[1] * f, m6 = R.g1[2] * f, m7 = R.g1[3] * f;
#pragma unroll
    for (int j = 0; j < 4; ++j) { const int n = (lane >> 3) + 8 * j; const LAS float* s = scr + (8 * c) * 33 + n;
        const float v0 = s[0 * 33] * m0, v1 = s[1 * 33] * m1, v2 = s[2 * 33] * m2, v3 = s[3 * 33] * m3, v4 = s[4 * 33] * m4, v5 = s[5 * 33] * m5, v6 = s[6 * 33] * m6, v7 = s[7 * 33] * m7;
        const int kk0 = k0 + 8 * c; const int nn = n0 + n, kc = kk0 >> 3;
        const size_t eo = d.frag ? ((size_t)((nn >> 5) * 128 + (kc >> 1)) * 64 + (kc & 1) * 32 + (nn & 31)) * 8 : (size_t)nn * d.dpitch + d.koff + (d.kperm ? kperm8(kk0) : kk0);
        if (d.f8s != 0.f) { pg8::u32x2 o; o.x = pg8::cvt4_fp8(v0, v1, v2, v3); o.y = pg8::cvt4_fp8(v4, v5, v6, v7); *(GAS pg8::u32x2*)(d.WT + eo) = o; }
        else { v4u o; o.x = pk2(v0, v1); o.y = pk2(v2, v3); o.z = pk2(v4, v5); o.w = pk2(v6, v7); *(GAS v4u*)(d.WT + 2 * eo) = o; } }
    LDS_WAIT();
}
__device__ __forceinline__ void p0_items(const Ptrs& P, LAS unsigned char* lds, int first, int last, int worker, int nworkers, int wave, int lane) {
    LAS float* scr = (LAS float*)(lds + wave * 16384);
    int it = first + worker;
    if (it >= last) return;
    P0Item dA = p0_decode(P, it), dB = dA; P0Regs rA, rB; p0_load(dA, lane, rA);
    for (;;) {
        int nx = it + nworkers; bool more = nx < last;
        if (more) { dB = p0_decode(P, nx); p0_load(dB, lane, rB); }
        p0_finish(dA, rA, scr, lane);
        if (!more) break;
        it = nx; nx = it + nworkers; more = nx < last;
        if (more) { dA = p0_decode(P, nx); p0_load(dA, lane, rA); }
        p0_finish(dB, rB, scr, lane);
        if (!more) break;
        it = nx;
    }
}
__device__ __forceinline__ void p0_prologue(const Ptrs& P, LAS unsigned char* lds, int gw, int NGW, int wave, int lane) {
    bf16* H = (bf16*)((unsigned char*)P.out + DO_H); unsigned char* H8 = P.ws + WS_H8;
    f32x4 va[4], vb[4];
    { const int m = gw, m2 = m + NGW < M ? m + NGW : m;
      const GAS f32x4* xa = (const GAS f32x4*)(P.in[0] + (size_t)m * DM) + lane; const GAS f32x4* xb = (const GAS f32x4*)(P.in[0] + (size_t)m2 * DM) + lane;
#pragma unroll
      for (int j = 0; j < 4; ++j) { va[j] = xa[64 * j]; vb[j] = xb[64 * j]; } }
    p0_items(P, lds, 0, P0_EARLY, gw, NGW, wave, lane);
#define P0_ROWS_LOAD(VA, VB, MM) { const int m_ = (MM), m2_ = m_ + NGW < M ? m_ + NGW : m_; \
        const GAS f32x4* xa_ = (const GAS f32x4*)(P.in[0] + (size_t)m_ * DM) + lane; const GAS f32x4* xb_ = (const GAS f32x4*)(P.in[0] + (size_t)m2_ * DM) + lane; \
        _Pragma("unroll") for (int j = 0; j < 4; ++j) { VA[j] = xa_[64 * j]; VB[j] = xb_[64 * j]; } }
#define P0_ROWS_DO(VA, VB, MM) { const int mr_ = (MM), mr2_ = mr_ + NGW < M ? mr_ + NGW : mr_; \
        const GAS f32x4* gr = (const GAS f32x4*)P.in[1] + lane; float sa = 0.f, sb = 0.f; \
        _Pragma("unroll") for (int j = 0; j < 4; ++j) { sa += (VA[j].x * VA[j].x + VA[j].y * VA[j].y) + (VA[j].z * VA[j].z + VA[j].w * VA[j].w); sb += (VB[j].x * VB[j].x + VB[j].y * VB[j].y) + (VB[j].z * VB[j].z + VB[j].w * VB[j].w); } \
        const float ra = rsqrtf(wave_sum(sa) * (1.f / DM) + RMS_EPS), rb = rsqrtf(wave_sum(sb) * (1.f / DM) + RMS_EPS); \
        GAS unsigned long long* oa = (GAS unsigned long long*)(H + (size_t)mr_ * DM) + lane; GAS unsigned long long* ob = (GAS unsigned long long*)(H + (size_t)mr2_ * DM) + lane; \
        GAS unsigned* qa = (GAS unsigned*)(H8 + (size_t)mr_ * DM) + lane; GAS unsigned* qb = (GAS unsigned*)(H8 + (size_t)mr2_ * DM) + lane; \
        _Pragma("unroll") for (int j = 0; j < 4; ++j) { const f32x4 gg = gr[64 * j]; \
            oa[64 * j] = (unsigned long long)pk2(VA[j].x * ra * gg.x, VA[j].y * ra * gg.y) | ((unsigned long long)pk2(VA[j].z * ra * gg.z, VA[j].w * ra * gg.w) << 32); \
            qa[64 * j] = pg8::cvt4_fp8(VA[j].x * ra * gg.x, VA[j].y * ra * gg.y, VA[j].z * ra * gg.z, VA[j].w * ra * gg.w); \
            if (mr2_ != mr_) { ob[64 * j] = (unsigned long long)pk2(VB[j].x * rb * gg.x, VB[j].y * rb * gg.y) | ((unsigned long long)pk2(VB[j].z * rb * gg.z, VB[j].w * rb * gg.w) << 32); \
                qb[64 * j] = pg8::cvt4_fp8(VB[j].x * rb * gg.x, VB[j].y * rb * gg.y, VB[j].z * rb * gg.z, VB[j].w * rb * gg.w); } } }
    f32x4 na[4], nb[4];
    for (int m = gw; m < M; ) {
        int mn = m + 2 * NGW;
        if (mn < M) P0_ROWS_LOAD(na, nb, mn)
        P0_ROWS_DO(va, vb, m)
        if (mn >= M) break;
        m = mn; mn = m + 2 * NGW;
        if (mn < M) P0_ROWS_LOAD(va, vb, mn)
        P0_ROWS_DO(na, nb, m)
        if (mn >= M) break;
        m = mn;
    }
#undef P0_ROWS_LOAD
#undef P0_ROWS_DO
}

__device__ __forceinline__ float gelu_tanh(float x) { const float u = 0.7978845608028654f * (x + 0.044715f * x * x * x); return 0.5f * x * (1.0f + tanhf(u)); }

__device__ __forceinline__ void latent_group(const Ptrs& P, int grp, int lane) {
    const int r32 = lane & 31, hi = lane >> 5; const int tok = 32 * grp + r32;
    const bf16* PROJ = (const bf16*)(P.ws + WS_PROJ); const bf16* WLT = (const bf16*)(P.ws + WS_WLT);
    unsigned char* dob = (unsigned char*)P.out; bf16* KA = (bf16*)(dob + DO_KA); bf16* VAT = (bf16*)(dob + DO_VAT);
    bf16x8 cb[8]; float ss = 0.f;
    const bf16* cp = PROJ + (size_t)tok * PITCH + C_CA + hi * 8;
#pragma unroll
    for (int ks = 0; ks < 8; ++ks) { const v4u w = *(const GAS v4u*)(cp + ks * 16); cb[ks] = __builtin_bit_cast(bf16x8, w); float f[8]; unpack8(w, f);
#pragma unroll
        for (int j = 0; j < 8; ++j) ss += f[j] * f[j]; }
    ss = xhalf_sum(ss);
    const float rstd = rsqrtf(ss * (1.f / 128.f) + RMS_EPS);
    f32x16 acc[4];
#pragma unroll
    for (int nb = 0; nb < 4; ++nb) {
#pragma unroll
        for (int r = 0; r < 16; ++r) acc[nb][r] = 0.f;
#pragma unroll
        for (int ks = 0; ks < 8; ++ks) { const bf16x8 a = *(const GAS bf16x8*)(WLT + (size_t)(32 * nb + r32) * 128 + ks * 16 + hi * 8); acc[nb] = __builtin_amdgcn_mfma_f32_32x32x16_bf16(a, cb[ks], acc[nb], 0, 0, 0); } }
    float sk = 0.f;
#pragma unroll
    for (int nb = 0; nb < 2; ++nb)
#pragma unroll
        for (int r = 0; r < 16; ++r) { const float v = acc[nb][r] * rstd; sk += v * v; }
    sk = xhalf_sum(sk);
    const float kr = rsqrtf(sk * (1.f / 64.f) + RMS_EPS) * rstd;
    const float* gk = P.in[4];
#pragma unroll
    for (int nb = 0; nb < 2; ++nb)
#pragma unroll
        for (int a = 0; a < 4; ++a) { const int n0 = 32 * nb + 8 * a + 4 * hi; const f32x4 gg = *(const GAS f32x4*)(gk + n0);
            pg8::u32x2 w; w.x = pg8::cvt_pk_bf16(acc[nb][4 * a] * kr * gg[0], acc[nb][4 * a + 1] * kr * gg[1]); w.y = pg8::cvt_pk_bf16(acc[nb][4 * a + 2] * kr * gg[2], acc[nb][4 * a + 3] * kr * gg[3]);
            *(GAS pg8::u32x2*)(KA + (size_t)tok * 64 + n0) = w; }
    const int b = tok / SEQ, s = tok % SEQ;
#pragma unroll
    for (int nb = 2; nb < 4; ++nb)
#pragma unroll
        for (int r = 0; r < 16; ++r) { const int d = 32 * (nb - 2) + (r & 3) + 8 * (r >> 2) + 4 * hi; VAT[((size_t)b * 64 + d) * SEQ + s] = (bf16)f2bf(acc[nb][r] * rstd); }
}
__device__ __forceinline__ void compress_unit(const Ptrs& P, LAS unsigned char* lds, int unit, int tid, int wave, int lane) {
    const int cbk = unit & 3, kh = (unit >> 2) & 1, b = (unit >> 3) & 7, kv = unit >> 6;
    const int r32 = lane & 31, hi = lane >> 5, nb = wave & 3, kq = wave >> 2;
    const bf16* PROJ = (const bf16*)(P.ws + WS_PROJ);
    const bf16* W1T = (const bf16*)(P.ws + WS_W1T) + (size_t)kv * 128 * 2048; const bf16* W2T = (const bf16*)(P.ws + WS_W2T) + (size_t)kv * 64 * 128;
    unsigned char* dob = (unsigned char*)P.out; bf16* KC = (bf16*)(dob + DO_KC); bf16* VCT = (bf16*)(dob + DO_VCT);
    const bf16* src = PROJ + (size_t)(b * SEQ) * PITCH + (kv ? C_VC : C_KC) + kh * 64;
    const float* pe = P.in[12];
    const int c = 32 * cbk + r32;
    LAS float* red = (LAS float*)lds;
    LAS float* peL = (LAS float*)(lds + 32768);
    for (int i = tid; i < 2048; i += NWAVES * 64) peL[i] = pe[i];
    __syncthreads();
    LAS unsigned char* hidL = lds + 16384;
    LAS unsigned char* srcL = lds + 49152;
    { const int t0 = 512 * cbk;
      for (int i = tid; i < 528 * 8; i += NWAVES * 64) { const int row = i >> 3, ch = i & 7; int tokn = t0 + row; tokn = tokn > SEQ - 1 ? SEQ - 1 : tokn;
          *(LAS v4u*)(srcL + row * 128 + ((ch ^ ((row >> 4) & 7)) * 16)) = *(const GAS v4u*)(src + (size_t)tokn * PITCH + ch * 8); } }
    __syncthreads();
    f32x16 acc;
#pragma unroll
    for (int r = 0; r < 16; ++r) acc[r] = 0.f;
    const bf16* w1p = W1T + ((size_t)(nb * 128) * 64 + lane) * 8;
#pragma unroll 8
    for (int ks = 64 * kq; ks < 64 * kq + 64; ++ks) {
        const int l = ks >> 2, d = 16 * (ks & 3) + 8 * hi; const int row = 16 * r32 + l;
        const v4u raw = *(LAS const v4u*)(srcL + row * 128 + ((((d >> 3)) ^ ((row >> 4) & 7)) * 16)); float a8[8]; unpack8(raw, a8);
        const f32x4 p0 = *(LAS const f32x4*)(peL + l * 64 + d), p1 = *(LAS const f32x4*)(peL + l * 64 + d + 4);
        pg8::u32x4 aw; aw.x = cvt2(a8[0] + p0[0], a8[1] + p0[1]); aw.y = cvt2(a8[2] + p0[2], a8[3] + p0[3]); aw.z = cvt2(a8[4] + p1[0], a8[5] + p1[1]); aw.w = cvt2(a8[6] + p1[2], a8[7] + p1[3]);
        const bf16x8 bw = *(const GAS bf16x8*)(w1p + (size_t)ks * 512);
        acc = __builtin_amdgcn_mfma_f32_32x32x16_bf16(__builtin_bit_cast(bf16x8, aw), bw, acc, 0, 0, 0);
    }
    if (kq == 1) {
#pragma unroll
        for (int r = 0; r < 16; ++r) red[(nb * 16 + r) * 64 + lane] = acc[r]; }
    __syncthreads();
    if (kq == 0) {
#pragma unroll
        for (int r = 0; r < 16; ++r) { const float h = gelu_tanh(acc[r] + red[(nb * 16 + r) * 64 + lane]); const int cr = (r & 3) + 8 * (r >> 2) + 4 * hi;
            *(LAS bf16*)(hidL + cr * 272 + (32 * nb + r32) * 2) = (bf16)f2bf(h); } }
    __syncthreads();
    if (wave == 0) {
        f32x16 o2[2];
#pragma unroll
        for (int db = 0; db < 2; ++db) {
#pragma unroll
            for (int r = 0; r < 16; ++r) o2[db][r] = 0.f;
#pragma unroll
            for (int ks = 0; ks < 8; ++ks) { const bf16x8 a = *(const GAS bf16x8*)(W2T + (size_t)(32 * db + r32) * 128 + ks * 16 + hi * 8);
                const bf16x8 hb = *(LAS const bf16x8*)(hidL + r32 * 272 + (ks * 16 + hi * 8) * 2);
                o2[db] = __builtin_amdgcn_mfma_f32_32x32x16_bf16(a, hb, o2[db], 0, 0, 0); } }
        const size_t bk = (size_t)(b * 2 + kh);
        if (kv == 0) {
            float sk = 0.f;
#pragma unroll
            for (int db = 0; db < 2; ++db)
#pragma unroll
                for (int r = 0; r < 16; ++r) sk += o2[db][r] * o2[db][r];
            sk = xhalf_sum(sk);
            const float kr = (c < NCMP) ? rsqrtf(sk * (1.f / 64.f) + RMS_EPS) : 0.f;
            const float* gkc = P.in[9];
#pragma unroll
            for (int db = 0; db < 2; ++db)
#pragma unroll
                for (int a = 0; a < 4; ++a) { const int d0 = 32 * db + 8 * a + 4 * hi; const f32x4 gg = *(const GAS f32x4*)(gkc + d0);
                    pg8::u32x2 w; w.x = pg8::cvt_pk_bf16(o2[db][4 * a] * kr * gg[0], o2[db][4 * a + 1] * kr * gg[1]); w.y = pg8::cvt_pk_bf16(o2[db][4 * a + 2] * kr * gg[2], o2[db][4 * a + 3] * kr * gg[3]);
                    *(GAS pg8::u32x2*)(KC + (bk * 128 + c) * 64 + d0) = w; }
        } else {
            const float z = (c < NCMP) ? 1.f : 0.f;
#pragma unroll
            for (int db = 0; db < 2; ++db)
#pragma unroll
                for (int r = 0; r < 16; ++r) { const int d = 32 * db + (r & 3) + 8 * (r >> 2) + 4 * hi; VCT[(bk * 64 + d) * 128 + c] = (bf16)f2bf(o2[db][r] * z); }
        }
    }
    __syncthreads();
}
__device__ __forceinline__ void p2_fast(const Ptrs& P, LAS unsigned char* lds, int vcu, int G, int tid, int wave, int lane) {
    for (int u = vcu; u < 128; u += G) compress_unit(P, lds, u, tid, wave, lane);
    for (int grp = G * NWAVES - 1 - (vcu * NWAVES + wave); grp < M / 32; grp += G * NWAVES) latent_group(P, grp, lane);
}

__device__ __forceinline__ unsigned ord_u32(float f) { const unsigned u = __float_as_uint(f); return (u & 0x80000000u) ? ~u : (u | 0x80000000u); }

__device__ __forceinline__ float inv_ord_u32(unsigned u) { return __uint_as_float((u & 0x80000000u) ? (u ^ 0x80000000u) : ~u); }
template <int CTRL> __device__ __forceinline__ unsigned dpp_mov(unsigned x) { return (unsigned)__builtin_amdgcn_update_dpp(0, (int)x, CTRL, 0xf, 0xf, true); }
__device__ __forceinline__ unsigned wave_umax(unsigned x) {
    unsigned y = dpp_mov<0xB1>(x); x = x > y ? x : y; y = dpp_mov<0x4E>(x); x = x > y ? x : y; y = dpp_mov<0x141>(x); x = x > y ? x : y; y = dpp_mov<0x140>(x); x = x > y ? x : y;
    const unsigned a = __builtin_amdgcn_readlane(x, 0), b = __builtin_amdgcn_readlane(x, 16), c = __builtin_amdgcn_readlane(x, 32), d = __builtin_amdgcn_readlane(x, 48);
    const unsigned ab = a > b ? a : b, cd = c > d ? c : d; return ab > cd ? ab : cd;
}
__device__ __forceinline__ unsigned wave_umin(unsigned x) {
    unsigned y = dpp_mov<0xB1>(x); x = x < y ? x : y; y = dpp_mov<0x4E>(x); x = x < y ? x : y; y = dpp_mov<0x141>(x); x = x < y ? x : y; y = dpp_mov<0x140>(x); x = x < y ? x : y;
    const unsigned a = __builtin_amdgcn_readlane(x, 0), b = __builtin_amdgcn_readlane(x, 16), c = __builtin_amdgcn_readlane(x, 32), d = __builtin_amdgcn_readlane(x, 48);
    const unsigned ab = a < b ? a : b, cd = c < d ? c : d; return ab < cd ? ab : cd;
}
__device__ __forceinline__ unsigned wave_usum(unsigned x) {
    x += dpp_mov<0xB1>(x); x += dpp_mov<0x4E>(x); x += dpp_mov<0x141>(x); x += dpp_mov<0x140>(x);
    return (__builtin_amdgcn_readlane(x, 0) + __builtin_amdgcn_readlane(x, 16)) + (__builtin_amdgcn_readlane(x, 32) + __builtin_amdgcn_readlane(x, 48));
}

constexpr int KT_STRIDE = 144, VT_STRIDE = 144;
constexpr int KT_BYTES = 64 * KT_STRIDE, VT_BYTES = 64 * VT_STRIDE, TILE_BYTES = KT_BYTES + VT_BYTES;
constexpr int A_TILE0 = 0, A_TILE1 = TILE_BYTES, A_STG = 36864, A_IMP = 69632, A_EFF = 102400, A_SEL = 110592;
constexpr int D_MASK = 131072, A_WSC = 139264;
constexpr int D_KMAX = 143360;
constexpr int D_M8 = 36864, M8_STRIDE = 2064;
constexpr int SROW = 2048;


__device__ __forceinline__ float max3f(float a, float b, float c) { float r; asm("v_max3_f32 %0, %1, %2, %3" : "=v"(r) : "v"(a), "v"(b), "v"(c)); return r; }
struct TileRegs { v4u k, v; };
__device__ __forceinline__ TileRegs tile_fetch(const bf16* Kb, size_t kpitch, const bf16* Vb, size_t vpitch, int tid) {
    const int row = tid >> 3, ch = tid & 7; TileRegs r;
    r.k = *(const GAS v4u*)(Kb + (size_t)row * kpitch + ch * 8);
    r.v = *(const GAS v4u*)(Vb + (size_t)row * vpitch + ch * 8);
    return r;
}
__device__ __forceinline__ void tile_store(LAS unsigned char* buf, const TileRegs& r, int tid) {
    const int row = tid >> 3, ch = tid & 7;
    *(LAS v4u*)(buf + row * KT_STRIDE + ch * 16) = r.k;
    LAS u64* vp = (LAS u64*)(buf + KT_BYTES + row * VT_STRIDE + (ch >> 1) * 32 + (ch & 1) * 8);
    vp[0] = (u64)r.v.x | ((u64)r.v.y << 32); vp[2] = (u64)r.v.z | ((u64)r.v.w << 32);
}
struct AttnState { f32x16 o0, o1, la; pg8::u32x4 qx; float m; bool started; };
struct KxOps { pg8::u32x4 k0, k1; };
__device__ __forceinline__ KxOps kx_ops(int r32, int hi) {
    KxOps k; k.k0 = (pg8::u32x4){0u, 0u, 0u, 0u}; k.k1 = k.k0;
    if (hi == 0) { const unsigned v0 = f2bf((float)r32), v1 = f2bf((float)(r32 + 32)); k.k0.y = v0 * 0x10001u; k.k1.y = v1 * 0x10001u; k.k0.z = k.k0.w = k.k1.z = k.k1.w = 0x3F803F80u; }
    return k;
}
__device__ __forceinline__ void attn_init(AttnState& s, float slope2, int hi) {
#pragma unroll
    for (int r = 0; r < 16; ++r) { s.o0[r] = 0.f; s.o1[r] = 0.f; s.la[r] = 0.f; }
    s.qx = (pg8::u32x4){0u, 0u, 0u, 0u};
    if (hi == 0) { const unsigned sh = f2bf(slope2); const unsigned sl = f2bf(slope2 - __uint_as_float(sh << 16)); s.qx.x = sh | (sl << 16); s.qx.y = s.qx.x; }
    s.m = 0.f; s.started = false;
}
__device__ __forceinline__ void attn_init_fixed(AttnState& s, float slope2, float m0, int hi) {
    attn_init(s, slope2, hi); s.m = m0; s.started = true;
    const float nm = -m0; const unsigned m1 = f2bf(nm); const float r1 = nm - __uint_as_float(m1 << 16); const unsigned m2 = f2bf(r1); const float r2 = r1 - __uint_as_float(m2 << 16); const unsigned m3 = f2bf(r2);
    if (hi == 0) { s.qx.z = m1 | (m2 << 16); s.qx.w = m3; }
}
__device__ __forceinline__ bf16x8 pack8(const f32x16& p, int b0) {
    pg8::u32x4 w; w.x = cvt2(p[b0], p[b0 + 1]); w.y = cvt2(p[b0 + 2], p[b0 + 3]); w.z = cvt2(p[b0 + 4], p[b0 + 5]); w.w = cvt2(p[b0 + 6], p[b0 + 7]);
    return __builtin_bit_cast(bf16x8, w);
}
constexpr float ATT_THR = 8.0f;
struct MaskMM { pg8::i32x8 a0, a1; LAS const unsigned char* row; };
template <bool BITS, bool IMP, bool QLDS, bool FIXM = false>
__device__ __forceinline__ void tile_compute(AttnState& st, const bf16x8 (&qf)[4], LAS const unsigned char* qlds, KxOps& KX, float koff, bool active, bool all_active, LAS const unsigned char* buf, LAS float* wsc,
                                             bool need_mask, int lo, int hi_, unsigned mw0, unsigned mw1, f32x16& oimp, int c0, int r32, int hi, const MaskMM* mm = nullptr) {
    f32x16 p0, p1;
    { const unsigned kw = (hi == 0) ? f2bf(koff) * 0x10001u : 0u; KX.k0.x = kw; KX.k1.x = kw;
      pg8::u32x4 q = st.qx; if (!all_active) q.w = (q.w & 0xffffu) | ((active || hi != 0) ? 0u : 0xff800000u);
#pragma unroll
      for (int r = 0; r < 16; ++r) { p0[r] = 0.f; p1[r] = 0.f; }
      if (BITS) {
          const pg8::i32x8 mb = *(LAS const pg8::i32x8*)(mm->row + mw0);
          p0 = __builtin_amdgcn_mfma_scale_f32_32x32x64_f8f6f4(mm->a0, mb, p0, 0, 0, 0, 0x7F7F7F7F, 0, (int)0x93939393u);
          p1 = __builtin_amdgcn_mfma_scale_f32_32x32x64_f8f6f4(mm->a1, mb, p1, 0, 0, 0, 0x7F7F7F7F, 0, (int)0x93939393u); }
      p0 = __builtin_amdgcn_mfma_f32_32x32x16_bf16(__builtin_bit_cast(bf16x8, KX.k0), __builtin_bit_cast(bf16x8, q), p0, 0, 0, 0);
      p1 = __builtin_amdgcn_mfma_f32_32x32x16_bf16(__builtin_bit_cast(bf16x8, KX.k1), __builtin_bit_cast(bf16x8, q), p1, 0, 0, 0); }
    { LAS const unsigned char* kp = buf + r32 * KT_STRIDE + hi * 16;
      bf16x8 kf0[4], kf1[4];
#pragma unroll
      for (int ds = 0; ds < 4; ++ds) { kf0[ds] = *(LAS const bf16x8*)(kp + ds * 32); kf1[ds] = *(LAS const bf16x8*)(kp + 32 * KT_STRIDE + ds * 32); }
      __builtin_amdgcn_sched_barrier(0);
#pragma unroll
      for (int ds = 0; ds < 4; ++ds) {
          const bf16x8 qv = QLDS ? *(LAS const bf16x8*)(qlds + (((2 * ds + hi) ^ (r32 & 7)) * 16)) : qf[ds];
          p0 = __builtin_amdgcn_mfma_f32_32x32x16_bf16(kf0[ds], qv, p0, 0, 0, 0);
          p1 = __builtin_amdgcn_mfma_f32_32x32x16_bf16(kf1[ds], qv, p1, 0, 0, 0); } }
    v4u vx0[4], vx1[4];
    { LAS const unsigned char* vp = buf + KT_BYTES + r32 * VT_STRIDE + hi * 16;
#pragma unroll
      for (int s = 0; s < 4; ++s) { vx0[s] = *(LAS const v4u*)(vp + s * 32); vx1[s] = *(LAS const v4u*)(vp + 32 * VT_STRIDE + s * 32); } }
    __builtin_amdgcn_sched_barrier(0);
    if (BITS) { }
    else if (need_mask) { const int lo2 = lo - 4 * hi, hi2 = hi_ - 4 * hi;
#pragma unroll
        for (int r = 0; r < 16; ++r) { const int c = (r & 3) + 8 * (r >> 2); if (c < lo2 || c > hi2) p0[r] = -INFINITY; if (c + 32 < lo2 || c + 32 > hi2) p1[r] = -INFINITY; } }
    if (!FIXM) {
    asm volatile("s_nop 15\n\ts_nop 7" : "+v"(p0), "+v"(p1));
    float rm;
    { float a = max3f(p0[0], p0[1], p1[0]), b = max3f(p0[2], p0[3], p1[1]); a = max3f(a, p1[2], p1[3]);
#pragma unroll
      for (int r = 4; r < 16; r += 4) { a = max3f(a, p0[r], p0[r + 1]); b = max3f(b, p0[r + 2], p0[r + 3]); a = max3f(a, p1[r], p1[r + 1]); b = max3f(b, p1[r + 2], p1[r + 3]); }
      rm = max3f(a, b, b); }
    rm = xhalf_max(rm);
    const bool need = st.started ? (rm > ATT_THR) : (rm > -1e8f);
    if (__any(need)) {
        const float dl = need ? rm : 0.f; const float f = st.started ? __builtin_amdgcn_exp2f(-dl) : 1.0f;
        st.m += dl; st.started = st.started || need;
        { const float nm = -st.m; const unsigned m1 = f2bf(nm); const float r1 = nm - __uint_as_float(m1 << 16); const unsigned m2 = f2bf(r1); const float r2 = r1 - __uint_as_float(m2 << 16); const unsigned m3 = f2bf(r2);
          if (hi == 0) { st.qx.z = m1 | (m2 << 16); st.qx.w = m3; } }
#pragma unroll
        for (int r = 0; r < 16; ++r) { p0[r] -= dl; p1[r] -= dl; }
        if (hi == 0) wsc[r32] = f;
        LDS_WAIT();
#pragma unroll
        for (int a = 0; a < 4; ++a) { const f32x4 av = *(LAS const f32x4*)(wsc + 8 * a + 4 * hi);
#pragma unroll
            for (int i = 0; i < 4; ++i) { st.o0[4 * a + i] *= av[i]; st.o1[4 * a + i] *= av[i]; st.la[4 * a + i] *= av[i]; if (IMP) oimp[4 * a + i] *= av[i]; } }
        LDS_WAIT();
    }
    }
#pragma unroll
    for (int r = 0; r < 16; ++r) { p0[r] = __builtin_amdgcn_exp2f(p0[r]); p1[r] = __builtin_amdgcn_exp2f(p1[r]); }
    bf16x8 pa[4]; pa[0] = pack8(p0, 0); pa[1] = pack8(p0, 8); pa[2] = pack8(p1, 0); pa[3] = pack8(p1, 8);
    {
#pragma unroll
      for (int s = 0; s < 4; ++s) {
          const v4u x0 = vx0[s], x1 = vx1[s];
          st.o0 = __builtin_amdgcn_mfma_f32_32x32x16_bf16(pa[s], __builtin_bit_cast(bf16x8, x0), st.o0, 0, 0, 0);
          st.o1 = __builtin_amdgcn_mfma_f32_32x32x16_bf16(pa[s], __builtin_bit_cast(bf16x8, x1), st.o1, 0, 0, 0);
          st.la = __builtin_amdgcn_mfma_f32_32x32x16_bf16(pa[s], __builtin_bit_cast(bf16x8, (pg8::u32x4){0x3F803F80u, 0x3F803F80u, 0x3F803F80u, 0x3F803F80u}), st.la, 0, 0, 0); } }
    if (IMP) {
#pragma unroll
        for (int s = 0; s < 4; ++s) { bf16x8 ov;
#pragma unroll
            for (int e = 0; e < 8; ++e) { const int c = c0 + 16 * s + 8 * (e >> 2) + 4 * hi + (e & 3); ov[e] = (c >= 4 * r32 - 1 && c <= 4 * r32 + 3) ? (short)0x3F80 : (short)0; }
            oimp = __builtin_amdgcn_mfma_f32_32x32x16_bf16(pa[s], ov, oimp, 0, 0, 0); } }
}
__device__ __forceinline__ void attn_accum(f32x16& out0, f32x16& out1, const AttnState& st, float gate, LAS float* wsc, int r32, int hi) {
    if (hi == 0) wsc[r32] = gate;
    LDS_WAIT();
#pragma unroll
    for (int a = 0; a < 4; ++a) { const f32x4 av = *(LAS const f32x4*)(wsc + 8 * a + 4 * hi);
#pragma unroll
        for (int i = 0; i < 4; ++i) { const float l = st.la[4 * a + i]; const float f = l > 0.f ? av[i] * __builtin_amdgcn_rcpf(l) : 0.f; out0[4 * a + i] += st.o0[4 * a + i] * f; out1[4 * a + i] += st.o1[4 * a + i] * f; } }
    LDS_WAIT();
}
__device__ __forceinline__ void store_tile_fp8(const f32x16& out0, const f32x16& out1, LAS unsigned char* stg, unsigned char* dst, size_t pitch, int lane, int r32, int hi) {
#pragma unroll
    for (int r = 0; r < 16; ++r) { const int q = (r & 3) + 8 * (r >> 2) + 4 * hi;
        const unsigned w = (unsigned)__builtin_amdgcn_cvt_pk_fp8_f32(__builtin_amdgcn_fmed3f(out0[r] * 16.f, -448.f, 448.f), __builtin_amdgcn_fmed3f(out1[r] * 16.f, -448.f, 448.f), 0, false);
        stg[q * 64 + r32] = (unsigned char)(w & 0xffu); stg[q * 64 + 32 + r32] = (unsigned char)((w >> 8) & 0xffu); }
    LDS_WAIT();
#pragma unroll
    for (int i = 0; i < 2; ++i) { const int row = i * 16 + (lane >> 2), ch = lane & 3; const v4u v = *(LAS const v4u*)(stg + row * 64 + ch * 16); *(GAS v4u*)(dst + (size_t)row * pitch + ch * 16) = v; }
    LDS_WAIT();
}


#define TILE_PIPELINE(FIRST, AFTER, FETCH, COMPUTE) do { \
        int jc_ = (FIRST); int jn_ = AFTER(jc_); int jnn_; TileRegs rA_ = FETCH(jc_), rB_; \
        tile_store(buf0, rA_, tid); if (jn_ >= 0) rB_ = FETCH(jn_); \
        __syncthreads(); \
        for (;;) { \
            jnn_ = jn_ >= 0 ? AFTER(jn_) : -1; if (jnn_ >= 0) rA_ = FETCH(jnn_); \
            COMPUTE(jc_, buf0); \
            if (jn_ < 0) break; \
            tile_store(buf1, rB_, tid); __syncthreads(); jc_ = jn_; jn_ = jnn_; \
            jnn_ = jn_ >= 0 ? AFTER(jn_) : -1; if (jnn_ >= 0) rB_ = FETCH(jnn_); \
            COMPUTE(jc_, buf1); \
            if (jn_ < 0) break; \
            tile_store(buf0, rA_, tid); __syncthreads(); jc_ = jn_; jn_ = jnn_; \
        } } while (0)
__device__ __forceinline__ void nsa_unit(const Ptrs& P, LAS unsigned char* lds, int b, int kh, int qb, int tid, int wave, int lane) {
    asm volatile("" : "+v"(tid), "+v"(lane));
    const int r32 = lane & 31, hi = lane >> 5, th = wave >> 2, g = th ? 3 - (wave & 3) : (wave & 3);
    bf16* PROJ = (bf16*)(P.ws + WS_PROJ);
    unsigned char* dob = (unsigned char*)P.out;
    const bf16* KCb = (const bf16*)(dob + DO_KC) + (size_t)(b * 2 + kh) * 128 * 64; const bf16* VCTb = (const bf16*)(dob + DO_VCT) + (size_t)(b * 2 + kh) * 64 * 128;
    const bf16* VSTb = (const bf16*)(dob + DO_VST) + (size_t)(b * 2 + kh) * 64 * SEQ; const bf16* VWTb = (const bf16*)(dob + DO_VWT) + (size_t)(b * 2 + kh) * 64 * SEQ;
    LAS unsigned char* buf0 = lds + A_TILE0; LAS unsigned char* buf1 = lds + A_TILE1;
    LAS float* wsc = (LAS float*)(lds + A_WSC) + wave * 64;
    LAS float* impL = (LAS float*)(lds + A_IMP); LAS float* effL = (LAS float*)(lds + A_EFF); LAS unsigned* selL = (LAS unsigned*)(lds + A_SEL);
    const int tq = 64 * qb + 32 * th + r32;
    const bf16* prow = PROJ + (size_t)(b * SEQ + tq) * PITCH;
    const float slope2 = exp2f(-(float)(kh * 4 + g + 1)) * LOG2E;
    bf16x8 qf[4];
#pragma unroll
    for (int ds = 0; ds < 4; ++ds) qf[ds] = *(const GAS bf16x8*)(prow + C_QB + (kh * 4 + g) * 64 + ds * 16 + hi * 8);
    KxOps KX = kx_ops(r32, hi);
    float qkb;
    { const float gq = fabsf(P.in[8][lane]); const float gk = fmaxf(fmaxf(fabsf(P.in[9][lane]), fabsf(P.in[10][lane])), fabsf(P.in[11][lane]));
      qkb = 64.0f * QSCALE * 1.02f * __uint_as_float(wave_umax(__float_as_uint(gq))) * __uint_as_float(wave_umax(__float_as_uint(gk))) + 0.25f; }
    const float cutthr = 2.0f * qkb + 64.0f;
    const int jcut = qb - (int)ceilf((cutthr / slope2 + (float)(63 - 32 * th)) * (1.0f / 64.0f));
    const int jdrop = qb - (int)ceilf((cutthr / (exp2f(-(float)(kh * 4 + 4)) * LOG2E) + 63.0f) * (1.0f / 64.0f));
    LAS unsigned char* qlds = lds + A_STG + wave * 4096 + r32 * 128;
#pragma unroll
    for (int ds = 0; ds < 4; ++ds) *(LAS bf16x8*)(qlds + (((2 * ds + hi) ^ (r32 & 7)) * 16)) = qf[ds];
#define NSA_GATE(i) pg8::sigm(bf2f(PROJ[(size_t)(b * SEQ + tq) * PITCH + C_GB + (kh * 4 + g) * 3 + (i)]))
    f32x16 oimp;
#pragma unroll
    for (int r = 0; r < 16; ++r) oimp[r] = 0.f;
    float* slab = (float*)(P.ws + WS_OUTSCR) + ((size_t)blockIdx.x * NWAVES + wave) * 2048;
    AttnState st;
    {
        TileRegs tr = tile_fetch(KCb, 64, VCTb, 128, tid); tile_store(buf0, tr, tid);
        tr = tile_fetch(KCb + 64 * 64, 64, VCTb + 64, 128, tid); tile_store(buf1, tr, tid);
        if (tid < 64) selL[tid] = 0u;
        __syncthreads();
        attn_init_fixed(st, 0.f, qkb, hi);
        const int hc = (tq - 31) >> 4;
#pragma unroll 1
        for (int ct = 0; ct < 2; ++ct) { tile_compute<false, true, true, true>(st, qf, qlds, KX, 0.f, true, true, ct ? buf1 : buf0, wsc, true, -(1 << 20), hc - 64 * ct, 0u, 0u, oimp, 64 * ct, r32, hi); __builtin_amdgcn_sched_barrier(0); }
        { f32x16 o0, o1;
#pragma unroll
          for (int r = 0; r < 16; ++r) { o0[r] = 0.f; o1[r] = 0.f; }
          attn_accum(o0, o1, st, NSA_GATE(0), wsc, r32, hi);
#pragma unroll
          for (int r = 0; r < 16; ++r) { slab[r * 64 + lane] = o0[r]; slab[(16 + r) * 64 + lane] = o1[r]; } }
#pragma unroll
        for (int a = 0; a < 4; ++a)
#pragma unroll
            for (int i = 0; i < 4; ++i) { const int q = 8 * a + 4 * hi + i; const float l = st.la[4 * a + i]; impL[(wave * 32 + q) * 32 + r32] = l > 0.f ? oimp[4 * a + i] * __builtin_amdgcn_rcpf(l) : 0.f; }
        LDS_WAIT();
        __syncthreads();
        const int tk = tid >> 3, th2 = tk >> 5, q2 = tk & 31, sub = tid & 7;
        float e[4];
#pragma unroll
        for (int i = 0; i < 4; ++i) { const int j = sub * 4 + i; float imp = 0.f;
#pragma unroll
            for (int g2 = 0; g2 < 4; ++g2) imp += impL[((th2 * 4 + g2) * 32 + q2) * 32 + j];
            const bool forced = (j == 0) || (j == qb) || (j == qb - 1);
            e[i] = (j > qb) ? -INFINITY : (imp + (forced ? 1e6f : 0.f)); effL[tk * 32 + j] = e[i]; }
        __syncthreads();
        int rank[4] = {0, 0, 0, 0};
#pragma unroll 1
        for (int jp = 0; jp < 32; ++jp) { const float e2 = effL[tk * 32 + jp];
#pragma unroll
            for (int i = 0; i < 4; ++i) rank[i] += (e2 > e[i] || (e2 == e[i] && jp < sub * 4 + i)) ? 1 : 0; }
        unsigned bits = 0u;
#pragma unroll
        for (int i = 0; i < 4; ++i) if (rank[i] < 16 && sub * 4 + i <= qb) bits |= 1u << (sub * 4 + i);
        if (bits) __hip_atomic_fetch_or(selL + tk, bits, __ATOMIC_RELAXED, __HIP_MEMORY_SCOPE_WORKGROUP);
        __syncthreads();
    }
    unsigned U = 0u;
#pragma unroll
    for (int k = 0; k < 16; ++k) { const v4u w = *(LAS const v4u*)(selL + 4 * k); U |= (w.x | w.y) | (w.z | w.w); }
    U = __builtin_amdgcn_readfirstlane(U);
    if (jdrop >= 0) U &= ~((2u << jdrop) - 1u);
    const unsigned msk = selL[32 * th + r32];
    {
        const bf16* Kb = PROJ + (size_t)b * SEQ * PITCH + C_KS + kh * 64;
        attn_init_fixed(st, slope2, slope2 * (float)tq + qkb, hi);
#define SEL_AFTER(j) ((U & ((1u << (j)) - 1u)) ? 31 - __builtin_clz(U & ((1u << (j)) - 1u)) : -1)
#define SEL_FETCH(j) tile_fetch(Kb + (size_t)(64 * (j)) * PITCH, PITCH, VSTb + 64 * (j), SEQ, tid)
#define SEL_COMPUTE(j, buf) { const bool rowsel = (msk >> (j)) & 1u; const int dq = tq - 64 * (j); \
            if ((j) > jcut && __any(rowsel)) tile_compute<false, false, false, true>(st, qf, qlds, KX, (float)(64 * (j)), rowsel, __all(rowsel) != 0, buf, wsc, (j) == qb, -(1 << 20), dq, 0u, 0u, oimp, 0, r32, hi); }
        TILE_PIPELINE(31 - __builtin_clz(U), SEL_AFTER, SEL_FETCH, SEL_COMPUTE);
#undef SEL_AFTER
#undef SEL_FETCH
#undef SEL_COMPUTE
        { f32x16 o0, o1;
#pragma unroll
          for (int r = 0; r < 16; ++r) { o0[r] = slab[r * 64 + lane]; o1[r] = slab[(16 + r) * 64 + lane]; }
          attn_accum(o0, o1, st, NSA_GATE(1), wsc, r32, hi);
#pragma unroll
          for (int r = 0; r < 16; ++r) { slab[r * 64 + lane] = o0[r]; slab[(16 + r) * 64 + lane] = o1[r]; } }
        __syncthreads();
    }
    f32x16 out0, out1;
    {
        const bf16* Kb = PROJ + (size_t)b * SEQ * PITCH + C_KW + kh * 64;
        attn_init_fixed(st, slope2, slope2 * (float)tq + qkb, hi);
        int jlo = qb - 8 < 0 ? 0 : qb - 8; jlo = jdrop + 1 > jlo ? jdrop + 1 : jlo;
#define WIN_AFTER(j) ((j) > jlo ? (j) - 1 : -1)
#define WIN_FETCH(j) tile_fetch(Kb + (size_t)(64 * (j)) * PITCH, PITCH, VWTb + 64 * (j), SEQ, tid)
#define WIN_COMPUTE(j, buf) if ((j) > jcut) { const int dq = tq - 64 * (j); \
            tile_compute<false, false, false, true>(st, qf, qlds, KX, (float)(64 * (j)), true, true, buf, wsc, ((j) == qb) || ((j) == qb - 8), dq - 511, dq, 0u, 0u, oimp, 0, r32, hi); }
        TILE_PIPELINE(qb, WIN_AFTER, WIN_FETCH, WIN_COMPUTE);
#undef WIN_AFTER
#undef WIN_FETCH
#undef WIN_COMPUTE
#pragma unroll
        for (int r = 0; r < 16; ++r) { out0[r] = slab[r * 64 + lane]; out1[r] = slab[(16 + r) * 64 + lane]; }
        attn_accum(out0, out1, st, NSA_GATE(2), wsc, r32, hi);
    }
    store_tile_fp8(out0, out1, lds + A_STG + wave * 4096, P.ws + WS_H8 + (size_t)(b * SEQ + 64 * qb + 32 * th) * DM + 512 + (kh * 4 + g) * 64, DM, lane, r32, hi);
    __syncthreads();
}


__device__ __forceinline__ void dsa_unit(const Ptrs& P, LAS unsigned char* lds, int b, int ti, int tid, int wave, int lane) {
    asm volatile("" : "+v"(tid), "+v"(lane));
    const int r32 = lane & 31, hi = lane >> 5, fr = lane & 15, fq = lane >> 4;
    bf16* PROJ = (bf16*)(P.ws + WS_PROJ);
    unsigned char* dob = (unsigned char*)P.out;
    const bf16* Kb = (const bf16*)(dob + DO_KA) + (size_t)b * SEQ * 64; const bf16* VTb = (const bf16*)(dob + DO_VAT) + (size_t)b * 64 * SEQ;
    const bf16* PB = PROJ + (size_t)b * SEQ * PITCH;
    LAS float* scL = (LAS float*)lds; LAS unsigned* maskL = (LAS unsigned*)(lds + D_MASK);
    LAS float* wsc = (LAS float*)(lds + A_WSC) + wave * 64;
    const int t0 = 32 * ti;
    bf16x8 qaN[8]; v4u wvN[4];
    const bf16* kbase = PB + (size_t)fr * PITCH + C_KI + fq * 8;
#define DSA_LOAD_HALF(H) { const int th0_ = t0 + 16 * (H); const bf16* qrow_ = PB + (size_t)(th0_ + fr) * PITCH + C_QI + fq * 8; \
        _Pragma("unroll") for (int hh = 0; hh < 8; ++hh) qaN[hh] = *(const GAS bf16x8*)(qrow_ + hh * 32); \
        _Pragma("unroll") for (int i = 0; i < 4; ++i) wvN[i] = *(const GAS v4u*)(PB + (size_t)(th0_ + 4 * fq + i) * PITCH + C_WI); \
        }
    DSA_LOAD_HALF(0)
    for (int half_ = 0; half_ < 2 * PROBE_DPRE; ++half_) {
        const int half = half_ & 1;
        const int th0 = t0 + 16 * half; const int ntile = (th0 >> 4) + 1;
        {
            bf16x8 qa[8];
#pragma unroll
            for (int hh = 0; hh < 8; ++hh) qa[hh] = qaN[hh];
            float wv[4][8];
#pragma unroll
            for (int i = 0; i < 4; ++i) unpack8(wvN[i], wv[i]);
            bf16x8 kbn[4];
#pragma unroll
            for (int q4 = 0; q4 < 4; ++q4) { int kt = wave + 8 * q4; kt = kt < ntile ? kt : ntile - 1; kbn[q4] = *(const GAS bf16x8*)(kbase + (size_t)(16 * kt) * PITCH); }
            for (int rep_ = 0; rep_ < PROBE_DIDX; ++rep_)
            for (int kt0 = wave; kt0 < ntile; kt0 += 32) {
                bf16x8 kbc[4];
#pragma unroll
                for (int q4 = 0; q4 < 4; ++q4) kbc[q4] = kbn[q4];
                if (kt0 + 32 < ntile) {
#pragma unroll
                    for (int q4 = 0; q4 < 4; ++q4) { int kt = kt0 + 32 + 8 * q4; kt = kt < ntile ? kt : ntile - 1; kbn[q4] = *(const GAS bf16x8*)(kbase + (size_t)(16 * kt) * PITCH); } }
#pragma unroll
                for (int q4 = 0; q4 < 4; ++q4) { const int kt = kt0 + 8 * q4;
                    if (kt < ntile) {
                        float sc[4] = {0.f, 0.f, 0.f, 0.f};
                        f32x4 acc8[8];
#pragma unroll
                        for (int hh = 0; hh < 8; ++hh) { const f32x4 z = {0.f, 0.f, 0.f, 0.f}; acc8[hh] = __builtin_amdgcn_mfma_f32_16x16x32_bf16(qa[hh], kbc[q4], z, 0, 0, 0); }
                        __builtin_amdgcn_sched_barrier(0);
#pragma unroll
                        for (int hh = 0; hh < 8; ++hh)
#pragma unroll
                            for (int i = 0; i < 4; ++i) { const int rb = __float_as_int(acc8[hh][i]); sc[i] += __int_as_float(rb > 0 ? rb : 0) * wv[i][hh]; }
#pragma unroll
                        for (int i = 0; i < 4; ++i) scL[(4 * fq + i) * SROW + 16 * kt + fr] = sc[i] + 0.0f;
                    } }
            }
        }
        __syncthreads();
        if (half_ + 1 < 2 * PROBE_DPRE) DSA_LOAD_HALF((half_ + 1) & 1)
        for (int rep_ = 0; rep_ < PROBE_DTHR; ++rep_) {
            const int rowA = 2 * wave, rowB = rowA + 1; const int tA = th0 + rowA, tB = tA + 1;
            unsigned uA[32], uB[32];
#pragma unroll
            for (int i = 0; i < 32; ++i) { const int s = lane + 64 * i; const float xa = scL[rowA * SROW + (s & (SROW - 1))], xb = scL[rowB * SROW + (s & (SROW - 1))]; uA[i] = ord_u32(xa); uB[i] = ord_u32(xb); }
            const int nvA = lane <= tA ? ((tA - lane) >> 6) + 1 : 0, nvB = lane <= tB ? ((tB - lane) >> 6) + 1 : 0;
            unsigned candA = nvA >= 32 ? 0xffffffffu : ((1u << nvA) - 1u), candB = nvB >= 32 ? 0xffffffffu : ((1u << nvB) - 1u);
            unsigned selA = candA, selB = candB;
            if (tB + 1 > TOPK) {
#define DSA_TSTAGE(U, J, MSK) _Pragma("unroll") for (int k0 = 0; k0 < 32; k0 += 2 * (J)) _Pragma("unroll") for (int k1 = 0; k1 < (J); ++k1) { const int k = k0 + k1; \
                    const unsigned a_ = U[k], b_ = U[k + (J)]; U[k] = ((MSK) & a_) | (~(MSK) & (b_ << (J))); U[k + (J)] = ((MSK) & (a_ >> (J))) | (~(MSK) & b_); }
#define DSA_PSTAGE(U, J, S_LO, S_HI) _Pragma("unroll") for (int k0 = 0; k0 < 32; k0 += 2 * (J)) _Pragma("unroll") for (int k1 = 0; k1 < (J); ++k1) { const int k = k0 + k1; \
                    const unsigned a_ = U[k], b_ = U[k + (J)]; U[k] = __builtin_amdgcn_perm(b_, a_, S_LO); U[k + (J)] = __builtin_amdgcn_perm(b_, a_, S_HI); }
                DSA_PSTAGE(uA, 16, 0x05040100u, 0x07060302u) DSA_PSTAGE(uA, 8, 0x06020400u, 0x07030501u) DSA_TSTAGE(uA, 4, 0x0f0f0f0fu) DSA_TSTAGE(uA, 2, 0x33333333u) DSA_TSTAGE(uA, 1, 0x55555555u)
                DSA_PSTAGE(uB, 16, 0x05040100u, 0x07060302u) DSA_PSTAGE(uB, 8, 0x06020400u, 0x07030501u) DSA_TSTAGE(uB, 4, 0x0f0f0f0fu) DSA_TSTAGE(uB, 2, 0x33333333u) DSA_TSTAGE(uB, 1, 0x55555555u)
#undef DSA_PSTAGE
#undef DSA_TSTAGE
#pragma unroll
                for (int k = 0; k < 32; k += 8) {
                    asm volatile("" : "+v"(uA[k]), "+v"(uA[k + 1]), "+v"(uA[k + 2]), "+v"(uA[k + 3]), "+v"(uA[k + 4]), "+v"(uA[k + 5]), "+v"(uA[k + 6]), "+v"(uA[k + 7]));
                    asm volatile("" : "+v"(uB[k]), "+v"(uB[k + 1]), "+v"(uB[k + 2]), "+v"(uB[k + 3]), "+v"(uB[k + 4]), "+v"(uB[k + 5]), "+v"(uB[k + 6]), "+v"(uB[k + 7])); }
                unsigned aboveA = 0u, aboveB = 0u; int needA = TOPK, needB = TOPK, ccA = tA + 1, ccB = tB + 1; bool doneA = false, doneB = false;
                if (ccA <= TOPK) { aboveA = candA; candA = 0u; needA = 0; ccA = 0; doneA = true; }
#pragma unroll
                for (int bb = 31; bb >= 0; --bb) {
                    if (!(doneA && doneB)) {
                        const unsigned onesA = candA & uA[bb], onesB = candB & uB[bb];
                        const unsigned S = wave_usum((unsigned)__builtin_popcount(onesA) | ((unsigned)__builtin_popcount(onesB) << 16));
                        const int c1A = (int)(S & 0xffffu), c1B = (int)(S >> 16);
                        { const bool take = c1A >= needA; aboveA = take ? aboveA : (aboveA | onesA); candA = take ? onesA : (candA & ~uA[bb]); needA = take ? needA : needA - c1A; ccA = take ? c1A : ccA - c1A;
                          const bool fin = ccA == needA; aboveA = fin ? (aboveA | candA) : aboveA; candA = fin ? 0u : candA; needA = fin ? 0 : needA; ccA = fin ? 0 : ccA; doneA = doneA || fin; }
                        { const bool take = c1B >= needB; aboveB = take ? aboveB : (aboveB | onesB); candB = take ? onesB : (candB & ~uB[bb]); needB = take ? needB : needB - c1B; ccB = take ? c1B : ccB - c1B;
                          const bool fin = ccB == needB; aboveB = fin ? (aboveB | candB) : aboveB; candB = fin ? 0u : candB; needB = fin ? 0 : needB; ccB = fin ? 0 : ccB; doneB = doneB || fin; }
                    }
                }
                selA = aboveA; selB = aboveB;
                if (!doneA) {
                    int ties = 0; const u64 ltm = (1ull << lane) - 1ull;
#pragma unroll 1
                    for (int i = 0; i < 32; ++i) { const bool eq = (candA >> i) & 1u; const u64 meq = __ballot(eq); const int myrank = ties + __popcll(meq & ltm); selA |= (unsigned)(eq && myrank < needA) << i; ties += __popcll(meq); }
                }
                if (!doneB) {
                    int ties = 0; const u64 ltm = (1ull << lane) - 1ull;
#pragma unroll 1
                    for (int i = 0; i < 32; ++i) { const bool eq = (candB >> i) & 1u; const u64 meq = __ballot(eq); const int myrank = ties + __popcll(meq & ltm); selB |= (unsigned)(eq && myrank < needB) << i; ties += __popcll(meq); }
                }
            }
            {
                LAS unsigned* mrA = maskL + (16 * half + rowA) * 64; LAS unsigned* mrB = mrA + 64;
                unsigned wloA = 0u, whiA = 0u, wloB = 0u, whiB = 0u;
#pragma unroll
                for (int i = 0; i < 32; ++i) { const u64 ma = __ballot((selA >> i) & 1u), mb = __ballot((selB >> i) & 1u);
                    wloA = (lane == i) ? (unsigned)ma : wloA; whiA = (lane == i) ? (unsigned)(ma >> 32) : whiA; wloB = (lane == i) ? (unsigned)mb : wloB; whiB = (lane == i) ? (unsigned)(mb >> 32) : whiB; }
                if (lane < 32) { mrA[2 * lane] = wloA; mrA[2 * lane + 1] = whiA; mrB[2 * lane] = wloB; mrB[2 * lane + 1] = whiB; }
                const unsigned kA = wave_umax(selA ? (unsigned)(lane + 64 * (31 - __builtin_clz(selA))) + 1u : 0u), kB = wave_umax(selB ? (unsigned)(lane + 64 * (31 - __builtin_clz(selB))) + 1u : 0u);
                if (lane == 0) { LAS int* km = (LAS int*)(lds + D_KMAX); km[16 * half + rowA] = (int)kA - 1; km[16 * half + rowB] = (int)kB - 1; }
            }
        }
        __syncthreads();
    }
    {
    int tid_b = tid, lane_b = lane; asm volatile("" : "+v"(tid_b), "+v"(lane_b));
    const int tid = tid_b, lane = lane_b, r32 = lane & 31, hi = lane >> 5;
    {
        LAS unsigned char* m8 = lds + D_M8; const int nw = 2 * (((t0 + 31) >> 6) + 1); const int row = tid >> 4;
        for (int w = tid & 15; w < nw; w += 16) { const unsigned bits = maskL[row * 64 + w]; v4u o[2];
#pragma unroll
            for (int n = 0; n < 8; ++n) { const unsigned x = (bits >> (4 * n)) & 15u; const unsigned y = ((x * 0x00204081u) & 0x01010101u) ^ 0x01010101u; o[n >> 2][n & 3] = y * 0xFEu; }
            *(LAS v4u*)(m8 + row * M8_STRIDE + 32 * w) = o[0]; *(LAS v4u*)(m8 + row * M8_STRIDE + 32 * w + 16) = o[1]; }
    }
    MaskMM MM;
    { const unsigned one = 0x38u << (8 * (r32 & 3));
#pragma unroll
      for (int w = 0; w < 8; ++w) { const unsigned x = ((r32 >> 2) == w) ? one : 0u; MM.a0[w] = (hi == 0) ? (int)x : 0; MM.a1[w] = (hi == 1) ? (int)x : 0; }
      MM.row = lds + D_M8 + r32 * M8_STRIDE + 32 * hi; }
    const int tq = t0 + r32; const int h = wave;
    const bf16* prow = PB + (size_t)tq * PITCH;
    bf16x8 qf[4];
#pragma unroll
    for (int ds = 0; ds < 4; ++ds) qf[ds] = *(const GAS bf16x8*)(prow + C_QA + h * 64 + ds * 16 + hi * 8);
    const float slope2 = exp2f(-(float)(h + 1)) * LOG2E;
    int jcutD; float qkbD; const int kmaxrow = ((LAS const int*)(lds + D_KMAX))[r32];
    { const float gq = fabsf(P.in[3][lane]), gk = fabsf(P.in[4][lane]);
      qkbD = 64.0f * QSCALE * 1.02f * __uint_as_float(wave_umax(__float_as_uint(gq))) * __uint_as_float(wave_umax(__float_as_uint(gk))) + 0.25f;
      const int kmin = (int)wave_umin((unsigned)(kmaxrow + 1)) - 1;
      const int dcut = (int)ceilf((2.0f * qkbD + 64.0f) / slope2);
      const int num = kmin - dcut - 63; jcutD = num >= 0 ? (num >> 6) : -1; }
    KxOps KX = kx_ops(r32, hi);
    LAS unsigned char* buf0 = lds + A_TILE0; LAS unsigned char* buf1 = lds + A_TILE1;
    AttnState st;
    f32x16 dummy;
#pragma unroll
    for (int r = 0; r < 16; ++r) dummy[r] = 0.f;
    for (int rep = 0; rep < PROBE_DATT; ++rep) {
    attn_init_fixed(st, slope2, slope2 * (float)kmaxrow + qkbD, hi);
#define DSA_AFTER(j) ((j) - 1)
#define DSA_FETCH(j) tile_fetch(Kb + (size_t)(64 * (j)) * 64, 64, VTb + 64 * (j), SEQ, tid)
#define DSA_COMPUTE(j, buf) if ((j) > jcutD) tile_compute<true, false, false, true>(st, qf, nullptr, KX, (float)(64 * (j)), true, true, buf, wsc, false, 0, 0, (unsigned)(64 * (j)), 0u, dummy, 0, r32, hi, &MM)
    TILE_PIPELINE((t0 + 31) >> 6, DSA_AFTER, DSA_FETCH, DSA_COMPUTE);
#undef DSA_AFTER
#undef DSA_FETCH
#undef DSA_COMPUTE
    __syncthreads();
    }
    f32x16 out0, out1;
#pragma unroll
    for (int r = 0; r < 16; ++r) { out0[r] = 0.f; out1[r] = 0.f; }
    attn_accum(out0, out1, st, 1.0f, wsc, r32, hi);
    __syncthreads();
    store_tile_fp8(out0, out1, lds + A_TILE0 + wave * 2048, P.ws + WS_H8 + (size_t)(b * SEQ + t0) * DM + h * 64, DM, lane, r32, hi);
    __syncthreads();
    }
}

__device__ __forceinline__ int nsa_tbl(int i, unsigned long long c0, unsigned long long c1, unsigned long long c2, unsigned long long c3) { const unsigned long long c = (i & 16) ? ((i & 8) ? c3 : c2) : ((i & 8) ? c1 : c0); return (int)((c >> (8 * (i & 7))) & 0xffull); }
__device__ __forceinline__ int nsa_ua(int i) { return nsa_tbl(i, 0x38393a3b3c3d3e3full, 0x3031323334353637ull, 0x28292a2b2c2d2e2full, 0x130c12110d0e0f10ull); }
__device__ __forceinline__ int nsa_ub(int i) { return nsa_tbl(i, 0x1c1e090807250504ull, 0x2303220221012000ull, 0x1b270a1d1f260624ull, 0x1415160b1a191817ull); }
__device__ __forceinline__ void p3_fast(const Ptrs& P, LAS unsigned char* lds, int vcu, int G, int tid, int wave, int lane) {
    for (int u = vcu; u < 256; u += G)
        for (int k = 0; k < 2; ++k) { const int b = u >> 5, p = u & 31; dsa_unit(P, lds, b, k ? p : 63 - p, tid, wave, lane); }
    asm volatile("" ::: "memory");
    for (int u = vcu; u < 256; u += G)
        for (int k = 0; k < 2 * PROBE_NSA; ++k) { const int b = u >> 5, i = u & 31;
            const int c = (k & 1) ? nsa_ub(i) : nsa_ua(i); nsa_unit(P, lds, b, c >> 5, c & 31, tid, wave, lane); }
}

struct Args { Ptrs p; };
__global__ void __launch_bounds__(NWAVES * 64, 2) fwd_kernel(Args args) {
    extern __shared__ __attribute__((aligned(16))) unsigned char lds_raw[];
    LAS unsigned char* lds = (LAS unsigned char*)lds_raw;
    const Ptrs& P = args.p;
    const int tid = threadIdx.x, lane = tid & 63, wave = __builtin_amdgcn_readfirstlane(tid >> 6);
    const int G = gridDim.x; const int bx = blockIdx.x; const int vcu = (G % 8 == 0) ? (bx % 8) * (G / 8) + bx / 8 : bx;
    const int gw = vcu * NWAVES + wave, NGW = G * NWAVES;
    volatile LAS unsigned* MISC = (volatile LAS unsigned*)(lds + MISC_OFF);
    for (int u = tid; u < (LDS_BYTES - RING_BYTES) / 4; u += NWAVES * 64) ((LAS unsigned*)(lds + RING_BYTES))[u] = 0u;
    __syncthreads();
    unsigned* ctl = (unsigned*)(P.ws + WS_CTL);
    XcdBarrier bar = xcd_barrier_post(ctl + CW_BAR, MISC + 8);
    if (tid == 0) { (void)__hip_atomic_fetch_or(ctl + CW_BAR + XB_MIS + (bx & 7), 1u << bar.x, __ATOMIC_RELAXED, __HIP_MEMORY_SCOPE_AGENT); if ((G & 7) != 0) (void)xb_add(ctl + CW_BAR + XB_MIS + 8, 1u); }
#if PROBE_BAR
    int pb_k = 0;
#define GRIDBAR() do { const unsigned long long t0_ = __builtin_amdgcn_s_memrealtime(); xcd_barrier(bar); const unsigned long long t1_ = __builtin_amdgcn_s_memrealtime(); \
        if (tid == 0) { const unsigned w_ = (unsigned)(t1_ - t0_); atomicMax(ctl + 8192 + 64 * pb_k, 0x7fffffffu - w_); atomicMax(ctl + 8192 + 1024 + 64 * pb_k, w_); } ++pb_k; } while (0)
#elif PROBE_SPAN
    int pb_k = 0; unsigned long long sp_prev = __builtin_amdgcn_s_memrealtime(), sp_acc = 0;
#define GRIDBAR() do { xcd_barrier(bar); const unsigned long long t_ = __builtin_amdgcn_s_memrealtime(); if ((PROBE_SPAN >> pb_k) & 1) sp_acc += t_ - sp_prev; sp_prev = t_; ++pb_k; } while (0)
#else
#define GRIDBAR() xcd_barrier(bar)
#endif
#if PROBE_BAR || PROBE_SPAN
#define GRIDBAR_L() GRIDBAR()
#define GRIDBAR_X() GRIDBAR()
#else
#define GRIDBAR_L() xcd_barrier(bar, 1)
#define GRIDBAR_X() xcd_barrier(bar, 2)
#endif

    bf16* H = (bf16*)((unsigned char*)P.out + DO_H);
    bf16* PROJ = (bf16*)(P.ws + WS_PROJ); bf16* HID = (bf16*)(P.ws + WS_PROJ);
    bf16* MERGED = (bf16*)(P.ws + WS_MERGED); bf16* X1B = (bf16*)(P.ws + WS_X1B); float* PARTS = (float*)(P.ws + WS_PARTS);

    for (int rep = 0; rep < PROBE_P0; ++rep) p0_prologue(P, lds, gw, NGW, wave, lane);
    GRIDBAR();
    for (int rep = 0; rep < PROBE_P1; ++rep) {
        pg8::Gemm g{H, (const bf16*)(P.ws + WS_WIN), M, 1024, DM, DM}; pg8::StaticOrder S; S.init(M, 1024, G, bx);
        pg8::EpiProj E{PROJ, PITCH, P.in[3], P.in[8], P.in[10], P.in[11], (bf16*)((unsigned char*)P.out + DO_VST), (bf16*)((unsigned char*)P.out + DO_VWT), QSCALE, RMS_EPS, SEQ, (bf16*)(P.ws + WS_GT)};
        pg8::gemm_phase<pg8::EpiProj, pg8::StaticOrder, true>(lds, g, S, E);
        {
            pg8::Gemm g8{(const bf16*)(P.ws + WS_H8), (const bf16*)(P.ws + WS_WIN8C), M, 3072, DM / 2, DM / 2}; pg8::StaticOrder S8; S8.init(M, 3072, G, bx);
            pg8::EpiProjGate8 E8{pg8::EpiProjT<1>{PROJ, PITCH, P.in[3], P.in[8], P.in[10], P.in[11], (bf16*)((unsigned char*)P.out + DO_VST), (bf16*)((unsigned char*)P.out + DO_VWT), QSCALE, RMS_EPS, SEQ, (bf16*)(P.ws + WS_GT)}, pg8::EpiGateSig{P.ws + WS_GT}};
            pg8::gemm_phase<pg8::EpiProjGate8, pg8::StaticOrder, true>(lds, g8, S8, E8);
        }
        if (rep == 0 && G != 256) { int lane2 = lane; asm volatile("" : "+v"(lane2)); const int rem = S.nwg % G;
            if (rem == 0) p0_items(P, lds, P0_EARLY, P0_ALL, bx * NWAVES + wave, G * NWAVES, wave, lane2);
            else if (bx >= rem) p0_items(P, lds, P0_EARLY, P0_ALL, (bx - rem) * NWAVES + wave, (G - rem) * NWAVES, wave, lane2); }
    }
    GRIDBAR_X();
    int vp = vcu;
    if (G == 256) { const int cx = vcu >> 5, cj = vcu & 31; vp = cj < 16 ? (cj >> 3) * 64 + cx * 8 + (cj & 7) : (cj < 24 ? 128 + 8 * cx + (cj - 16) : 248 - 8 * cx + (cj - 24)); }
    for (int rep = 0; rep < PROBE_P2; ++rep) {
        p2_fast(P, lds, vp, G, tid, wave, lane);
        if (rep == 0 && G == 256 && vp >= 192) { int lane2 = lane; asm volatile("" : "+v"(lane2));
            p0_items(P, lds, P0_EARLY, P0_EARLY + 3584, (vp - 192) * NWAVES + wave, 64 * NWAVES, wave, lane2); }
        {
            const bool idle64 = (G == 256);
            if (!idle64 || (vp >= 128 && vp < 192)) {
                pg8::Gemm g{(const bf16*)(P.ws + WS_H8), (const bf16*)(P.ws + WS_WIN8T - (size_t)8 * 256 * DM), M, 2304, DM / 2, DM / 2};
                pg8::ColTileOrder S{8, idle64 ? vp - 128 : vp, idle64 ? 64 : G, M / 256};
                pg8::EpiProjT<1> E{PROJ, PITCH, P.in[3], P.in[8], P.in[10], P.in[11], (bf16*)((unsigned char*)P.out + DO_VST), (bf16*)((unsigned char*)P.out + DO_VWT), QSCALE, RMS_EPS, SEQ, (bf16*)(P.ws + WS_GT)};
                pg8::gemm_phase<pg8::EpiProjT<1>, pg8::ColTileOrder, false>(lds, g, S, E);
                if (rep == 0 && idle64) { int lane3 = lane; asm volatile("" : "+v"(lane3)); p0_items(P, lds, P0_EARLY + 3584, P0_ALL, (vp - 128) * NWAVES + wave, 64 * NWAVES, wave, lane3); }
            }
        }
    }
    GRIDBAR_X();
    for (int rep = 0; rep < PROBE_P3; ++rep) p3_fast(P, lds, vcu, G, tid, wave, lane);
    GRIDBAR();
    const int TRP = (G == 256 && M / 256 == 64) ? 1 : 0;
    for (int rep = 0; rep < PROBE_P4; ++rep) {
        pg8::StaticOrder S; S.init(M, DM, G, bx); S.tr = TRP;
        const bf16* OB = (const bf16*)(P.ws + WS_H8);
        pg8::Gemm g{OB, (const bf16*)(P.ws + WS_WUPA), M, DM, DM / 2, DM / 2}; pg8::EpiGate2 E{(unsigned char*)MERGED, DM, P.ws + WS_GT};
        pg8::gemm_phase<pg8::EpiGate2, pg8::StaticOrder, true>(lds, g, S, E);
    }
    GRIDBAR_L();
    for (int rep = 0; rep < PROBE_P5; ++rep) {
        pg8::Gemm g{MERGED, (const bf16*)(P.ws + WS_WOUT), M, DM, DM / 2, DM / 2}; pg8::StaticOrder S; S.init(M, DM, G, bx); S.tr = TRP;
        pg8::EpiOutRes E{P.in[0], P.out, X1B, DM, PARTS, P.ws + WS_OUTSCR};
        pg8::gemm_phase<pg8::EpiOutRes, pg8::StaticOrder, true>(lds, g, S, E);
    }
    GRIDBAR_L();
    for (int rep = 0; rep < PROBE_P6; ++rep) {
        pg8::Gemm g{(const bf16*)(P.ws + WS_OUTSCR), (const bf16*)(P.ws + WS_WFF1), M, FF, DM / 2, DM / 2}; pg8::StaticOrder S; S.init(M, FF, G, bx); S.tr = TRP;
        LAS float* rstdL = (LAS float*)(lds + RING_BYTES);
        int pmA = -1, pmB = -1, pmC = -1, pmD = -1;
        { pg8::Unit uu; if (S.next(0, uu)) pmA = uu.pm; if (S.next(1, uu)) pmB = uu.pm; if (S.next(2, uu)) pmC = uu.pm; if (S.next(3, uu)) pmD = uu.pm; }
        __syncthreads();
#pragma unroll
        for (int i = 0; i < 2; ++i) { const int idx = tid + 512 * i, slot = idx >> 8, r = idx & 255; const int pmv = slot == 0 ? pmA : (slot == 1 ? pmB : (slot == 2 ? pmC : pmD));
            if (pmv >= 0) { const f32x4* pp = (const f32x4*)(PARTS + (size_t)(pmv * 256 + r) * 16); const f32x4 p0 = pp[0], p1 = pp[1], p2 = pp[2], p3 = pp[3];
                const float ss = ((p0[0] + p0[1]) + (p0[2] + p0[3])) + ((p1[0] + p1[1]) + (p1[2] + p1[3])) + ((p2[0] + p2[1]) + (p2[2] + p2[3])) + ((p3[0] + p3[1]) + (p3[2] + p3[3]));
                rstdL[idx] = rsqrtf(ss * (1.0f / DM) + RMS_EPS) * 2.8284271247461903f; } }
        __syncthreads();
        pg8::EpiRelu2 E{(unsigned char*)HID, FF, rstdL, pmA, pmB, pmC};
        pg8::gemm_phase<pg8::EpiRelu2, pg8::StaticOrder, true>(lds, g, S, E);
    }
    GRIDBAR_L();
    {
        pg8::Gemm g{HID, (const bf16*)(P.ws + WS_WFF2), M, DM, FF / 2, FF / 2}; pg8::StaticOrder S; S.init(M, DM, G, bx); S.tr = TRP;
        pg8::EpiFinal E{P.out, X1B, DM};
        pg8::gemm_phase<pg8::EpiFinal, pg8::StaticOrder, true>(lds, g, S, E);
    }
#if PROBE_SPAN
    GRIDBAR();
    if (bx == 0) { const unsigned long long t0 = __builtin_amdgcn_s_memrealtime(); while (__builtin_amdgcn_s_memrealtime() - t0 < sp_acc) __builtin_amdgcn_s_sleep(8); }
#endif
#if PROBE_BAR
    xcd_barrier(bar);
    if (bx == 0 && tid == 0) { unsigned long long tot = 0;
        for (int k = 0; k < 7; ++k) { const unsigned a = __hip_atomic_load(ctl + 8192 + (PROBE_BAR == 1 ? 0 : 1024) + 64 * k, __ATOMIC_RELAXED, __HIP_MEMORY_SCOPE_AGENT); tot += (PROBE_BAR == 1) ? (0x7fffffffu - a) : a; }
        const unsigned long long t0 = __builtin_amdgcn_s_memrealtime(); while (__builtin_amdgcn_s_memrealtime() - t0 < 8ull * tot) __builtin_amdgcn_s_sleep(8); }
#endif
}

extern "C" void kernel_launch(void* const* d_in, const int* in_sizes, int n_in, void* d_out, int out_size, void* d_ws, size_t ws_size, hipStream_t stream) {
    static int grid = 0;
    if (grid == 0) {
        if (n_in != 23 || in_sizes[0] != M * DM || out_size != M * DM || ws_size < WS_END) { fprintf(stderr, "kernel_launch: unexpected shapes (n_in %d, in0 %d, out %d, ws %zu)\n", n_in, n_in > 0 ? in_sizes[0] : -1, out_size, ws_size); grid = -1; return; }
        int dev = 0, cus = 0, per_cu = 0;
        if (hipGetDevice(&dev) != hipSuccess || hipDeviceGetAttribute(&cus, hipDeviceAttributeMultiprocessorCount, dev) != hipSuccess) { grid = -1; return; }
        if (hipFuncSetAttribute((const void*)fwd_kernel, hipFuncAttributeMaxDynamicSharedMemorySize, LDS_BYTES) != hipSuccess) { fprintf(stderr, "kernel_launch: hipFuncSetAttribute failed\n"); grid = -1; return; }
        if (hipOccupancyMaxActiveBlocksPerMultiprocessor(&per_cu, (const void*)fwd_kernel, NWAVES * 64, LDS_BYTES) != hipSuccess || per_cu < 1) { fprintf(stderr, "kernel_launch: occupancy query reports %d blocks per CU\n", per_cu); }
        (void)hipGetLastError();
        grid = cus;
    }
    if (grid < 0) return;
    if (hipMemsetAsync((char*)d_ws + WS_CTL, 0, CTL_ZERO_BYTES, stream) != hipSuccess) { fprintf(stderr, "kernel_launch: memset failed\n"); return; }
    Args a{};
    for (int i = 0; i < 23; ++i) a.p.in[i] = (const float*)d_in[i];
    a.p.out = (float*)d_out; a.p.ws = (unsigned char*)d_ws;
    void* kargs[] = {&a};
    hipError_t e = hipLaunchCooperativeKernel((const void*)fwd_kernel, dim3(grid), dim3(NWAVES * 64), kargs, LDS_BYTES, stream);
    if (e != hipSuccess) fprintf(stderr, "kernel_launch: cooperative launch failed: %s (grid %d)\n", hipGetErrorString(e), grid);
}
```
